# Optimizing an MI355X kernel written in HIP

```python
import math
import jax
import jax.numpy as jnp
from jax import lax
import numpy as np

D_MODEL = 2048
BATCH = 4
SEQ = 2048
DEPTH = 2

MEM_LEN = 256
MIX_W = D_MODEL
LRU_W = MIX_W // 4
LRU_BLOCKS = 4
LRU_CONV = 4
LRU_C = 8.0
ML_W = 3 * MIX_W // 8
ML_HEADS = 4
ML_DH = ML_W // ML_HEADS
ML_QKV_BLOCK = 4
ML_CONV = 4
ML_CHUNK = 128
MO_W = MIX_W - LRU_W - ML_W
MO_HEADS = 6
MO_DH = MO_W // MO_HEADS
MOBA_BLOCK = 256
MOBA_TOPK = 3
MOBA_Q_CHUNK = 16
XA_HEADS = 4
XA_DH = 128
XA_W = XA_HEADS * XA_DH

RMS_EPS = 1e-6
LN_EPS = 1e-5
NEG_INF = -1e30

SPLIT_SIZES = (LRU_W, LRU_W, ML_W, ML_W, ML_W, ML_HEADS, ML_HEADS, MO_W, MO_W, MO_W, MO_W)
IN_COLS = sum(SPLIT_SIZES)
SPLIT_POINTS = tuple(int(v) for v in np.cumsum(SPLIT_SIZES)[:-1])

kernel_name = "hybrid_lru_mlstm_moba_block"


def rms_norm(x, g):
    x32 = x.astype(jnp.float32)
    y = x32 * lax.rsqrt(jnp.mean(x32 * x32, axis=-1, keepdims=True) + RMS_EPS)
    return (y * g.astype(jnp.float32)).astype(x.dtype)


def causal_conv(x, w, b):
    K = w.shape[0]
    T = x.shape[1]
    xp = jnp.pad(x, ((0, 0), (K - 1, 0), (0, 0)))
    return sum(xp[:, j:j + T] * w[j] for j in range(K)) + b


def block_diag(x, w):
    G, bi, bo = w.shape
    xs = x.reshape(x.shape[:-1] + (G, bi))
    return jnp.einsum('...gi,gio->...go', xs, w).reshape(x.shape[:-1] + (G * bo,))


def alibi_slopes(n):
    def pow2(m):
        start = 2.0 ** (-8.0 / m)
        return [start ** (i + 1) for i in range(m)]
    if math.log2(n).is_integer():
        s = pow2(n)
    else:
        c = 2 ** int(math.floor(math.log2(n)))
        s = pow2(c) + pow2(2 * c)[0::2][:n - c]
    return jnp.array(s, dtype=jnp.float32)


def rg_lru_branch(xb, zb, conv_w, conv_b, wa, ba, wx, bx, lam):
    xc = causal_conv(xb, conv_w, conv_b).astype(jnp.float32)
    r = jax.nn.sigmoid(block_diag(xc, wa) + ba)
    i = jax.nn.sigmoid(block_diag(xc, wx) + bx)
    log_a = -LRU_C * r * jax.nn.softplus(-lam.astype(jnp.float32))
    a = jnp.exp(log_a)
    u = jnp.sqrt(-jnp.expm1(2.0 * log_a)) * (i * xc)

    def combine(left, right):
        a1, b1 = left
        a2, b2 = right
        return a1 * a2, a2 * b1 + b2

    _, h = lax.associative_scan(combine, (a, u), axis=1)
    return (h * jax.nn.silu(zb.astype(jnp.float32))).astype(xb.dtype)


def mlstm_chunkwise(q, k, v, ig, lf):
    B, H, T, dh = q.shape
    L = ML_CHUNK
    nc = T // L
    q, k, v = (t.reshape(B, H, nc, L, dh) for t in (q, k, v))
    ig = ig.reshape(B, H, nc, L)
    lf = lf.reshape(B, H, nc, L)
    b = jnp.cumsum(lf, axis=-1)
    g = b[..., -1]
    a = g[..., None] - b + ig
    m_loc = jnp.max(a, axis=-1)
    w = jnp.exp(a - m_loc[..., None])
    c_loc = jnp.einsum('bhcl,bhcld,bhcle->bhcde', w, k, v)
    n_loc = jnp.einsum('bhcl,bhcld->bhcd', w, k)

    def step(carry, inp):
        c_st, n_st, m_st = carry
        c_l, n_l, m_l, g_c = inp
        m_new = jnp.maximum(g_c + m_st, m_l)
        s_old = jnp.exp(g_c + m_st - m_new)
        s_new = jnp.exp(m_l - m_new)
        c_new = s_old[..., None, None] * c_st + s_new[..., None, None] * c_l
        n_new = s_old[..., None] * n_st + s_new[..., None] * n_l
        return (c_new, n_new, m_new), (c_st, n_st, m_st)

    init = (jnp.zeros((B, H, dh, dh), jnp.float32), jnp.zeros((B, H, dh), jnp.float32),
            jnp.zeros((B, H), jnp.float32))
    xs = tuple(jnp.moveaxis(t, 2, 0) for t in (c_loc, n_loc, m_loc, g))
    _, (c_prev, n_prev, m_prev) = lax.scan(step, init, xs)
    c_prev = jnp.moveaxis(c_prev, 0, 2)
    n_prev = jnp.moveaxis(n_prev, 0, 2)
    m_prev = jnp.moveaxis(m_prev, 0, 2)
    causal = jnp.tril(jnp.ones((L, L), dtype=bool))
    d = jnp.where(causal, b[..., :, None] - b[..., None, :] + ig[..., None, :], -jnp.inf)
    inter = b + m_prev[..., None]
    m = jnp.maximum(inter, jnp.max(d, axis=-1))
    s = jnp.einsum('bhcjd,bhcsd->bhcjs', q, k) * jnp.exp(d - m[..., None])
    s_int = jnp.exp(inter - m)
    num = (jnp.einsum('bhcjs,bhcsd->bhcjd', s, v)
           + s_int[..., None] * jnp.einsum('bhcjd,bhcde->bhcje', q, c_prev))
    den = jnp.sum(s, axis=-1) + s_int * jnp.einsum('bhcjd,bhcd->bhcj', q, n_prev)
    h = num / jnp.maximum(jnp.abs(den), jnp.exp(-m))[..., None]
    return h.reshape(B, H, T, dh)


def mlstm_branch(u, o, z, ig_pre, fg_pre, conv_w, conv_b, wq, wk, wv, bi, bf, norm_g):
    B, T, _ = u.shape
    uc = jax.nn.silu(causal_conv(u, conv_w, conv_b))
    q = block_diag(uc, wq)
    k = block_diag(uc, wk) * (ML_DH ** -0.5)
    v = block_diag(u, wv)

    def heads(t):
        return t.astype(jnp.float32).reshape(B, T, ML_HEADS, ML_DH).transpose(0, 2, 1, 3)

    ig = (ig_pre.astype(jnp.float32) + bi).transpose(0, 2, 1)
    lf = jax.nn.log_sigmoid(fg_pre.astype(jnp.float32) + bf).transpose(0, 2, 1)
    h = mlstm_chunkwise(heads(q), heads(k), heads(v), ig, lf).transpose(0, 2, 1, 3)
    h = jax.nn.sigmoid(o.astype(jnp.float32)).reshape(B, T, ML_HEADS, ML_DH) * h
    mu = jnp.mean(h, axis=-1, keepdims=True)
    var = jnp.mean(jnp.square(h - mu), axis=-1, keepdims=True)
    hn = (h - mu) * lax.rsqrt(var + LN_EPS) * norm_g.astype(jnp.float32).reshape(ML_HEADS, ML_DH)
    return (hn.reshape(B, T, ML_W) * jax.nn.silu(z.astype(jnp.float32))).astype(u.dtype)


def moba_attention(q, k, v):
    B, H, T, dh = q.shape
    nb = -(-T // MOBA_BLOCK)
    tp = nb * MOBA_BLOCK
    pad = ((0, 0), (0, 0), (0, tp - T), (0, 0))
    q, k, v = (jnp.pad(t, pad) for t in (q, k, v))
    kb = k.reshape(B, H, nb, MOBA_BLOCK, dh)
    vb = v.reshape(B, H, nb, MOBA_BLOCK, dh)
    kmean = jnp.mean(kb.astype(jnp.float32), axis=3)
    n_sel = min(MOBA_TOPK, nb - 1)
    slopes = alibi_slopes(H)
    scale = dh ** -0.5
    nq = tp // MOBA_Q_CHUNK
    qc = jnp.moveaxis(q.reshape(B, H, nq, MOBA_Q_CHUNK, dh), 2, 0)
    bidx = jnp.arange(B)[:, None, None, None]
    hidx = jnp.arange(H)[None, :, None, None]
    s_local = jnp.arange(MOBA_BLOCK)

    def one_chunk(args):
        qch, ci = args
        qch = qch.astype(jnp.float32)
        t = ci * MOBA_Q_CHUNK + jnp.arange(MOBA_Q_CHUNK)
        bq = (ci * MOBA_Q_CHUNK) // MOBA_BLOCK
        k_own = lax.dynamic_index_in_dim(kb, bq, axis=2, keepdims=False).astype(jnp.float32)
        v_own = lax.dynamic_index_in_dim(vb, bq, axis=2, keepdims=False).astype(jnp.float32)
        dist_own = (t[:, None] - (bq * MOBA_BLOCK + s_local)[None, :]).astype(jnp.float32)
        l_own = jnp.einsum('bhqd,bhsd->bhqs', qch, k_own) * scale - slopes[:, None, None] * dist_own
        l_own = jnp.where(dist_own >= 0, l_own, NEG_INF)
        if n_sel == 0:
            p_own = jax.nn.softmax(l_own, axis=-1)
            return jnp.einsum('bhqs,bhsd->bhqd', p_own, v_own)
        gate = jnp.einsum('bhqd,bhnd->bhqn', qch, kmean)
        gate = jnp.where(jnp.arange(nb) < bq, gate, -jnp.inf)
        _, idx = lax.top_k(gate, n_sel)
        k_sel = kb[bidx, hidx, idx].astype(jnp.float32)
        v_sel = vb[bidx, hidx, idx].astype(jnp.float32)
        dist_sel = (t[:, None, None] - (idx[..., None] * MOBA_BLOCK + s_local)).astype(jnp.float32)
        l_sel = (jnp.einsum('bhqd,bhqnsd->bhqns', qch, k_sel) * scale
                 - slopes[:, None, None, None] * dist_sel)
        l_sel = jnp.where((jnp.arange(n_sel) < bq)[:, None], l_sel, NEG_INF)
        n_past = n_sel * MOBA_BLOCK
        logits = jnp.concatenate(
            [l_sel.reshape(B, H, MOBA_Q_CHUNK, n_past), l_own], axis=-1)
        p = jax.nn.softmax(logits, axis=-1)
        p_sel = p[..., :n_past].reshape(B, H, MOBA_Q_CHUNK, n_sel, MOBA_BLOCK)
        p_own = p[..., n_past:]
        return (jnp.einsum('bhqns,bhqnsd->bhqd', p_sel, v_sel)
                + jnp.einsum('bhqs,bhsd->bhqd', p_own, v_own))

    out = lax.map(one_chunk, (qc, jnp.arange(nq)))
    out = jnp.moveaxis(out, 0, 2).reshape(B, H, tp, dh)
    return out[:, :, :T]


def moba_branch(qb, kb, vb, zb):
    B, T, _ = qb.shape

    def heads(t):
        return t.reshape(B, T, MO_HEADS, MO_DH).transpose(0, 2, 1, 3)

    o = moba_attention(heads(qb), heads(kb), heads(vb)).transpose(0, 2, 1, 3).reshape(B, T, MO_W)
    return (o * jax.nn.silu(zb.astype(jnp.float32))).astype(qb.dtype)


def memory_cross_attention(h, mem_n, wq, wkv, wo):
    B, T, _ = h.shape
    M = mem_n.shape[1]
    q = (h @ wq).reshape(B, T, XA_HEADS, XA_DH)
    k, v = jnp.split(mem_n @ wkv, 2, axis=-1)
    k = k.reshape(B, M, XA_HEADS, XA_DH)
    v = v.reshape(B, M, XA_HEADS, XA_DH)
    s = jnp.einsum('bthd,bmhd->bhtm', q, k).astype(jnp.float32) * (XA_DH ** -0.5)
    p = jax.nn.softmax(s, axis=-1).astype(v.dtype)
    o = jnp.einsum('bhtm,bmhd->bthd', p, v).reshape(B, T, XA_W)
    return o @ wo


def setup_inputs(seed: int = 0) -> dict:
    key = jax.random.key(seed)
    ks = jax.random.split(key, 26)

    def nrm(k, shape, scale):
        return scale * jax.random.normal(k, shape, jnp.float32)

    def gain(k, shape):
        return 1.0 + 0.02 * jax.random.normal(k, shape, jnp.float32)

    u = jax.random.uniform(ks[10], (DEPTH, LRU_W), jnp.float32, 0.9, 0.999)
    a = u ** (1.0 / LRU_C)
    lam = jnp.log(a) - jnp.log1p(-a)
    bl = LRU_W // LRU_BLOCKS
    nqkv = ML_W // ML_QKV_BLOCK
    return {
        "x": nrm(ks[0], (BATCH, SEQ, D_MODEL), 1.0),
        "mem": nrm(ks[1], (BATCH, MEM_LEN, D_MODEL), 1.0),
        "mix_norm_g": gain(ks[2], (DEPTH, D_MODEL)),
        "w_in": nrm(ks[3], (DEPTH, D_MODEL, IN_COLS), D_MODEL ** -0.5),
        "lru_conv_w": nrm(ks[4], (DEPTH, LRU_CONV, LRU_W), LRU_CONV ** -0.5),
        "lru_conv_b": nrm(ks[5], (DEPTH, LRU_W), 0.02),
        "lru_wa": nrm(ks[6], (DEPTH, LRU_BLOCKS, bl, bl), bl ** -0.5),
        "lru_ba": nrm(ks[7], (DEPTH, LRU_W), 0.02),
        "lru_wx": nrm(ks[8], (DEPTH, LRU_BLOCKS, bl, bl), bl ** -0.5),
        "lru_bx": nrm(ks[9], (DEPTH, LRU_W), 0.02),
        "lru_lambda": lam,
        "ml_conv_w": nrm(ks[11], (DEPTH, ML_CONV, ML_W), ML_CONV ** -0.5),
        "ml_conv_b": nrm(ks[12], (DEPTH, ML_W), 0.02),
        "ml_wq": nrm(ks[13], (DEPTH, nqkv, ML_QKV_BLOCK, ML_QKV_BLOCK), ML_QKV_BLOCK ** -0.5),
        "ml_wk": nrm(ks[14], (DEPTH, nqkv, ML_QKV_BLOCK, ML_QKV_BLOCK), ML_QKV_BLOCK ** -0.5),
        "ml_wv": nrm(ks[15], (DEPTH, nqkv, ML_QKV_BLOCK, ML_QKV_BLOCK), ML_QKV_BLOCK ** -0.5),
        "ml_bi": nrm(ks[16], (DEPTH, ML_HEADS), 0.1),
        "ml_bf": jnp.linspace(3.0, 6.0, ML_HEADS, dtype=jnp.float32)[None, :] + nrm(ks[17], (DEPTH, ML_HEADS), 0.02),
        "ml_norm_g": gain(ks[18], (DEPTH, ML_W)),
        "w_out": nrm(ks[19], (DEPTH, MIX_W, D_MODEL), MIX_W ** -0.5),
        "xa_norm_g": gain(ks[20], (DEPTH, D_MODEL)),
        "mem_norm_g": gain(ks[21], (DEPTH, D_MODEL)),
        "xa_wq": nrm(ks[22], (DEPTH, D_MODEL, XA_W), D_MODEL ** -0.5),
        "xa_wkv": nrm(ks[23], (DEPTH, D_MODEL, 2 * XA_W), D_MODEL ** -0.5),
        "xa_wo": nrm(ks[24], (DEPTH, XA_W, D_MODEL), XA_W ** -0.5),
        "final_norm_g": gain(ks[25], (D_MODEL,)),
    }


def reference(x, mem, mix_norm_g, w_in, lru_conv_w, lru_conv_b, lru_wa, lru_ba, lru_wx, lru_bx,
              lru_lambda, ml_conv_w, ml_conv_b, ml_wq, ml_wk, ml_wv, ml_bi, ml_bf, ml_norm_g,
              w_out, xa_norm_g, mem_norm_g, xa_wq, xa_wkv, xa_wo, final_norm_g):
    for l in range(DEPTH):
        h = rms_norm(x, mix_norm_g[l])
        p = h @ w_in[l]
        (lru_x, lru_z, ml_u, ml_o, ml_z, ml_i, ml_f,
         mo_q, mo_k, mo_v, mo_z) = jnp.split(p, SPLIT_POINTS, axis=-1)
        y_lru = rg_lru_branch(lru_x, lru_z, lru_conv_w[l], lru_conv_b[l], lru_wa[l], lru_ba[l],
                              lru_wx[l], lru_bx[l], lru_lambda[l])
        y_ml = mlstm_branch(ml_u, ml_o, ml_z, ml_i, ml_f, ml_conv_w[l], ml_conv_b[l], ml_wq[l],
                            ml_wk[l], ml_wv[l], ml_bi[l], ml_bf[l], ml_norm_g[l])
        y_mo = moba_branch(mo_q, mo_k, mo_v, mo_z)
        y = jnp.concatenate([y_lru, y_ml, y_mo], axis=-1)
        x = x + y @ w_out[l]
        hx = rms_norm(x, xa_norm_g[l])
        hm = rms_norm(mem, mem_norm_g[l])
        x = x + memory_cross_attention(hx, hm, xa_wq[l], xa_wkv[l], xa_wo[l])
    return rms_norm(x, final_norm_g)
```

```cpp
#include <hip/hip_runtime.h>
#include <cstdio>
#include <cstdint>
namespace pg8 {
#define PG8_LAS __attribute__((address_space(3)))
typedef unsigned short bf16_t;
typedef short bf16x8 __attribute__((ext_vector_type(8)));
typedef float f32x4 __attribute__((ext_vector_type(4)));
typedef unsigned u32x4 __attribute__((ext_vector_type(4)));
constexpr int BM = 256, BK = 64, HALF = 128, HTB = HALF * BK * 2  , STAGE_BYTES = 8 * HTB, NXCD = 8, WGM = 8;

__host__ __device__ __forceinline__ int lds_byte(int r, int c) { const int st = (r >> 4) * 2 + (c >> 5), rr = r & 15, cc = c & 31, ob = rr * 64 + cc * 2; return st * 1024 + (ob ^ (((ob >> 9) & 1) << 5)); }
__host__ __device__ __forceinline__ void stage_rc(int b, int& R, int& C) { const int st = b / 1024, sb = b % 1024, swz = sb ^ (((sb >> 9) & 1) << 5); R = (st >> 1) * 16 + swz / 64; C = (st & 1) * 32 + (swz % 64) / 2; }
__host__ __device__ __forceinline__ int perm32(int rho) { const int n = rho >> 4, i = rho & 15; return 8 * (i >> 2) + 4 * n + (i & 3); }

struct Unit { int pm, pn; };
struct Gemm { const bf16_t* A; const bf16_t* Bt; int M, N, K, pad; };

struct StaticOrder {
    int nM, nN, nwg, G, c;
    __host__ __device__ void init(int M, int N, int G_, int c_) { nM = M / BM; nN = N / BM; nwg = nM * nN; G = G_; c = c_; }
    __host__ __device__ bool next(int i, Unit& u) const {
        const long L = (long)i * G + c; if (L >= nwg) return false;
        int wgid = (int)L; { const int q = nwg / NXCD, r = nwg % NXCD, xcd = wgid % NXCD, off = wgid / NXCD; wgid = (xcd < r ? xcd * (q + 1) : r * (q + 1) + (xcd - r) * q) + off; }
        const int nig = WGM * nN, gid = wgid / nig, fm = gid * WGM, gsz = (nM - fm) < WGM ? (nM - fm) : WGM;
        u.pm = fm + ((wgid % nig) % gsz); u.pn = (wgid % nig) / gsz; return true;
    }
    __device__ __forceinline__ void a_ready(const Unit&) const {}
    __device__ __forceinline__ void done(const Unit&) const {}
};

__device__ __forceinline__ unsigned cvt_pk_bf16(float lo, float hi) { unsigned r; asm volatile("v_cvt_pk_bf16_f32 %0, %1, %2" : "=v"(r) : "v"(lo), "v"(hi)); return r; }
template <class Epi, class Sched, bool ALIGN_EPI = false, bool SP2 = false>
__device__ __forceinline__ void gemm_phase(PG8_LAS unsigned char* lds, const Gemm g, const Sched& S, const Epi& E) {
    const int tid = threadIdx.x, wid = __builtin_amdgcn_readfirstlane(tid >> 6), lane = tid & 63, wr = wid >> 2, wc = wid & 3, fr = lane & 15, fq = lane >> 4;
    const int K = g.K, nt = K / BK;
    unsigned voffA[2], voffB[2];
#pragma unroll
    for (int i = 0; i < 2; ++i) { int R, C; stage_rc(tid * 16 + i * 8192, R, C); const int Rb = Epi::PERM ? ((R & ~31) + perm32(R & 31)) : R;
        voffA[i] = (unsigned)(R * K + C) * 2u; voffB[i] = (unsigned)(Rb * K + C) * 2u; }
    const size_t kstep = (size_t)(BK * 2);
    const size_t hstep = (size_t)HALF * K * 2;
    const size_t tstep = 2 * hstep;
    const unsigned ldsw = (unsigned)wid * 1024u;
    const int aoff = lds_byte(wr * 64 + fr, fq * 8), boff = lds_byte(wc * 32 + fr, fq * 8);
#define PG8_SA(b, h) (((b) * 2 + (h)) * HTB)
#define PG8_SB(b, h) ((4 + (b) * 2 + (h)) * HTB)
#define PG8_STAGE(bufoff, gbase, voff) do { _Pragma("unroll") for (int _i = 0; _i < 2; ++_i) \
        __builtin_amdgcn_global_load_lds((const unsigned*)((const char*)(gbase) + (voff)[_i]), (PG8_LAS unsigned*)(lds + (bufoff) + ldsw + _i * 8192), 16, 0, 0); } while (0)
#define PG8_LDA(dst, b, h) do { _Pragma("unroll") for (int m = 0; m < 4; ++m) _Pragma("unroll") for (int k = 0; k < 2; ++k) dst[m][k] = *(const PG8_LAS bf16x8*)(lds + PG8_SA(b, h) + aoff + m * 2048 + k * 1024); } while (0)
#define PG8_LDB(dst, b, h) do { _Pragma("unroll") for (int n = 0; n < 2; ++n) _Pragma("unroll") for (int k = 0; k < 2; ++k) dst[n][k] = *(const PG8_LAS bf16x8*)(lds + PG8_SB(b, h) + boff + n * 2048 + k * 1024); } while (0)
#define PG8_MMA(ai, bj, At, Bt) do { __builtin_amdgcn_s_setprio(1); _Pragma("unroll") for (int m = 0; m < 4; ++m) _Pragma("unroll") for (int n = 0; n < 2; ++n) _Pragma("unroll") for (int k = 0; k < 2; ++k) \
        acc[ai][bj][m][n] = __builtin_amdgcn_mfma_f32_16x16x32_bf16(Bt[n][k], At[m][k], acc[ai][bj][m][n], 0, 0, 0); __builtin_amdgcn_s_setprio(0); } while (0)
#define PG8_WAIT_V(n) asm volatile("s_waitcnt vmcnt(" #n ")" ::: "memory")
#define PG8_WAIT_L(n) asm volatile("s_waitcnt lgkmcnt(" #n ")" ::: "memory")
#define PG8_BAR __builtin_amdgcn_s_barrier()
#define PG8_SCHED __builtin_amdgcn_sched_barrier(0)
    Unit cur, nxt; int ui = 0;
    if (!S.next(0, cur)) return;
    f32x4 acc[2][2][4][2];
#pragma unroll
    for (int a = 0; a < 2; ++a)
#pragma unroll
        for (int b = 0; b < 2; ++b)
#pragma unroll
            for (int m = 0; m < 4; ++m)
#pragma unroll
                for (int n = 0; n < 2; ++n) acc[a][b][m][n] = (f32x4){0.f, 0.f, 0.f, 0.f};
    bf16x8 At[4][2], B0[2][2], B1[2][2];
    const char* cA = (const char*)g.A + (size_t)cur.pm * tstep; const char* cB = (const char*)g.Bt + (size_t)cur.pn * tstep;
    S.a_ready(cur);
    if constexpr (SP2) {
        PG8_STAGE(PG8_SB(0, 0), cB, voffB); PG8_STAGE(PG8_SB(0, 1), cB + hstep, voffB); PG8_STAGE(PG8_SA(0, 0), cA, voffA); PG8_STAGE(PG8_SA(0, 1), cA + hstep, voffA);
        if (wr == 1) PG8_BAR;
        PG8_WAIT_V(2); PG8_BAR;
        PG8_STAGE(PG8_SB(1, 0), cB + kstep, voffB); PG8_STAGE(PG8_SA(1, 0), cA + kstep, voffA); PG8_STAGE(PG8_SB(1, 1), cB + hstep + kstep, voffB);
        PG8_WAIT_V(6); PG8_BAR;
    } else {
        PG8_STAGE(PG8_SB(0, 0), cB, voffB); PG8_STAGE(PG8_SA(0, 0), cA, voffA); PG8_STAGE(PG8_SB(0, 1), cB + hstep, voffB); PG8_STAGE(PG8_SA(0, 1), cA + hstep, voffA);
        if (wr == 1) PG8_BAR;
        PG8_WAIT_V(4); PG8_BAR;
        PG8_STAGE(PG8_SB(1, 0), cB + kstep, voffB); PG8_STAGE(PG8_SA(1, 0), cA + kstep, voffA); PG8_STAGE(PG8_SB(1, 1), cB + hstep + kstep, voffB);
        PG8_WAIT_V(6); PG8_BAR;
    }
    for (;;) {
        const bool has_next = S.next(ui + 1, nxt);
        const char* nA = has_next ? (const char*)g.A + (size_t)nxt.pm * tstep : cA; const char* nB = has_next ? (const char*)g.Bt + (size_t)nxt.pn * tstep : cB;
        for (int t = 0; t < nt; t += 2) {
            const bool last = (t == nt - 2);
            const char* a1 = cA + (size_t)(t + 1) * kstep;
            const char* a2 = last ? nA : cA + (size_t)(t + 2) * kstep; const char* b2 = last ? nB : cB + (size_t)(t + 2) * kstep;
            const char* a3 = a2 + kstep; const char* b3 = b2 + kstep;
            if (last && has_next) S.a_ready(nxt);
            if constexpr (SP2) {
            PG8_LDB(B0, 0, 0); PG8_LDB(B1, 0, 1); PG8_SCHED; PG8_LDA(At, 0, 0); PG8_STAGE(PG8_SA(1, 1), a1 + hstep, voffA);
            PG8_WAIT_V(8); PG8_WAIT_L(0); PG8_BAR; PG8_MMA(0, 0, At, B0); PG8_MMA(0, 1, At, B1); PG8_BAR; PG8_SCHED;
            PG8_LDA(At, 0, 1); PG8_STAGE(PG8_SB(0, 0), b2, voffB); PG8_STAGE(PG8_SB(0, 1), b2 + hstep, voffB); PG8_STAGE(PG8_SA(0, 0), a2, voffA);
            PG8_WAIT_V(8); PG8_WAIT_L(0); PG8_BAR; PG8_MMA(1, 0, At, B0); PG8_MMA(1, 1, At, B1); PG8_BAR; PG8_SCHED;
            PG8_LDB(B0, 1, 0); PG8_LDB(B1, 1, 1); PG8_SCHED; PG8_LDA(At, 1, 0); PG8_STAGE(PG8_SA(0, 1), a2 + hstep, voffA);
            PG8_WAIT_V(8); PG8_WAIT_L(0); PG8_BAR; PG8_MMA(0, 0, At, B0); PG8_MMA(0, 1, At, B1); PG8_BAR; PG8_SCHED;
            PG8_LDA(At, 1, 1); PG8_STAGE(PG8_SB(1, 0), b3, voffB); PG8_STAGE(PG8_SB(1, 1), b3 + hstep, voffB); PG8_STAGE(PG8_SA(1, 0), a3, voffA);
            PG8_WAIT_V(8); PG8_WAIT_L(0); PG8_BAR; PG8_MMA(1, 0, At, B0); PG8_MMA(1, 1, At, B1); PG8_BAR; PG8_SCHED;
            } else {
            PG8_LDB(B0, 0, 0); PG8_SCHED; PG8_LDA(At, 0, 0); PG8_STAGE(PG8_SA(1, 1), a1 + hstep, voffA);
            PG8_WAIT_L(8); PG8_BAR; PG8_WAIT_L(0); PG8_MMA(0, 0, At, B0); PG8_BAR; PG8_SCHED;
            PG8_LDB(B1, 0, 1); PG8_STAGE(PG8_SB(0, 0), b2, voffB);
            PG8_BAR; PG8_WAIT_L(0); PG8_MMA(0, 1, At, B1); PG8_BAR;
            PG8_LDA(At, 0, 1); PG8_STAGE(PG8_SA(0, 0), a2, voffA);
            PG8_BAR; PG8_WAIT_L(0); PG8_MMA(1, 0, At, B0); PG8_BAR; PG8_SCHED;
            PG8_STAGE(PG8_SB(0, 1), b2 + hstep, voffB);
            PG8_WAIT_V(6); PG8_BAR; PG8_MMA(1, 1, At, B1); PG8_BAR;
            PG8_LDB(B0, 1, 0); PG8_SCHED; PG8_LDA(At, 1, 0); PG8_STAGE(PG8_SA(0, 1), a2 + hstep, voffA);
            PG8_WAIT_L(8); PG8_BAR; PG8_WAIT_L(0); PG8_MMA(0, 0, At, B0); PG8_BAR; PG8_SCHED;
            PG8_LDB(B1, 1, 1); PG8_STAGE(PG8_SB(1, 0), b3, voffB);
            PG8_BAR; PG8_WAIT_L(0); PG8_MMA(0, 1, At, B1); PG8_BAR;
            PG8_LDA(At, 1, 1); PG8_STAGE(PG8_SA(1, 0), a3, voffA);
            PG8_BAR; PG8_WAIT_L(0); PG8_MMA(1, 0, At, B0); PG8_BAR; PG8_SCHED;
            PG8_STAGE(PG8_SB(1, 1), b3 + hstep, voffB);
            PG8_WAIT_V(6); PG8_BAR; PG8_MMA(1, 1, At, B1); PG8_BAR;
            }
        }
        if constexpr (ALIGN_EPI) { if (wr == 0) PG8_BAR; }
        if constexpr (!Epi::AFTER_DRAIN) { E(acc, cur, wr, wc, fr, fq); S.done(cur); }
        if (!has_next) break;
#pragma unroll
        for (int a = 0; a < 2; ++a)
#pragma unroll
            for (int b = 0; b < 2; ++b)
#pragma unroll
                for (int m = 0; m < 4; ++m)
#pragma unroll
                    for (int n = 0; n < 2; ++n) acc[a][b][m][n] = (f32x4){0.f, 0.f, 0.f, 0.f};
        cur = nxt; cA = nA; cB = nB; ++ui;
        if constexpr (ALIGN_EPI) { if (wr == 1) PG8_BAR; }
    }
    PG8_WAIT_V(0);
    if constexpr (!ALIGN_EPI) { if (wr == 0) PG8_BAR; }
    PG8_BAR;
    if constexpr (Epi::AFTER_DRAIN) { E.fused(acc, cur, wr, wc, fr, fq, lds, wid, lane); S.done(cur); }
#undef PG8_SA
#undef PG8_SB
#undef PG8_STAGE
#undef PG8_LDA
#undef PG8_LDB
#undef PG8_MMA
#undef PG8_WAIT_V
#undef PG8_WAIT_L
#undef PG8_BAR
#undef PG8_SCHED
}
}

constexpr int NB = 4, T = 2048, D = 2048, M = NB * T, DEPTH = 2, MEM = 256, MM = NB * MEM;
constexpr int INC = 6408, NP = 6400;
constexpr int ML_DH = 192, MO_DH = 128;
constexpr int C_LX = 0, C_LZ = 512, C_MU = 1024, C_MO = 1792, C_MZ = 2560, C_Q = 3328, C_K = 4096, C_V = 4864, C_Z = 5632;
constexpr int SRC_GATE = 3328;
constexpr float RMS_EPS = 1e-6f, LN_EPS = 1e-5f;

typedef unsigned short bf16;
#define LAS __attribute__((address_space(3)))
__device__ __forceinline__ float bf2f(bf16 v) { return __uint_as_float(((unsigned)v) << 16); }
__device__ __forceinline__ bf16 f2bf(float f) { unsigned u = __float_as_uint(f); return (bf16)((u + 0x7fffu + ((u >> 16) & 1u)) >> 16); }
__device__ __forceinline__ unsigned pk2(float lo, float hi) { return (unsigned)f2bf(lo) | ((unsigned)f2bf(hi) << 16); }
__device__ __forceinline__ float sigm(float x) { return 1.f / (1.f + expf(-x)); }
__device__ __forceinline__ float silu(float x) { return x / (1.f + expf(-x)); }
__device__ __forceinline__ float logsig(float x) { return fminf(x, 0.f) - log1pf(expf(-fabsf(x))); }
__device__ __forceinline__ float wave_sum(float v) {
#pragma unroll
    for (int o = 1; o < 64; o <<= 1) v += __shfl_xor(v, o);
    return v;
}

constexpr size_t al256(size_t x) { return (x + 255) & ~(size_t)255; }
constexpr size_t WS_CTL = 0;
constexpr size_t WS_WIN = 1u << 20;
constexpr size_t WS_WOUT = WS_WIN + (size_t)DEPTH * NP * D * 2;
constexpr size_t WS_WQ = WS_WOUT + (size_t)DEPTH * D * D * 2;
constexpr size_t WS_WKV = WS_WQ + (size_t)DEPTH * 512 * D * 2;
constexpr size_t WS_WO = WS_WKV + (size_t)DEPTH * 1024 * D * 2;
constexpr size_t WS_WG = WS_WO + (size_t)DEPTH * D * 512 * 2;
constexpr size_t WS_MEMB = WS_WG + (size_t)DEPTH * D * 8 * 4;
constexpr size_t WS_RINVM = WS_MEMB + (size_t)MM * D * 2;
constexpr size_t WS_KV = WS_RINVM + (size_t)MM * 4;
constexpr size_t WS_XB = WS_KV + (size_t)DEPTH * MM * 1024 * 2;
constexpr size_t WS_RINV = WS_XB + (size_t)M * D * 2;
constexpr size_t WS_GATES = WS_RINV + (size_t)M * 4;
constexpr size_t WS_XRES = WS_GATES + (size_t)M * 8 * 4;
constexpr size_t WS_Y = WS_XRES + (size_t)M * D * 4;
constexpr size_t WS_P = WS_Y + (size_t)M * D * 2;
constexpr size_t WS_A = WS_P + (size_t)M * NP * 2;
constexpr size_t WS_U = WS_A + (size_t)M * 512 * 4;
constexpr size_t WS_MQ = WS_U + (size_t)M * 512 * 4;
constexpr size_t WS_MK = WS_MQ + (size_t)M * 768 * 2;
constexpr size_t WS_MV = WS_MK + (size_t)M * 768 * 2;
constexpr size_t WS_F = WS_MV + (size_t)M * 768 * 2;
constexpr size_t WS_I = WS_F + (size_t)16 * T * 4;
constexpr size_t WS_KMEAN = WS_I + (size_t)16 * T * 4;
constexpr size_t WS_SEL = WS_KMEAN + (size_t)NB * 6 * 8 * 128 * 4;
constexpr size_t WS_END = WS_SEL + (size_t)M * 8;
constexpr size_t WS_XQ = WS_P;
constexpr size_t WS_XO = WS_P + (size_t)M * 512 * 2;
static_assert(WS_END <= 419954688ull, "workspace map exceeds the guaranteed ws_size");

__device__ __forceinline__ void wt_item(const float* W, int ldw, int src_col, const float* g, bf16* Wt, int K, int dst_row, float* scr, int k0, int lane) {
#pragma unroll 8
    for (int i = 0; i < 32; ++i) { const int kk = 2 * i + (lane >> 5); float v = W[(size_t)(k0 + kk) * ldw + src_col + (lane & 31)]; if (g) v *= g[k0 + kk]; scr[kk * 33 + (lane & 31)] = v; }
    __builtin_amdgcn_s_waitcnt(0xc07f); asm volatile("" ::: "memory");
    const int c = lane & 7;
#pragma unroll
    for (int j = 0; j < 4; ++j) { const int n = (lane >> 3) + 8 * j; const float* s = scr + (8 * c) * 33 + n;
        uint4 o; o.x = pk2(s[0 * 33], s[1 * 33]); o.y = pk2(s[2 * 33], s[3 * 33]); o.z = pk2(s[4 * 33], s[5 * 33]); o.w = pk2(s[6 * 33], s[7 * 33]);
        *(uint4*)(Wt + (size_t)(dst_row + n) * K + k0 + 8 * c) = o; }
    __builtin_amdgcn_s_waitcnt(0xc07f); asm volatile("" ::: "memory");
}
__global__ void __launch_bounds__(256) k_wt(const float* W, int ldw, int K, int N, const float* g, bf16* Wt, int mode) {
    __shared__ float scr_all[4][64 * 33];
    const int lane = threadIdx.x & 63, wave = threadIdx.x >> 6;
    float* scr = scr_all[wave];
    const int nblk = N / 32, nitems = (K / 64) * nblk;
    for (int it = blockIdx.x * 4 + wave; it < nitems; it += gridDim.x * 4) {
        const int kb = it / nblk, nb = it % nblk, n0 = nb * 32;
        const int src = (mode == 1 && n0 >= SRC_GATE) ? n0 + 8 : n0;
        wt_item(W, ldw, src, g, Wt, K, n0, scr, kb * 64, lane);
    }
}
__global__ void k_gatew(const float* W, const float* g, float* Wg) {
    const int idx = blockIdx.x * 256 + threadIdx.x; if (idx >= D * 8) return;
    const int k = idx >> 3, c = idx & 7; Wg[idx] = g[k] * W[(size_t)k * INC + SRC_GATE + c];
}

__global__ void __launch_bounds__(256) k_prep(const float* x, bf16* xb, float* rinv, const float* Wg, float* gates, int nrows) {
    const int lane = threadIdx.x & 63, wave = threadIdx.x >> 6; const int row = blockIdx.x * 4 + wave; if (row >= nrows) return;
    const float4* xr = (const float4*)(x + (size_t)row * D); float4 v[8]; float ss = 0.f;
#pragma unroll
    for (int j = 0; j < 8; ++j) { v[j] = xr[lane + 64 * j]; ss += v[j].x * v[j].x + v[j].y * v[j].y + v[j].z * v[j].z + v[j].w * v[j].w; }
    ss = wave_sum(ss); const float r = 1.0f / sqrtf(ss * (1.0f / D) + RMS_EPS);
    uint2* ob = (uint2*)(xb + (size_t)row * D);
#pragma unroll
    for (int j = 0; j < 8; ++j) { uint2 o; o.x = pk2(v[j].x, v[j].y); o.y = pk2(v[j].z, v[j].w); ob[lane + 64 * j] = o; }
    if (lane == 0) rinv[row] = r;
    if (Wg) {
        float a0 = 0, a1 = 0, a2 = 0, a3 = 0, a4 = 0, a5 = 0, a6 = 0, a7 = 0;
#pragma unroll
        for (int j = 0; j < 8; ++j) {
            const float xe[4] = {v[j].x, v[j].y, v[j].z, v[j].w};
#pragma unroll
            for (int e = 0; e < 4; ++e) { const int k = 4 * (lane + 64 * j) + e; const float4 w0 = *(const float4*)(Wg + (size_t)k * 8), w1 = *(const float4*)(Wg + (size_t)k * 8 + 4);
                a0 += xe[e] * w0.x; a1 += xe[e] * w0.y; a2 += xe[e] * w0.z; a3 += xe[e] * w0.w; a4 += xe[e] * w1.x; a5 += xe[e] * w1.y; a6 += xe[e] * w1.z; a7 += xe[e] * w1.w; }
        }
        a0 = wave_sum(a0); a1 = wave_sum(a1); a2 = wave_sum(a2); a3 = wave_sum(a3); a4 = wave_sum(a4); a5 = wave_sum(a5); a6 = wave_sum(a6); a7 = wave_sum(a7);
        if (lane == 0) { float4* go = (float4*)(gates + (size_t)row * 8); go[0] = make_float4(a0 * r, a1 * r, a2 * r, a3 * r); go[1] = make_float4(a4 * r, a5 * r, a6 * r, a7 * r); }
    }
}

struct EpiScaleBf16 {
    static constexpr bool PERM = true, AFTER_DRAIN = false;
    bf16* O; const float* rs; int ldc, pad;
    __device__ __forceinline__ void operator()(const pg8::f32x4 (&acc)[2][2][4][2], const pg8::Unit& u, int wr, int wc, int fr, int fq) const {
        const int row0 = u.pm * 256 + wr * 64 + fr, col0 = u.pn * 256 + wc * 32 + 8 * fq;
#pragma unroll
        for (int ai = 0; ai < 2; ++ai)
#pragma unroll
            for (int m = 0; m < 4; ++m) { const int row = row0 + ai * 128 + m * 16; const float s = rs ? rs[row] : 1.f; bf16* rowp = O + (size_t)row * ldc + col0;
#pragma unroll
                for (int bj = 0; bj < 2; ++bj) { const pg8::f32x4 v0 = acc[ai][bj][m][0] * s, v1 = acc[ai][bj][m][1] * s; pg8::u32x4 w;
                    w.x = pg8::cvt_pk_bf16(v0[0], v0[1]); w.y = pg8::cvt_pk_bf16(v0[2], v0[3]); w.z = pg8::cvt_pk_bf16(v1[0], v1[1]); w.w = pg8::cvt_pk_bf16(v1[2], v1[3]);
                    *(pg8::u32x4*)(rowp + bj * 128) = w; } }
    }
};
struct EpiResF32 {
    static constexpr bool PERM = false, AFTER_DRAIN = false;
    const float* base; float* out; int ldc, pad;
    __device__ __forceinline__ void operator()(const pg8::f32x4 (&acc)[2][2][4][2], const pg8::Unit& u, int wr, int wc, int fr, int fq) const {
        const int row0 = u.pm * 256 + wr * 64 + fr, col0 = u.pn * 256 + wc * 32 + 4 * fq;
#pragma unroll
        for (int ai = 0; ai < 2; ++ai)
#pragma unroll
            for (int m = 0; m < 4; ++m) { const size_t off = (size_t)(row0 + ai * 128 + m * 16) * ldc + col0;
#pragma unroll
                for (int bj = 0; bj < 2; ++bj)
#pragma unroll
                    for (int n = 0; n < 2; ++n) { const pg8::f32x4 b = *(const pg8::f32x4*)(base + off + bj * 128 + n * 16); *(pg8::f32x4*)(out + off + bj * 128 + n * 16) = b + acc[ai][bj][m][n]; } }
    }
};
template <class Epi> __global__ void __launch_bounds__(512, 2) k_gemm(pg8::Gemm g, Epi E) {
    extern __shared__ __attribute__((aligned(16))) unsigned char lds[];
    pg8::StaticOrder S; S.init(g.M, g.N, (int)gridDim.x, (int)blockIdx.x);
    pg8::gemm_phase<Epi, pg8::StaticOrder, true, true>((PG8_LAS unsigned char*)lds, g, S, E);
}

__global__ void __launch_bounds__(256) k_lru_gates(const bf16* p, const float* cw, const float* cb, const float* wa, const float* ba, const float* wx, const float* bx, const float* lam, float* A, float* U) {
    __shared__ float xc[512];
    const int m = blockIdx.x, t = m % T, tid = threadIdx.x;
#pragma unroll
    for (int q = 0; q < 2; ++q) { const int c = tid + 256 * q; float s = cb[c];
#pragma unroll
        for (int j = 0; j < 4; ++j) { const int tt = t - 3 + j; if (tt >= 0) s += cw[j * 512 + c] * bf2f(p[(size_t)(m - 3 + j) * NP + C_LX + c]); }
        xc[c] = s; }
    __syncthreads();
#pragma unroll
    for (int q = 0; q < 2; ++q) { const int c = tid + 256 * q, g = c >> 7, o = c & 127; float ra = ba[c], ri = bx[c];
        for (int i = 0; i < 128; ++i) { const float xv = xc[g * 128 + i]; ra += xv * wa[(size_t)(g * 128 + i) * 128 + o]; ri += xv * wx[(size_t)(g * 128 + i) * 128 + o]; }
        const float r = sigm(ra), ig = sigm(ri); const float la = -8.0f * r * log1pf(expf(-lam[c])); const float a = expf(la); const float u = sqrtf(-expm1f(2.0f * la)) * (ig * xc[c]);
        A[(size_t)m * 512 + c] = a; U[(size_t)m * 512 + c] = u; }
}
__global__ void __launch_bounds__(256) k_lru_scan(const float* A, const float* U, const bf16* p, bf16* y) {
    const int idx = blockIdx.x * 256 + threadIdx.x; const int b = idx / 512, c = idx % 512; float h = 0.f;
    for (int t = 0; t < T; ++t) { const size_t m = (size_t)b * T + t; h = A[m * 512 + c] * h + U[m * 512 + c]; const float z = bf2f(p[m * NP + C_LZ + c]); y[m * D + c] = f2bf(h * silu(z)); }
}

__global__ void __launch_bounds__(192) k_ml_prep(const bf16* p, const float* cw, const float* cb, const float* wq, const float* wk, const float* wv, bf16* Q, bf16* K, bf16* V) {
    const int m = blockIdx.x, t = m % T, j = threadIdx.x;
    float u4[4], uc[4];
#pragma unroll
    for (int i = 0; i < 4; ++i) { const int c = 4 * j + i; float s = cb[c];
#pragma unroll
        for (int jj = 0; jj < 4; ++jj) { const int tt = t - 3 + jj; if (tt >= 0) s += cw[jj * 768 + c] * bf2f(p[(size_t)(m - 3 + jj) * NP + C_MU + c]); }
        uc[i] = silu(s); u4[i] = bf2f(p[(size_t)m * NP + C_MU + c]); }
    const float ks = 0.07216878364870322f;
#pragma unroll
    for (int o = 0; o < 4; ++o) { float q = 0.f, k = 0.f, v = 0.f;
#pragma unroll
        for (int i = 0; i < 4; ++i) { q += uc[i] * wq[(j * 4 + i) * 4 + o]; k += uc[i] * wk[(j * 4 + i) * 4 + o]; v += u4[i] * wv[(j * 4 + i) * 4 + o]; }
        Q[(size_t)m * 768 + 4 * j + o] = f2bf(q); K[(size_t)m * 768 + 4 * j + o] = f2bf(k * ks); V[(size_t)m * 768 + 4 * j + o] = f2bf(v); }
}
__global__ void k_ml_F(const float* gates, const float* bi, const float* bf, float* Fb, float* Ib) {
    const int bh = threadIdx.x; if (bh >= 16) return; const int b = bh >> 2, h = bh & 3; float F = 0.f;
    for (int t = 0; t < T; ++t) { const size_t m = (size_t)b * T + t; F += logsig(gates[m * 8 + 4 + h] + bf[h]); Fb[bh * T + t] = F; Ib[bh * T + t] = gates[m * 8 + h] + bi[h]; }
}
__global__ void __launch_bounds__(256) k_ml_attn(const bf16* Q, const bf16* K, const bf16* V, const float* Fb, const float* Ib, const bf16* p, const float* ng, bf16* y) {
    __shared__ float Qs[16][192]; __shared__ float Ks[32][193]; __shared__ float Vs[32][192]; __shared__ float Ss[16][32]; __shared__ float Ft[16]; __shared__ float Fs[32]; __shared__ float Is[32];
    const int tid = threadIdx.x, bh = blockIdx.y, b = bh >> 2, h = bh & 3, t0 = blockIdx.x * 16;
    for (int e = tid; e < 16 * 192; e += 256) { const int r = e / 192, d = e % 192; Qs[r][d] = bf2f(Q[(size_t)(b * T + t0 + r) * 768 + h * 192 + d]); }
    if (tid < 16) Ft[tid] = Fb[bh * T + t0 + tid];
    const int r = tid >> 4, cl = tid & 15;
    float acc[12]; float den = 0.f;
#pragma unroll
    for (int i = 0; i < 12; ++i) acc[i] = 0.f;
    for (int s0 = 0; s0 < t0 + 16; s0 += 32) {
        __syncthreads();
        for (int e = tid; e < 32 * 192; e += 256) { const int i = e / 192, d = e % 192; const size_t g = (size_t)(b * T + s0 + i) * 768 + h * 192 + d; Ks[i][d] = bf2f(K[g]); Vs[i][d] = bf2f(V[g]); }
        if (tid < 32) { Fs[tid] = Fb[bh * T + s0 + tid]; Is[tid] = Ib[bh * T + s0 + tid]; }
        __syncthreads();
#pragma unroll
        for (int w = 0; w < 2; ++w) { const int s = cl + 16 * w; float dot = 0.f;
            for (int d = 0; d < 192; ++d) dot += Qs[r][d] * Ks[s][d];
            const int tt = t0 + r, ss = s0 + s; const float wgt = (ss <= tt) ? expf(Ft[r] - Fs[s] + Is[s]) : 0.f; Ss[r][s] = dot * wgt; }
        __syncthreads();
        for (int s = 0; s < 32; ++s) { const float sv = Ss[r][s]; den += sv;
#pragma unroll
            for (int i = 0; i < 12; ++i) acc[i] += sv * Vs[s][cl + 16 * i]; }
    }
    const float dn = fmaxf(fabsf(den), 1.0f); const size_t m = (size_t)b * T + t0 + r; float hv[12]; float s1 = 0.f;
#pragma unroll
    for (int i = 0; i < 12; ++i) { const int d = cl + 16 * i; hv[i] = acc[i] / dn * sigm(bf2f(p[m * NP + C_MO + h * 192 + d])); s1 += hv[i]; }
    s1 += __shfl_xor(s1, 1); s1 += __shfl_xor(s1, 2); s1 += __shfl_xor(s1, 4); s1 += __shfl_xor(s1, 8);
    const float mu = s1 * (1.0f / 192.0f); float s2 = 0.f;
#pragma unroll
    for (int i = 0; i < 12; ++i) { const float dd = hv[i] - mu; s2 += dd * dd; }
    s2 += __shfl_xor(s2, 1); s2 += __shfl_xor(s2, 2); s2 += __shfl_xor(s2, 4); s2 += __shfl_xor(s2, 8);
    const float rs = 1.0f / sqrtf(s2 * (1.0f / 192.0f) + LN_EPS);
#pragma unroll
    for (int i = 0; i < 12; ++i) { const int d = cl + 16 * i; const float z = bf2f(p[m * NP + C_MZ + h * 192 + d]); y[m * D + 512 + h * 192 + d] = f2bf((hv[i] - mu) * rs * ng[h * 192 + d] * silu(z)); }
}

__global__ void k_mo_kmean(const bf16* p, float* kmean) {
    const int idx = blockIdx.x * 256 + threadIdx.x; if (idx >= NB * 6 * 8 * 128) return;
    const int d = idx & 127, blk = (idx >> 7) & 7, bh = idx >> 10, b = bh / 6, h = bh % 6; float s = 0.f;
    for (int i = 0; i < 256; ++i) s += bf2f(p[(size_t)(b * T + blk * 256 + i) * NP + C_K + h * 128 + d]);
    kmean[idx] = s * (1.0f / 256.0f);
}
__global__ void k_mo_sel(const bf16* p, const float* kmean, unsigned char* sel) {
    const int idx = blockIdx.x * 256 + threadIdx.x; if (idx >= NB * 6 * T) return;
    const int t = idx % T, bh = idx / T, b = bh / 6, h = bh % 6, bq = t >> 8;
    const bf16* q = p + (size_t)(b * T + t) * NP + C_Q + h * 128;
    float g0 = 0, g1 = 0, g2 = 0, g3 = 0, g4 = 0, g5 = 0, g6 = 0;
    const float* km = kmean + (size_t)bh * 8 * 128;
    for (int d = 0; d < 128; ++d) { const float qv = bf2f(q[d]); g0 += qv * km[d]; g1 += qv * km[128 + d]; g2 += qv * km[256 + d]; g3 += qv * km[384 + d]; g4 += qv * km[512 + d]; g5 += qv * km[640 + d]; g6 += qv * km[768 + d]; }
    const float gv[7] = {g0, g1, g2, g3, g4, g5, g6};
    unsigned mask = 0;
    if (bq <= 3) mask = (1u << bq) - 1u;
    else {
#pragma unroll
        for (int pass = 0; pass < 3; ++pass) { float best = -INFINITY; int bi = -1;
#pragma unroll
            for (int j = 0; j < 7; ++j) if (j < bq && !((mask >> j) & 1u) && gv[j] > best) { best = gv[j]; bi = j; }
            if (bi >= 0) mask |= 1u << bi; }
    }
    mask |= 1u << bq;
    sel[(size_t)(b * T + t) * 8 + h] = (unsigned char)mask;
}
template <int MODE> __global__ void __launch_bounds__(256) k_attn16(const bf16* Qp, int ldq, int qcol, const bf16* Kp, const bf16* Vp, int ldk, const unsigned char* sel, const bf16* zp, bf16* outp, int ldo, int ocol) {
    __shared__ float Qs[16][128]; __shared__ float Ks[32][129]; __shared__ float Vs[32][128]; __shared__ float Ss[16][32]; __shared__ unsigned anym;
    const int tid = threadIdx.x, t0 = blockIdx.x * 16; const int NH = MODE == 0 ? 6 : 4; const int bh = blockIdx.y, b = bh / NH, h = bh % NH;
    const int r = tid >> 4, cl = tid & 15; const size_t m = (size_t)b * T + t0 + r;
    for (int e = tid; e < 16 * 128; e += 256) { const int rr = e >> 7, d = e & 127; Qs[rr][d] = bf2f(Qp[(size_t)(b * T + t0 + rr) * ldq + qcol + h * 128 + d]); }
    unsigned mymask = 0xffffffffu;
    if (MODE == 0) { if (tid == 0) anym = 0; __syncthreads(); mymask = sel[m * 8 + h]; if (cl == 0) atomicOr(&anym, mymask); __syncthreads(); }
    const float scale = 0.08838834764831845f;
    float slope = 0.f;
    if (MODE == 0) { slope = (h == 0) ? 0.25f : (h == 1) ? 0.0625f : (h == 2) ? 0.015625f : (h == 3) ? 0.00390625f : (h == 4) ? 0.5f : 0.125f; }
    float acc[8]; float mrun = -1e30f, l = 0.f;
#pragma unroll
    for (int i = 0; i < 8; ++i) acc[i] = 0.f;
    const int nblk = MODE == 0 ? (t0 >> 8) + 1 : 1; const unsigned am = MODE == 0 ? anym : 1u;
    const int kbase = MODE == 0 ? b * T : b * MEM;
    for (int j = 0; j < nblk; ++j) {
        if (!((am >> j) & 1u)) continue;
        for (int ch = 0; ch < 8; ++ch) {
            const int s0 = j * 256 + ch * 32; if (MODE == 0 && s0 > t0 + 15) break;
            __syncthreads();
            for (int e = tid; e < 32 * 128; e += 256) { const int i = e >> 7, d = e & 127; const size_t g = (size_t)(kbase + s0 + i) * ldk + h * 128 + d; Ks[i][d] = bf2f(Kp[g]); Vs[i][d] = bf2f(Vp[g]); }
            __syncthreads();
#pragma unroll
            for (int w = 0; w < 2; ++w) { const int s = cl + 16 * w; float dot = 0.f;
                for (int d = 0; d < 128; ++d) dot += Qs[r][d] * Ks[s][d];
                float lg = dot * scale;
                if (MODE == 0) { const int tt = t0 + r, ss = s0 + s; const bool valid = ((mymask >> j) & 1u) && (ss <= tt); lg = valid ? lg - slope * (float)(tt - ss) : -INFINITY; }
                Ss[r][s] = lg; }
            __syncthreads();
            float mx = -INFINITY;
            for (int s = 0; s < 32; ++s) mx = fmaxf(mx, Ss[r][s]);
            const float mnew = fmaxf(mrun, mx); const float corr = expf(mrun - mnew); l *= corr;
#pragma unroll
            for (int i = 0; i < 8; ++i) acc[i] *= corr;
            for (int s = 0; s < 32; ++s) { const float pv = expf(Ss[r][s] - mnew); l += pv;
#pragma unroll
                for (int i = 0; i < 8; ++i) acc[i] += pv * Vs[s][cl + 16 * i]; }
            mrun = mnew;
        }
    }
    const float inv = 1.0f / l;
#pragma unroll
    for (int i = 0; i < 8; ++i) { const int d = cl + 16 * i; float o = acc[i] * inv;
        if (MODE == 0) { const float z = bf2f(zp[m * NP + C_Z + h * 128 + d]); o *= silu(z); }
        outp[m * ldo + ocol + h * 128 + d] = f2bf(o); }
}

__global__ void __launch_bounds__(256) k_final(const float* x, const float* g, float* out) {
    const int lane = threadIdx.x & 63, wave = threadIdx.x >> 6; const int row = blockIdx.x * 4 + wave;
    const float4* xr = (const float4*)(x + (size_t)row * D); float4 v[8]; float ss = 0.f;
#pragma unroll
    for (int j = 0; j < 8; ++j) { v[j] = xr[lane + 64 * j]; ss += v[j].x * v[j].x + v[j].y * v[j].y + v[j].z * v[j].z + v[j].w * v[j].w; }
    ss = wave_sum(ss); const float r = 1.0f / sqrtf(ss * (1.0f / D) + RMS_EPS);
    float4* o = (float4*)(out + (size_t)row * D); const float4* gg = (const float4*)g;
#pragma unroll
    for (int j = 0; j < 8; ++j) { const float4 gv = gg[lane + 64 * j]; o[lane + 64 * j] = make_float4(v[j].x * r * gv.x, v[j].y * r * gv.y, v[j].z * r * gv.z, v[j].w * r * gv.w); }
}

extern "C" void kernel_launch(void* const* d_in, const int* in_sizes, int n_in, void* d_out, int out_size, void* d_ws, size_t ws_size, hipStream_t stream) {
    static int inited = 0;
    if (!inited) {
        if (ws_size < WS_END) fprintf(stderr, "kernel_launch: ws_size %zu < %zu\n", ws_size, (size_t)WS_END);
        (void)hipFuncSetAttribute((const void*)k_gemm<EpiScaleBf16>, hipFuncAttributeMaxDynamicSharedMemorySize, pg8::STAGE_BYTES);
        (void)hipFuncSetAttribute((const void*)k_gemm<EpiResF32>, hipFuncAttributeMaxDynamicSharedMemorySize, pg8::STAGE_BYTES);
        inited = 1;
    }
    const float* x = (const float*)d_in[0]; const float* mem = (const float*)d_in[1];
    const float* mix_g = (const float*)d_in[2]; const float* w_in = (const float*)d_in[3];
    const float* lru_cw = (const float*)d_in[4]; const float* lru_cb = (const float*)d_in[5]; const float* lru_wa = (const float*)d_in[6]; const float* lru_ba = (const float*)d_in[7];
    const float* lru_wx = (const float*)d_in[8]; const float* lru_bx = (const float*)d_in[9]; const float* lru_lam = (const float*)d_in[10];
    const float* ml_cw = (const float*)d_in[11]; const float* ml_cb = (const float*)d_in[12]; const float* ml_wq = (const float*)d_in[13]; const float* ml_wk = (const float*)d_in[14]; const float* ml_wv = (const float*)d_in[15];
    const float* ml_bi = (const float*)d_in[16]; const float* ml_bf = (const float*)d_in[17]; const float* ml_ng = (const float*)d_in[18];
    const float* w_out = (const float*)d_in[19]; const float* xa_g = (const float*)d_in[20]; const float* mem_g = (const float*)d_in[21];
    const float* xa_wq = (const float*)d_in[22]; const float* xa_wkv = (const float*)d_in[23]; const float* xa_wo = (const float*)d_in[24]; const float* fin_g = (const float*)d_in[25];
    unsigned char* ws = (unsigned char*)d_ws; float* out = (float*)d_out;
    bf16* Win = (bf16*)(ws + WS_WIN); bf16* Wout = (bf16*)(ws + WS_WOUT); bf16* Wq = (bf16*)(ws + WS_WQ); bf16* Wkv = (bf16*)(ws + WS_WKV); bf16* Wo = (bf16*)(ws + WS_WO); float* Wg = (float*)(ws + WS_WG);
    bf16* memb = (bf16*)(ws + WS_MEMB); float* rinvm = (float*)(ws + WS_RINVM); bf16* KV = (bf16*)(ws + WS_KV);
    bf16* xb = (bf16*)(ws + WS_XB); float* rinv = (float*)(ws + WS_RINV); float* gates = (float*)(ws + WS_GATES); float* xres = (float*)(ws + WS_XRES);
    bf16* y = (bf16*)(ws + WS_Y); bf16* p = (bf16*)(ws + WS_P); float* A = (float*)(ws + WS_A); float* U = (float*)(ws + WS_U);
    bf16* MQ = (bf16*)(ws + WS_MQ); bf16* MK = (bf16*)(ws + WS_MK); bf16* MV = (bf16*)(ws + WS_MV); float* Fb = (float*)(ws + WS_F); float* Ib = (float*)(ws + WS_I);
    float* kmean = (float*)(ws + WS_KMEAN); unsigned char* sel = (unsigned char*)(ws + WS_SEL); bf16* XQ = (bf16*)(ws + WS_XQ); bf16* XO = (bf16*)(ws + WS_XO);
    const int G = 256;
    for (int l = 0; l < DEPTH; ++l) {
        k_wt<<<1024, 256, 0, stream>>>(w_in + (size_t)l * D * INC, INC, D, NP, mix_g + l * D, Win + (size_t)l * NP * D, 1);
        k_gatew<<<D * 8 / 256, 256, 0, stream>>>(w_in + (size_t)l * D * INC, mix_g + l * D, Wg + (size_t)l * D * 8);
        k_wt<<<1024, 256, 0, stream>>>(w_out + (size_t)l * D * D, D, D, D, nullptr, Wout + (size_t)l * D * D, 0);
        k_wt<<<1024, 256, 0, stream>>>(xa_wq + (size_t)l * D * 512, 512, D, 512, xa_g + l * D, Wq + (size_t)l * 512 * D, 0);
        k_wt<<<1024, 256, 0, stream>>>(xa_wkv + (size_t)l * D * 1024, 1024, D, 1024, mem_g + l * D, Wkv + (size_t)l * 1024 * D, 0);
        k_wt<<<1024, 256, 0, stream>>>(xa_wo + (size_t)l * 512 * D, D, 512, D, nullptr, Wo + (size_t)l * D * 512, 0);
    }
    k_prep<<<MM / 4, 256, 0, stream>>>(mem, memb, rinvm, nullptr, nullptr, MM);
    for (int l = 0; l < DEPTH; ++l) {
        pg8::Gemm g{memb, Wkv + (size_t)l * 1024 * D, MM, 1024, D, 0}; EpiScaleBf16 E{KV + (size_t)l * MM * 1024, rinvm, 1024, 0};
        k_gemm<EpiScaleBf16><<<G, 512, pg8::STAGE_BYTES, stream>>>(g, E);
    }
    const float* xcur = x;
    for (int l = 0; l < DEPTH; ++l) {
        k_prep<<<M / 4, 256, 0, stream>>>(xcur, xb, rinv, Wg + (size_t)l * D * 8, gates, M);
        { pg8::Gemm g{xb, Win + (size_t)l * NP * D, M, NP, D, 0}; EpiScaleBf16 E{p, rinv, NP, 0}; k_gemm<EpiScaleBf16><<<G, 512, pg8::STAGE_BYTES, stream>>>(g, E); }
        k_lru_gates<<<M, 256, 0, stream>>>(p, lru_cw + l * 4 * 512, lru_cb + l * 512, lru_wa + (size_t)l * 4 * 128 * 128, lru_ba + l * 512, lru_wx + (size_t)l * 4 * 128 * 128, lru_bx + l * 512, lru_lam + l * 512, A, U);
        k_lru_scan<<<8, 256, 0, stream>>>(A, U, p, y);
        k_ml_prep<<<M, 192, 0, stream>>>(p, ml_cw + l * 4 * 768, ml_cb + l * 768, ml_wq + l * 192 * 16, ml_wk + l * 192 * 16, ml_wv + l * 192 * 16, MQ, MK, MV);
        k_ml_F<<<1, 64, 0, stream>>>(gates, ml_bi + l * 4, ml_bf + l * 4, Fb, Ib);
        k_ml_attn<<<dim3(T / 16, 16), 256, 0, stream>>>(MQ, MK, MV, Fb, Ib, p, ml_ng + l * 768, y);
        k_mo_kmean<<<NB * 6 * 8 * 128 / 256, 256, 0, stream>>>(p, kmean);
        k_mo_sel<<<NB * 6 * T / 256, 256, 0, stream>>>(p, kmean, sel);
        k_attn16<0><<<dim3(T / 16, NB * 6), 256, 0, stream>>>(p, NP, C_Q, p + C_K, p + C_V, NP, sel, p, y, D, 1280);
        { pg8::Gemm g{y, Wout + (size_t)l * D * D, M, D, D, 0}; EpiResF32 E{xcur, xres, D, 0}; k_gemm<EpiResF32><<<G, 512, pg8::STAGE_BYTES, stream>>>(g, E); }
        k_prep<<<M / 4, 256, 0, stream>>>(xres, xb, rinv, nullptr, nullptr, M);
        { pg8::Gemm g{xb, Wq + (size_t)l * 512 * D, M, 512, D, 0}; EpiScaleBf16 E{XQ, rinv, 512, 0}; k_gemm<EpiScaleBf16><<<G, 512, pg8::STAGE_BYTES, stream>>>(g, E); }
        { const bf16* kvl = KV + (size_t)l * MM * 1024; k_attn16<1><<<dim3(T / 16, NB * 4), 256, 0, stream>>>(XQ, 512, 0, kvl, kvl + 512, 1024, nullptr, nullptr, XO, 512, 0); }
        { pg8::Gemm g{XO, Wo + (size_t)l * D * 512, M, D, 512, 0}; EpiResF32 E{xres, xres, D, 0}; k_gemm<EpiResF32><<<G, 512, pg8::STAGE_BYTES, stream>>>(g, E); }
        xcur = xres;
    }
    k_final<<<M / 4, 256, 0, stream>>>(xres, fin_g, out);
}
```

```cpp
#include <hip/hip_runtime.h>
#include <cstdio>
#include <cstdint>
namespace pg8 {
#define PG8_LAS __attribute__((address_space(3)))
typedef unsigned short bf16_t;
typedef short bf16x8 __attribute__((ext_vector_type(8)));
typedef float f32x4 __attribute__((ext_vector_type(4)));
typedef unsigned u32x4 __attribute__((ext_vector_type(4)));
constexpr int BM = 256, BK = 64, HALF = 128, HTB = HALF * BK * 2  , STAGE_BYTES = 8 * HTB, NXCD = 8, WGM = 8;

__host__ __device__ __forceinline__ int lds_byte(int r, int c) { const int st = (r >> 4) * 2 + (c >> 5), rr = r & 15, cc = c & 31, ob = rr * 64 + cc * 2; return st * 1024 + (ob ^ (((ob >> 9) & 1) << 5)); }
__host__ __device__ __forceinline__ void stage_rc(int b, int& R, int& C) { const int st = b / 1024, sb = b % 1024, swz = sb ^ (((sb >> 9) & 1) << 5); R = (st >> 1) * 16 + swz / 64; C = (st & 1) * 32 + (swz % 64) / 2; }
__host__ __device__ __forceinline__ int perm32(int rho) { const int n = rho >> 4, i = rho & 15; return 8 * (i >> 2) + 4 * n + (i & 3); }

struct Unit { int pm, pn; };
struct Gemm { const bf16_t* A; const bf16_t* Bt; int M, N, K, pad; };

struct StaticOrder {
    int nM, nN, nwg, G, c;
    __host__ __device__ void init(int M, int N, int G_, int c_) { nM = M / BM; nN = N / BM; nwg = nM * nN; G = G_; c = c_; }
    __host__ __device__ bool next(int i, Unit& u) const {
        const long L = (long)i * G + c; if (L >= nwg) return false;
        int wgid = (int)L; { const int q = nwg / NXCD, r = nwg % NXCD, xcd = wgid % NXCD, off = wgid / NXCD; wgid = (xcd < r ? xcd * (q + 1) : r * (q + 1) + (xcd - r) * q) + off; }
        const int nig = WGM * nN, gid = wgid / nig, fm = gid * WGM, gsz = (nM - fm) < WGM ? (nM - fm) : WGM;
        u.pm = fm + ((wgid % nig) % gsz); u.pn = (wgid % nig) / gsz; return true;
    }
    __device__ __forceinline__ void a_ready(const Unit&) const {}
    __device__ __forceinline__ void done(const Unit&) const {}
};

__device__ __forceinline__ unsigned cvt_pk_bf16(float lo, float hi) { unsigned r; asm volatile("v_cvt_pk_bf16_f32 %0, %1, %2" : "=v"(r) : "v"(lo), "v"(hi)); return r; }
template <class Epi, class Sched, bool ALIGN_EPI = false, bool SP2 = false>
__device__ __forceinline__ void gemm_phase(PG8_LAS unsigned char* lds, const Gemm g, const Sched& S, const Epi& E) {
    const int tid = threadIdx.x, wid = __builtin_amdgcn_readfirstlane(tid >> 6), lane = tid & 63, wr = wid >> 2, wc = wid & 3, fr = lane & 15, fq = lane >> 4;
    const int K = g.K, nt = K / BK;
    unsigned voffA[2], voffB[2];
#pragma unroll
    for (int i = 0; i < 2; ++i) { int R, C; stage_rc(tid * 16 + i * 8192, R, C); const int Rb = Epi::PERM ? ((R & ~31) + perm32(R & 31)) : R;
        voffA[i] = (unsigned)(R * K + C) * 2u; voffB[i] = (unsigned)(Rb * K + C) * 2u; }
    const size_t kstep = (size_t)(BK * 2);
    const size_t hstep = (size_t)HALF * K * 2;
    const size_t tstep = 2 * hstep;
    const unsigned ldsw = (unsigned)wid * 1024u;
    const int aoff = lds_byte(wr * 64 + fr, fq * 8), boff = lds_byte(wc * 32 + fr, fq * 8);
#define PG8_SA(b, h) (((b) * 2 + (h)) * HTB)
#define PG8_SB(b, h) ((4 + (b) * 2 + (h)) * HTB)
#define PG8_STAGE(bufoff, gbase, voff) do { _Pragma("unroll") for (int _i = 0; _i < 2; ++_i) \
        __builtin_amdgcn_global_load_lds((const unsigned*)((const char*)(gbase) + (voff)[_i]), (PG8_LAS unsigned*)(lds + (bufoff) + ldsw + _i * 8192), 16, 0, 0); } while (0)
#define PG8_LDA(dst, b, h) do { _Pragma("unroll") for (int m = 0; m < 4; ++m) _Pragma("unroll") for (int k = 0; k < 2; ++k) dst[m][k] = *(const PG8_LAS bf16x8*)(lds + PG8_SA(b, h) + aoff + m * 2048 + k * 1024); } while (0)
#define PG8_LDB(dst, b, h) do { _Pragma("unroll") for (int n = 0; n < 2; ++n) _Pragma("unroll") for (int k = 0; k < 2; ++k) dst[n][k] = *(const PG8_LAS bf16x8*)(lds + PG8_SB(b, h) + boff + n * 2048 + k * 1024); } while (0)
#define PG8_MMA(ai, bj, At, Bt) do { __builtin_amdgcn_s_setprio(1); _Pragma("unroll") for (int m = 0; m < 4; ++m) _Pragma("unroll") for (int n = 0; n < 2; ++n) _Pragma("unroll") for (int k = 0; k < 2; ++k) \
        acc[ai][bj][m][n] = __builtin_amdgcn_mfma_f32_16x16x32_bf16(Bt[n][k], At[m][k], acc[ai][bj][m][n], 0, 0, 0); __builtin_amdgcn_s_setprio(0); } while (0)
#define PG8_WAIT_V(n) asm volatile("s_waitcnt vmcnt(" #n ")" ::: "memory")
#define PG8_WAIT_L(n) asm volatile("s_waitcnt lgkmcnt(" #n ")" ::: "memory")
#define PG8_BAR __builtin_amdgcn_s_barrier()
#define PG8_SCHED __builtin_amdgcn_sched_barrier(0)
    Unit cur, nxt; int ui = 0;
    if (!S.next(0, cur)) return;
    f32x4 acc[2][2][4][2];
#pragma unroll
    for (int a = 0; a < 2; ++a)
#pragma unroll
        for (int b = 0; b < 2; ++b)
#pragma unroll
            for (int m = 0; m < 4; ++m)
#pragma unroll
                for (int n = 0; n < 2; ++n) acc[a][b][m][n] = (f32x4){0.f, 0.f, 0.f, 0.f};
    bf16x8 At[4][2], B0[2][2], B1[2][2];
    const char* cA = (const char*)g.A + (size_t)cur.pm * tstep; const char* cB = (const char*)g.Bt + (size_t)cur.pn * tstep;
    S.a_ready(cur);
    if constexpr (SP2) {
        PG8_STAGE(PG8_SB(0, 0), cB, voffB); PG8_STAGE(PG8_SB(0, 1), cB + hstep, voffB); PG8_STAGE(PG8_SA(0, 0), cA, voffA); PG8_STAGE(PG8_SA(0, 1), cA + hstep, voffA);
        if (wr == 1) PG8_BAR;
        PG8_WAIT_V(2); PG8_BAR;
        PG8_STAGE(PG8_SB(1, 0), cB + kstep, voffB); PG8_STAGE(PG8_SA(1, 0), cA + kstep, voffA); PG8_STAGE(PG8_SB(1, 1), cB + hstep + kstep, voffB);
        PG8_WAIT_V(6); PG8_BAR;
    } else {
        PG8_STAGE(PG8_SB(0, 0), cB, voffB); PG8_STAGE(PG8_SA(0, 0), cA, voffA); PG8_STAGE(PG8_SB(0, 1), cB + hstep, voffB); PG8_STAGE(PG8_SA(0, 1), cA + hstep, voffA);
        if (wr == 1) PG8_BAR;
        PG8_WAIT_V(4); PG8_BAR;
        PG8_STAGE(PG8_SB(1, 0), cB + kstep, voffB); PG8_STAGE(PG8_SA(1, 0), cA + kstep, voffA); PG8_STAGE(PG8_SB(1, 1), cB + hstep + kstep, voffB);
        PG8_WAIT_V(6); PG8_BAR;
    }
    for (;;) {
        const bool has_next = S.next(ui + 1, nxt);
        const char* nA = has_next ? (const char*)g.A + (size_t)nxt.pm * tstep : cA; const char* nB = has_next ? (const char*)g.Bt + (size_t)nxt.pn * tstep : cB;
        for (int t = 0; t < nt; t += 2) {
            const bool last = (t == nt - 2);
            const char* a1 = cA + (size_t)(t + 1) * kstep;
            const char* a2 = last ? nA : cA + (size_t)(t + 2) * kstep; const char* b2 = last ? nB : cB + (size_t)(t + 2) * kstep;
            const char* a3 = a2 + kstep; const char* b3 = b2 + kstep;
            if (last && has_next) S.a_ready(nxt);
            if constexpr (SP2) {
            PG8_LDB(B0, 0, 0); PG8_LDB(B1, 0, 1); PG8_SCHED; PG8_LDA(At, 0, 0); PG8_STAGE(PG8_SA(1, 1), a1 + hstep, voffA);
            PG8_WAIT_V(8); PG8_WAIT_L(0); PG8_BAR; PG8_MMA(0, 0, At, B0); PG8_MMA(0, 1, At, B1); PG8_BAR; PG8_SCHED;
            PG8_LDA(At, 0, 1); PG8_STAGE(PG8_SB(0, 0), b2, voffB); PG8_STAGE(PG8_SB(0, 1), b2 + hstep, voffB); PG8_STAGE(PG8_SA(0, 0), a2, voffA);
            PG8_WAIT_V(8); PG8_WAIT_L(0); PG8_BAR; PG8_MMA(1, 0, At, B0); PG8_MMA(1, 1, At, B1); PG8_BAR; PG8_SCHED;
            PG8_LDB(B0, 1, 0); PG8_LDB(B1, 1, 1); PG8_SCHED; PG8_LDA(At, 1, 0); PG8_STAGE(PG8_SA(0, 1), a2 + hstep, voffA);
            PG8_WAIT_V(8); PG8_WAIT_L(0); PG8_BAR; PG8_MMA(0, 0, At, B0); PG8_MMA(0, 1, At, B1); PG8_BAR; PG8_SCHED;
            PG8_LDA(At, 1, 1); PG8_STAGE(PG8_SB(1, 0), b3, voffB); PG8_STAGE(PG8_SB(1, 1), b3 + hstep, voffB); PG8_STAGE(PG8_SA(1, 0), a3, voffA);
            PG8_WAIT_V(8); PG8_WAIT_L(0); PG8_BAR; PG8_MMA(1, 0, At, B0); PG8_MMA(1, 1, At, B1); PG8_BAR; PG8_SCHED;
            } else {
            PG8_LDB(B0, 0, 0); PG8_SCHED; PG8_LDA(At, 0, 0); PG8_STAGE(PG8_SA(1, 1), a1 + hstep, voffA);
            PG8_WAIT_L(8); PG8_BAR; PG8_WAIT_L(0); PG8_MMA(0, 0, At, B0); PG8_BAR; PG8_SCHED;
            PG8_LDB(B1, 0, 1); PG8_STAGE(PG8_SB(0, 0), b2, voffB);
            PG8_BAR; PG8_WAIT_L(0); PG8_MMA(0, 1, At, B1); PG8_BAR;
            PG8_LDA(At, 0, 1); PG8_STAGE(PG8_SA(0, 0), a2, voffA);
            PG8_BAR; PG8_WAIT_L(0); PG8_MMA(1, 0, At, B0); PG8_BAR; PG8_SCHED;
            PG8_STAGE(PG8_SB(0, 1), b2 + hstep, voffB);
            PG8_WAIT_V(6); PG8_BAR; PG8_MMA(1, 1, At, B1); PG8_BAR;
            PG8_LDB(B0, 1, 0); PG8_SCHED; PG8_LDA(At, 1, 0); PG8_STAGE(PG8_SA(0, 1), a2 + hstep, voffA);
            PG8_WAIT_L(8); PG8_BAR; PG8_WAIT_L(0); PG8_MMA(0, 0, At, B0); PG8_BAR; PG8_SCHED;
            PG8_LDB(B1, 1, 1); PG8_STAGE(PG8_SB(1, 0), b3, voffB);
            PG8_BAR; PG8_WAIT_L(0); PG8_MMA(0, 1, At, B1); PG8_BAR;
            PG8_LDA(At, 1, 1); PG8_STAGE(PG8_SA(1, 0), a3, voffA);
            PG8_BAR; PG8_WAIT_L(0); PG8_MMA(1, 0, At, B0); PG8_BAR; PG8_SCHED;
            PG8_STAGE(PG8_SB(1, 1), b3 + hstep, voffB);
            PG8_WAIT_V(6); PG8_BAR; PG8_MMA(1, 1, At, B1); PG8_BAR;
            }
        }
        if constexpr (ALIGN_EPI) { if (wr == 0) PG8_BAR; }
        if constexpr (!Epi::AFTER_DRAIN) { E(acc, cur, wr, wc, fr, fq); S.done(cur); }
        if (!has_next) break;
#pragma unroll
        for (int a = 0; a < 2; ++a)
#pragma unroll
            for (int b = 0; b < 2; ++b)
#pragma unroll
                for (int m = 0; m < 4; ++m)
#pragma unroll
                    for (int n = 0; n < 2; ++n) acc[a][b][m][n] = (f32x4){0.f, 0.f, 0.f, 0.f};
        cur = nxt; cA = nA; cB = nB; ++ui;
        if constexpr (ALIGN_EPI) { if (wr == 1) PG8_BAR; }
    }
    PG8_WAIT_V(0);
    if constexpr (!ALIGN_EPI) { if (wr == 0) PG8_BAR; }
    PG8_BAR;
    if constexpr (Epi::AFTER_DRAIN) { E.fused(acc, cur, wr, wc, fr, fq, lds, wid, lane); S.done(cur); }
#undef PG8_SA
#undef PG8_SB
#undef PG8_STAGE
#undef PG8_LDA
#undef PG8_LDB
#undef PG8_MMA
#undef PG8_WAIT_V
#undef PG8_WAIT_L
#undef PG8_BAR
#undef PG8_SCHED
}
}

constexpr int NB = 4, T = 2048, D = 2048, M = NB * T, DEPTH = 2, MEM = 256, MM = NB * MEM;
constexpr int INC = 6408, NP = 6400;
constexpr int ML_DH = 192, MO_DH = 128;
constexpr int C_LX = 0, C_LZ = 512, C_MU = 1024, C_MO = 1792, C_MZ = 2560, C_Q = 3328, C_K = 4096, C_V = 4864, C_Z = 5632;
constexpr int SRC_GATE = 3328;
constexpr float RMS_EPS = 1e-6f, LN_EPS = 1e-5f;

typedef unsigned short bf16;
#define LAS __attribute__((address_space(3)))
__device__ __forceinline__ float bf2f(bf16 v) { return __uint_as_float(((unsigned)v) << 16); }
__device__ __forceinline__ bf16 f2bf(float f) { unsigned u = __float_as_uint(f); return (bf16)((u + 0x7fffu + ((u >> 16) & 1u)) >> 16); }
__device__ __forceinline__ unsigned pk2(float lo, float hi) { return (unsigned)f2bf(lo) | ((unsigned)f2bf(hi) << 16); }
__device__ __forceinline__ float sigm(float x) { return 1.f / (1.f + expf(-x)); }
__device__ __forceinline__ float silu(float x) { return x / (1.f + expf(-x)); }
__device__ __forceinline__ float logsig(float x) { return fminf(x, 0.f) - log1pf(expf(-fabsf(x))); }
__device__ __forceinline__ float wave_sum(float v) {
#pragma unroll
    for (int o = 1; o < 64; o <<= 1) v += __shfl_xor(v, o);
    return v;
}

constexpr size_t al256(size_t x) { return (x + 255) & ~(size_t)255; }
constexpr size_t WS_CTL = 0;
constexpr size_t WS_WIN = 1u << 20;
constexpr size_t WS_WOUT = WS_WIN + (size_t)DEPTH * NP * D * 2;
constexpr size_t WS_WQ = WS_WOUT + (size_t)DEPTH * D * D * 2;
constexpr size_t WS_WKV = WS_WQ + (size_t)DEPTH * 512 * D * 2;
constexpr size_t WS_WO = WS_WKV + (size_t)DEPTH * 1024 * D * 2;
constexpr size_t WS_WG = WS_WO + (size_t)DEPTH * D * 512 * 2;
constexpr size_t WS_MEMB = WS_WG + (size_t)DEPTH * D * 8 * 4;
constexpr size_t WS_RINVM = WS_MEMB + (size_t)MM * D * 2;
constexpr size_t WS_KV = WS_RINVM + (size_t)MM * 4;
constexpr size_t WS_XB = WS_KV + (size_t)DEPTH * MM * 1024 * 2;
constexpr size_t WS_RINV = WS_XB + (size_t)M * D * 2;
constexpr size_t WS_GATES = WS_RINV + (size_t)M * 4;
constexpr size_t WS_XRES = WS_GATES + (size_t)M * 8 * 4;
constexpr size_t WS_Y = WS_XRES + (size_t)M * D * 4;
constexpr size_t WS_P = WS_Y + (size_t)M * D * 2;
constexpr size_t WS_A = WS_P + (size_t)M * NP * 2;
constexpr size_t WS_U = WS_A + (size_t)M * 512 * 4;
constexpr size_t WS_MQ = WS_U + (size_t)M * 512 * 4;
constexpr size_t WS_MK = WS_MQ + (size_t)M * 768 * 2;
constexpr size_t WS_MV = WS_MK + (size_t)M * 768 * 2;
constexpr size_t WS_F = WS_MV + (size_t)M * 768 * 2;
constexpr size_t WS_I = WS_F + (size_t)16 * T * 4;
constexpr size_t WS_KMEAN = WS_I + (size_t)16 * T * 4;
constexpr size_t WS_SEL = WS_KMEAN + (size_t)NB * 6 * 8 * 128 * 4;
constexpr size_t WS_END = WS_SEL + (size_t)M * 8;
constexpr size_t WS_XQ = WS_P;
constexpr size_t WS_XO = WS_P + (size_t)M * 512 * 2;
static_assert(WS_END <= 419954688ull, "workspace map exceeds the guaranteed ws_size");

__device__ __forceinline__ void wt_item(const float* W, int ldw, int src_col, const float* g, bf16* Wt, int K, int dst_row, float* scr, int k0, int lane) {
#pragma unroll 8
    for (int i = 0; i < 32; ++i) { const int kk = 2 * i + (lane >> 5); float v = W[(size_t)(k0 + kk) * ldw + src_col + (lane & 31)]; if (g) v *= g[k0 + kk]; scr[kk * 33 + (lane & 31)] = v; }
    __builtin_amdgcn_s_waitcnt(0xc07f); asm volatile("" ::: "memory");
    const int c = lane & 7;
#pragma unroll
    for (int j = 0; j < 4; ++j) { const int n = (lane >> 3) + 8 * j; const float* s = scr + (8 * c) * 33 + n;
        uint4 o; o.x = pk2(s[0 * 33], s[1 * 33]); o.y = pk2(s[2 * 33], s[3 * 33]); o.z = pk2(s[4 * 33], s[5 * 33]); o.w = pk2(s[6 * 33], s[7 * 33]);
        *(uint4*)(Wt + (size_t)(dst_row + n) * K + k0 + 8 * c) = o; }
    __builtin_amdgcn_s_waitcnt(0xc07f); asm volatile("" ::: "memory");
}
struct EpiScaleBf16 {
    static constexpr bool PERM = true, AFTER_DRAIN = false;
    bf16* O; const float* rs; int ldc, pad;
    __device__ __forceinline__ void operator()(const pg8::f32x4 (&acc)[2][2][4][2], const pg8::Unit& u, int wr, int wc, int fr, int fq) const {
        const int row0 = u.pm * 256 + wr * 64 + fr, col0 = u.pn * 256 + wc * 32 + 8 * fq;
#pragma unroll
        for (int ai = 0; ai < 2; ++ai)
#pragma unroll
            for (int m = 0; m < 4; ++m) { const int row = row0 + ai * 128 + m * 16; const float s = rs ? rs[row] : 1.f; bf16* rowp = O + (size_t)row * ldc + col0;
#pragma unroll
                for (int bj = 0; bj < 2; ++bj) { const pg8::f32x4 v0 = acc[ai][bj][m][0] * s, v1 = acc[ai][bj][m][1] * s; pg8::u32x4 w;
                    w.x = pg8::cvt_pk_bf16(v0[0], v0[1]); w.y = pg8::cvt_pk_bf16(v0[2], v0[3]); w.z = pg8::cvt_pk_bf16(v1[0], v1[1]); w.w = pg8::cvt_pk_bf16(v1[2], v1[3]);
                    *(pg8::u32x4*)(rowp + bj * 128) = w; } }
    }
};
struct EpiResF32 {
    static constexpr bool PERM = false, AFTER_DRAIN = false;
    const float* base; float* out; int ldc, pad;
    __device__ __forceinline__ void operator()(const pg8::f32x4 (&acc)[2][2][4][2], const pg8::Unit& u, int wr, int wc, int fr, int fq) const {
        const int row0 = u.pm * 256 + wr * 64 + fr, col0 = u.pn * 256 + wc * 32 + 4 * fq;
#pragma unroll
        for (int ai = 0; ai < 2; ++ai)
#pragma unroll
            for (int m = 0; m < 4; ++m) { const size_t off = (size_t)(row0 + ai * 128 + m * 16) * ldc + col0;
#pragma unroll
                for (int bj = 0; bj < 2; ++bj)
#pragma unroll
                    for (int n = 0; n < 2; ++n) { const pg8::f32x4 b = *(const pg8::f32x4*)(base + off + bj * 128 + n * 16); *(pg8::f32x4*)(out + off + bj * 128 + n * 16) = b + acc[ai][bj][m][n]; } }
    }
};
typedef __attribute__((address_space(1))) unsigned gu32;
#define RLX_AGENT __ATOMIC_RELAXED, __HIP_MEMORY_SCOPE_AGENT
#define XB_TMO      128
#define XB_XCNT(j)  (256  + 64 * (j))
#define XB_XSUB(j)  (1280 + 64 * (j))
#define XB_XGEN(j)  (2304 + 64 * (j))
#define XB_TOP      3328
#define XB_TOPGEN   3392
#define XCD_BAR_WORDS 3456
#define XB_SPIN_CAP (1u << 18)

__device__ __forceinline__ unsigned xb_ld(unsigned* p)              { return __hip_atomic_load(p, __ATOMIC_RELAXED, __HIP_MEMORY_SCOPE_AGENT); }
__device__ __forceinline__ unsigned xb_add(unsigned* p, unsigned v) { return __hip_atomic_fetch_add(p, v, __ATOMIC_RELAXED, __HIP_MEMORY_SCOPE_AGENT); }
__device__ __forceinline__ unsigned xb_xcc_id() { return (unsigned)__builtin_amdgcn_s_getreg((3 << 11) | 20) & 0xFu; }
#define XB_SPIN(cond, bar) do { unsigned _sp = 0; while (cond) { __builtin_amdgcn_s_sleep(1); \
    if ((++_sp & 255u) == 0u) { if (xb_ld(&(bar)[XB_TMO])) break; if (_sp > XB_SPIN_CAP) { atomicAdd(&(bar)[XB_TMO], 1u); break; } } } } while (0)

struct XcdBarrier {
    unsigned* bar; unsigned x;
    volatile LAS unsigned* st;
};

__device__ __forceinline__ XcdBarrier xcd_barrier_post(unsigned* bar, volatile LAS unsigned* st) {
    XcdBarrier b; b.bar = bar; b.x = xb_xcc_id(); b.st = st;
    if (threadIdx.x == 0) (void)xb_add(&bar[XB_XCNT(b.x)], 1u);
    return b;
}
__device__ __forceinline__ void xcd_barrier_complete(unsigned* bar, unsigned x, unsigned& nloc, unsigned& nx) {
    const unsigned G = gridDim.x * gridDim.y * gridDim.z;
    unsigned sum, cnt, mine, sp = 0u;
    for (;;) {
        sum = 0u; cnt = 0u; mine = 0u;
#pragma unroll
        for (unsigned j = 0; j < 16; ++j) { const unsigned c = xb_ld(&bar[XB_XCNT(j)]); sum += c; cnt += (c > 0u) ? 1u : 0u; mine = (j == x) ? c : mine; }
        if (sum == G) break;
        __builtin_amdgcn_s_sleep(1);
        if ((++sp & 255u) == 0u) { if (xb_ld(&bar[XB_TMO])) break; if (sp > XB_SPIN_CAP) { atomicAdd(&bar[XB_TMO], 1u); break; } }
    }
    nloc = mine > 0u ? mine : 1u; nx = cnt > 0u ? cnt : 1u;
}

__device__ __forceinline__ void xcd_barrier(const XcdBarrier& b) {
    asm volatile("s_waitcnt vmcnt(0)" ::: "memory");
    __syncthreads();
    if (threadIdx.x == 0) {
        unsigned* bar = b.bar;
        __builtin_amdgcn_s_waitcnt(0);
        unsigned nloc = b.st[0], nx = b.st[1];
        if (nloc == 0u) { xcd_barrier_complete(bar, b.x, nloc, nx); b.st[0] = nloc; b.st[1] = nx; }
        const unsigned old = xb_add(&bar[XB_XSUB(b.x)], 1u);
        const unsigned gen = old / nloc;
        if (old + 1u == (gen + 1u) * nloc) {
            __builtin_amdgcn_fence(__ATOMIC_RELEASE, "agent");
            asm volatile("s_waitcnt vmcnt(0)" ::: "memory");
            const unsigned og = xb_add(&bar[XB_TOP], 1u);
            const unsigned tg = og / nx;
            if (og + 1u == (tg + 1u) * nx) xb_add(&bar[XB_TOPGEN], 1u);
            else XB_SPIN(xb_ld(&bar[XB_TOPGEN]) == tg, bar);
            __builtin_amdgcn_fence(__ATOMIC_ACQUIRE, "agent");
            xb_add(&bar[XB_XGEN(b.x)], 1u);
            asm volatile("s_waitcnt vmcnt(0)" ::: "memory");
        } else {
            XB_SPIN(xb_ld(&bar[XB_XGEN(b.x)]) == gen, bar);
            __builtin_amdgcn_fence(__ATOMIC_ACQUIRE, "agent");
            asm volatile("s_waitcnt vmcnt(0)" ::: "memory");
        }
    }
    __syncthreads();
}

constexpr int NWAVES = 8, NTHR = 512;
constexpr int RING_BYTES = 131072, LDSCTL_OFF = RING_BYTES, MISC_OFF = LDSCTL_OFF + 320, LDS_BYTES = 147456;
constexpr size_t CTL_ZERO_BYTES = 1u << 20;
constexpr int CW_BAR = 4096;

struct Args { const float* in[26]; float* out; unsigned char* ws; };

__device__ __forceinline__ void ph_wt(const float* W, int ldw, int K, int N, const float* g, bf16* Wt, int mode, float* scr, int gw, int NGW, int lane) {
    const int nblk = N / 32, nitems = (K / 64) * nblk;
    for (int it = gw; it < nitems; it += NGW) {
        const int kb = it / nblk, nb = it % nblk, n0 = nb * 32;
        const int src = (mode == 1 && n0 >= SRC_GATE) ? n0 + 8 : n0;
        wt_item(W, ldw, src, g, Wt, K, n0, scr, kb * 64, lane);
    }
}
__device__ __forceinline__ void ph_gatew(const float* W, const float* g, float* Wg, int gt, int NGT) {
    for (int idx = gt; idx < D * 8; idx += NGT) { const int k = idx >> 3, c = idx & 7; Wg[idx] = g[k] * W[(size_t)k * INC + SRC_GATE + c]; }
}
__device__ __forceinline__ void ph_prep(const float* x, bf16* xb, float* rinv, const float* Wg, float* gates, int nrows, int gw, int NGW, int lane) {
    for (int row = gw; row < nrows; row += NGW) {
        const float4* xr = (const float4*)(x + (size_t)row * D); float4 v[8]; float ss = 0.f;
#pragma unroll
        for (int j = 0; j < 8; ++j) { v[j] = xr[lane + 64 * j]; ss += v[j].x * v[j].x + v[j].y * v[j].y + v[j].z * v[j].z + v[j].w * v[j].w; }
        ss = wave_sum(ss); const float r = 1.0f / sqrtf(ss * (1.0f / D) + RMS_EPS);
        uint2* ob = (uint2*)(xb + (size_t)row * D);
#pragma unroll
        for (int j = 0; j < 8; ++j) { uint2 o; o.x = pk2(v[j].x, v[j].y); o.y = pk2(v[j].z, v[j].w); ob[lane + 64 * j] = o; }
        if (lane == 0) rinv[row] = r;
        if (Wg) {
            float a0 = 0, a1 = 0, a2 = 0, a3 = 0, a4 = 0, a5 = 0, a6 = 0, a7 = 0;
#pragma unroll
            for (int j = 0; j < 8; ++j) {
                const float xe[4] = {v[j].x, v[j].y, v[j].z, v[j].w};
#pragma unroll
                for (int e = 0; e < 4; ++e) { const int k = 4 * (lane + 64 * j) + e; const float4 w0 = *(const float4*)(Wg + (size_t)k * 8), w1 = *(const float4*)(Wg + (size_t)k * 8 + 4);
                    a0 += xe[e] * w0.x; a1 += xe[e] * w0.y; a2 += xe[e] * w0.z; a3 += xe[e] * w0.w; a4 += xe[e] * w1.x; a5 += xe[e] * w1.y; a6 += xe[e] * w1.z; a7 += xe[e] * w1.w; }
            }
            a0 = wave_sum(a0); a1 = wave_sum(a1); a2 = wave_sum(a2); a3 = wave_sum(a3); a4 = wave_sum(a4); a5 = wave_sum(a5); a6 = wave_sum(a6); a7 = wave_sum(a7);
            if (lane == 0) { float4* go = (float4*)(gates + (size_t)row * 8); go[0] = make_float4(a0 * r, a1 * r, a2 * r, a3 * r); go[1] = make_float4(a4 * r, a5 * r, a6 * r, a7 * r); }
        }
    }
}
__device__ __forceinline__ void ph_final(const float* x, const float* g, float* out, int gw, int NGW, int lane) {
    for (int row = gw; row < M; row += NGW) {
        const float4* xr = (const float4*)(x + (size_t)row * D); float4 v[8]; float ss = 0.f;
#pragma unroll
        for (int j = 0; j < 8; ++j) { v[j] = xr[lane + 64 * j]; ss += v[j].x * v[j].x + v[j].y * v[j].y + v[j].z * v[j].z + v[j].w * v[j].w; }
        ss = wave_sum(ss); const float r = 1.0f / sqrtf(ss * (1.0f / D) + RMS_EPS);
        float4* o = (float4*)(out + (size_t)row * D); const float4* gg = (const float4*)g;
#pragma unroll
        for (int j = 0; j < 8; ++j) { const float4 gv = gg[lane + 64 * j]; o[lane + 64 * j] = make_float4(v[j].x * r * gv.x, v[j].y * r * gv.y, v[j].z * r * gv.z, v[j].w * r * gv.w); }
    }
}
__device__ __forceinline__ void ph_lru_gates(float* xc, const bf16* p, const float* cw, const float* cb, const float* wa, const float* ba, const float* wx, const float* bx, const float* lam, float* A, float* U, int vb, int G, int tid) {
    for (int m = vb; m < M; m += G) {
        const int t = m % T, c = tid;
        { float s = cb[c];
#pragma unroll
          for (int j = 0; j < 4; ++j) { const int tt = t - 3 + j; if (tt >= 0) s += cw[j * 512 + c] * bf2f(p[(size_t)(m - 3 + j) * NP + C_LX + c]); }
          xc[c] = s; }
        __syncthreads();
        { const int g = c >> 7, o = c & 127; float ra = ba[c], ri = bx[c];
          for (int i = 0; i < 128; ++i) { const float xv = xc[g * 128 + i]; ra += xv * wa[(size_t)(g * 128 + i) * 128 + o]; ri += xv * wx[(size_t)(g * 128 + i) * 128 + o]; }
          const float r = sigm(ra), ig = sigm(ri); const float la = -8.0f * r * log1pf(expf(-lam[c])); const float a = expf(la); const float u = sqrtf(-expm1f(2.0f * la)) * (ig * xc[c]);
          A[(size_t)m * 512 + c] = a; U[(size_t)m * 512 + c] = u; }
        __syncthreads();
    }
}
__device__ __forceinline__ void ph_lru_scan(const float* A, const float* U, const bf16* p, bf16* y, int gt) {
    if (gt < NB * 512) { const int b = gt / 512, c = gt % 512; float h = 0.f;
        for (int t = 0; t < T; ++t) { const size_t m = (size_t)b * T + t; h = A[m * 512 + c] * h + U[m * 512 + c]; const float z = bf2f(p[m * NP + C_LZ + c]); y[m * D + c] = f2bf(h * silu(z)); } }
}
__device__ __forceinline__ void ph_ml_prep(const bf16* p, const float* cw, const float* cb, const float* wq, const float* wk, const float* wv, bf16* Q, bf16* K, bf16* V, int gt, int NGT) {
    for (int idx = gt; idx < M * 192; idx += NGT) {
        const int m = idx / 192, j = idx % 192, t = m % T;
        float u4[4], uc[4];
#pragma unroll
        for (int i = 0; i < 4; ++i) { const int c = 4 * j + i; float s = cb[c];
#pragma unroll
            for (int jj = 0; jj < 4; ++jj) { const int tt = t - 3 + jj; if (tt >= 0) s += cw[jj * 768 + c] * bf2f(p[(size_t)(m - 3 + jj) * NP + C_MU + c]); }
            uc[i] = silu(s); u4[i] = bf2f(p[(size_t)m * NP + C_MU + c]); }
        const float ks = 0.07216878364870322f;
#pragma unroll
        for (int o = 0; o < 4; ++o) { float q = 0.f, k = 0.f, v = 0.f;
#pragma unroll
            for (int i = 0; i < 4; ++i) { q += uc[i] * wq[(j * 4 + i) * 4 + o]; k += uc[i] * wk[(j * 4 + i) * 4 + o]; v += u4[i] * wv[(j * 4 + i) * 4 + o]; }
            Q[(size_t)m * 768 + 4 * j + o] = f2bf(q); K[(size_t)m * 768 + 4 * j + o] = f2bf(k * ks); V[(size_t)m * 768 + 4 * j + o] = f2bf(v); }
    }
}
__device__ __forceinline__ void ph_ml_F(const float* gates, const float* bi, const float* bf, float* Fb, float* Ib, int vb, int tid) {
    if (vb < 16 && tid == 0) { const int bh = vb, b = bh >> 2, h = bh & 3; float F = 0.f;
        for (int t = 0; t < T; ++t) { const size_t m = (size_t)b * T + t; F += logsig(gates[m * 8 + 4 + h] + bf[h]); Fb[bh * T + t] = F; Ib[bh * T + t] = gates[m * 8 + h] + bi[h]; } }
}
__device__ __forceinline__ void ph_ml_attn(float* L, const bf16* Q, const bf16* K, const bf16* V, const float* Fb, const float* Ib, const bf16* p, const float* ng, bf16* y, int vb, int G, int tid) {
    float* Qs = L; float* Ks = Qs + 32 * 192; float* Vs = Ks + 32 * 193; float* Ss = Vs + 32 * 192; float* Ft = Ss + 32 * 32; float* Fs = Ft + 32; float* Is = Fs + 32;
    const int r = tid >> 4, cl = tid & 15;
    for (int unit = vb; unit < 16 * 64; unit += G) {
        const int bh = unit >> 6, b = bh >> 2, h = bh & 3, t0 = (unit & 63) * 32;
        __syncthreads();
        for (int e = tid; e < 32 * 192; e += NTHR) { const int rr = e / 192, d = e % 192; Qs[rr * 192 + d] = bf2f(Q[(size_t)(b * T + t0 + rr) * 768 + h * 192 + d]); }
        if (tid < 32) Ft[tid] = Fb[bh * T + t0 + tid];
        float acc[12]; float den = 0.f;
#pragma unroll
        for (int i = 0; i < 12; ++i) acc[i] = 0.f;
        for (int s0 = 0; s0 < t0 + 32; s0 += 32) {
            __syncthreads();
            for (int e = tid; e < 32 * 192; e += NTHR) { const int i = e / 192, d = e % 192; const size_t g = (size_t)(b * T + s0 + i) * 768 + h * 192 + d; Ks[i * 193 + d] = bf2f(K[g]); Vs[i * 192 + d] = bf2f(V[g]); }
            if (tid < 32) { Fs[tid] = Fb[bh * T + s0 + tid]; Is[tid] = Ib[bh * T + s0 + tid]; }
            __syncthreads();
#pragma unroll
            for (int w = 0; w < 2; ++w) { const int s = cl + 16 * w; float dot = 0.f;
                for (int d = 0; d < 192; ++d) dot += Qs[r * 192 + d] * Ks[s * 193 + d];
                const int tt = t0 + r, ss = s0 + s; const float wgt = (ss <= tt) ? expf(Ft[r] - Fs[s] + Is[s]) : 0.f; Ss[r * 32 + s] = dot * wgt; }
            __syncthreads();
            for (int s = 0; s < 32; ++s) { const float sv = Ss[r * 32 + s]; den += sv;
#pragma unroll
                for (int i = 0; i < 12; ++i) acc[i] += sv * Vs[s * 192 + cl + 16 * i]; }
        }
        const float dn = fmaxf(fabsf(den), 1.0f); const size_t m = (size_t)b * T + t0 + r; float hv[12]; float s1 = 0.f;
#pragma unroll
        for (int i = 0; i < 12; ++i) { const int d = cl + 16 * i; hv[i] = acc[i] / dn * sigm(bf2f(p[m * NP + C_MO + h * 192 + d])); s1 += hv[i]; }
        s1 += __shfl_xor(s1, 1); s1 += __shfl_xor(s1, 2); s1 += __shfl_xor(s1, 4); s1 += __shfl_xor(s1, 8);
        const float mu = s1 * (1.0f / 192.0f); float s2 = 0.f;
#pragma unroll
        for (int i = 0; i < 12; ++i) { const float dd = hv[i] - mu; s2 += dd * dd; }
        s2 += __shfl_xor(s2, 1); s2 += __shfl_xor(s2, 2); s2 += __shfl_xor(s2, 4); s2 += __shfl_xor(s2, 8);
        const float rs = 1.0f / sqrtf(s2 * (1.0f / 192.0f) + LN_EPS);
#pragma unroll
        for (int i = 0; i < 12; ++i) { const int d = cl + 16 * i; const float z = bf2f(p[m * NP + C_MZ + h * 192 + d]); y[m * D + 512 + h * 192 + d] = f2bf((hv[i] - mu) * rs * ng[h * 192 + d] * silu(z)); }
    }
}
__device__ __forceinline__ void ph_mo_kmean(const bf16* p, float* kmean, int gt, int NGT) {
    for (int idx = gt; idx < NB * 6 * 8 * 128; idx += NGT) {
        const int d = idx & 127, blk = (idx >> 7) & 7, bh = idx >> 10, b = bh / 6, h = bh % 6; float s = 0.f;
        for (int i = 0; i < 256; ++i) s += bf2f(p[(size_t)(b * T + blk * 256 + i) * NP + C_K + h * 128 + d]);
        kmean[idx] = s * (1.0f / 256.0f);
    }
}
__device__ __forceinline__ void ph_mo_sel(const bf16* p, const float* kmean, unsigned char* sel, int gt, int NGT) {
    for (int idx = gt; idx < NB * 6 * T; idx += NGT) {
        const int t = idx % T, bh = idx / T, b = bh / 6, h = bh % 6, bq = t >> 8;
        const bf16* q = p + (size_t)(b * T + t) * NP + C_Q + h * 128;
        float g0 = 0, g1 = 0, g2 = 0, g3 = 0, g4 = 0, g5 = 0, g6 = 0;
        const float* km = kmean + (size_t)bh * 8 * 128;
        for (int d = 0; d < 128; ++d) { const float qv = bf2f(q[d]); g0 += qv * km[d]; g1 += qv * km[128 + d]; g2 += qv * km[256 + d]; g3 += qv * km[384 + d]; g4 += qv * km[512 + d]; g5 += qv * km[640 + d]; g6 += qv * km[768 + d]; }
        const float gv[7] = {g0, g1, g2, g3, g4, g5, g6};
        unsigned mask = 0;
        if (bq <= 3) mask = (1u << bq) - 1u;
        else {
#pragma unroll
            for (int pass = 0; pass < 3; ++pass) { float best = -INFINITY; int bi = -1;
#pragma unroll
                for (int j = 0; j < 7; ++j) if (j < bq && !((mask >> j) & 1u) && gv[j] > best) { best = gv[j]; bi = j; }
                if (bi >= 0) mask |= 1u << bi; }
        }
        mask |= 1u << bq;
        sel[(size_t)(b * T + t) * 8 + h] = (unsigned char)mask;
    }
}
template <int MODE> __device__ __forceinline__ void ph_attn32(float* L, const bf16* Qp, int ldq, int qcol, const bf16* Kp, const bf16* Vp, int ldk, const unsigned char* sel, const bf16* zp, bf16* outp, int ldo, int ocol, int vb, int G, int tid) {
    float* Qs = L; float* Ks = Qs + 32 * 128; float* Vs = Ks + 32 * 129; float* Ss = Vs + 32 * 128; unsigned* anym = (unsigned*)(Ss + 32 * 32);
    constexpr int NH = MODE == 0 ? 6 : 4; const int r = tid >> 4, cl = tid & 15;
    for (int unit = vb; unit < NB * NH * 64; unit += G) {
        const int bh = unit >> 6, b = bh / NH, h = bh % NH, t0 = (unit & 63) * 32; const size_t m = (size_t)b * T + t0 + r;
        __syncthreads();
        for (int e = tid; e < 32 * 128; e += NTHR) { const int rr = e >> 7, d = e & 127; Qs[rr * 128 + d] = bf2f(Qp[(size_t)(b * T + t0 + rr) * ldq + qcol + h * 128 + d]); }
        unsigned mymask = 0xffffffffu;
        if (MODE == 0) { if (tid == 0) *anym = 0; __syncthreads(); mymask = sel[m * 8 + h]; if (cl == 0) atomicOr(anym, mymask); __syncthreads(); }
        const float scale = 0.08838834764831845f;
        float slope = 0.f;
        if (MODE == 0) { slope = (h == 0) ? 0.25f : (h == 1) ? 0.0625f : (h == 2) ? 0.015625f : (h == 3) ? 0.00390625f : (h == 4) ? 0.5f : 0.125f; }
        float acc[8]; float mrun = -1e30f, l = 0.f;
#pragma unroll
        for (int i = 0; i < 8; ++i) acc[i] = 0.f;
        const int nblk = MODE == 0 ? (t0 >> 8) + 1 : 1; const unsigned am = MODE == 0 ? *anym : 1u;
        const int kbase = MODE == 0 ? b * T : b * MEM;
        for (int j = 0; j < nblk; ++j) {
            if (!((am >> j) & 1u)) continue;
            for (int ch = 0; ch < 8; ++ch) {
                const int s0 = j * 256 + ch * 32; if (MODE == 0 && s0 > t0 + 31) break;
                __syncthreads();
                for (int e = tid; e < 32 * 128; e += NTHR) { const int i = e >> 7, d = e & 127; const size_t g = (size_t)(kbase + s0 + i) * ldk + h * 128 + d; Ks[i * 129 + d] = bf2f(Kp[g]); Vs[i * 128 + d] = bf2f(Vp[g]); }
                __syncthreads();
#pragma unroll
                for (int w = 0; w < 2; ++w) { const int s = cl + 16 * w; float dot = 0.f;
                    for (int d = 0; d < 128; ++d) dot += Qs[r * 128 + d] * Ks[s * 129 + d];
                    float lg = dot * scale;
                    if (MODE == 0) { const int tt = t0 + r, ss = s0 + s; const bool valid = ((mymask >> j) & 1u) && (ss <= tt); lg = valid ? lg - slope * (float)(tt - ss) : -INFINITY; }
                    Ss[r * 32 + s] = lg; }
                __syncthreads();
                float mx = -INFINITY;
                for (int s = 0; s < 32; ++s) mx = fmaxf(mx, Ss[r * 32 + s]);
                const float mnew = fmaxf(mrun, mx); const float corr = expf(mrun - mnew); l *= corr;
#pragma unroll
                for (int i = 0; i < 8; ++i) acc[i] *= corr;
                for (int s = 0; s < 32; ++s) { const float pv = expf(Ss[r * 32 + s] - mnew); l += pv;
#pragma unroll
                    for (int i = 0; i < 8; ++i) acc[i] += pv * Vs[s * 128 + cl + 16 * i]; }
                mrun = mnew;
            }
        }
        const float inv = 1.0f / l;
#pragma unroll
        for (int i = 0; i < 8; ++i) { const int d = cl + 16 * i; float o = acc[i] * inv;
            if (MODE == 0) { const float z = bf2f(zp[m * NP + C_Z + h * 128 + d]); o *= silu(z); }
            outp[m * ldo + ocol + h * 128 + d] = f2bf(o); }
    }
}

typedef const __attribute__((address_space(4))) Args* kargs_t;
#define PH_VARS \
    kargs_t ap = (kargs_t)__builtin_amdgcn_kernarg_segment_ptr(); asm volatile("" : "+s"(ap)); \
    unsigned char* const ws = ap->ws; (void)ws; \
    int tid = threadIdx.x; asm volatile("" : "+v"(tid)); const int lane = tid & 63, wave = __builtin_amdgcn_readfirstlane(tid >> 6); (void)lane; \
    const int G = gridDim.x, vb = blockIdx.x, gw = vb * NWAVES + wave, NGW = G * NWAVES, gt = vb * NTHR + tid, NGT = G * NTHR; (void)gw; (void)NGW; (void)gt; (void)NGT; \
    float* const Lf = (float*)lds; (void)Lf; LAS unsigned char* const ldsl = (LAS unsigned char*)lds; (void)ldsl;
#define WSP(T, off) ((T*)(ws + (off)))
__global__ void __launch_bounds__(NTHR, 2) mk_fwd(Args a_unused) {
    extern __shared__ __attribute__((aligned(16))) unsigned char lds[];
    XcdBarrier bar;
    { PH_VARS
      for (int u = tid; u < (LDS_BYTES - LDSCTL_OFF) / 4; u += NTHR) ((LAS unsigned*)(ldsl + LDSCTL_OFF))[u] = 0u;
      __syncthreads();
      bar = xcd_barrier_post((unsigned*)(ws + WS_CTL) + CW_BAR, (volatile LAS unsigned*)(ldsl + MISC_OFF) + 8); }
#define GRID_BAR() xcd_barrier(bar)
    { PH_VARS
      float* scr = Lf + wave * (64 * 33);
      for (int l = 0; l < DEPTH; ++l) {
        ph_wt(ap->in[3] + (size_t)l * D * INC, INC, D, NP, ap->in[2] + l * D, WSP(bf16, WS_WIN) + (size_t)l * NP * D, 1, scr, gw, NGW, lane);
        ph_gatew(ap->in[3] + (size_t)l * D * INC, ap->in[2] + l * D, WSP(float, WS_WG) + (size_t)l * D * 8, gt, NGT);
        ph_wt(ap->in[19] + (size_t)l * D * D, D, D, D, nullptr, WSP(bf16, WS_WOUT) + (size_t)l * D * D, 0, scr, gw, NGW, lane);
        ph_wt(ap->in[22] + (size_t)l * D * 512, 512, D, 512, ap->in[20] + l * D, WSP(bf16, WS_WQ) + (size_t)l * 512 * D, 0, scr, gw, NGW, lane);
        ph_wt(ap->in[23] + (size_t)l * D * 1024, 1024, D, 1024, ap->in[21] + l * D, WSP(bf16, WS_WKV) + (size_t)l * 1024 * D, 0, scr, gw, NGW, lane);
        ph_wt(ap->in[24] + (size_t)l * 512 * D, D, 512, D, nullptr, WSP(bf16, WS_WO) + (size_t)l * D * 512, 0, scr, gw, NGW, lane);
      }
      ph_prep(ap->in[1], WSP(bf16, WS_MEMB), WSP(float, WS_RINVM), nullptr, nullptr, MM, gw, NGW, lane); }
    GRID_BAR();
    { PH_VARS ph_prep(ap->in[0], WSP(bf16, WS_XB), WSP(float, WS_RINV), WSP(float, WS_WG), WSP(float, WS_GATES), M, gw, NGW, lane); }
    GRID_BAR();
#pragma unroll 1
    for (int l = 0; l < DEPTH; ++l) { PH_VARS
        pg8::Gemm g{WSP(bf16, WS_MEMB), WSP(bf16, WS_WKV) + (size_t)l * 1024 * D, MM, 1024, D, 0}; EpiScaleBf16 E{WSP(bf16, WS_KV) + (size_t)l * MM * 1024, WSP(float, WS_RINVM), 1024, 0};
        pg8::StaticOrder S; S.init(MM, 1024, G, (vb + 64 + 32 * l) % G);
        pg8::gemm_phase<EpiScaleBf16, pg8::StaticOrder, true, true>(ldsl, g, S, E);
    }
#pragma unroll 1
    for (int l = 0; l < DEPTH; ++l) {
        { PH_VARS pg8::Gemm g{WSP(bf16, WS_XB), WSP(bf16, WS_WIN) + (size_t)l * NP * D, M, NP, D, 0}; EpiScaleBf16 E{WSP(bf16, WS_P), WSP(float, WS_RINV), NP, 0}; pg8::StaticOrder S; S.init(M, NP, G, vb);
          pg8::gemm_phase<EpiScaleBf16, pg8::StaticOrder, true, true>(ldsl, g, S, E); }
        GRID_BAR();
        { PH_VARS ph_lru_gates(Lf, WSP(bf16, WS_P), ap->in[4] + l * 4 * 512, ap->in[5] + l * 512, ap->in[6] + (size_t)l * 4 * 128 * 128, ap->in[7] + l * 512, ap->in[8] + (size_t)l * 4 * 128 * 128, ap->in[9] + l * 512, ap->in[10] + l * 512, WSP(float, WS_A), WSP(float, WS_U), vb, G, tid); }
        { PH_VARS ph_ml_prep(WSP(bf16, WS_P), ap->in[11] + l * 4 * 768, ap->in[12] + l * 768, ap->in[13] + l * 192 * 16, ap->in[14] + l * 192 * 16, ap->in[15] + l * 192 * 16, WSP(bf16, WS_MQ), WSP(bf16, WS_MK), WSP(bf16, WS_MV), gt, NGT); }
        { PH_VARS ph_ml_F(WSP(float, WS_GATES), ap->in[16] + l * 4, ap->in[17] + l * 4, WSP(float, WS_F), WSP(float, WS_I), vb, tid);
          ph_mo_kmean(WSP(bf16, WS_P), WSP(float, WS_KMEAN), gt, NGT); }
        GRID_BAR();
        { PH_VARS ph_lru_scan(WSP(float, WS_A), WSP(float, WS_U), WSP(bf16, WS_P), WSP(bf16, WS_Y), gt);
          ph_mo_sel(WSP(bf16, WS_P), WSP(float, WS_KMEAN), WSP(unsigned char, WS_SEL), gt, NGT); }
        { PH_VARS ph_ml_attn(Lf, WSP(bf16, WS_MQ), WSP(bf16, WS_MK), WSP(bf16, WS_MV), WSP(float, WS_F), WSP(float, WS_I), WSP(bf16, WS_P), ap->in[18] + l * 768, WSP(bf16, WS_Y), vb, G, tid); }
        GRID_BAR();
        { PH_VARS ph_attn32<0>(Lf, WSP(bf16, WS_P), NP, C_Q, WSP(bf16, WS_P) + C_K, WSP(bf16, WS_P) + C_V, NP, WSP(unsigned char, WS_SEL), WSP(bf16, WS_P), WSP(bf16, WS_Y), D, 1280, vb, G, tid); }
        GRID_BAR();
        { PH_VARS const float* xcur = l == 0 ? ap->in[0] : WSP(float, WS_XRES);
          pg8::Gemm g{WSP(bf16, WS_Y), WSP(bf16, WS_WOUT) + (size_t)l * D * D, M, D, D, 0}; EpiResF32 E{xcur, WSP(float, WS_XRES), D, 0}; pg8::StaticOrder S; S.init(M, D, G, vb);
          pg8::gemm_phase<EpiResF32, pg8::StaticOrder, true, true>(ldsl, g, S, E); }
        GRID_BAR();
        { PH_VARS ph_prep(WSP(float, WS_XRES), WSP(bf16, WS_XB), WSP(float, WS_RINV), nullptr, nullptr, M, gw, NGW, lane); }
        GRID_BAR();
        { PH_VARS pg8::Gemm g{WSP(bf16, WS_XB), WSP(bf16, WS_WQ) + (size_t)l * 512 * D, M, 512, D, 0}; EpiScaleBf16 E{WSP(bf16, WS_XQ), WSP(float, WS_RINV), 512, 0}; pg8::StaticOrder S; S.init(M, 512, G, vb);
          pg8::gemm_phase<EpiScaleBf16, pg8::StaticOrder, true, true>(ldsl, g, S, E); }
        GRID_BAR();
        { PH_VARS const bf16* kvl = WSP(bf16, WS_KV) + (size_t)l * MM * 1024; ph_attn32<1>(Lf, WSP(bf16, WS_XQ), 512, 0, kvl, kvl + 512, 1024, nullptr, nullptr, WSP(bf16, WS_XO), 512, 0, vb, G, tid); }
        GRID_BAR();
        { PH_VARS pg8::Gemm g{WSP(bf16, WS_XO), WSP(bf16, WS_WO) + (size_t)l * D * 512, M, D, 512, 0}; EpiResF32 E{WSP(float, WS_XRES), WSP(float, WS_XRES), D, 0}; pg8::StaticOrder S; S.init(M, D, G, vb);
          pg8::gemm_phase<EpiResF32, pg8::StaticOrder, true, true>(ldsl, g, S, E); }
        GRID_BAR();
        if (l + 1 < DEPTH) { { PH_VARS ph_prep(WSP(float, WS_XRES), WSP(bf16, WS_XB), WSP(float, WS_RINV), WSP(float, WS_WG) + (size_t)(l + 1) * D * 8, WSP(float, WS_GATES), M, gw, NGW, lane); } GRID_BAR(); }
    }
    { PH_VARS ph_final(WSP(float, WS_XRES), ap->in[25], ap->out, gw, NGW, lane); }
}

extern "C" void kernel_launch(void* const* d_in, const int* in_sizes, int n_in, void* d_out, int out_size, void* d_ws, size_t ws_size, hipStream_t stream) {
    static int grid = 0;
    if (grid == 0) {
        if (ws_size < WS_END || n_in != 26) { fprintf(stderr, "kernel_launch: ws_size %zu < %zu or n_in %d != 26\n", ws_size, (size_t)WS_END, n_in); grid = -1; return; }
        int dev = 0, cus = 0, per_cu = 0;
        if (hipGetDevice(&dev) != hipSuccess || hipDeviceGetAttribute(&cus, hipDeviceAttributeMultiprocessorCount, dev) != hipSuccess) { grid = -1; return; }
        if (hipFuncSetAttribute((const void*)mk_fwd, hipFuncAttributeMaxDynamicSharedMemorySize, LDS_BYTES) != hipSuccess) { fprintf(stderr, "kernel_launch: hipFuncSetAttribute failed\n"); grid = -1; return; }
        if (hipOccupancyMaxActiveBlocksPerMultiprocessor(&per_cu, (const void*)mk_fwd, NTHR, LDS_BYTES) != hipSuccess || per_cu < 1) fprintf(stderr, "kernel_launch: occupancy query reports %d\n", per_cu);
        (void)hipGetLastError();
        grid = cus;
    }
    if (grid < 0) return;
    if (hipMemsetAsync((char*)d_ws + WS_CTL, 0, CTL_ZERO_BYTES, stream) != hipSuccess) { fprintf(stderr, "kernel_launch: memset failed\n"); return; }
    Args a{};
    for (int i = 0; i < 26; ++i) a.in[i] = (const float*)d_in[i];
    a.out = (float*)d_out; a.ws = (unsigned char*)d_ws;
    hipLaunchKernelGGL(mk_fwd, dim3(grid), dim3(NTHR), LDS_BYTES, stream, a);
}
```

```cpp
#include <hip/hip_runtime.h>
#include <cstdio>
#include <cstdint>
namespace pg8 {
#define PG8_LAS __attribute__((address_space(3)))
typedef unsigned short bf16_t;
typedef short bf16x8 __attribute__((ext_vector_type(8)));
typedef float f32x4 __attribute__((ext_vector_type(4)));
typedef unsigned u32x4 __attribute__((ext_vector_type(4)));
constexpr int BM = 256, BK = 64, HALF = 128, HTB = HALF * BK * 2  , STAGE_BYTES = 8 * HTB, NXCD = 8, WGM = 8;

__host__ __device__ __forceinline__ int lds_byte(int r, int c) { const int st = (r >> 4) * 2 + (c >> 5), rr = r & 15, cc = c & 31, ob = rr * 64 + cc * 2; return st * 1024 + (ob ^ (((ob >> 9) & 1) << 5)); }
__host__ __device__ __forceinline__ void stage_rc(int b, int& R, int& C) { const int st = b / 1024, sb = b % 1024, swz = sb ^ (((sb >> 9) & 1) << 5); R = (st >> 1) * 16 + swz / 64; C = (st & 1) * 32 + (swz % 64) / 2; }
__host__ __device__ __forceinline__ int perm32(int rho) { const int n = rho >> 4, i = rho & 15; return 8 * (i >> 2) + 4 * n + (i & 3); }

struct Unit { int pm, pn; };
struct Gemm { const bf16_t* A; const bf16_t* Bt; int M, N, K, pad; };

struct StaticOrder {
    int nM, nN, nwg, G, c;
    __host__ __device__ void init(int M, int N, int G_, int c_) { nM = M / BM; nN = N / BM; nwg = nM * nN; G = G_; c = c_; }
    __host__ __device__ bool next(int i, Unit& u) const {
        const long L = (long)i * G + c; if (L >= nwg) return false;
        int wgid = (int)L; { const int q = nwg / NXCD, r = nwg % NXCD, xcd = wgid % NXCD, off = wgid / NXCD; wgid = (xcd < r ? xcd * (q + 1) : r * (q + 1) + (xcd - r) * q) + off; }
        const int nig = WGM * nN, gid = wgid / nig, fm = gid * WGM, gsz = (nM - fm) < WGM ? (nM - fm) : WGM;
        u.pm = fm + ((wgid % nig) % gsz); u.pn = (wgid % nig) / gsz; return true;
    }
    __device__ __forceinline__ void a_ready(const Unit&) const {}
    __device__ __forceinline__ void done(const Unit&) const {}
};

__device__ __forceinline__ unsigned cvt_pk_bf16(float lo, float hi) { unsigned r; asm volatile("v_cvt_pk_bf16_f32 %0, %1, %2" : "=v"(r) : "v"(lo), "v"(hi)); return r; }
template <class Epi, class Sched, bool ALIGN_EPI = false, bool SP2 = false>
__device__ __forceinline__ void gemm_phase(PG8_LAS unsigned char* lds, const Gemm g, const Sched& S, const Epi& E) {
    int tid_ = threadIdx.x; asm volatile("" : "+v"(tid_));
    const int tid = tid_, wid = __builtin_amdgcn_readfirstlane(tid >> 6), lane = tid & 63, wr = wid >> 2, wc = wid & 3, fr = lane & 15, fq = lane >> 4;
    const int K = g.K, nt = K / BK;
    unsigned voffA[2], voffB[2];
#pragma unroll
    for (int i = 0; i < 2; ++i) { int R, C; stage_rc(tid * 16 + i * 8192, R, C); const int Rb = Epi::PERM ? ((R & ~31) + perm32(R & 31)) : R;
        voffA[i] = (unsigned)(R * K + C) * 2u; voffB[i] = (unsigned)(Rb * K + C) * 2u; }
    const size_t kstep = (size_t)(BK * 2);
    const size_t hstep = (size_t)HALF * K * 2;
    const size_t tstep = 2 * hstep;
    const unsigned ldsw = (unsigned)wid * 1024u;
    const int aoff = lds_byte(wr * 64 + fr, fq * 8), boff = lds_byte(wc * 32 + fr, fq * 8);
#define PG8_SA(b, h) (((b) * 2 + (h)) * HTB)
#define PG8_SB(b, h) ((4 + (b) * 2 + (h)) * HTB)
#define PG8_STAGE(bufoff, gbase, voff) do { _Pragma("unroll") for (int _i = 0; _i < 2; ++_i) \
        __builtin_amdgcn_global_load_lds((const unsigned*)((const char*)(gbase) + (voff)[_i]), (PG8_LAS unsigned*)(lds + (bufoff) + ldsw + _i * 8192), 16, 0, 0); } while (0)
#define PG8_LDA(dst, b, h) do { _Pragma("unroll") for (int m = 0; m < 4; ++m) _Pragma("unroll") for (int k = 0; k < 2; ++k) dst[m][k] = *(const PG8_LAS bf16x8*)(lds + PG8_SA(b, h) + aoff + m * 2048 + k * 1024); } while (0)
#define PG8_LDB(dst, b, h) do { _Pragma("unroll") for (int n = 0; n < 2; ++n) _Pragma("unroll") for (int k = 0; k < 2; ++k) dst[n][k] = *(const PG8_LAS bf16x8*)(lds + PG8_SB(b, h) + boff + n * 2048 + k * 1024); } while (0)
#define PG8_MMA(ai, bj, At, Bt) do { __builtin_amdgcn_s_setprio(1); _Pragma("unroll") for (int m = 0; m < 4; ++m) _Pragma("unroll") for (int n = 0; n < 2; ++n) _Pragma("unroll") for (int k = 0; k < 2; ++k) \
        acc[ai][bj][m][n] = __builtin_amdgcn_mfma_f32_16x16x32_bf16(Bt[n][k], At[m][k], acc[ai][bj][m][n], 0, 0, 0); __builtin_amdgcn_s_setprio(0); } while (0)
#define PG8_WAIT_V(n) asm volatile("s_waitcnt vmcnt(" #n ")" ::: "memory")
#define PG8_WAIT_L(n) asm volatile("s_waitcnt lgkmcnt(" #n ")" ::: "memory")
#define PG8_BAR __builtin_amdgcn_s_barrier()
#define PG8_SCHED __builtin_amdgcn_sched_barrier(0)
    Unit cur, nxt; int ui = 0;
    if (!S.next(0, cur)) return;
    f32x4 acc[2][2][4][2];
#pragma unroll
    for (int a = 0; a < 2; ++a)
#pragma unroll
        for (int b = 0; b < 2; ++b)
#pragma unroll
            for (int m = 0; m < 4; ++m)
#pragma unroll
                for (int n = 0; n < 2; ++n) acc[a][b][m][n] = (f32x4){0.f, 0.f, 0.f, 0.f};
    bf16x8 At[4][2], B0[2][2], B1[2][2];
    const char* cA = (const char*)g.A + (size_t)cur.pm * tstep; const char* cB = (const char*)g.Bt + (size_t)cur.pn * tstep;
    S.a_ready(cur);
    if constexpr (SP2) {
        PG8_STAGE(PG8_SB(0, 0), cB, voffB); PG8_STAGE(PG8_SB(0, 1), cB + hstep, voffB); PG8_STAGE(PG8_SA(0, 0), cA, voffA); PG8_STAGE(PG8_SA(0, 1), cA + hstep, voffA);
        if (wr == 1) PG8_BAR;
        PG8_WAIT_V(2); PG8_BAR;
        PG8_STAGE(PG8_SB(1, 0), cB + kstep, voffB); PG8_STAGE(PG8_SA(1, 0), cA + kstep, voffA); PG8_STAGE(PG8_SB(1, 1), cB + hstep + kstep, voffB);
        PG8_WAIT_V(6); PG8_BAR;
    } else {
        PG8_STAGE(PG8_SB(0, 0), cB, voffB); PG8_STAGE(PG8_SA(0, 0), cA, voffA); PG8_STAGE(PG8_SB(0, 1), cB + hstep, voffB); PG8_STAGE(PG8_SA(0, 1), cA + hstep, voffA);
        if (wr == 1) PG8_BAR;
        PG8_WAIT_V(4); PG8_BAR;
        PG8_STAGE(PG8_SB(1, 0), cB + kstep, voffB); PG8_STAGE(PG8_SA(1, 0), cA + kstep, voffA); PG8_STAGE(PG8_SB(1, 1), cB + hstep + kstep, voffB);
        PG8_WAIT_V(6); PG8_BAR;
    }
    for (;;) {
        const bool has_next = S.next(ui + 1, nxt);
        const char* nA = has_next ? (const char*)g.A + (size_t)nxt.pm * tstep : cA; const char* nB = has_next ? (const char*)g.Bt + (size_t)nxt.pn * tstep : cB;
        for (int t = 0; t < nt; t += 2) {
            const bool last = (t == nt - 2);
            const char* a1 = cA + (size_t)(t + 1) * kstep;
            const char* a2 = last ? nA : cA + (size_t)(t + 2) * kstep; const char* b2 = last ? nB : cB + (size_t)(t + 2) * kstep;
            const char* a3 = a2 + kstep; const char* b3 = b2 + kstep;
            if (last && has_next) S.a_ready(nxt);
            if constexpr (SP2) {
            PG8_LDB(B0, 0, 0); PG8_LDB(B1, 0, 1); PG8_SCHED; PG8_LDA(At, 0, 0); PG8_STAGE(PG8_SA(1, 1), a1 + hstep, voffA);
            PG8_WAIT_V(8); PG8_WAIT_L(0); PG8_BAR; PG8_MMA(0, 0, At, B0); PG8_MMA(0, 1, At, B1); PG8_BAR; PG8_SCHED;
            PG8_LDA(At, 0, 1); PG8_STAGE(PG8_SB(0, 0), b2, voffB); PG8_STAGE(PG8_SB(0, 1), b2 + hstep, voffB); PG8_STAGE(PG8_SA(0, 0), a2, voffA);
            PG8_WAIT_V(8); PG8_WAIT_L(0); PG8_BAR; PG8_MMA(1, 0, At, B0); PG8_MMA(1, 1, At, B1); PG8_BAR; PG8_SCHED;
            PG8_LDB(B0, 1, 0); PG8_LDB(B1, 1, 1); PG8_SCHED; PG8_LDA(At, 1, 0); PG8_STAGE(PG8_SA(0, 1), a2 + hstep, voffA);
            PG8_WAIT_V(8); PG8_WAIT_L(0); PG8_BAR; PG8_MMA(0, 0, At, B0); PG8_MMA(0, 1, At, B1); PG8_BAR; PG8_SCHED;
            PG8_LDA(At, 1, 1); PG8_STAGE(PG8_SB(1, 0), b3, voffB); PG8_STAGE(PG8_SB(1, 1), b3 + hstep, voffB); PG8_STAGE(PG8_SA(1, 0), a3, voffA);
            PG8_WAIT_V(8); PG8_WAIT_L(0); PG8_BAR; PG8_MMA(1, 0, At, B0); PG8_MMA(1, 1, At, B1); PG8_BAR; PG8_SCHED;
            } else {
            PG8_LDB(B0, 0, 0); PG8_SCHED; PG8_LDA(At, 0, 0); PG8_STAGE(PG8_SA(1, 1), a1 + hstep, voffA);
            PG8_WAIT_L(8); PG8_BAR; PG8_WAIT_L(0); PG8_MMA(0, 0, At, B0); PG8_BAR; PG8_SCHED;
            PG8_LDB(B1, 0, 1); PG8_STAGE(PG8_SB(0, 0), b2, voffB);
            PG8_BAR; PG8_WAIT_L(0); PG8_MMA(0, 1, At, B1); PG8_BAR;
            PG8_LDA(At, 0, 1); PG8_STAGE(PG8_SA(0, 0), a2, voffA);
            PG8_BAR; PG8_WAIT_L(0); PG8_MMA(1, 0, At, B0); PG8_BAR; PG8_SCHED;
            PG8_STAGE(PG8_SB(0, 1), b2 + hstep, voffB);
            PG8_WAIT_V(6); PG8_BAR; PG8_MMA(1, 1, At, B1); PG8_BAR;
            PG8_LDB(B0, 1, 0); PG8_SCHED; PG8_LDA(At, 1, 0); PG8_STAGE(PG8_SA(0, 1), a2 + hstep, voffA);
            PG8_WAIT_L(8); PG8_BAR; PG8_WAIT_L(0); PG8_MMA(0, 0, At, B0); PG8_BAR; PG8_SCHED;
            PG8_LDB(B1, 1, 1); PG8_STAGE(PG8_SB(1, 0), b3, voffB);
            PG8_BAR; PG8_WAIT_L(0); PG8_MMA(0, 1, At, B1); PG8_BAR;
            PG8_LDA(At, 1, 1); PG8_STAGE(PG8_SA(1, 0), a3, voffA);
            PG8_BAR; PG8_WAIT_L(0); PG8_MMA(1, 0, At, B0); PG8_BAR; PG8_SCHED;
            PG8_STAGE(PG8_SB(1, 1), b3 + hstep, voffB);
            PG8_WAIT_V(6); PG8_BAR; PG8_MMA(1, 1, At, B1); PG8_BAR;
            }
        }
        if constexpr (ALIGN_EPI) { if (wr == 0) PG8_BAR; }
        if constexpr (!Epi::AFTER_DRAIN) { E(acc, cur, wr, wc, fr, fq); S.done(cur); }
        if (!has_next) break;
#pragma unroll
        for (int a = 0; a < 2; ++a)
#pragma unroll
            for (int b = 0; b < 2; ++b)
#pragma unroll
                for (int m = 0; m < 4; ++m)
#pragma unroll
                    for (int n = 0; n < 2; ++n) acc[a][b][m][n] = (f32x4){0.f, 0.f, 0.f, 0.f};
        cur = nxt; cA = nA; cB = nB; ++ui;
        if constexpr (ALIGN_EPI) { if (wr == 1) PG8_BAR; }
    }
    PG8_WAIT_V(0);
    if constexpr (!ALIGN_EPI) { if (wr == 0) PG8_BAR; }
    PG8_BAR;
    if constexpr (Epi::AFTER_DRAIN) { E.fused(acc, cur, wr, wc, fr, fq, lds, wid, lane); S.done(cur); }
#undef PG8_SA
#undef PG8_SB
#undef PG8_STAGE
#undef PG8_LDA
#undef PG8_LDB
#undef PG8_MMA
#undef PG8_WAIT_V
#undef PG8_WAIT_L
#undef PG8_BAR
#undef PG8_SCHED
}
}

constexpr int NB = 4, T = 2048, D = 2048, M = NB * T, DEPTH = 2, MEM = 256, MM = NB * MEM;
constexpr int INC = 6408, NP = 6400;
constexpr int ML_DH = 192, MO_DH = 128;
constexpr int C_LX = 0, C_LZ = 512, C_MU = 1024, C_MO = 1792, C_MZ = 2560, C_Q = 3328, C_K = 4096, C_V = 4864, C_Z = 5632;
constexpr int SRC_GATE = 3328;
constexpr float RMS_EPS = 1e-6f, LN_EPS = 1e-5f;

typedef unsigned short bf16;
#define LAS __attribute__((address_space(3)))
__device__ __forceinline__ float bf2f(bf16 v) { return __uint_as_float(((unsigned)v) << 16); }
__device__ __forceinline__ bf16 f2bf(float f) { unsigned u = __float_as_uint(f); return (bf16)((u + 0x7fffu + ((u >> 16) & 1u)) >> 16); }
__device__ __forceinline__ unsigned pk2(float lo, float hi) { return (unsigned)f2bf(lo) | ((unsigned)f2bf(hi) << 16); }
__device__ __forceinline__ float sigm(float x) { return 1.f / (1.f + expf(-x)); }
__device__ __forceinline__ float silu(float x) { return x / (1.f + expf(-x)); }
__device__ __forceinline__ float logsig(float x) { return fminf(x, 0.f) - log1pf(expf(-fabsf(x))); }
__device__ __forceinline__ float wave_sum(float v) {
#pragma unroll
    for (int o = 1; o < 64; o <<= 1) v += __shfl_xor(v, o);
    return v;
}

constexpr size_t al256(size_t x) { return (x + 255) & ~(size_t)255; }
constexpr size_t WS_CTL = 0;
constexpr size_t WS_WIN = 1u << 20;
constexpr size_t WS_WOUT = WS_WIN + (size_t)DEPTH * NP * D * 2;
constexpr size_t WS_WQ = WS_WOUT + (size_t)DEPTH * D * D * 2;
constexpr size_t WS_WKV = WS_WQ + (size_t)DEPTH * 512 * D * 2;
constexpr size_t WS_WO = WS_WKV + (size_t)DEPTH * 1024 * D * 2;
constexpr size_t WS_WG = WS_WO + (size_t)DEPTH * D * 512 * 2;
constexpr size_t WS_MEMB = WS_WG + (size_t)DEPTH * D * 8 * 4;
constexpr size_t WS_RINVM = WS_MEMB + (size_t)MM * D * 2;
constexpr size_t WS_KV = WS_RINVM + (size_t)MM * 4;
constexpr size_t WS_XB = WS_KV + (size_t)DEPTH * MM * 1024 * 2;
constexpr size_t WS_RINV = WS_XB + (size_t)M * D * 2;
constexpr size_t WS_GATES = WS_RINV + (size_t)M * 4;
constexpr size_t WS_XRES = WS_GATES + (size_t)M * 8 * 4;
constexpr size_t WS_Y = WS_XRES + (size_t)M * D * 4;
constexpr size_t WS_P = WS_Y + (size_t)M * D * 2;
constexpr size_t WS_A = WS_P + (size_t)M * NP * 2;
constexpr size_t WS_U = WS_A + (size_t)M * 512 * 4;
constexpr size_t WS_MQ = WS_U + (size_t)M * 512 * 4;
constexpr size_t WS_MK = WS_MQ + (size_t)M * 768 * 2;
constexpr size_t WS_MV = WS_MK + (size_t)M * 768 * 2;
constexpr size_t WS_F = WS_MV + (size_t)M * 768 * 2;
constexpr size_t WS_I = WS_F + (size_t)16 * T * 4;
constexpr size_t WS_KMEAN = WS_I + (size_t)16 * T * 4;
constexpr size_t WS_SEL = WS_KMEAN + (size_t)NB * 6 * 8 * 128 * 4;
constexpr size_t WS_MOVT = WS_SEL + (size_t)M * 8;
constexpr size_t WS_END = WS_MOVT + (size_t)NB * 6 * 128 * T * 2;
constexpr size_t WS_XQ = WS_P;
constexpr size_t WS_XO = WS_P + (size_t)M * 512 * 2;
constexpr size_t WS_MKT = WS_XB;
constexpr size_t WS_CPREV = WS_XB + (size_t)16 * 192 * T * 2;
static_assert(WS_CPREV + (size_t)256 * 36864 * 2 <= WS_RINV, "xb overlay");
constexpr size_t WS_VTM = WS_MEMB;
constexpr size_t WS_LRUW = 512u << 10;
constexpr size_t OUT_CLOC = 0, OUT_NLOC = (size_t)256 * 36864, OUT_NPREV = OUT_NLOC + 256 * 192, OUT_AGGA = OUT_NPREV + 256 * 192, OUT_AGGH = OUT_AGGA + 512 * 512, OUT_CARRY = OUT_AGGH + 512 * 512;
static_assert(OUT_CARRY + 512 * 512 <= (size_t)M * D, "d_out scratch");
static_assert(WS_END <= 419954688ull, "workspace map exceeds the guaranteed ws_size");

__device__ __forceinline__ void wt_item(const float* W, int ldw, int src_col, const float* g, bf16* Wt, int K, int dst_row, float* scr, int k0, int lane) {
#pragma unroll 8
    for (int i = 0; i < 32; ++i) { const int kk = 2 * i + (lane >> 5); float v = W[(size_t)(k0 + kk) * ldw + src_col + (lane & 31)]; if (g) v *= g[k0 + kk]; scr[kk * 33 + (lane & 31)] = v; }
    __builtin_amdgcn_s_waitcnt(0xc07f); asm volatile("" ::: "memory");
    const int c = lane & 7;
#pragma unroll
    for (int j = 0; j < 4; ++j) { const int n = (lane >> 3) + 8 * j; const float* s = scr + (8 * c) * 33 + n;
        uint4 o; o.x = pk2(s[0 * 33], s[1 * 33]); o.y = pk2(s[2 * 33], s[3 * 33]); o.z = pk2(s[4 * 33], s[5 * 33]); o.w = pk2(s[6 * 33], s[7 * 33]);
        *(uint4*)(Wt + (size_t)(dst_row + n) * K + k0 + 8 * c) = o; }
    __builtin_amdgcn_s_waitcnt(0xc07f); asm volatile("" ::: "memory");
}
struct EpiScaleBf16 {
    static constexpr bool PERM = true, AFTER_DRAIN = false;
    bf16* O; const float* rs; int ldc, pad;
    __device__ __forceinline__ void operator()(const pg8::f32x4 (&acc)[2][2][4][2], const pg8::Unit& u, int wr, int wc, int fr, int fq) const {
        const int row0 = u.pm * 256 + wr * 64 + fr, col0 = u.pn * 256 + wc * 32 + 8 * fq;
#pragma unroll
        for (int ai = 0; ai < 2; ++ai)
#pragma unroll
            for (int m = 0; m < 4; ++m) { const int row = row0 + ai * 128 + m * 16; const float s = rs ? rs[row] : 1.f; bf16* rowp = O + (size_t)row * ldc + col0;
#pragma unroll
                for (int bj = 0; bj < 2; ++bj) { const pg8::f32x4 v0 = acc[ai][bj][m][0] * s, v1 = acc[ai][bj][m][1] * s; pg8::u32x4 w;
                    w.x = pg8::cvt_pk_bf16(v0[0], v0[1]); w.y = pg8::cvt_pk_bf16(v0[2], v0[3]); w.z = pg8::cvt_pk_bf16(v1[0], v1[1]); w.w = pg8::cvt_pk_bf16(v1[2], v1[3]);
                    *(pg8::u32x4*)(rowp + bj * 128) = w; } }
    }
};
struct EpiResF32 {
    static constexpr bool PERM = false, AFTER_DRAIN = false;
    const float* base; float* out; int ldc, pad;
    __device__ __forceinline__ void operator()(const pg8::f32x4 (&acc)[2][2][4][2], const pg8::Unit& u, int wr, int wc, int fr, int fq) const {
        const int row0 = u.pm * 256 + wr * 64 + fr, col0 = u.pn * 256 + wc * 32 + 4 * fq;
#pragma unroll
        for (int ai = 0; ai < 2; ++ai)
#pragma unroll
            for (int m = 0; m < 4; ++m) { const size_t off = (size_t)(row0 + ai * 128 + m * 16) * ldc + col0;
#pragma unroll
                for (int bj = 0; bj < 2; ++bj)
#pragma unroll
                    for (int n = 0; n < 2; ++n) { const pg8::f32x4 b = *(const pg8::f32x4*)(base + off + bj * 128 + n * 16); *(pg8::f32x4*)(out + off + bj * 128 + n * 16) = b + acc[ai][bj][m][n]; } }
    }
};
constexpr int NWAVES = 8, NTHR = 512;
constexpr int RING_BYTES = 131072, LDSCTL_OFF = RING_BYTES, MISC_OFF = LDSCTL_OFF + 320, LDS_BYTES = 147456;
constexpr size_t CTL_ZERO_BYTES = 1u << 20;
constexpr int CW_BAR = 4096;
typedef __attribute__((address_space(1))) unsigned gu32;
#define RLX_AGENT __ATOMIC_RELAXED, __HIP_MEMORY_SCOPE_AGENT
#define XB_TMO      128
#define XB_XCNT(j)  (256  + 64 * (j))
#define XB_XSUB(j)  (1280 + 64 * (j))
#define XB_XGEN(j)  (2304 + 64 * (j))
#define XB_TOP      3328
#define XB_TOPGEN   3392
#define XCD_BAR_WORDS 3456
#define XB_SPIN_CAP (1u << 18)

__device__ __forceinline__ unsigned xb_ld(unsigned* p)              { return __hip_atomic_load(p, __ATOMIC_RELAXED, __HIP_MEMORY_SCOPE_AGENT); }
__device__ __forceinline__ unsigned xb_add(unsigned* p, unsigned v) { return __hip_atomic_fetch_add(p, v, __ATOMIC_RELAXED, __HIP_MEMORY_SCOPE_AGENT); }
__device__ __forceinline__ unsigned xb_xcc_id() { return (unsigned)__builtin_amdgcn_s_getreg((3 << 11) | 20) & 0xFu; }
#define XB_SPIN(cond, bar) do { unsigned _sp = 0; while (cond) { __builtin_amdgcn_s_sleep(1); \
    if ((++_sp & 255u) == 0u) { if (xb_ld(&(bar)[XB_TMO])) break; if (_sp > XB_SPIN_CAP) { atomicAdd(&(bar)[XB_TMO], 1u); break; } } } } while (0)

struct XcdBarrier {
    unsigned* bar; unsigned x;
    volatile LAS unsigned* st;
};

__device__ __forceinline__ XcdBarrier xcd_barrier_post(unsigned* bar, volatile LAS unsigned* st) {
    XcdBarrier b; b.bar = bar; b.x = xb_xcc_id(); b.st = st;
    if (threadIdx.x == 0) (void)xb_add(&bar[XB_XCNT(b.x)], 1u);
    return b;
}
__device__ __forceinline__ void xcd_barrier_complete(unsigned* bar, unsigned x, unsigned& nloc, unsigned& nx) {
    const unsigned G = gridDim.x * gridDim.y * gridDim.z;
    unsigned sum, cnt, mine, sp = 0u;
    for (;;) {
        sum = 0u; cnt = 0u; mine = 0u;
#pragma unroll
        for (unsigned j = 0; j < 16; ++j) { const unsigned c = xb_ld(&bar[XB_XCNT(j)]); sum += c; cnt += (c > 0u) ? 1u : 0u; mine = (j == x) ? c : mine; }
        if (sum == G) break;
        __builtin_amdgcn_s_sleep(1);
        if ((++sp & 255u) == 0u) { if (xb_ld(&bar[XB_TMO])) break; if (sp > XB_SPIN_CAP) { atomicAdd(&bar[XB_TMO], 1u); break; } }
    }
    nloc = mine > 0u ? mine : 1u; nx = cnt > 0u ? cnt : 1u;
}

__device__ __forceinline__ void xcd_barrier(const XcdBarrier& b) {
    asm volatile("s_waitcnt vmcnt(0)" ::: "memory");
    __syncthreads();
    if (threadIdx.x == 0) {
        unsigned* bar = b.bar;
        __builtin_amdgcn_s_waitcnt(0);
        unsigned nloc = b.st[0], nx = b.st[1];
        if (nloc == 0u) { xcd_barrier_complete(bar, b.x, nloc, nx); b.st[0] = nloc; b.st[1] = nx; }
        const unsigned old = xb_add(&bar[XB_XSUB(b.x)], 1u);
        const unsigned gen = old / nloc;
        if (old + 1u == (gen + 1u) * nloc) {
            __builtin_amdgcn_fence(__ATOMIC_RELEASE, "agent");
            asm volatile("s_waitcnt vmcnt(0)" ::: "memory");
            const unsigned og = xb_add(&bar[XB_TOP], 1u);
            const unsigned tg = og / nx;
            if (og + 1u == (tg + 1u) * nx) xb_add(&bar[XB_TOPGEN], 1u);
            else XB_SPIN(xb_ld(&bar[XB_TOPGEN]) == tg, bar);
            __builtin_amdgcn_fence(__ATOMIC_ACQUIRE, "agent");
            xb_add(&bar[XB_XGEN(b.x)], 1u);
            asm volatile("s_waitcnt vmcnt(0)" ::: "memory");
        } else {
            XB_SPIN(xb_ld(&bar[XB_XGEN(b.x)]) == gen, bar);
            __builtin_amdgcn_fence(__ATOMIC_ACQUIRE, "agent");
            asm volatile("s_waitcnt vmcnt(0)" ::: "memory");
        }
    }
    __syncthreads();
}

typedef short bf16x8 __attribute__((ext_vector_type(8)));
typedef unsigned u32x4 __attribute__((ext_vector_type(4)));
typedef unsigned u32x2 __attribute__((ext_vector_type(2)));
typedef short s16x4 __attribute__((ext_vector_type(4)));
typedef float f32x16 __attribute__((ext_vector_type(16)));
typedef float f32x2_t __attribute__((ext_vector_type(2)));
typedef __bf16 bf16x2_t __attribute__((ext_vector_type(2)));
__device__ __forceinline__ unsigned cvtpk(float lo, float hi) { f32x2_t v = {lo, hi}; bf16x2_t b = __builtin_convertvector(v, bf16x2_t); return __builtin_bit_cast(unsigned, b); }
__device__ __forceinline__ bf16x8 pack8(float a0, float a1, float a2, float a3, float a4, float a5, float a6, float a7) {
    u32x4 u; u.x = cvtpk(a0, a1); u.y = cvtpk(a2, a3); u.z = cvtpk(a4, a5); u.w = cvtpk(a6, a7); return __builtin_bit_cast(bf16x8, u);
}
#define MFMA32(a, b, c) __builtin_amdgcn_mfma_f32_32x32x16_bf16((a), (b), (c), 0, 0, 0)

__device__ __forceinline__ void tr64_item(const bf16* src, size_t ld, bf16* dst, size_t ldt, LAS bf16* scr, int lane) {
#pragma unroll
    for (int i = 0; i < 8; ++i) { const int row = 8 * i + (lane >> 3), ch = lane & 7; const u32x4 v = *(const u32x4*)(src + (size_t)row * ld + ch * 8);
        LAS unsigned* w = (LAS unsigned*)(scr + row * 66 + ch * 8); w[0] = v.x; w[1] = v.y; w[2] = v.z; w[3] = v.w; }
    __builtin_amdgcn_s_waitcnt(0xc07f); asm volatile("" ::: "memory");
#pragma unroll
    for (int i = 0; i < 8; ++i) { const int c = 8 * i + (lane >> 3), tch = lane & 7;
        unsigned short e[8];
#pragma unroll
        for (int k = 0; k < 8; ++k) e[k] = scr[(tch * 8 + k) * 66 + c];
        u32x4 o; o.x = e[0] | ((unsigned)e[1] << 16); o.y = e[2] | ((unsigned)e[3] << 16); o.z = e[4] | ((unsigned)e[5] << 16); o.w = e[6] | ((unsigned)e[7] << 16);
        *(u32x4*)(dst + (size_t)c * ldt + tch * 8) = o; }
    __builtin_amdgcn_s_waitcnt(0xc07f); asm volatile("" ::: "memory");
}
__device__ __forceinline__ void ph_mo_vt(const bf16* p, bf16* VT, LAS unsigned char* L, int gw, int NGW, int wave, int lane) {
    LAS bf16* scr = (LAS bf16*)(L + wave * 8448);
    for (int it = gw; it < NB * (T / 64) * 12; it += NGW) {
        const int cb = it % 12, tb = (it / 12) % (T / 64), b = it / (12 * (T / 64));
        const int h = cb >> 1, d0 = (cb & 1) * 64, t0 = tb * 64;
        tr64_item(p + (size_t)(b * T + t0) * NP + C_V + h * 128 + d0, NP, VT + ((size_t)(b * 6 + h) * 128 + d0) * T + t0, T, scr, lane);
    }
}
__device__ __forceinline__ void ph_mo_kmean2(const bf16* p, float* kmean, float* Lf, int vb, int G, int tid) {
    for (int unit = vb; unit < NB * 6 * 8; unit += G) {
        const int blk = unit & 7, bh = unit >> 3, b = bh / 6, h = bh % 6, d = tid & 127, part = tid >> 7; float s = 0.f;
        for (int i = 0; i < 64; ++i) s += bf2f(p[(size_t)(b * T + blk * 256 + part * 64 + i) * NP + C_K + h * 128 + d]);
        __syncthreads(); Lf[tid] = s; __syncthreads();
        if (tid < 128) kmean[(size_t)unit * 128 + tid] = (Lf[tid] + Lf[128 + tid] + Lf[256 + tid] + Lf[384 + tid]) * (1.0f / 256.0f);
    }
}

constexpr int MO_KST = 272, MO_VST = 136;
constexpr int MO_KB = 64 * MO_KST, MO_VB = 128 * MO_VST, MO_GRP = MO_KB + MO_VB;
constexpr int MO_KM_OFF = 2 * MO_GRP;
constexpr int MO_Q_OFF = MO_KM_OFF + 4096;
template <int MODE> __device__ __forceinline__ void attn_unit(LAS unsigned char* L, const bf16* p, const bf16* VT, const float* kmean, bf16* y, int unit) {
    int tid_ = threadIdx.x; asm volatile("" : "+v"(tid_));
    const int tid = tid_, lane = tid & 63, wave = __builtin_amdgcn_readfirstlane(tid >> 6), grp = wave >> 2, wq = wave & 3, r = lane & 31, hh = lane >> 5, tg = tid & 255;
    constexpr int NH = MODE == 0 ? 6 : 4, LDQ = MODE == 0 ? NP : 512, LDK = MODE == 0 ? NP : 1024, LDV = MODE == 0 ? T : MEM, QC = MODE == 0 ? C_Q : 0, KC = MODE == 0 ? C_K : 0;
    const int qh = MODE == 0 ? 15 - unit / 24 : unit / 16, bh = MODE == 0 ? unit % 24 : unit % 16, b = bh / NH, h = bh % NH, qb = qh >> 1, half = qh & 1, t0 = qh * 128;
    const int tq = t0 + 32 * wq + r;
    const bf16* prow = p + (size_t)(b * T) * LDQ;
    const bf16* krow = MODE == 0 ? prow : (const bf16*)kmean + (size_t)(b * MEM) * LDK;
    const bf16* vt = VT + (size_t)(b * NH + h) * 128 * LDV;
    LAS float* km = (LAS float*)(L + MO_KM_OFF);
    __syncthreads();
    if (MODE == 0) for (int e = tid; e < 8 * 128; e += NTHR) km[e] = kmean[(size_t)bh * 8 * 128 + e];
    LAS unsigned char* Qt = L + MO_Q_OFF;
#pragma unroll
    for (int i_ = 0; i_ < 4; ++i_) { const int c_ = tid + 512 * i_; *(LAS u32x4*)(Qt + (c_ >> 4) * MO_KST + (c_ & 15) * 16) = *(const u32x4*)(prow + (size_t)(t0 + (c_ >> 4)) * LDQ + QC + h * 128 + (c_ & 15) * 8); }
    __syncthreads();
    const LAS unsigned char* qrow = Qt + (32 * wq + r) * MO_KST + 16 * hh;
#define MO_QF(ks) (*(const LAS bf16x8*)(qrow + 32 * (ks)))
    unsigned mask = 0xffffffffu;
    if (MODE == 0) {
        float g0 = 0, g1 = 0, g2 = 0, g3 = 0, g4 = 0, g5 = 0, g6 = 0;
#pragma unroll
        for (int ks = 0; ks < 8; ++ks)
            { const bf16x8 qv8 = MO_QF(ks);
#pragma unroll
            for (int j = 0; j < 8; ++j) { const float qv = bf2f((bf16)qv8[j]); const int d = 16 * ks + 8 * hh + j;
                g0 += qv * km[d]; g1 += qv * km[128 + d]; g2 += qv * km[256 + d]; g3 += qv * km[384 + d]; g4 += qv * km[512 + d]; g5 += qv * km[640 + d]; g6 += qv * km[768 + d]; } }
        g0 += __shfl_xor(g0, 32); g1 += __shfl_xor(g1, 32); g2 += __shfl_xor(g2, 32); g3 += __shfl_xor(g3, 32); g4 += __shfl_xor(g4, 32); g5 += __shfl_xor(g5, 32); g6 += __shfl_xor(g6, 32);
        const float gv[7] = {g0, g1, g2, g3, g4, g5, g6};
        mask = 0;
        if (qb <= 3) mask = (1u << qb) - 1u;
        else {
#pragma unroll
            for (int pass = 0; pass < 3; ++pass) { float best = -INFINITY; int bi = -1;
#pragma unroll
                for (int j = 0; j < 7; ++j) if (j < qb && !((mask >> j) & 1u) && gv[j] > best) { best = gv[j]; bi = j; }
                if (bi >= 0) mask |= 1u << bi; }
        }
        mask |= 1u << qb;
    }
    const float LOG2E = 1.4426950408889634f;
    const float c1 = 0.08838834764831845f * LOG2E;
    const float slope = (h == 0) ? 0.25f : (h == 1) ? 0.0625f : (h == 2) ? 0.015625f : (h == 3) ? 0.00390625f : (h == 4) ? 0.5f : 0.125f;
    const float slope2 = MODE == 0 ? slope * LOG2E : 0.f;
    const int nt = MODE == 0 ? 4 * qb + (half ? 4 : 2) : 4, nh = nt >> 1, tile0 = grp * nh;
    LAS unsigned char* Kt = L + grp * MO_GRP; LAS unsigned char* Vt = Kt + MO_KB;
    f32x16 O[4];
#pragma unroll
    for (int i = 0; i < 4; ++i)
#pragma unroll
        for (int j = 0; j < 16; ++j) O[i][j] = 0.f;
    float mrun = -1e30f, lsum = 0.f;
    u32x4 kreg[4], vreg[4];
#define MO_LOAD(ti) do { const int s0_ = (ti) * 64; _Pragma("unroll") for (int i_ = 0; i_ < 4; ++i_) { const int c_ = tg + 256 * i_; \
        kreg[i_] = *(const u32x4*)(krow + (size_t)(s0_ + (c_ >> 4)) * LDK + KC + h * 128 + (c_ & 15) * 8); \
        vreg[i_] = *(const u32x4*)(vt + (size_t)(c_ >> 3) * LDV + s0_ + (c_ & 7) * 8); } } while (0)
#define MO_STORE() do { _Pragma("unroll") for (int i_ = 0; i_ < 4; ++i_) { const int c_ = tg + 256 * i_; \
        *(LAS u32x4*)(Kt + (c_ >> 4) * MO_KST + (c_ & 15) * 16) = kreg[i_]; \
        LAS u32x2* vd_ = (LAS u32x2*)(Vt + (c_ >> 3) * MO_VST + (c_ & 7) * 16); vd_[0] = (u32x2){vreg[i_].x, vreg[i_].y}; vd_[1] = (u32x2){vreg[i_].z, vreg[i_].w}; } } while (0)
    MO_LOAD(tile0);
    for (int i = 0; i < nh; ++i) {
        const int ti = tile0 + i, s0 = ti * 64, j = ti >> 2;
        MO_STORE();
        __syncthreads();
        if (i + 1 < nh) MO_LOAD(ti + 1);
        const bool sel = MODE == 0 ? ((mask >> j) & 1u) : true;
        const bool active = MODE == 0 ? ((__ballot(sel) != 0ull) && (s0 <= t0 + 32 * wq + 31)) : true;
        if (active) {
            f32x16 S0, S1;
#pragma unroll
            for (int q = 0; q < 16; ++q) { S0[q] = 0.f; S1[q] = 0.f; }
#pragma unroll
            for (int ks = 0; ks < 8; ++ks) {
                const bf16x8 k0 = *(const LAS bf16x8*)(Kt + r * MO_KST + (16 * ks + 8 * hh) * 2);
                const bf16x8 k1 = *(const LAS bf16x8*)(Kt + (32 + r) * MO_KST + (16 * ks + 8 * hh) * 2);
                const bf16x8 qq = MO_QF(ks); S0 = MFMA32(k0, qq, S0); S1 = MFMA32(k1, qq, S1);
            }
            const float base0 = MODE == 0 ? slope2 * (float)(s0 + 4 * hh - tq) : 0.f;
            float mx = -INFINITY;
#pragma unroll
            for (int R = 0; R < 16; ++R) { const int ko = (R & 3) + 8 * (R >> 2);
                const int sa = s0 + 4 * hh + ko, sb = sa + 32;
                float za = S0[R] * c1 + (base0 + slope2 * (float)ko), zb = S1[R] * c1 + (base0 + slope2 * (float)(ko + 32));
                if (MODE == 0) { za = (sel && sa <= tq) ? za : -INFINITY; zb = (sel && sb <= tq) ? zb : -INFINITY; }
                S0[R] = za; S1[R] = zb; mx = fmaxf(mx, fmaxf(za, zb)); }
            mx = fmaxf(mx, __shfl_xor(mx, 32));
            const float mnew = fmaxf(mrun, mx), alpha = exp2f(mrun - mnew); mrun = mnew;
            float ps = 0.f;
#pragma unroll
            for (int R = 0; R < 16; ++R) { S0[R] = exp2f(S0[R] - mnew); S1[R] = exp2f(S1[R] - mnew); ps += S0[R] + S1[R]; }
            lsum = lsum * alpha + ps;
            if (__any(alpha != 1.0f)) {
#pragma unroll
                for (int i2 = 0; i2 < 4; ++i2)
#pragma unroll
                    for (int q = 0; q < 16; ++q) O[i2][q] *= alpha;
            }
            const bf16x8 p00 = pack8(S0[0], S0[1], S0[2], S0[3], S0[4], S0[5], S0[6], S0[7]), p01 = pack8(S0[8], S0[9], S0[10], S0[11], S0[12], S0[13], S0[14], S0[15]);
            const bf16x8 p10 = pack8(S1[0], S1[1], S1[2], S1[3], S1[4], S1[5], S1[6], S1[7]), p11 = pack8(S1[8], S1[9], S1[10], S1[11], S1[12], S1[13], S1[14], S1[15]);
#pragma unroll
            for (int db = 0; db < 4; ++db) {
                const LAS unsigned char* vrow = Vt + (32 * db + r) * MO_VST + 8 * hh;
#define MO_VF(kb, s) ({ const u32x2 lo_ = *(const LAS u32x2*)(vrow + (32 * (kb) + 16 * (s)) * 2), hi_ = *(const LAS u32x2*)(vrow + (32 * (kb) + 16 * (s) + 8) * 2); \
                        u32x4 u_ = {lo_.x, lo_.y, hi_.x, hi_.y}; __builtin_bit_cast(bf16x8, u_); })
                O[db] = MFMA32(MO_VF(0, 0), p00, O[db]); O[db] = MFMA32(MO_VF(0, 1), p01, O[db]);
                O[db] = MFMA32(MO_VF(1, 0), p10, O[db]); O[db] = MFMA32(MO_VF(1, 1), p11, O[db]);
            }
        }
        __syncthreads();
    }
    lsum += __shfl_xor(lsum, 32);
    LAS float* X = (LAS float*)L;
    if (grp == 1) {
#pragma unroll
        for (int db = 0; db < 4; ++db)
#pragma unroll
            for (int q = 0; q < 16; ++q) X[(wq * 66 + db * 16 + q) * 64 + lane] = O[db][q];
        X[(wq * 66 + 64) * 64 + lane] = mrun; X[(wq * 66 + 65) * 64 + lane] = lsum;
    }
    __syncthreads();
    if (grp == 0) {
        const float m1 = X[(wq * 66 + 64) * 64 + lane], l1 = X[(wq * 66 + 65) * 64 + lane];
        const float mm = fmaxf(mrun, m1), a0 = exp2f(mrun - mm), a1 = exp2f(m1 - mm);
        const float inv = 1.0f / (lsum * a0 + l1 * a1);
        const size_t m = (size_t)b * T + tq;
#pragma unroll
        for (int db = 0; db < 4; ++db)
#pragma unroll
            for (int g4 = 0; g4 < 4; ++g4) { const int d = 32 * db + 8 * g4 + 4 * hh;
                float o[4];
#pragma unroll
                for (int e = 0; e < 4; ++e) o[e] = (O[db][4 * g4 + e] * a0 + X[(wq * 66 + db * 16 + 4 * g4 + e) * 64 + lane] * a1) * inv;
                if (MODE == 0) { const u32x2 zz = *(const u32x2*)(p + m * NP + C_Z + h * 128 + d);
                    const float z0 = bf2f((bf16)(zz.x & 0xffff)), z1 = bf2f((bf16)(zz.x >> 16)), z2 = bf2f((bf16)(zz.y & 0xffff)), z3 = bf2f((bf16)(zz.y >> 16));
                    u32x2 w; w.x = cvtpk(o[0] * silu(z0), o[1] * silu(z1)); w.y = cvtpk(o[2] * silu(z2), o[3] * silu(z3));
                    *(u32x2*)(y + m * D + 1280 + h * 128 + d) = w; }
                else { u32x2 w; w.x = cvtpk(o[0], o[1]); w.y = cvtpk(o[2], o[3]); *(u32x2*)(y + m * 512 + h * 128 + d) = w; } }
    }
#undef MO_LOAD
#undef MO_STORE
#undef MO_VF
#undef MO_QF
}
__device__ __forceinline__ void ph_moba(LAS unsigned char* L, const bf16* p, const bf16* VT, const float* kmean, bf16* y, int vb, int G) {
    for (int unit = vb; unit < 384; unit += G) attn_unit<0>(L, p, VT, kmean, y, unit);
}
__device__ __forceinline__ void ph_mem_vt(const bf16* KV, bf16* VTm, LAS unsigned char* L, int gw, int NGW, int wave, int lane) {
    LAS bf16* scr = (LAS bf16*)(L + wave * 8448);
    for (int it = gw; it < DEPTH * NB * 4 * 8; it += NGW) {
        const int cb = it & 7, sb = (it >> 3) & 3, b = (it >> 5) & 3, l = it >> 7; const int h = cb >> 1, d0 = (cb & 1) * 64, s0 = sb * 64;
        tr64_item(KV + ((size_t)l * MM + b * MEM + s0) * 1024 + 512 + h * 128 + d0, 1024, VTm + (((size_t)l * 16 + b * 4 + h) * 128 + d0) * MEM + s0, MEM, scr, lane);
    }
}
__device__ __forceinline__ void ph_ml_F2(const float* gates, const float* bi, const float* bf, float* Fb, float* Ib, int gw, int lane) {
    if (gw < 16) { const int bh = gw, b = bh >> 2, h = bh & 3; const float bfh = bf[h], bih = bi[h];
        float tot = 0.f;
        for (int i = 0; i < 32; ++i) { const size_t m = (size_t)b * T + 32 * lane + i; tot += logsig(gates[m * 8 + 4 + h] + bfh); }
        float inc = tot;
#pragma unroll
        for (int o = 1; o < 64; o <<= 1) { const float v = __shfl_up(inc, o); if (lane >= o) inc += v; }
        float run = inc - tot;
        for (int i = 0; i < 32; ++i) { const int t = 32 * lane + i; const size_t m = (size_t)b * T + t; run += logsig(gates[m * 8 + 4 + h] + bfh); Fb[bh * T + t] = run; Ib[bh * T + t] = gates[m * 8 + h] + bih; }
    }
}
__device__ __forceinline__ void ml_prep_unit(LAS unsigned char* L, const bf16* p, const float* cw, const float* cb, const float* wq, const float* wk, const float* wv, bf16* Q, bf16* K, bf16* VT, bf16* KT, int unit) {
    int tid_ = threadIdx.x; asm volatile("" : "+v"(tid_)); const int tid = tid_;
    const int h = unit & 3, tb = (unit >> 2) & 31, b = unit >> 7, t0 = tb * 64;
    LAS bf16* Vs = (LAS bf16*)L; LAS bf16* Ks = Vs + 64 * 194;
    __syncthreads();
#pragma unroll 1
    for (int i = 0; i < 6; ++i) {
        const int idx = tid + 512 * i, tl = idx / 48, j4 = idx % 48, t = t0 + tl, c = h * 192 + 4 * j4; const size_t m = (size_t)b * T + t;
        float s[4], u4[4], uc[4];
#pragma unroll
        for (int e = 0; e < 4; ++e) s[e] = cb[c + e];
#pragma unroll
        for (int jj = 0; jj < 4; ++jj) { const int tt = t - 3 + jj; if (tt >= 0) { const u32x2 uu = *(const u32x2*)(p + (m - 3 + jj) * NP + C_MU + c);
            const float x0 = bf2f((bf16)(uu.x & 0xffff)), x1 = bf2f((bf16)(uu.x >> 16)), x2 = bf2f((bf16)(uu.y & 0xffff)), x3 = bf2f((bf16)(uu.y >> 16));
            s[0] += cw[jj * 768 + c] * x0; s[1] += cw[jj * 768 + c + 1] * x1; s[2] += cw[jj * 768 + c + 2] * x2; s[3] += cw[jj * 768 + c + 3] * x3;
            if (jj == 3) { u4[0] = x0; u4[1] = x1; u4[2] = x2; u4[3] = x3; } } }
#pragma unroll
        for (int e = 0; e < 4; ++e) uc[e] = silu(s[e]);
        const float ks = 0.07216878364870322f;
        const int jg = h * 48 + j4; float q[4], k[4], v[4];
#pragma unroll
        for (int o = 0; o < 4; ++o) { float qq = 0.f, kk = 0.f, vv = 0.f;
#pragma unroll
            for (int e = 0; e < 4; ++e) { qq += uc[e] * wq[(jg * 4 + e) * 4 + o]; kk += uc[e] * wk[(jg * 4 + e) * 4 + o]; vv += u4[e] * wv[(jg * 4 + e) * 4 + o]; }
            q[o] = qq; k[o] = kk * ks; v[o] = vv; }
        u32x2 qw, kw; qw.x = cvtpk(q[0], q[1]); qw.y = cvtpk(q[2], q[3]); kw.x = cvtpk(k[0], k[1]); kw.y = cvtpk(k[2], k[3]);
        *(u32x2*)(Q + m * 768 + c) = qw; *(u32x2*)(K + m * 768 + c) = kw;
        LAS unsigned* vd = (LAS unsigned*)(Vs + tl * 194 + 4 * j4); vd[0] = cvtpk(v[0], v[1]); vd[1] = cvtpk(v[2], v[3]);
        LAS unsigned* kd = (LAS unsigned*)(Ks + tl * 194 + 4 * j4); kd[0] = kw.x; kd[1] = kw.y;
    }
    __syncthreads();
#pragma unroll 1
    for (int i = 0; i < 3; ++i) {
        const int idx = tid + 512 * i, d = idx >> 3, ch = idx & 7;
        unsigned short ev[8], ek[8];
#pragma unroll
        for (int k = 0; k < 8; ++k) { ev[k] = Vs[(ch * 8 + k) * 194 + d]; ek[k] = Ks[(ch * 8 + k) * 194 + d]; }
        u32x4 ov, ok; ov.x = ev[0] | ((unsigned)ev[1] << 16); ov.y = ev[2] | ((unsigned)ev[3] << 16); ov.z = ev[4] | ((unsigned)ev[5] << 16); ov.w = ev[6] | ((unsigned)ev[7] << 16);
        ok.x = ek[0] | ((unsigned)ek[1] << 16); ok.y = ek[2] | ((unsigned)ek[3] << 16); ok.z = ek[4] | ((unsigned)ek[5] << 16); ok.w = ek[6] | ((unsigned)ek[7] << 16);
        const size_t o = ((size_t)(b * 4 + h) * 192 + d) * T + t0 + ch * 8;
        *(u32x4*)(VT + o) = ov; *(u32x4*)(KT + o) = ok;
    }
}
constexpr int MLC_ST = 272;
__device__ __forceinline__ void ml_cloc_unit(LAS unsigned char* L, const bf16* VT, const bf16* KT, const float* Fb, const float* Ib, float* Cloc, float* nloc, int unit) {
    int tid_ = threadIdx.x; asm volatile("" : "+v"(tid_)); const int tid = tid_, lane = tid & 63, wave = __builtin_amdgcn_readfirstlane(tid >> 6), r = lane & 31, hh = lane >> 5;
    const int c = unit & 15, bh = unit >> 4, t0 = c * 128;
    LAS unsigned char* At = L; LAS unsigned char* Bt = L + 192 * MLC_ST; LAS float* wv = (LAS float*)(L + 2 * 192 * MLC_ST);
    __syncthreads();
    if (tid < 128) wv[tid] = expf(Fb[bh * T + t0 + 127] - Fb[bh * T + t0 + tid] + Ib[bh * T + t0 + tid]);
    __syncthreads();
#pragma unroll 1
    for (int i = 0; i < 6; ++i) { const int idx = tid + 512 * i, d = idx >> 4, ch = idx & 15; const size_t g = ((size_t)bh * 192 + d) * T + t0 + ch * 8;
        *(LAS u32x4*)(At + d * MLC_ST + ch * 16) = *(const u32x4*)(VT + g);
        const u32x4 kk = *(const u32x4*)(KT + g); const LAS float* w8 = wv + ch * 8;
        u32x4 o; o.x = cvtpk(bf2f((bf16)(kk.x & 0xffff)) * w8[0], bf2f((bf16)(kk.x >> 16)) * w8[1]); o.y = cvtpk(bf2f((bf16)(kk.y & 0xffff)) * w8[2], bf2f((bf16)(kk.y >> 16)) * w8[3]);
        o.z = cvtpk(bf2f((bf16)(kk.z & 0xffff)) * w8[4], bf2f((bf16)(kk.z >> 16)) * w8[5]); o.w = cvtpk(bf2f((bf16)(kk.w & 0xffff)) * w8[6], bf2f((bf16)(kk.w >> 16)) * w8[7]);
        *(LAS u32x4*)(Bt + d * MLC_ST + ch * 16) = o; }
    __syncthreads();
    if (tid < 192) { float s = 0.f; const LAS bf16* row = (const LAS bf16*)(Bt + tid * MLC_ST);
        for (int k = 0; k < 128; ++k) s += bf2f(row[k]);
        nloc[(size_t)unit * 192 + tid] = s; }
#pragma unroll 1
    for (int ti = wave; ti < 36; ti += 8) { const int rb = ti / 6, cbk = ti % 6;
        f32x16 acc;
#pragma unroll
        for (int q = 0; q < 16; ++q) acc[q] = 0.f;
#pragma unroll
        for (int ks = 0; ks < 8; ++ks) { const bf16x8 a = *(const LAS bf16x8*)(At + (32 * rb + r) * MLC_ST + (16 * ks + 8 * hh) * 2), bb = *(const LAS bf16x8*)(Bt + (32 * cbk + r) * MLC_ST + (16 * ks + 8 * hh) * 2);
            acc = MFMA32(a, bb, acc); }
        float* out = Cloc + ((size_t)unit * 192 + 32 * rb + 4 * hh) * 192 + 32 * cbk + r;
#pragma unroll
        for (int R = 0; R < 16; ++R) out[(size_t)((R & 3) + 8 * (R >> 2)) * 192] = acc[R];
    }
}
__device__ __forceinline__ void ph_ml_scan(const float* Cloc, const float* nloc, const float* Fb, bf16* Cprev, float* nprev, int gt, int NGT) {
    for (int idx = gt; idx < 16 * 36864; idx += NGT) { const int bh = idx / 36864, e = idx % 36864; float run = 0.f, fprev = 0.f;
        for (int c = 0; c < 16; ++c) { const size_t o = ((size_t)(bh * 16 + c)) * 36864 + e; Cprev[o] = f2bf(run);
            const float fend = Fb[bh * T + 128 * c + 127]; run = expf(fend - fprev) * run + Cloc[o]; fprev = fend; } }
    for (int idx = gt; idx < 16 * 192; idx += NGT) { const int bh = idx / 192, e = idx % 192; float run = 0.f, fprev = 0.f;
        for (int c = 0; c < 16; ++c) { const size_t o = ((size_t)(bh * 16 + c)) * 192 + e; nprev[o] = run;
            const float fend = Fb[bh * T + 128 * c + 127]; run = expf(fend - fprev) * run + nloc[o]; fprev = fend; } }
}
constexpr int MLO_KST = 400, MLO_VST = 264;
constexpr int MLO_V_OFF = 128 * MLO_KST, MLO_T_OFF = MLO_V_OFF + 192 * MLO_VST;
__device__ __forceinline__ void ml_out_unit(LAS unsigned char* L, const bf16* Q, const bf16* K, const bf16* VT, const bf16* Cprev, const float* nprev, const float* Fb, const float* Ib, const bf16* p, const float* ng, bf16* y, int unit) {
    int tid_ = threadIdx.x; asm volatile("" : "+v"(tid_)); const int tid = tid_, lane = tid & 63, wave = __builtin_amdgcn_readfirstlane(tid >> 6), r = lane & 31, hh = lane >> 5, tb = wave & 3, dh = wave >> 2;
    const int c = unit & 15, bh = unit >> 4, b = bh >> 2, h = bh & 3, t0 = c * 128;
    LAS unsigned char* Kt = L; LAS unsigned char* Vt = L + MLO_V_OFF;
    LAS float* Fs = (LAS float*)(L + MLO_T_OFF); LAS float* Is = Fs + 128; LAS float* np = Is + 128; LAS float* st = np + 192;
    __syncthreads();
    if (tid < 128) { Fs[tid] = Fb[bh * T + t0 + tid]; Is[tid] = Ib[bh * T + t0 + tid]; }
    if (tid >= 128 && tid < 320) np[tid - 128] = nprev[(size_t)unit * 192 + tid - 128];
#pragma unroll 1
    for (int i = 0; i < 6; ++i) { const int idx = tid + 512 * i;
        { const int s = idx / 24, ch = idx % 24; *(LAS u32x4*)(Kt + s * MLO_KST + ch * 16) = *(const u32x4*)(K + (size_t)(b * T + t0 + s) * 768 + h * 192 + ch * 8); }
        { const int d = idx >> 4, ch = idx & 15; const u32x4 v = *(const u32x4*)(VT + ((size_t)bh * 192 + d) * T + t0 + ch * 8);
          LAS u32x2* vd = (LAS u32x2*)(Vt + d * MLO_VST + ch * 16); vd[0] = (u32x2){v.x, v.y}; vd[1] = (u32x2){v.z, v.w}; } }
    const int t = t0 + 32 * tb + r; const size_t m = (size_t)b * T + t;
    bf16x8 qf[12];
#pragma unroll
    for (int ks = 0; ks < 12; ++ks) qf[ks] = *(const bf16x8*)(Q + m * 768 + h * 192 + 16 * ks + 8 * hh);
    __syncthreads();
    const float Ft = Fs[32 * tb + r], Fprev = c ? Fb[bh * T + t0 - 1] : 0.f, dec = expf(Ft - Fprev);
    f32x16 acc[3];
#pragma unroll
    for (int i = 0; i < 3; ++i)
#pragma unroll
        for (int q = 0; q < 16; ++q) acc[i][q] = 0.f;
    const bf16* cp = Cprev + ((size_t)unit * 192 + 32 * (3 * dh) + r) * 192 + 8 * hh;
#pragma unroll
    for (int blk = 0; blk < 3; ++blk)
#pragma unroll
        for (int ks = 0; ks < 12; ++ks) { const bf16x8 a = *(const bf16x8*)(cp + (size_t)(32 * blk) * 192 + 16 * ks); acc[blk] = MFMA32(a, qf[ks], acc[blk]); }
#pragma unroll
    for (int i = 0; i < 3; ++i)
#pragma unroll
        for (int q = 0; q < 16; ++q) acc[i][q] *= dec;
    float qn = 0.f;
#pragma unroll
    for (int ks = 0; ks < 12; ++ks)
#pragma unroll
        for (int j = 0; j < 8; ++j) qn += bf2f((bf16)qf[ks][j]) * np[16 * ks + 8 * hh + j];
    qn += __shfl_xor(qn, 32);
    float den = dec * qn, dpart = 0.f;
    for (int kb = 0; kb <= tb; ++kb) {
        f32x16 S;
#pragma unroll
        for (int q = 0; q < 16; ++q) S[q] = 0.f;
#pragma unroll
        for (int ks = 0; ks < 12; ++ks) { const bf16x8 kf = *(const LAS bf16x8*)(Kt + (32 * kb + r) * MLO_KST + (16 * ks + 8 * hh) * 2); S = MFMA32(kf, qf[ks], S); }
#pragma unroll
        for (int R = 0; R < 16; ++R) { const int sl = 32 * kb + (R & 3) + 8 * (R >> 2) + 4 * hh; const float wgt = (t0 + sl <= t) ? expf(Ft - Fs[sl] + Is[sl]) : 0.f; S[R] *= wgt; dpart += S[R]; }
        const bf16x8 p0 = pack8(S[0], S[1], S[2], S[3], S[4], S[5], S[6], S[7]), p1 = pack8(S[8], S[9], S[10], S[11], S[12], S[13], S[14], S[15]);
#pragma unroll
        for (int blk = 0; blk < 3; ++blk) { const LAS unsigned char* vrow = Vt + (32 * (3 * dh + blk) + r) * MLO_VST + 8 * hh + 64 * kb;
            { const u32x2 lo = *(const LAS u32x2*)(vrow), hi = *(const LAS u32x2*)(vrow + 16); u32x4 u = {lo.x, lo.y, hi.x, hi.y}; acc[blk] = MFMA32(__builtin_bit_cast(bf16x8, u), p0, acc[blk]); }
            { const u32x2 lo = *(const LAS u32x2*)(vrow + 32), hi = *(const LAS u32x2*)(vrow + 48); u32x4 u = {lo.x, lo.y, hi.x, hi.y}; acc[blk] = MFMA32(__builtin_bit_cast(bf16x8, u), p1, acc[blk]); } }
    }
    den += dpart + __shfl_xor(dpart, 32);
    const float inv = 1.0f / fmaxf(fabsf(den), 1.0f);
    float s1 = 0.f, s2 = 0.f;
#pragma unroll
    for (int blk = 0; blk < 3; ++blk)
#pragma unroll
        for (int g4 = 0; g4 < 4; ++g4) { const int d = 32 * (3 * dh + blk) + 8 * g4 + 4 * hh; const u32x2 oo = *(const u32x2*)(p + m * NP + C_MO + h * 192 + d);
            const float o0 = bf2f((bf16)(oo.x & 0xffff)), o1 = bf2f((bf16)(oo.x >> 16)), o2 = bf2f((bf16)(oo.y & 0xffff)), o3 = bf2f((bf16)(oo.y >> 16));
            float v0 = acc[blk][4 * g4] * inv * sigm(o0), v1 = acc[blk][4 * g4 + 1] * inv * sigm(o1), v2 = acc[blk][4 * g4 + 2] * inv * sigm(o2), v3 = acc[blk][4 * g4 + 3] * inv * sigm(o3);
            acc[blk][4 * g4] = v0; acc[blk][4 * g4 + 1] = v1; acc[blk][4 * g4 + 2] = v2; acc[blk][4 * g4 + 3] = v3;
            s1 += (v0 + v1) + (v2 + v3); s2 += (v0 * v0 + v1 * v1) + (v2 * v2 + v3 * v3); }
    s1 += __shfl_xor(s1, 32); s2 += __shfl_xor(s2, 32);
    if (hh == 0) { st[(dh * 128 + 32 * tb + r) * 2] = s1; st[(dh * 128 + 32 * tb + r) * 2 + 1] = s2; }
    __syncthreads();
    const float t1 = st[(32 * tb + r) * 2] + st[(128 + 32 * tb + r) * 2], t2 = st[(32 * tb + r) * 2 + 1] + st[(128 + 32 * tb + r) * 2 + 1];
    const float mu = t1 * (1.0f / 192.0f), var = fmaxf(t2 * (1.0f / 192.0f) - mu * mu, 0.f), rs = 1.0f / sqrtf(var + LN_EPS);
#pragma unroll
    for (int blk = 0; blk < 3; ++blk)
#pragma unroll
        for (int g4 = 0; g4 < 4; ++g4) { const int d = 32 * (3 * dh + blk) + 8 * g4 + 4 * hh; const u32x2 zz = *(const u32x2*)(p + m * NP + C_MZ + h * 192 + d);
            const float z0 = bf2f((bf16)(zz.x & 0xffff)), z1 = bf2f((bf16)(zz.x >> 16)), z2 = bf2f((bf16)(zz.y & 0xffff)), z3 = bf2f((bf16)(zz.y >> 16));
            const float4 gg = *(const float4*)(ng + h * 192 + d);
            u32x2 w; w.x = cvtpk((acc[blk][4 * g4] - mu) * rs * gg.x * silu(z0), (acc[blk][4 * g4 + 1] - mu) * rs * gg.y * silu(z1));
            w.y = cvtpk((acc[blk][4 * g4 + 2] - mu) * rs * gg.z * silu(z2), (acc[blk][4 * g4 + 3] - mu) * rs * gg.w * silu(z3));
            *(u32x2*)(y + m * D + 512 + h * 192 + d) = w; }
}
typedef float f32x4v __attribute__((ext_vector_type(4)));
#define MFMA16(a, b, c) __builtin_amdgcn_mfma_f32_16x16x32_bf16((a), (b), (c), 0, 0, 0)
__device__ __forceinline__ void ph_lru_wt(const float* wa, const float* wx, bf16* Wt, int gt, int NGT) {
    for (int idx = gt; idx < DEPTH * 2 * 4 * 128 * 128; idx += NGT) {
        const int i = idx & 127, o = (idx >> 7) & 127, g = (idx >> 14) & 3, gate = (idx >> 16) & 1, l = idx >> 17;
        const float* src = gate ? wx : wa;
        Wt[idx] = f2bf(src[(((size_t)l * 4 + g) * 128 + i) * 128 + o]);
    }
}
constexpr int LR_XCB_OFF = 32768, LR_XCB_ST = 1040, LR_A_OFF = LR_XCB_OFF + 16 * LR_XCB_ST, LR_U_OFF = LR_A_OFF + 32768;
__device__ __forceinline__ void lru_unit(LAS unsigned char* L, const bf16* p, const float* cw, const float* cb, const bf16* Wt  , const float* ba, const float* bx, const float* lam,
                                         float* hloc, float* cumA, float* aggA, float* aggH, int unit) {
    int tid_ = threadIdx.x; asm volatile("" : "+v"(tid_)); const int tid = tid_, lane = tid & 63, wave = __builtin_amdgcn_readfirstlane(tid >> 6);
    const int m0 = unit * 16, t0 = m0 % T;
    LAS float* xcf = (LAS float*)L; LAS unsigned char* xcb = L + LR_XCB_OFF; LAS float* As = (LAS float*)(L + LR_A_OFF); LAS float* Us = (LAS float*)(L + LR_U_OFF);
    __syncthreads();
    { const int c = tid; const float w0 = cw[c], w1 = cw[512 + c], w2 = cw[1024 + c], w3 = cw[1536 + c], bb = cb[c];
      float x0 = (t0 >= 3) ? bf2f(p[(size_t)(m0 - 3) * NP + C_LX + c]) : 0.f, x1 = (t0 >= 2) ? bf2f(p[(size_t)(m0 - 2) * NP + C_LX + c]) : 0.f, x2 = (t0 >= 1) ? bf2f(p[(size_t)(m0 - 1) * NP + C_LX + c]) : 0.f;
#pragma unroll
      for (int t = 0; t < 16; ++t) { const float x3 = bf2f(p[(size_t)(m0 + t) * NP + C_LX + c]); const float s = bb + w0 * x0 + w1 * x1 + w2 * x2 + w3 * x3;
          xcf[t * 512 + c] = s; *(LAS bf16*)(xcb + t * LR_XCB_ST + c * 2) = f2bf(s); x0 = x1; x1 = x2; x2 = x3; } }
    __syncthreads();
    const int g = wave >> 1, ob = (wave & 1) * 64, fr = lane & 15, kq = lane >> 4;
    f32x4v acc[2][4];
#pragma unroll
    for (int a = 0; a < 2; ++a)
#pragma unroll
        for (int nb = 0; nb < 4; ++nb) acc[a][nb] = (f32x4v){0.f, 0.f, 0.f, 0.f};
#pragma unroll
    for (int ks = 0; ks < 4; ++ks) {
        const bf16x8 af = *(const LAS bf16x8*)(xcb + fr * LR_XCB_ST + (g * 128 + 32 * ks + 8 * kq) * 2);
#pragma unroll
        for (int a = 0; a < 2; ++a)
#pragma unroll
            for (int nb = 0; nb < 4; ++nb) { const bf16x8 bfg = *(const bf16x8*)(Wt + ((size_t)(a * 4 + g) * 128 + ob + 16 * nb + fr) * 128 + 32 * ks + 8 * kq);
                acc[a][nb] = MFMA16(af, bfg, acc[a][nb]); }
    }
#pragma unroll
    for (int nb = 0; nb < 4; ++nb) { const int c = 64 * wave + 16 * nb + fr; const float bav = ba[c], bxv = bx[c], sp8 = 8.0f * log1pf(expf(-lam[c]));
#pragma unroll
        for (int rg = 0; rg < 4; ++rg) { const int t = 4 * kq + rg; const float r = sigm(acc[0][nb][rg] + bav), ig = sigm(acc[1][nb][rg] + bxv);
            const float la = -r * sp8, a = expf(la), u = sqrtf(-expm1f(2.0f * la)) * (ig * xcf[t * 512 + c]);
            As[t * 512 + c] = a; Us[t * 512 + c] = u; } }
    __syncthreads();
    { const int c = tid; float h = 0.f, P = 1.f;
#pragma unroll
      for (int t = 0; t < 16; ++t) { const float a = As[t * 512 + c], u = Us[t * 512 + c]; P *= a; h = a * h + u; hloc[(size_t)(m0 + t) * 512 + c] = h; cumA[(size_t)(m0 + t) * 512 + c] = P; }
      aggA[(size_t)unit * 512 + c] = P; aggH[(size_t)unit * 512 + c] = h; }
}
__device__ __forceinline__ void ph_lru_carry(const float* aggA, const float* aggH, float* carry, int gt) {
    if (gt < NB * 512) { const int b = gt >> 9, c = gt & 511; float h = 0.f;
#pragma unroll 1
        for (int k0 = 0; k0 < 128; k0 += 16) { float a[16], hh[16];
#pragma unroll
            for (int k = 0; k < 16; ++k) { const size_t o = (size_t)(b * 128 + k0 + k) * 512 + c; a[k] = aggA[o]; hh[k] = aggH[o]; }
#pragma unroll
            for (int k = 0; k < 16; ++k) { carry[(size_t)(b * 128 + k0 + k) * 512 + c] = h; h = a[k] * h + hh[k]; } } }
}
__device__ __forceinline__ void ph_lru_apply(const float* hloc, const float* cumA, const float* carry, const bf16* p, bf16* y, int gt, int NGT) {
    for (int idx = gt; idx < M * 128; idx += NGT) { const int m = idx >> 7, c = (idx & 127) * 4;
        const float4 h = *(const float4*)(hloc + (size_t)m * 512 + c), a = *(const float4*)(cumA + (size_t)m * 512 + c), cr = *(const float4*)(carry + (size_t)(m >> 4) * 512 + c);
        const u32x2 zz = *(const u32x2*)(p + (size_t)m * NP + C_LZ + c);
        const float z0 = bf2f((bf16)(zz.x & 0xffff)), z1 = bf2f((bf16)(zz.x >> 16)), z2 = bf2f((bf16)(zz.y & 0xffff)), z3 = bf2f((bf16)(zz.y >> 16));
        u32x2 w; w.x = cvtpk((h.x + a.x * cr.x) * silu(z0), (h.y + a.y * cr.y) * silu(z1)); w.y = cvtpk((h.z + a.z * cr.z) * silu(z2), (h.w + a.w * cr.w) * silu(z3));
        *(u32x2*)(y + (size_t)m * D + c) = w; }
}

struct Args { const float* in[26]; float* out; unsigned char* ws; };

__device__ __forceinline__ void ph_wt(const float* W, int ldw, int K, int N, const float* g, bf16* Wt, int mode, float* scr, int gw, int NGW, int lane) {
    const int nblk = N / 32, nitems = (K / 64) * nblk;
    for (int it = gw; it < nitems; it += NGW) {
        const int kb = it / nblk, nb = it % nblk, n0 = nb * 32;
        const int src = (mode == 1 && n0 >= SRC_GATE) ? n0 + 8 : n0;
        wt_item(W, ldw, src, g, Wt, K, n0, scr, kb * 64, lane);
    }
}
__device__ __forceinline__ void ph_gatew(const float* W, const float* g, float* Wg, int gt, int NGT) {
    for (int idx = gt; idx < D * 8; idx += NGT) { const int k = idx >> 3, c = idx & 7; Wg[idx] = g[k] * W[(size_t)k * INC + SRC_GATE + c]; }
}
__device__ __forceinline__ void ph_prep(const float* x, bf16* xb, float* rinv, const float* Wg, float* gates, int nrows, int gw, int NGW, int lane) {
    for (int row = gw; row < nrows; row += NGW) {
        const float4* xr = (const float4*)(x + (size_t)row * D); float4 v[8]; float ss = 0.f;
#pragma unroll
        for (int j = 0; j < 8; ++j) { v[j] = xr[lane + 64 * j]; ss += v[j].x * v[j].x + v[j].y * v[j].y + v[j].z * v[j].z + v[j].w * v[j].w; }
        ss = wave_sum(ss); const float r = 1.0f / sqrtf(ss * (1.0f / D) + RMS_EPS);
        uint2* ob = (uint2*)(xb + (size_t)row * D);
#pragma unroll
        for (int j = 0; j < 8; ++j) { uint2 o; o.x = pk2(v[j].x, v[j].y); o.y = pk2(v[j].z, v[j].w); ob[lane + 64 * j] = o; }
        if (lane == 0) rinv[row] = r;
        if (Wg) {
            float a0 = 0, a1 = 0, a2 = 0, a3 = 0, a4 = 0, a5 = 0, a6 = 0, a7 = 0;
#pragma unroll
            for (int j = 0; j < 8; ++j) {
                const float xe[4] = {v[j].x, v[j].y, v[j].z, v[j].w};
#pragma unroll
                for (int e = 0; e < 4; ++e) { const int k = 4 * (lane + 64 * j) + e; const float4 w0 = *(const float4*)(Wg + (size_t)k * 8), w1 = *(const float4*)(Wg + (size_t)k * 8 + 4);
                    a0 += xe[e] * w0.x; a1 += xe[e] * w0.y; a2 += xe[e] * w0.z; a3 += xe[e] * w0.w; a4 += xe[e] * w1.x; a5 += xe[e] * w1.y; a6 += xe[e] * w1.z; a7 += xe[e] * w1.w; }
            }
            a0 = wave_sum(a0); a1 = wave_sum(a1); a2 = wave_sum(a2); a3 = wave_sum(a3); a4 = wave_sum(a4); a5 = wave_sum(a5); a6 = wave_sum(a6); a7 = wave_sum(a7);
            if (lane == 0) { float4* go = (float4*)(gates + (size_t)row * 8); go[0] = make_float4(a0 * r, a1 * r, a2 * r, a3 * r); go[1] = make_float4(a4 * r, a5 * r, a6 * r, a7 * r); }
        }
    }
}
__device__ __forceinline__ void ph_final(const float* x, const float* g, float* out, int gw, int NGW, int lane) {
    for (int row = gw; row < M; row += NGW) {
        const float4* xr = (const float4*)(x + (size_t)row * D); float4 v[8]; float ss = 0.f;
#pragma unroll
        for (int j = 0; j < 8; ++j) { v[j] = xr[lane + 64 * j]; ss += v[j].x * v[j].x + v[j].y * v[j].y + v[j].z * v[j].z + v[j].w * v[j].w; }
        ss = wave_sum(ss); const float r = 1.0f / sqrtf(ss * (1.0f / D) + RMS_EPS);
        float4* o = (float4*)(out + (size_t)row * D); const float4* gg = (const float4*)g;
#pragma unroll
        for (int j = 0; j < 8; ++j) { const float4 gv = gg[lane + 64 * j]; o[lane + 64 * j] = make_float4(v[j].x * r * gv.x, v[j].y * r * gv.y, v[j].z * r * gv.z, v[j].w * r * gv.w); }
    }
}
__device__ __forceinline__ void ph_lru_gates(float* xc, const bf16* p, const float* cw, const float* cb, const float* wa, const float* ba, const float* wx, const float* bx, const float* lam, float* A, float* U, int vb, int G, int tid) {
    for (int m = vb; m < M; m += G) {
        const int t = m % T, c = tid;
        { float s = cb[c];
#pragma unroll
          for (int j = 0; j < 4; ++j) { const int tt = t - 3 + j; if (tt >= 0) s += cw[j * 512 + c] * bf2f(p[(size_t)(m - 3 + j) * NP + C_LX + c]); }
          xc[c] = s; }
        __syncthreads();
        { const int g = c >> 7, o = c & 127; float ra = ba[c], ri = bx[c];
          for (int i = 0; i < 128; ++i) { const float xv = xc[g * 128 + i]; ra += xv * wa[(size_t)(g * 128 + i) * 128 + o]; ri += xv * wx[(size_t)(g * 128 + i) * 128 + o]; }
          const float r = sigm(ra), ig = sigm(ri); const float la = -8.0f * r * log1pf(expf(-lam[c])); const float a = expf(la); const float u = sqrtf(-expm1f(2.0f * la)) * (ig * xc[c]);
          A[(size_t)m * 512 + c] = a; U[(size_t)m * 512 + c] = u; }
        __syncthreads();
    }
}
__device__ __forceinline__ void ph_lru_scan(const float* A, const float* U, const bf16* p, bf16* y, int gt) {
    if (gt < NB * 512) { const int b = gt / 512, c = gt % 512; float h = 0.f;
        for (int t = 0; t < T; ++t) { const size_t m = (size_t)b * T + t; h = A[m * 512 + c] * h + U[m * 512 + c]; const float z = bf2f(p[m * NP + C_LZ + c]); y[m * D + c] = f2bf(h * silu(z)); } }
}
__device__ __forceinline__ void ph_ml_prep(const bf16* p, const float* cw, const float* cb, const float* wq, const float* wk, const float* wv, bf16* Q, bf16* K, bf16* V, int gt, int NGT) {
    for (int idx = gt; idx < M * 192; idx += NGT) {
        const int m = idx / 192, j = idx % 192, t = m % T;
        float u4[4], uc[4];
#pragma unroll
        for (int i = 0; i < 4; ++i) { const int c = 4 * j + i; float s = cb[c];
#pragma unroll
            for (int jj = 0; jj < 4; ++jj) { const int tt = t - 3 + jj; if (tt >= 0) s += cw[jj * 768 + c] * bf2f(p[(size_t)(m - 3 + jj) * NP + C_MU + c]); }
            uc[i] = silu(s); u4[i] = bf2f(p[(size_t)m * NP + C_MU + c]); }
        const float ks = 0.07216878364870322f;
#pragma unroll
        for (int o = 0; o < 4; ++o) { float q = 0.f, k = 0.f, v = 0.f;
#pragma unroll
            for (int i = 0; i < 4; ++i) { q += uc[i] * wq[(j * 4 + i) * 4 + o]; k += uc[i] * wk[(j * 4 + i) * 4 + o]; v += u4[i] * wv[(j * 4 + i) * 4 + o]; }
            Q[(size_t)m * 768 + 4 * j + o] = f2bf(q); K[(size_t)m * 768 + 4 * j + o] = f2bf(k * ks); V[(size_t)m * 768 + 4 * j + o] = f2bf(v); }
    }
}
__device__ __forceinline__ void ph_ml_F(const float* gates, const float* bi, const float* bf, float* Fb, float* Ib, int vb, int tid) {
    if (vb < 16 && tid == 0) { const int bh = vb, b = bh >> 2, h = bh & 3; float F = 0.f;
        for (int t = 0; t < T; ++t) { const size_t m = (size_t)b * T + t; F += logsig(gates[m * 8 + 4 + h] + bf[h]); Fb[bh * T + t] = F; Ib[bh * T + t] = gates[m * 8 + h] + bi[h]; } }
}
__device__ __forceinline__ void ph_ml_attn(float* L, const bf16* Q, const bf16* K, const bf16* V, const float* Fb, const float* Ib, const bf16* p, const float* ng, bf16* y, int vb, int G, int tid) {
    float* Qs = L; float* Ks = Qs + 32 * 192; float* Vs = Ks + 32 * 193; float* Ss = Vs + 32 * 192; float* Ft = Ss + 32 * 32; float* Fs = Ft + 32; float* Is = Fs + 32;
    const int r = tid >> 4, cl = tid & 15;
    for (int unit = vb; unit < 16 * 64; unit += G) {
        const int bh = unit >> 6, b = bh >> 2, h = bh & 3, t0 = (unit & 63) * 32;
        __syncthreads();
        for (int e = tid; e < 32 * 192; e += NTHR) { const int rr = e / 192, d = e % 192; Qs[rr * 192 + d] = bf2f(Q[(size_t)(b * T + t0 + rr) * 768 + h * 192 + d]); }
        if (tid < 32) Ft[tid] = Fb[bh * T + t0 + tid];
        float acc[12]; float den = 0.f;
#pragma unroll
        for (int i = 0; i < 12; ++i) acc[i] = 0.f;
        for (int s0 = 0; s0 < t0 + 32; s0 += 32) {
            __syncthreads();
            for (int e = tid; e < 32 * 192; e += NTHR) { const int i = e / 192, d = e % 192; const size_t g = (size_t)(b * T + s0 + i) * 768 + h * 192 + d; Ks[i * 193 + d] = bf2f(K[g]); Vs[i * 192 + d] = bf2f(V[g]); }
            if (tid < 32) { Fs[tid] = Fb[bh * T + s0 + tid]; Is[tid] = Ib[bh * T + s0 + tid]; }
            __syncthreads();
#pragma unroll
            for (int w = 0; w < 2; ++w) { const int s = cl + 16 * w; float dot = 0.f;
                for (int d = 0; d < 192; ++d) dot += Qs[r * 192 + d] * Ks[s * 193 + d];
                const int tt = t0 + r, ss = s0 + s; const float wgt = (ss <= tt) ? expf(Ft[r] - Fs[s] + Is[s]) : 0.f; Ss[r * 32 + s] = dot * wgt; }
            __syncthreads();
            for (int s = 0; s < 32; ++s) { const float sv = Ss[r * 32 + s]; den += sv;
#pragma unroll
                for (int i = 0; i < 12; ++i) acc[i] += sv * Vs[s * 192 + cl + 16 * i]; }
        }
        const float dn = fmaxf(fabsf(den), 1.0f); const size_t m = (size_t)b * T + t0 + r; float hv[12]; float s1 = 0.f;
#pragma unroll
        for (int i = 0; i < 12; ++i) { const int d = cl + 16 * i; hv[i] = acc[i] / dn * sigm(bf2f(p[m * NP + C_MO + h * 192 + d])); s1 += hv[i]; }
        s1 += __shfl_xor(s1, 1); s1 += __shfl_xor(s1, 2); s1 += __shfl_xor(s1, 4); s1 += __shfl_xor(s1, 8);
        const float mu = s1 * (1.0f / 192.0f); float s2 = 0.f;
#pragma unroll
        for (int i = 0; i < 12; ++i) { const float dd = hv[i] - mu; s2 += dd * dd; }
        s2 += __shfl_xor(s2, 1); s2 += __shfl_xor(s2, 2); s2 += __shfl_xor(s2, 4); s2 += __shfl_xor(s2, 8);
        const float rs = 1.0f / sqrtf(s2 * (1.0f / 192.0f) + LN_EPS);
#pragma unroll
        for (int i = 0; i < 12; ++i) { const int d = cl + 16 * i; const float z = bf2f(p[m * NP + C_MZ + h * 192 + d]); y[m * D + 512 + h * 192 + d] = f2bf((hv[i] - mu) * rs * ng[h * 192 + d] * silu(z)); }
    }
}
__device__ __forceinline__ void ph_mo_kmean(const bf16* p, float* kmean, int gt, int NGT) {
    for (int idx = gt; idx < NB * 6 * 8 * 128; idx += NGT) {
        const int d = idx & 127, blk = (idx >> 7) & 7, bh = idx >> 10, b = bh / 6, h = bh % 6; float s = 0.f;
        for (int i = 0; i < 256; ++i) s += bf2f(p[(size_t)(b * T + blk * 256 + i) * NP + C_K + h * 128 + d]);
        kmean[idx] = s * (1.0f / 256.0f);
    }
}
__device__ __forceinline__ void ph_mo_sel(const bf16* p, const float* kmean, unsigned char* sel, int gt, int NGT) {
    for (int idx = gt; idx < NB * 6 * T; idx += NGT) {
        const int t = idx % T, bh = idx / T, b = bh / 6, h = bh % 6, bq = t >> 8;
        const bf16* q = p + (size_t)(b * T + t) * NP + C_Q + h * 128;
        float g0 = 0, g1 = 0, g2 = 0, g3 = 0, g4 = 0, g5 = 0, g6 = 0;
        const float* km = kmean + (size_t)bh * 8 * 128;
        for (int d = 0; d < 128; ++d) { const float qv = bf2f(q[d]); g0 += qv * km[d]; g1 += qv * km[128 + d]; g2 += qv * km[256 + d]; g3 += qv * km[384 + d]; g4 += qv * km[512 + d]; g5 += qv * km[640 + d]; g6 += qv * km[768 + d]; }
        const float gv[7] = {g0, g1, g2, g3, g4, g5, g6};
        unsigned mask = 0;
        if (bq <= 3) mask = (1u << bq) - 1u;
        else {
#pragma unroll
            for (int pass = 0; pass < 3; ++pass) { float best = -INFINITY; int bi = -1;
#pragma unroll
                for (int j = 0; j < 7; ++j) if (j < bq && !((mask >> j) & 1u) && gv[j] > best) { best = gv[j]; bi = j; }
                if (bi >= 0) mask |= 1u << bi; }
        }
        mask |= 1u << bq;
        sel[(size_t)(b * T + t) * 8 + h] = (unsigned char)mask;
    }
}
template <int MODE> __device__ __forceinline__ void ph_attn32(float* L, const bf16* Qp, int ldq, int qcol, const bf16* Kp, const bf16* Vp, int ldk, const unsigned char* sel, const bf16* zp, bf16* outp, int ldo, int ocol, int vb, int G, int tid) {
    float* Qs = L; float* Ks = Qs + 32 * 128; float* Vs = Ks + 32 * 129; float* Ss = Vs + 32 * 128; unsigned* anym = (unsigned*)(Ss + 32 * 32);
    constexpr int NH = MODE == 0 ? 6 : 4; const int r = tid >> 4, cl = tid & 15;
    for (int unit = vb; unit < NB * NH * 64; unit += G) {
        const int bh = unit >> 6, b = bh / NH, h = bh % NH, t0 = (unit & 63) * 32; const size_t m = (size_t)b * T + t0 + r;
        __syncthreads();
        for (int e = tid; e < 32 * 128; e += NTHR) { const int rr = e >> 7, d = e & 127; Qs[rr * 128 + d] = bf2f(Qp[(size_t)(b * T + t0 + rr) * ldq + qcol + h * 128 + d]); }
        unsigned mymask = 0xffffffffu;
        if (MODE == 0) { if (tid == 0) *anym = 0; __syncthreads(); mymask = sel[m * 8 + h]; if (cl == 0) atomicOr(anym, mymask); __syncthreads(); }
        const float scale = 0.08838834764831845f;
        float slope = 0.f;
        if (MODE == 0) { slope = (h == 0) ? 0.25f : (h == 1) ? 0.0625f : (h == 2) ? 0.015625f : (h == 3) ? 0.00390625f : (h == 4) ? 0.5f : 0.125f; }
        float acc[8]; float mrun = -1e30f, l = 0.f;
#pragma unroll
        for (int i = 0; i < 8; ++i) acc[i] = 0.f;
        const int nblk = MODE == 0 ? (t0 >> 8) + 1 : 1; const unsigned am = MODE == 0 ? *anym : 1u;
        const int kbase = MODE == 0 ? b * T : b * MEM;
        for (int j = 0; j < nblk; ++j) {
            if (!((am >> j) & 1u)) continue;
            for (int ch = 0; ch < 8; ++ch) {
                const int s0 = j * 256 + ch * 32; if (MODE == 0 && s0 > t0 + 31) break;
                __syncthreads();
                for (int e = tid; e < 32 * 128; e += NTHR) { const int i = e >> 7, d = e & 127; const size_t g = (size_t)(kbase + s0 + i) * ldk + h * 128 + d; Ks[i * 129 + d] = bf2f(Kp[g]); Vs[i * 128 + d] = bf2f(Vp[g]); }
                __syncthreads();
#pragma unroll
                for (int w = 0; w < 2; ++w) { const int s = cl + 16 * w; float dot = 0.f;
                    for (int d = 0; d < 128; ++d) dot += Qs[r * 128 + d] * Ks[s * 129 + d];
                    float lg = dot * scale;
                    if (MODE == 0) { const int tt = t0 + r, ss = s0 + s; const bool valid = ((mymask >> j) & 1u) && (ss <= tt); lg = valid ? lg - slope * (float)(tt - ss) : -INFINITY; }
                    Ss[r * 32 + s] = lg; }
                __syncthreads();
                float mx = -INFINITY;
                for (int s = 0; s < 32; ++s) mx = fmaxf(mx, Ss[r * 32 + s]);
                const float mnew = fmaxf(mrun, mx); const float corr = expf(mrun - mnew); l *= corr;
#pragma unroll
                for (int i = 0; i < 8; ++i) acc[i] *= corr;
                for (int s = 0; s < 32; ++s) { const float pv = expf(Ss[r * 32 + s] - mnew); l += pv;
#pragma unroll
                    for (int i = 0; i < 8; ++i) acc[i] += pv * Vs[s * 128 + cl + 16 * i]; }
                mrun = mnew;
            }
        }
        const float inv = 1.0f / l;
#pragma unroll
        for (int i = 0; i < 8; ++i) { const int d = cl + 16 * i; float o = acc[i] * inv;
            if (MODE == 0) { const float z = bf2f(zp[m * NP + C_Z + h * 128 + d]); o *= silu(z); }
            outp[m * ldo + ocol + h * 128 + d] = f2bf(o); }
    }
}

typedef const __attribute__((address_space(4))) Args* kargs_t;
#define PH_VARS \
    kargs_t ap = (kargs_t)__builtin_amdgcn_kernarg_segment_ptr(); asm volatile("" : "+s"(ap)); \
    unsigned char* const ws = ap->ws; (void)ws; \
    int tid = threadIdx.x; asm volatile("" : "+v"(tid)); const int lane = tid & 63, wave = __builtin_amdgcn_readfirstlane(tid >> 6); (void)lane; \
    const int G = gridDim.x, vb = blockIdx.x, gw = vb * NWAVES + wave, NGW = G * NWAVES, gt = vb * NTHR + tid, NGT = G * NTHR; (void)gw; (void)NGW; (void)gt; (void)NGT; \
    float* const Lf = (float*)lds; (void)Lf; LAS unsigned char* const ldsl = (LAS unsigned char*)lds; (void)ldsl;
#define WSP(T, off) ((T*)(ws + (off)))
__global__ void __launch_bounds__(NTHR, 2) mk_fwd(Args a_unused) {
    extern __shared__ __attribute__((aligned(16))) unsigned char lds[];
    { PH_VARS
      for (int u = tid; u < (LDS_BYTES - LDSCTL_OFF) / 4; u += NTHR) ((LAS unsigned*)(ldsl + LDSCTL_OFF))[u] = 0u;
      __syncthreads();
      (void)xcd_barrier_post((unsigned*)(ws + WS_CTL) + CW_BAR, (volatile LAS unsigned*)(ldsl + MISC_OFF) + 8); }
#define GRID_BAR() do { PH_VARS XcdBarrier bar_; bar_.bar = (unsigned*)(ws + WS_CTL) + CW_BAR; bar_.x = xb_xcc_id(); bar_.st = (volatile LAS unsigned*)(ldsl + MISC_OFF) + 8; xcd_barrier(bar_); } while (0)
#pragma unroll 1
    for (int l = 0; l < DEPTH; ++l) {
      { PH_VARS float* scr = Lf + wave * (64 * 33); ph_wt(ap->in[3] + (size_t)l * D * INC, INC, D, NP, ap->in[2] + l * D, WSP(bf16, WS_WIN) + (size_t)l * NP * D, 1, scr, gw, NGW, lane); }
      if (l == 0) { PH_VARS ph_lru_wt(ap->in[6], ap->in[8], WSP(bf16, WS_LRUW), gt, NGT); }
      { PH_VARS ph_gatew(ap->in[3] + (size_t)l * D * INC, ap->in[2] + l * D, WSP(float, WS_WG) + (size_t)l * D * 8, gt, NGT); }
      { PH_VARS float* scr = Lf + wave * (64 * 33); ph_wt(ap->in[19] + (size_t)l * D * D, D, D, D, nullptr, WSP(bf16, WS_WOUT) + (size_t)l * D * D, 0, scr, gw, NGW, lane); }
      { PH_VARS float* scr = Lf + wave * (64 * 33); ph_wt(ap->in[22] + (size_t)l * D * 512, 512, D, 512, ap->in[20] + l * D, WSP(bf16, WS_WQ) + (size_t)l * 512 * D, 0, scr, gw, NGW, lane); }
      { PH_VARS float* scr = Lf + wave * (64 * 33); ph_wt(ap->in[23] + (size_t)l * D * 1024, 1024, D, 1024, ap->in[21] + l * D, WSP(bf16, WS_WKV) + (size_t)l * 1024 * D, 0, scr, gw, NGW, lane); }
      { PH_VARS float* scr = Lf + wave * (64 * 33); ph_wt(ap->in[24] + (size_t)l * 512 * D, D, 512, D, nullptr, WSP(bf16, WS_WO) + (size_t)l * D * 512, 0, scr, gw, NGW, lane); }
    }
    { PH_VARS ph_prep(ap->in[1], WSP(bf16, WS_MEMB), WSP(float, WS_RINVM), nullptr, nullptr, MM, gw, NGW, lane); }
    GRID_BAR();
    { PH_VARS ph_prep(ap->in[0], WSP(bf16, WS_XB), WSP(float, WS_RINV), WSP(float, WS_WG), WSP(float, WS_GATES), M, gw, NGW, lane); }
    GRID_BAR();
#pragma unroll 1
    for (int l = 0; l < DEPTH; ++l) { PH_VARS
        pg8::Gemm g{WSP(bf16, WS_MEMB), WSP(bf16, WS_WKV) + (size_t)l * 1024 * D, MM, 1024, D, 0}; EpiScaleBf16 E{WSP(bf16, WS_KV) + (size_t)l * MM * 1024, WSP(float, WS_RINVM), 1024, 0};
        pg8::StaticOrder S; S.init(MM, 1024, G, (vb + 64 + 32 * l) % G);
        pg8::gemm_phase<EpiScaleBf16, pg8::StaticOrder, true, true>(ldsl, g, S, E);
    }
#pragma unroll 1
    for (int l = 0; l < DEPTH; ++l) {
        { PH_VARS pg8::Gemm g{WSP(bf16, WS_XB), WSP(bf16, WS_WIN) + (size_t)l * NP * D, M, NP, D, 0}; EpiScaleBf16 E{WSP(bf16, WS_P), WSP(float, WS_RINV), NP, 0}; pg8::StaticOrder S; S.init(M, NP, G, vb);
          pg8::gemm_phase<EpiScaleBf16, pg8::StaticOrder, true, true>(ldsl, g, S, E); }
        GRID_BAR();
        { PH_VARS for (int unit = vb; unit < 512; unit += G) lru_unit(ldsl, WSP(bf16, WS_P), ap->in[4] + l * 4 * 512, ap->in[5] + l * 512, WSP(bf16, WS_LRUW) + (size_t)l * 2 * 4 * 128 * 128, ap->in[7] + l * 512, ap->in[9] + l * 512, ap->in[10] + l * 512, WSP(float, WS_A), WSP(float, WS_U), ap->out + OUT_AGGA, ap->out + OUT_AGGH, unit); }
        { PH_VARS for (int unit = vb; unit < 512; unit += G) ml_prep_unit(ldsl, WSP(bf16, WS_P), ap->in[11] + l * 4 * 768, ap->in[12] + l * 768, ap->in[13] + l * 192 * 16, ap->in[14] + l * 192 * 16, ap->in[15] + l * 192 * 16, WSP(bf16, WS_MQ), WSP(bf16, WS_MK), WSP(bf16, WS_MV), WSP(bf16, WS_MKT), unit); }
        { PH_VARS ph_ml_F2(WSP(float, WS_GATES), ap->in[16] + l * 4, ap->in[17] + l * 4, WSP(float, WS_F), WSP(float, WS_I), gw, lane);
          ph_mo_kmean2(WSP(bf16, WS_P), WSP(float, WS_KMEAN), Lf, vb, G, tid); }
        { PH_VARS __syncthreads(); ph_mo_vt(WSP(bf16, WS_P), WSP(bf16, WS_MOVT), ldsl, gw, NGW, wave, lane); }
        if (l == 0) { PH_VARS ph_mem_vt(WSP(bf16, WS_KV), WSP(bf16, WS_VTM), ldsl, gw, NGW, wave, lane); }
        GRID_BAR();
        { PH_VARS ph_lru_carry(ap->out + OUT_AGGA, ap->out + OUT_AGGH, ap->out + OUT_CARRY, gt); }
        { PH_VARS for (int unit = vb; unit < 256; unit += G) ml_cloc_unit(ldsl, WSP(bf16, WS_MV), WSP(bf16, WS_MKT), WSP(float, WS_F), WSP(float, WS_I), ap->out, ap->out + OUT_NLOC, unit); }
        GRID_BAR();
        { PH_VARS ph_lru_apply(WSP(float, WS_A), WSP(float, WS_U), ap->out + OUT_CARRY, WSP(bf16, WS_P), WSP(bf16, WS_Y), gt, NGT); }
        { PH_VARS ph_ml_scan(ap->out, ap->out + OUT_NLOC, WSP(float, WS_F), WSP(bf16, WS_CPREV), ap->out + OUT_NPREV, gt, NGT); }
        { PH_VARS ph_moba(ldsl, WSP(bf16, WS_P), WSP(bf16, WS_MOVT), WSP(float, WS_KMEAN), WSP(bf16, WS_Y), vb, G); }
        GRID_BAR();
        { PH_VARS for (int unit = vb; unit < 256; unit += G) ml_out_unit(ldsl, WSP(bf16, WS_MQ), WSP(bf16, WS_MK), WSP(bf16, WS_MV), WSP(bf16, WS_CPREV), ap->out + OUT_NPREV, WSP(float, WS_F), WSP(float, WS_I), WSP(bf16, WS_P), ap->in[18] + l * 768, WSP(bf16, WS_Y), unit); }
        GRID_BAR();
        { PH_VARS const float* xcur = l == 0 ? ap->in[0] : WSP(float, WS_XRES);
          pg8::Gemm g{WSP(bf16, WS_Y), WSP(bf16, WS_WOUT) + (size_t)l * D * D, M, D, D, 0}; EpiResF32 E{xcur, WSP(float, WS_XRES), D, 0}; pg8::StaticOrder S; S.init(M, D, G, vb);
          pg8::gemm_phase<EpiResF32, pg8::StaticOrder, true, true>(ldsl, g, S, E); }
        GRID_BAR();
        { PH_VARS ph_prep(WSP(float, WS_XRES), WSP(bf16, WS_XB), WSP(float, WS_RINV), nullptr, nullptr, M, gw, NGW, lane); }
        GRID_BAR();
        { PH_VARS pg8::Gemm g{WSP(bf16, WS_XB), WSP(bf16, WS_WQ) + (size_t)l * 512 * D, M, 512, D, 0}; EpiScaleBf16 E{WSP(bf16, WS_XQ), WSP(float, WS_RINV), 512, 0}; pg8::StaticOrder S; S.init(M, 512, G, vb);
          pg8::gemm_phase<EpiScaleBf16, pg8::StaticOrder, true, true>(ldsl, g, S, E); }
        GRID_BAR();
        { PH_VARS const bf16* kvl = WSP(bf16, WS_KV) + (size_t)l * MM * 1024; for (int unit = vb; unit < 256; unit += G) attn_unit<1>(ldsl, WSP(bf16, WS_XQ), WSP(bf16, WS_VTM) + (size_t)l * 16 * 128 * MEM, (const float*)kvl, WSP(bf16, WS_XO), unit); }
        GRID_BAR();
        { PH_VARS pg8::Gemm g{WSP(bf16, WS_XO), WSP(bf16, WS_WO) + (size_t)l * D * 512, M, D, 512, 0}; EpiResF32 E{WSP(float, WS_XRES), WSP(float, WS_XRES), D, 0}; pg8::StaticOrder S; S.init(M, D, G, vb);
          pg8::gemm_phase<EpiResF32, pg8::StaticOrder, true, true>(ldsl, g, S, E); }
        GRID_BAR();
        if (l + 1 < DEPTH) { { PH_VARS ph_prep(WSP(float, WS_XRES), WSP(bf16, WS_XB), WSP(float, WS_RINV), WSP(float, WS_WG) + (size_t)(l + 1) * D * 8, WSP(float, WS_GATES), M, gw, NGW, lane); } GRID_BAR(); }
    }
    { PH_VARS ph_final(WSP(float, WS_XRES), ap->in[25], ap->out, gw, NGW, lane); }
}

extern "C" void kernel_launch(void* const* d_in, const int* in_sizes, int n_in, void* d_out, int out_size, void* d_ws, size_t ws_size, hipStream_t stream) {
    static int grid = 0;
    if (grid == 0) {
        if (ws_size < WS_END || n_in != 26) { fprintf(stderr, "kernel_launch: ws_size %zu < %zu or n_in %d != 26\n", ws_size, (size_t)WS_END, n_in); grid = -1; return; }
        int dev = 0, cus = 0, per_cu = 0;
        if (hipGetDevice(&dev) != hipSuccess || hipDeviceGetAttribute(&cus, hipDeviceAttributeMultiprocessorCount, dev) != hipSuccess) { grid = -1; return; }
        if (hipFuncSetAttribute((const void*)mk_fwd, hipFuncAttributeMaxDynamicSharedMemorySize, LDS_BYTES) != hipSuccess) { fprintf(stderr, "kernel_launch: hipFuncSetAttribute failed\n"); grid = -1; return; }
        if (hipOccupancyMaxActiveBlocksPerMultiprocessor(&per_cu, (const void*)mk_fwd, NTHR, LDS_BYTES) != hipSuccess || per_cu < 1) fprintf(stderr, "kernel_launch: occupancy query reports %d\n", per_cu);
        (void)hipGetLastError();
        grid = cus;
    }
    if (grid < 0) return;
    if (hipMemsetAsync((char*)d_ws + WS_CTL, 0, CTL_ZERO_BYTES, stream) != hipSuccess) { fprintf(stderr, "kernel_launch: memset failed\n"); return; }
    Args a{};
    for (int i = 0; i < 26; ++i) a.in[i] = (const float*)d_in[i];
    a.out = (float*)d_out; a.ws = (unsigned char*)d_ws;
    hipLaunchKernelGGL(mk_fwd, dim3(grid), dim3(NTHR), LDS_BYTES, stream, a);
}
```

```cpp
#include <hip/hip_runtime.h>
#include <cstdio>
#include <cstdint>
namespace pg8 {
#define PG8_LAS __attribute__((address_space(3)))
typedef unsigned short bf16_t;
typedef short bf16x8 __attribute__((ext_vector_type(8)));
typedef float f32x4 __attribute__((ext_vector_type(4)));
typedef unsigned u32x4 __attribute__((ext_vector_type(4)));
constexpr int BM = 256, BK = 64, HALF = 128, HTB = HALF * BK * 2  , STAGE_BYTES = 8 * HTB, NXCD = 8, WGM = 8;

__host__ __device__ __forceinline__ int lds_byte(int r, int c) { const int st = (r >> 4) * 2 + (c >> 5), rr = r & 15, cc = c & 31, ob = rr * 64 + cc * 2; return st * 1024 + (ob ^ (((ob >> 9) & 1) << 5)); }
__host__ __device__ __forceinline__ void stage_rc(int b, int& R, int& C) { const int st = b / 1024, sb = b % 1024, swz = sb ^ (((sb >> 9) & 1) << 5); R = (st >> 1) * 16 + swz / 64; C = (st & 1) * 32 + (swz % 64) / 2; }
__host__ __device__ __forceinline__ int perm32(int rho) { const int n = rho >> 4, i = rho & 15; return 8 * (i >> 2) + 4 * n + (i & 3); }

struct Unit { int pm, pn; };
struct Gemm { const bf16_t* A; const bf16_t* Bt; int M, N, K, pad; };

struct StaticOrder {
    int nM, nN, nwg, G, c;
    __host__ __device__ void init(int M, int N, int G_, int c_) { nM = M / BM; nN = N / BM; nwg = nM * nN; G = G_; c = c_; }
    __host__ __device__ bool next(int i, Unit& u) const {
        const long L = (long)i * G + c; if (L >= nwg) return false;
        int wgid = (int)L; { const int q = nwg / NXCD, r = nwg % NXCD, xcd = wgid % NXCD, off = wgid / NXCD; wgid = (xcd < r ? xcd * (q + 1) : r * (q + 1) + (xcd - r) * q) + off; }
        const int nig = WGM * nN, gid = wgid / nig, fm = gid * WGM, gsz = (nM - fm) < WGM ? (nM - fm) : WGM;
        u.pm = fm + ((wgid % nig) % gsz); u.pn = (wgid % nig) / gsz; return true;
    }
    __device__ __forceinline__ void a_ready(const Unit&) const {}
    __device__ __forceinline__ void done(const Unit&) const {}
};

__device__ __forceinline__ unsigned cvt_pk_bf16(float lo, float hi) { unsigned r; asm volatile("v_cvt_pk_bf16_f32 %0, %1, %2" : "=v"(r) : "v"(lo), "v"(hi)); return r; }
template <class Epi, class Sched, bool ALIGN_EPI = false, bool SP2 = false>
__device__ __forceinline__ void gemm_phase(PG8_LAS unsigned char* lds, const Gemm g, const Sched& S, const Epi& E) {
    int tid_ = threadIdx.x; asm volatile("" : "+v"(tid_));
    const int tid = tid_, wid = __builtin_amdgcn_readfirstlane(tid >> 6), lane = tid & 63, wr = wid >> 2, wc = wid & 3, fr = lane & 15, fq = lane >> 4;
    const int K = g.K, nt = K / BK;
    unsigned voffA[2], voffB[2];
#pragma unroll
    for (int i = 0; i < 2; ++i) { int R, C; stage_rc(tid * 16 + i * 8192, R, C); const int Rb = Epi::PERM ? ((R & ~31) + perm32(R & 31)) : R;
        voffA[i] = (unsigned)(R * K + C) * 2u; voffB[i] = (unsigned)(Rb * K + C) * 2u; }
    const size_t kstep = (size_t)(BK * 2);
    const size_t hstep = (size_t)HALF * K * 2;
    const size_t tstep = 2 * hstep;
    const unsigned ldsw = (unsigned)wid * 1024u;
    const int aoff = lds_byte(wr * 64 + fr, fq * 8), boff = lds_byte(wc * 32 + fr, fq * 8);
#define PG8_SA(b, h) (((b) * 2 + (h)) * HTB)
#define PG8_SB(b, h) ((4 + (b) * 2 + (h)) * HTB)
#define PG8_STAGE(bufoff, gbase, voff) do { _Pragma("unroll") for (int _i = 0; _i < 2; ++_i) \
        __builtin_amdgcn_global_load_lds((const unsigned*)((const char*)(gbase) + (voff)[_i]), (PG8_LAS unsigned*)(lds + (bufoff) + ldsw + _i * 8192), 16, 0, 0); } while (0)
#define PG8_LDA(dst, b, h) do { _Pragma("unroll") for (int m = 0; m < 4; ++m) _Pragma("unroll") for (int k = 0; k < 2; ++k) dst[m][k] = *(const PG8_LAS bf16x8*)(lds + PG8_SA(b, h) + aoff + m * 2048 + k * 1024); } while (0)
#define PG8_LDB(dst, b, h) do { _Pragma("unroll") for (int n = 0; n < 2; ++n) _Pragma("unroll") for (int k = 0; k < 2; ++k) dst[n][k] = *(const PG8_LAS bf16x8*)(lds + PG8_SB(b, h) + boff + n * 2048 + k * 1024); } while (0)
#define PG8_MMA(ai, bj, At, Bt) do { __builtin_amdgcn_s_setprio(1); _Pragma("unroll") for (int m = 0; m < 4; ++m) _Pragma("unroll") for (int n = 0; n < 2; ++n) _Pragma("unroll") for (int k = 0; k < 2; ++k) \
        acc[ai][bj][m][n] = __builtin_amdgcn_mfma_f32_16x16x32_bf16(Bt[n][k], At[m][k], acc[ai][bj][m][n], 0, 0, 0); __builtin_amdgcn_s_setprio(0); } while (0)
#define PG8_WAIT_V(n) asm volatile("s_waitcnt vmcnt(" #n ")" ::: "memory")
#define PG8_WAIT_L(n) asm volatile("s_waitcnt lgkmcnt(" #n ")" ::: "memory")
#define PG8_BAR __builtin_amdgcn_s_barrier()
#define PG8_SCHED __builtin_amdgcn_sched_barrier(0)
    Unit cur, nxt; int ui = 0;
    if (!S.next(0, cur)) return;
    f32x4 acc[2][2][4][2];
#pragma unroll
    for (int a = 0; a < 2; ++a)
#pragma unroll
        for (int b = 0; b < 2; ++b)
#pragma unroll
            for (int m = 0; m < 4; ++m)
#pragma unroll
                for (int n = 0; n < 2; ++n) acc[a][b][m][n] = (f32x4){0.f, 0.f, 0.f, 0.f};
    bf16x8 At[4][2], B0[2][2], B1[2][2];
    const char* cA = (const char*)g.A + (size_t)cur.pm * tstep; const char* cB = (const char*)g.Bt + (size_t)cur.pn * tstep;
    S.a_ready(cur);
    if constexpr (SP2) {
        PG8_STAGE(PG8_SB(0, 0), cB, voffB); PG8_STAGE(PG8_SB(0, 1), cB + hstep, voffB); PG8_STAGE(PG8_SA(0, 0), cA, voffA); PG8_STAGE(PG8_SA(0, 1), cA + hstep, voffA);
        if (wr == 1) PG8_BAR;
        PG8_WAIT_V(2); PG8_BAR;
        PG8_STAGE(PG8_SB(1, 0), cB + kstep, voffB); PG8_STAGE(PG8_SA(1, 0), cA + kstep, voffA); PG8_STAGE(PG8_SB(1, 1), cB + hstep + kstep, voffB);
        PG8_WAIT_V(6); PG8_BAR;
    } else {
        PG8_STAGE(PG8_SB(0, 0), cB, voffB); PG8_STAGE(PG8_SA(0, 0), cA, voffA); PG8_STAGE(PG8_SB(0, 1), cB + hstep, voffB); PG8_STAGE(PG8_SA(0, 1), cA + hstep, voffA);
        if (wr == 1) PG8_BAR;
        PG8_WAIT_V(4); PG8_BAR;
        PG8_STAGE(PG8_SB(1, 0), cB + kstep, voffB); PG8_STAGE(PG8_SA(1, 0), cA + kstep, voffA); PG8_STAGE(PG8_SB(1, 1), cB + hstep + kstep, voffB);
        PG8_WAIT_V(6); PG8_BAR;
    }
    for (;;) {
        const bool has_next = S.next(ui + 1, nxt);
        const char* nA = has_next ? (const char*)g.A + (size_t)nxt.pm * tstep : cA; const char* nB = has_next ? (const char*)g.Bt + (size_t)nxt.pn * tstep : cB;
        for (int t = 0; t < nt; t += 2) {
            const bool last = (t == nt - 2);
            const char* a1 = cA + (size_t)(t + 1) * kstep;
            const char* a2 = last ? nA : cA + (size_t)(t + 2) * kstep; const char* b2 = last ? nB : cB + (size_t)(t + 2) * kstep;
            const char* a3 = a2 + kstep; const char* b3 = b2 + kstep;
            if (last && has_next) S.a_ready(nxt);
            if constexpr (SP2) {
            PG8_LDB(B0, 0, 0); PG8_LDB(B1, 0, 1); PG8_SCHED; PG8_LDA(At, 0, 0); PG8_STAGE(PG8_SA(1, 1), a1 + hstep, voffA);
            PG8_WAIT_V(8); PG8_WAIT_L(0); PG8_BAR; PG8_MMA(0, 0, At, B0); PG8_MMA(0, 1, At, B1); PG8_BAR; PG8_SCHED;
            PG8_LDA(At, 0, 1); PG8_STAGE(PG8_SB(0, 0), b2, voffB); PG8_STAGE(PG8_SB(0, 1), b2 + hstep, voffB); PG8_STAGE(PG8_SA(0, 0), a2, voffA);
            PG8_WAIT_V(8); PG8_WAIT_L(0); PG8_BAR; PG8_MMA(1, 0, At, B0); PG8_MMA(1, 1, At, B1); PG8_BAR; PG8_SCHED;
            PG8_LDB(B0, 1, 0); PG8_LDB(B1, 1, 1); PG8_SCHED; PG8_LDA(At, 1, 0); PG8_STAGE(PG8_SA(0, 1), a2 + hstep, voffA);
            PG8_WAIT_V(8); PG8_WAIT_L(0); PG8_BAR; PG8_MMA(0, 0, At, B0); PG8_MMA(0, 1, At, B1); PG8_BAR; PG8_SCHED;
            PG8_LDA(At, 1, 1); PG8_STAGE(PG8_SB(1, 0), b3, voffB); PG8_STAGE(PG8_SB(1, 1), b3 + hstep, voffB); PG8_STAGE(PG8_SA(1, 0), a3, voffA);
            PG8_WAIT_V(8); PG8_WAIT_L(0); PG8_BAR; PG8_MMA(1, 0, At, B0); PG8_MMA(1, 1, At, B1); PG8_BAR; PG8_SCHED;
            } else {
            PG8_LDB(B0, 0, 0); PG8_SCHED; PG8_LDA(At, 0, 0); PG8_STAGE(PG8_SA(1, 1), a1 + hstep, voffA);
            PG8_WAIT_L(8); PG8_BAR; PG8_WAIT_L(0); PG8_MMA(0, 0, At, B0); PG8_BAR; PG8_SCHED;
            PG8_LDB(B1, 0, 1); PG8_STAGE(PG8_SB(0, 0), b2, voffB);
            PG8_BAR; PG8_WAIT_L(0); PG8_MMA(0, 1, At, B1); PG8_BAR;
            PG8_LDA(At, 0, 1); PG8_STAGE(PG8_SA(0, 0), a2, voffA);
            PG8_BAR; PG8_WAIT_L(0); PG8_MMA(1, 0, At, B0); PG8_BAR; PG8_SCHED;
            PG8_STAGE(PG8_SB(0, 1), b2 + hstep, voffB);
            PG8_WAIT_V(6); PG8_BAR; PG8_MMA(1, 1, At, B1); PG8_BAR;
            PG8_LDB(B0, 1, 0); PG8_SCHED; PG8_LDA(At, 1, 0); PG8_STAGE(PG8_SA(0, 1), a2 + hstep, voffA);
            PG8_WAIT_L(8); PG8_BAR; PG8_WAIT_L(0); PG8_MMA(0, 0, At, B0); PG8_BAR; PG8_SCHED;
            PG8_LDB(B1, 1, 1); PG8_STAGE(PG8_SB(1, 0), b3, voffB);
            PG8_BAR; PG8_WAIT_L(0); PG8_MMA(0, 1, At, B1); PG8_BAR;
            PG8_LDA(At, 1, 1); PG8_STAGE(PG8_SA(1, 0), a3, voffA);
            PG8_BAR; PG8_WAIT_L(0); PG8_MMA(1, 0, At, B0); PG8_BAR; PG8_SCHED;
            PG8_STAGE(PG8_SB(1, 1), b3 + hstep, voffB);
            PG8_WAIT_V(6); PG8_BAR; PG8_MMA(1, 1, At, B1); PG8_BAR;
            }
        }
        if constexpr (ALIGN_EPI) { if (wr == 0) PG8_BAR; }
        if constexpr (!Epi::AFTER_DRAIN) { E(acc, cur, wr, wc, fr, fq); S.done(cur); }
        if (!has_next) break;
#pragma unroll
        for (int a = 0; a < 2; ++a)
#pragma unroll
            for (int b = 0; b < 2; ++b)
#pragma unroll
                for (int m = 0; m < 4; ++m)
#pragma unroll
                    for (int n = 0; n < 2; ++n) acc[a][b][m][n] = (f32x4){0.f, 0.f, 0.f, 0.f};
        cur = nxt; cA = nA; cB = nB; ++ui;
        if constexpr (ALIGN_EPI) { if (wr == 1) PG8_BAR; }
    }
    PG8_WAIT_V(0);
    if constexpr (!ALIGN_EPI) { if (wr == 0) PG8_BAR; }
    PG8_BAR;
    if constexpr (Epi::AFTER_DRAIN) { E.fused(acc, cur, wr, wc, fr, fq, lds, wid, lane); S.done(cur); }
#undef PG8_SA
#undef PG8_SB
#undef PG8_STAGE
#undef PG8_LDA
#undef PG8_LDB
#undef PG8_MMA
#undef PG8_WAIT_V
#undef PG8_WAIT_L
#undef PG8_BAR
#undef PG8_SCHED
}
}

constexpr int NB = 4, T = 2048, D = 2048, M = NB * T, DEPTH = 2, MEM = 256, MM = NB * MEM;
constexpr int INC = 6408, NP = 6400;
constexpr int ML_DH = 192, MO_DH = 128;
constexpr int C_LX = 0, C_LZ = 512, C_MU = 1024, C_MO = 1792, C_MZ = 2560, C_Q = 3328, C_K = 4096, C_V = 4864, C_Z = 5632;
constexpr int SRC_GATE = 3328;
constexpr float RMS_EPS = 1e-6f, LN_EPS = 1e-5f;

typedef unsigned short bf16;
#define LAS __attribute__((address_space(3)))
__device__ __forceinline__ float bf2f(bf16 v) { return __uint_as_float(((unsigned)v) << 16); }
__device__ __forceinline__ bf16 f2bf(float f) { unsigned u = __float_as_uint(f); return (bf16)((u + 0x7fffu + ((u >> 16) & 1u)) >> 16); }
__device__ __forceinline__ unsigned pk2(float lo, float hi) { return (unsigned)f2bf(lo) | ((unsigned)f2bf(hi) << 16); }
__device__ __forceinline__ float sigm(float x) { return 1.f / (1.f + expf(-x)); }
__device__ __forceinline__ float silu(float x) { return x / (1.f + expf(-x)); }
__device__ __forceinline__ float logsig(float x) { return fminf(x, 0.f) - log1pf(expf(-fabsf(x))); }
__device__ __forceinline__ float wave_sum(float v) {
#pragma unroll
    for (int o = 1; o < 64; o <<= 1) v += __shfl_xor(v, o);
    return v;
}

constexpr size_t al256(size_t x) { return (x + 255) & ~(size_t)255; }
constexpr size_t WS_CTL = 0;
constexpr size_t WS_WIN = 1u << 20;
constexpr size_t WS_WOUT = WS_WIN + (size_t)DEPTH * NP * D * 2;
constexpr size_t WS_WQ = WS_WOUT + (size_t)DEPTH * D * D * 2;
constexpr size_t WS_WKV = WS_WQ + (size_t)DEPTH * 512 * D * 2;
constexpr size_t WS_WO = WS_WKV + (size_t)DEPTH * 1024 * D * 2;
constexpr size_t WS_WG = WS_WO + (size_t)DEPTH * D * 512 * 2;
constexpr size_t WS_MEMB = WS_WG + (size_t)DEPTH * D * 8 * 4;
constexpr size_t WS_RINVM = WS_MEMB + (size_t)MM * D * 2;
constexpr size_t WS_KV = WS_RINVM + (size_t)MM * 4;
constexpr size_t WS_XB = WS_KV + (size_t)DEPTH * MM * 1024 * 2;
constexpr size_t WS_RINV = WS_XB + (size_t)M * D * 2;
constexpr size_t WS_GATES = WS_RINV + (size_t)M * 4;
constexpr size_t WS_XRES = WS_GATES + (size_t)M * 8 * 4;
constexpr size_t WS_Y = WS_XRES + (size_t)M * D * 4;
constexpr size_t WS_P = WS_Y + (size_t)M * D * 2;
constexpr size_t WS_A = WS_P + (size_t)M * NP * 2;
constexpr size_t WS_U = WS_A + (size_t)M * 512 * 4;
constexpr size_t WS_MQ = WS_U + (size_t)M * 512 * 4;
constexpr size_t WS_MK = WS_MQ + (size_t)M * 768 * 2;
constexpr size_t WS_MV = WS_MK + (size_t)M * 768 * 2;
constexpr size_t WS_F = WS_MV + (size_t)M * 768 * 2;
constexpr size_t WS_I = WS_F + (size_t)16 * T * 4;
constexpr size_t WS_KMEAN = WS_I + (size_t)16 * T * 4;
constexpr size_t WS_SEL = WS_KMEAN + (size_t)NB * 6 * 8 * 128 * 4;
constexpr size_t WS_MOVT = WS_SEL + (size_t)M * 8;
constexpr size_t WS_END = WS_MOVT + (size_t)NB * 6 * 128 * T * 2;
constexpr size_t WS_XQ = WS_P;
constexpr size_t WS_XO = WS_P + (size_t)M * 512 * 2;
constexpr size_t WS_CPREV = WS_XRES;
constexpr size_t WS_MOPART = WS_XRES + 20000000;
static_assert(WS_CPREV + (size_t)256 * 36864 * 2 <= WS_MOPART && WS_MOPART + (size_t)384 * 4 * 66 * 64 * 4 <= WS_Y, "xres region overlays");
constexpr size_t WS_VTM = WS_MEMB;
constexpr size_t WS_LRUW = 512u << 10;
constexpr size_t OUT_CLOC = 0, OUT_NLOC = (size_t)256 * 36864, OUT_NPREV = OUT_NLOC + 256 * 192, OUT_AGGA = OUT_NPREV + 256 * 192, OUT_AGGH = OUT_AGGA + 512 * 512, OUT_CARRY = OUT_AGGH + 512 * 512, OUT_PART = OUT_CARRY + 512 * 512;
static_assert(OUT_PART + (size_t)M * 32 <= (size_t)M * D, "d_out scratch");
static_assert(WS_END <= 419954688ull, "workspace map exceeds the guaranteed ws_size");

__device__ __forceinline__ void wt_item(const float* W, int ldw, int src_col, const float* g, bf16* Wt, int K, int dst_row, float* scr, int k0, int lane) {
    typedef float f32x4w __attribute__((ext_vector_type(4)));
    f32x4w v[8];
#pragma unroll
    for (int i = 0; i < 8; ++i) v[i] = *(const f32x4w*)(W + (size_t)(k0 + 8 * i + (lane >> 3)) * ldw + src_col + (lane & 7) * 4);
#pragma unroll
    for (int i = 0; i < 8; ++i) { const int kk = 8 * i + (lane >> 3); const float gg = g ? g[k0 + kk] : 1.f; float* d = scr + kk * 33 + (lane & 7) * 4;
        d[0] = v[i][0] * gg; d[1] = v[i][1] * gg; d[2] = v[i][2] * gg; d[3] = v[i][3] * gg; }
    __builtin_amdgcn_s_waitcnt(0xc07f); asm volatile("" ::: "memory");
    const int c = lane & 7;
#pragma unroll
    for (int j = 0; j < 4; ++j) { const int n = (lane >> 3) + 8 * j; const float* s = scr + (8 * c) * 33 + n;
        uint4 o; o.x = pk2(s[0 * 33], s[1 * 33]); o.y = pk2(s[2 * 33], s[3 * 33]); o.z = pk2(s[4 * 33], s[5 * 33]); o.w = pk2(s[6 * 33], s[7 * 33]);
        *(uint4*)(Wt + (size_t)(dst_row + n) * K + k0 + 8 * c) = o; }
    __builtin_amdgcn_s_waitcnt(0xc07f); asm volatile("" ::: "memory");
}
struct EpiScaleBf16 {
    static constexpr bool PERM = true, AFTER_DRAIN = false;
    bf16* O; const float* rs; int ldc, pad;
    __device__ __forceinline__ void operator()(const pg8::f32x4 (&acc)[2][2][4][2], const pg8::Unit& u, int wr, int wc, int fr, int fq) const {
        const int row0 = u.pm * 256 + wr * 64 + fr, col0 = u.pn * 256 + wc * 32 + 8 * fq;
#pragma unroll
        for (int ai = 0; ai < 2; ++ai)
#pragma unroll
            for (int m = 0; m < 4; ++m) { const int row = row0 + ai * 128 + m * 16; const float s = rs ? rs[row] : 1.f; bf16* rowp = O + (size_t)row * ldc + col0;
#pragma unroll
                for (int bj = 0; bj < 2; ++bj) { const pg8::f32x4 v0 = acc[ai][bj][m][0] * s, v1 = acc[ai][bj][m][1] * s; pg8::u32x4 w;
                    w.x = pg8::cvt_pk_bf16(v0[0], v0[1]); w.y = pg8::cvt_pk_bf16(v0[2], v0[3]); w.z = pg8::cvt_pk_bf16(v1[0], v1[1]); w.w = pg8::cvt_pk_bf16(v1[2], v1[3]);
                    *(pg8::u32x4*)(rowp + bj * 128) = w; } }
    }
};
template <bool BASE_F32> struct EpiResPart {
    static constexpr bool PERM = true, AFTER_DRAIN = false;
    const void* base; bf16* xb; float* part; unsigned* cnt; float* rinv; int ldc, pad;
    __device__ __forceinline__ void operator()(const pg8::f32x4 (&acc)[2][2][4][2], const pg8::Unit& u, int wr, int wc, int fr, int fq) const {
        const int row0 = u.pm * 256 + wr * 64 + fr, col0 = u.pn * 256 + wc * 32 + 8 * fq;
#pragma unroll
        for (int ai = 0; ai < 2; ++ai)
#pragma unroll
            for (int m = 0; m < 4; ++m) { const int row = row0 + ai * 128 + m * 16; const size_t off = (size_t)row * ldc + col0; float ss = 0.f;
#pragma unroll
                for (int bj = 0; bj < 2; ++bj) { pg8::f32x4 b0, b1;
                    if (BASE_F32) { b0 = *(const pg8::f32x4*)((const float*)base + off + bj * 128); b1 = *(const pg8::f32x4*)((const float*)base + off + bj * 128 + 4); }
                    else { const pg8::u32x4 bb = *(const pg8::u32x4*)((const bf16*)base + off + bj * 128);
                        b0 = (pg8::f32x4){__uint_as_float(bb.x << 16), __uint_as_float(bb.x & 0xffff0000u), __uint_as_float(bb.y << 16), __uint_as_float(bb.y & 0xffff0000u)};
                        b1 = (pg8::f32x4){__uint_as_float(bb.z << 16), __uint_as_float(bb.z & 0xffff0000u), __uint_as_float(bb.w << 16), __uint_as_float(bb.w & 0xffff0000u)}; }
                    const pg8::f32x4 v0 = b0 + acc[ai][bj][m][0], v1 = b1 + acc[ai][bj][m][1];
                    ss += ((v0[0] * v0[0] + v0[1] * v0[1]) + (v0[2] * v0[2] + v0[3] * v0[3])) + ((v1[0] * v1[0] + v1[1] * v1[1]) + (v1[2] * v1[2] + v1[3] * v1[3]));
                    pg8::u32x4 w; w.x = pg8::cvt_pk_bf16(v0[0], v0[1]); w.y = pg8::cvt_pk_bf16(v0[2], v0[3]); w.z = pg8::cvt_pk_bf16(v1[0], v1[1]); w.w = pg8::cvt_pk_bf16(v1[2], v1[3]);
                    *(pg8::u32x4*)(xb + off + bj * 128) = w; }
                ss += __shfl_xor(ss, 16); ss += __shfl_xor(ss, 32);
                if (fq == 0) __hip_atomic_store((unsigned*)part + (size_t)row * 32 + u.pn * 4 + wc, __float_as_uint(ss), __ATOMIC_RELAXED, __HIP_MEMORY_SCOPE_AGENT); }
        asm volatile("s_waitcnt vmcnt(0)" ::: "memory");
        unsigned old = 0u; const int lane = fq * 16 + fr;
        if (lane == 0) old = __hip_atomic_fetch_add(cnt + 64 * u.pm, 1u, __ATOMIC_RELAXED, __HIP_MEMORY_SCOPE_AGENT);
        old = (unsigned)__builtin_amdgcn_readfirstlane((int)old);
        if (old == 63u) {
            __builtin_amdgcn_fence(__ATOMIC_ACQUIRE, "agent"); asm volatile("s_waitcnt vmcnt(0)" ::: "memory");
#pragma unroll 1
            for (int i = 0; i < 4; ++i) { const int row = u.pm * 256 + lane + 64 * i; const pg8::f32x4* pp = (const pg8::f32x4*)(part + (size_t)row * 32); float s = 0.f;
#pragma unroll
                for (int k = 0; k < 8; ++k) { const pg8::f32x4 v = pp[k]; s += (v[0] + v[1]) + (v[2] + v[3]); }
                rinv[row] = 1.0f / sqrtf(s * (1.0f / D) + RMS_EPS); }
        }
    }
};
struct EpiResF32 {
    static constexpr bool PERM = false, AFTER_DRAIN = false;
    const float* base; float* out; int ldc, pad;
    __device__ __forceinline__ void operator()(const pg8::f32x4 (&acc)[2][2][4][2], const pg8::Unit& u, int wr, int wc, int fr, int fq) const {
        const int row0 = u.pm * 256 + wr * 64 + fr, col0 = u.pn * 256 + wc * 32 + 4 * fq;
#pragma unroll
        for (int ai = 0; ai < 2; ++ai)
#pragma unroll
            for (int m = 0; m < 4; ++m) { const size_t off = (size_t)(row0 + ai * 128 + m * 16) * ldc + col0;
#pragma unroll
                for (int bj = 0; bj < 2; ++bj)
#pragma unroll
                    for (int n = 0; n < 2; ++n) { const pg8::f32x4 b = *(const pg8::f32x4*)(base + off + bj * 128 + n * 16); *(pg8::f32x4*)(out + off + bj * 128 + n * 16) = b + acc[ai][bj][m][n]; } }
    }
};
constexpr int NWAVES = 8, NTHR = 512;
constexpr int RING_BYTES = 131072, LDSCTL_OFF = 162816, MISC_OFF = LDSCTL_OFF + 320, LDS_BYTES = 163840;
constexpr size_t CTL_ZERO_BYTES = 1u << 20;
constexpr int CW_BAR = 4096, CW_PANEL = 8192;
typedef __attribute__((address_space(1))) unsigned gu32;
#define RLX_AGENT __ATOMIC_RELAXED, __HIP_MEMORY_SCOPE_AGENT
#define XB_TMO      128
#define XB_XCNT(j)  (256  + 64 * (j))
#define XB_XSUB(j)  (1280 + 64 * (j))
#define XB_XGEN(j)  (2304 + 64 * (j))
#define XB_TOP      3328
#define XB_TOPGEN   3392
#define XCD_BAR_WORDS 3456
#define XB_SPIN_CAP (1u << 18)

__device__ __forceinline__ unsigned xb_ld(unsigned* p)              { return __hip_atomic_load(p, __ATOMIC_RELAXED, __HIP_MEMORY_SCOPE_AGENT); }
__device__ __forceinline__ unsigned xb_add(unsigned* p, unsigned v) { return __hip_atomic_fetch_add(p, v, __ATOMIC_RELAXED, __HIP_MEMORY_SCOPE_AGENT); }
__device__ __forceinline__ unsigned xb_xcc_id() { return (unsigned)__builtin_amdgcn_s_getreg((3 << 11) | 20) & 0xFu; }
#define XB_SPIN(cond, bar) do { unsigned _sp = 0; while (cond) { __builtin_amdgcn_s_sleep(1); \
    if ((++_sp & 255u) == 0u) { if (xb_ld(&(bar)[XB_TMO])) break; if (_sp > XB_SPIN_CAP) { atomicAdd(&(bar)[XB_TMO], 1u); break; } } } } while (0)

struct XcdBarrier {
    unsigned* bar; unsigned x;
    volatile LAS unsigned* st;
};

__device__ __forceinline__ XcdBarrier xcd_barrier_post(unsigned* bar, volatile LAS unsigned* st) {
    XcdBarrier b; b.bar = bar; b.x = xb_xcc_id(); b.st = st;
    if (threadIdx.x == 0) (void)xb_add(&bar[XB_XCNT(b.x)], 1u);
    return b;
}
__device__ __forceinline__ void xcd_barrier_complete(unsigned* bar, unsigned x, unsigned& nloc, unsigned& nx) {
    const unsigned G = gridDim.x * gridDim.y * gridDim.z;
    unsigned sum, cnt, mine, sp = 0u;
    for (;;) {
        sum = 0u; cnt = 0u; mine = 0u;
#pragma unroll
        for (unsigned j = 0; j < 16; ++j) { const unsigned c = xb_ld(&bar[XB_XCNT(j)]); sum += c; cnt += (c > 0u) ? 1u : 0u; mine = (j == x) ? c : mine; }
        if (sum == G) break;
        __builtin_amdgcn_s_sleep(1);
        if ((++sp & 255u) == 0u) { if (xb_ld(&bar[XB_TMO])) break; if (sp > XB_SPIN_CAP) { atomicAdd(&bar[XB_TMO], 1u); break; } }
    }
    nloc = mine > 0u ? mine : 1u; nx = cnt > 0u ? cnt : 1u;
}

__device__ __forceinline__ void xcd_barrier(const XcdBarrier& b) {
    asm volatile("s_waitcnt vmcnt(0)" ::: "memory");
    __syncthreads();
    if (threadIdx.x == 0) {
        unsigned* bar = b.bar;
        __builtin_amdgcn_s_waitcnt(0);
        unsigned nloc = b.st[0], nx = b.st[1];
        if (nloc == 0u) { xcd_barrier_complete(bar, b.x, nloc, nx); b.st[0] = nloc; b.st[1] = nx; }
        const unsigned old = xb_add(&bar[XB_XSUB(b.x)], 1u);
        const unsigned gen = old / nloc;
        if (old + 1u == (gen + 1u) * nloc) {
            __builtin_amdgcn_fence(__ATOMIC_RELEASE, "agent");
            asm volatile("s_waitcnt vmcnt(0)" ::: "memory");
            const unsigned og = xb_add(&bar[XB_TOP], 1u);
            const unsigned tg = og / nx;
            if (og + 1u == (tg + 1u) * nx) xb_add(&bar[XB_TOPGEN], 1u);
            else XB_SPIN(xb_ld(&bar[XB_TOPGEN]) == tg, bar);
            __builtin_amdgcn_fence(__ATOMIC_ACQUIRE, "agent");
            xb_add(&bar[XB_XGEN(b.x)], 1u);
            asm volatile("s_waitcnt vmcnt(0)" ::: "memory");
        } else {
            XB_SPIN(xb_ld(&bar[XB_XGEN(b.x)]) == gen, bar);
            __builtin_amdgcn_fence(__ATOMIC_ACQUIRE, "agent");
            asm volatile("s_waitcnt vmcnt(0)" ::: "memory");
        }
    }
    __syncthreads();
}

constexpr int MIX_K = 3;
__device__ const int MIX_TAB[256][3] = {{480,208,12},{481,209,13},{482,210,14},{483,211,15},{484,212,16},{485,213,17},{486,214,18},{487,215,19},{488,160,8203},{489,161,8235},{490,162,8267},{491,163,8299},{492,164,8202},{493,165,8234},{494,166,8266},{495,167,8298},{496,168,8201},{497,169,8233},{498,170,8265},{499,171,8297},{500,172,8200},{501,173,8232},{502,174,8264},{503,175,8296},{448,4224,20},{449,4240,21},{450,4256,22},{451,4272,23},{452,4288,8192},{453,4304,8224},{454,4320,8256},{455,4336,8288},{456,192,8199},{457,193,8231},{458,194,8263},{459,195,8295},{460,196,8198},{461,197,8230},{462,198,8262},{463,199,8294},{464,200,8197},{465,201,8229},{466,202,8261},{467,203,8293},{468,204,8196},{469,205,8228},{470,206,8260},{471,207,8292},{416,232,8195},{417,233,8227},{418,234,8259},{419,235,8291},{420,236,8194},{421,237,8226},{422,238,8258},{423,239,8290},{424,240,8193},{425,241,8225},{426,242,8257},{427,243,8289},{428,244,0},{429,245,1},{430,246,2},{431,247,3},{432,4096,4},{433,4112,5},{434,4128,6},{435,4144,7},{436,4160,8},{437,4176,9},{438,4192,10},{439,4208,11},{384,4097,8207},{385,4113,8239},{386,4129,8271},{387,4145,8303},{388,4161,8206},{389,4177,8238},{390,4193,8270},{391,4209,8302},{392,4225,8205},{393,4241,8237},{394,4257,8269},{395,4273,8301},{396,4289,8204},{397,4305,8236},{398,4321,8268},{399,4337,8300},{400,224,8209},{401,225,8241},{402,226,8273},{403,227,8305},{404,228,8208},{405,229,8240},{406,230,8272},{407,231,8304},{352,4227,36},{353,4243,37},{354,4259,38},{355,4275,39},{356,4291,40},{357,4307,41},{358,4323,42},{359,4339,43},{360,4098,112},{361,4114,113},{362,4130,114},{363,4146,115},{364,4162,116},{365,4178,117},{366,4194,118},{367,4210,119},{368,4226,64},{369,4242,65},{370,4258,66},{371,4274,67},{372,4290,68},{373,4306,69},{374,4322,70},{375,4338,71},{4111,4228,44},{4127,4244,45},{4143,4260,46},{4159,4276,47},{4175,4292,48},{4191,4308,49},{4207,4324,50},{4223,4340,51},{4239,4099,72},{4255,4115,73},{4271,4131,74},{4287,4147,75},{4303,4163,76},{4319,4179,77},{4335,4195,78},{4351,4211,79},{4110,272,80},{4126,273,81},{4142,274,82},{4158,275,83},{4174,276,84},{4190,277,85},{4206,278,86},{4222,279,87},{4238,4100,8223},{4254,4116,8255},{4270,4132,8287},{4286,4148,8319},{4302,4164,8222},{4318,4180,8254},{4334,4196,8286},{4350,4212,8318},{4109,256,176},{4125,257,177},{4141,258,178},{4157,259,179},{4173,260,180},{4189,261,181},{4205,262,182},{4221,263,183},{4237,264,128},{4253,265,129},{4269,266,130},{4285,267,131},{4301,268,132},{4317,269,133},{4333,270,134},{4349,271,135},{320,4231,52},{321,4247,53},{322,4263,54},{323,4279,55},{324,4295,8212},{325,4311,8244},{326,4327,8276},{327,4343,8308},{328,4102,8221},{329,4118,8253},{330,4134,8285},{331,4150,8317},{332,4166,8220},{333,4182,8252},{334,4198,8284},{335,4214,8316},{336,4230,8219},{337,4246,8251},{338,4262,8283},{339,4278,8315},{340,4294,8218},{341,4310,8250},{342,4326,8282},{343,4342,8314},{4108,4101,136},{4124,4117,137},{4140,4133,138},{4156,4149,139},{4172,4165,140},{4188,4181,141},{4204,4197,142},{4220,4213,143},{4236,4229,144},{4252,4245,145},{4268,4261,146},{4284,4277,147},{4300,4293,148},{4316,4309,149},{4332,4325,150},{4348,4341,151},{4107,4232,8211},{4123,4248,8243},{4139,4264,8275},{4155,4280,8307},{4171,4296,8210},{4187,4312,8242},{4203,4328,8274},{4219,4344,8306},{4235,4103,8217},{4251,4119,8249},{4267,4135,8281},{4283,4151,8313},{4299,4167,8216},{4315,4183,8248},{4331,4199,8280},{4347,4215,8312},{4106,304,8215},{4122,305,8247},{4138,306,8279},{4154,307,8311},{4170,308,8214},{4186,309,8246},{4202,310,8278},{4218,311,8310},{4234,4104,8213},{4250,4120,8245},{4266,4136,8277},{4282,4152,8309},{4298,4168,32},{4314,4184,33},{4330,4200,34},{4346,4216,35},{4105,288,96},{4121,289,97},{4137,290,98},{4153,291,99},{4169,292,100},{4185,293,101},{4201,294,102},{4217,295,103},{4233,296,104},{4249,297,105},{4265,298,106},{4281,299,107},{4297,300,108},{4313,301,109},{4329,302,110},{4345,303,111}};
typedef short bf16x8 __attribute__((ext_vector_type(8)));
typedef unsigned u32x4 __attribute__((ext_vector_type(4)));
typedef unsigned u32x2 __attribute__((ext_vector_type(2)));
typedef short s16x4 __attribute__((ext_vector_type(4)));
typedef float f32x16 __attribute__((ext_vector_type(16)));
typedef float f32x4v __attribute__((ext_vector_type(4)));
typedef float f32x2_t __attribute__((ext_vector_type(2)));
typedef __bf16 bf16x2_t __attribute__((ext_vector_type(2)));
__device__ __forceinline__ unsigned cvtpk(float lo, float hi) { f32x2_t v = {lo, hi}; bf16x2_t b = __builtin_convertvector(v, bf16x2_t); return __builtin_bit_cast(unsigned, b); }
__device__ __forceinline__ bf16x8 pack8(float a0, float a1, float a2, float a3, float a4, float a5, float a6, float a7) {
    u32x4 u; u.x = cvtpk(a0, a1); u.y = cvtpk(a2, a3); u.z = cvtpk(a4, a5); u.w = cvtpk(a6, a7); return __builtin_bit_cast(bf16x8, u);
}
#define MFMA32(a, b, c) __builtin_amdgcn_mfma_f32_32x32x16_bf16((a), (b), (c), 0, 0, 0)

__device__ __forceinline__ void tr64_item(const bf16* src, size_t ld, bf16* dst, size_t ldt, LAS bf16* scr, int lane) {
#pragma unroll
    for (int i = 0; i < 8; ++i) { const int row = 8 * i + (lane >> 3), ch = lane & 7; const u32x4 v = *(const u32x4*)(src + (size_t)row * ld + ch * 8);
        LAS unsigned* w = (LAS unsigned*)(scr + row * 66 + ch * 8); w[0] = v.x; w[1] = v.y; w[2] = v.z; w[3] = v.w; }
    __builtin_amdgcn_s_waitcnt(0xc07f); asm volatile("" ::: "memory");
#pragma unroll
    for (int i = 0; i < 8; ++i) { const int c = 8 * i + (lane >> 3), tch = lane & 7;
        unsigned short e[8];
#pragma unroll
        for (int k = 0; k < 8; ++k) e[k] = scr[(tch * 8 + k) * 66 + c];
        u32x4 o; o.x = e[0] | ((unsigned)e[1] << 16); o.y = e[2] | ((unsigned)e[3] << 16); o.z = e[4] | ((unsigned)e[5] << 16); o.w = e[6] | ((unsigned)e[7] << 16);
        *(u32x4*)(dst + (size_t)c * ldt + tch * 8) = o; }
    __builtin_amdgcn_s_waitcnt(0xc07f); asm volatile("" ::: "memory");
}
__device__ __forceinline__ void ph_mo_vt(const bf16* p, bf16* VT, LAS unsigned char* L, int gw, int NGW, int wave, int lane) {
    LAS bf16* scr = (LAS bf16*)(L + wave * 8448);
    for (int it = gw; it < NB * (T / 64) * 12; it += NGW) {
        const int cb = it % 12, tb = (it / 12) % (T / 64), b = it / (12 * (T / 64));
        const int h = cb >> 1, d0 = (cb & 1) * 64, t0 = tb * 64;
        tr64_item(p + (size_t)(b * T + t0) * NP + C_V + h * 128 + d0, NP, VT + ((size_t)(b * 6 + h) * 128 + d0) * T + t0, T, scr, lane);
    }
}
__device__ __forceinline__ void ph_mo_kmean2(const bf16* p, float* kmean, float* Lf, int vb, int G, int tid) {
    for (int unit = vb; unit < NB * 6 * 8; unit += G) {
        const int blk = unit & 7, bh = unit >> 3, b = bh / 6, h = bh % 6, d = tid & 127, part = tid >> 7; float s = 0.f;
        float s1 = 0.f, s2 = 0.f, s3 = 0.f;
#pragma unroll 4
        for (int i = 0; i < 64; i += 4) { const size_t o = (size_t)(b * T + blk * 256 + part * 64 + i) * NP + C_K + h * 128 + d; s += bf2f(p[o]); s1 += bf2f(p[o + NP]); s2 += bf2f(p[o + 2 * (size_t)NP]); s3 += bf2f(p[o + 3 * (size_t)NP]); }
        s = (s + s1) + (s2 + s3);
        __syncthreads(); Lf[tid] = s; __syncthreads();
        if (tid < 128) kmean[(size_t)unit * 128 + tid] = (Lf[tid] + Lf[128 + tid] + Lf[256 + tid] + Lf[384 + tid]) * (1.0f / 256.0f);
    }
}

constexpr int MO_KST = 272, MO_VST = 136;
constexpr int MO_KB = 64 * MO_KST, MO_VB = 128 * MO_VST, MO_GRP = MO_KB + MO_VB;
constexpr int MO_KM_OFF = 2 * MO_GRP;
constexpr int MO_Q_OFF = MO_KM_OFF + 4096;
template <int MODE> __device__ __forceinline__ void attn_unit(LAS unsigned char* L, const bf16* p, const bf16* VT, const float* kmean, bf16* y, int unit, const float* rinv = nullptr, const bf16* wqw = nullptr, int ta = 0, int tb = 0, int slot = -1, float* part = nullptr) {
    int tid_ = threadIdx.x; asm volatile("" : "+v"(tid_));
    const int tid = tid_, lane = tid & 63, wave = __builtin_amdgcn_readfirstlane(tid >> 6), grp = wave >> 2, wq = wave & 3, r = lane & 31, hh = lane >> 5, tg = tid & 255;
    constexpr int NH = MODE == 0 ? 6 : 4, LDQ = MODE == 0 ? NP : 512, LDK = MODE == 0 ? NP : 1024, LDV = MODE == 0 ? T : MEM, QC = MODE == 0 ? C_Q : 0, KC = MODE == 0 ? C_K : 0;
    const int qh = MODE == 0 ? unit >> 5 : unit / 16, bh = MODE == 0 ? unit & 31 : unit % 16,   b = bh / NH, h = bh % NH, qb = qh >> 1, half = qh & 1, t0 = qh * 128;
    const int tq = t0 + 32 * wq + r;
    const bf16* prow = p + (size_t)(b * T) * LDQ;
    const bf16* krow = MODE == 0 ? prow : (const bf16*)kmean + (size_t)(b * MEM) * LDK;
    const bf16* vt = VT + (size_t)(b * NH + h) * 128 * LDV;
    LAS float* km = (LAS float*)(L + MO_KM_OFF);
    __syncthreads();
    if (MODE == 0) for (int e = tid; e < 8 * 128; e += NTHR) km[e] = kmean[(size_t)bh * 8 * 128 + e];
    LAS unsigned char* Qt = L + MO_Q_OFF;
    if (MODE == 0) {
#pragma unroll
        for (int i_ = 0; i_ < 4; ++i_) { const int c_ = tid + 512 * i_; *(LAS u32x4*)(Qt + (c_ >> 4) * MO_KST + (c_ & 15) * 16) = *(const u32x4*)(prow + (size_t)(t0 + (c_ >> 4)) * LDQ + QC + h * 128 + (c_ & 15) * 8); }
    } else {
        constexpr int GST = 144, GTB = 128 * GST, GSTG = 2 * GTB;
        const bf16* xg = p + (size_t)(b * T + t0) * D; const bf16* wg = wqw + (size_t)(h * 128) * D;
        const int wd = wave >> 2;
        f32x16 acc0, acc1;
#pragma unroll
        for (int q = 0; q < 16; ++q) { acc0[q] = 0.f; acc1[q] = 0.f; }
        u32x4 ra[2], rb[2];
#define QG_LOAD(kt) do { _Pragma("unroll") for (int i_ = 0; i_ < 2; ++i_) { const int c_ = tid + 512 * i_; \
            ra[i_] = *(const u32x4*)(wg + (size_t)(c_ >> 3) * D + (kt) * 64 + (c_ & 7) * 8); rb[i_] = *(const u32x4*)(xg + (size_t)(c_ >> 3) * D + (kt) * 64 + (c_ & 7) * 8); } } while (0)
#define QG_STORE(st) do { _Pragma("unroll") for (int i_ = 0; i_ < 2; ++i_) { const int c_ = tid + 512 * i_; \
            *(LAS u32x4*)(L + (st) * GSTG + (c_ >> 3) * GST + (c_ & 7) * 16) = ra[i_]; *(LAS u32x4*)(L + (st) * GSTG + GTB + (c_ >> 3) * GST + (c_ & 7) * 16) = rb[i_]; } } while (0)
        QG_LOAD(0); QG_STORE(0);
        __syncthreads();
#pragma unroll 1
        for (int kt = 0; kt < 32; ++kt) {
            if (kt + 1 < 32) QG_LOAD(kt + 1);
            const LAS unsigned char* sa = L + (kt & 1) * GSTG + (64 * wd + r) * GST + 16 * hh; const LAS unsigned char* sb = L + (kt & 1) * GSTG + GTB + (32 * wq + r) * GST + 16 * hh;
#pragma unroll
            for (int ks = 0; ks < 4; ++ks) { const bf16x8 bq = *(const LAS bf16x8*)(sb + 32 * ks);
                acc0 = MFMA32(*(const LAS bf16x8*)(sa + 32 * ks), bq, acc0); acc1 = MFMA32(*(const LAS bf16x8*)(sa + 32 * GST + 32 * ks), bq, acc1); }
            if (kt + 1 < 32) QG_STORE((kt + 1) & 1);
            __syncthreads();
        }
#undef QG_LOAD
#undef QG_STORE
        const float rv = rinv[(size_t)b * T + tq];
#pragma unroll
        for (int g4 = 0; g4 < 4; ++g4) { const int d0 = 64 * wd + 8 * g4 + 4 * hh;
            *(LAS u32x2*)(Qt + (32 * wq + r) * MO_KST + d0 * 2) = (u32x2){cvtpk(acc0[4 * g4] * rv, acc0[4 * g4 + 1] * rv), cvtpk(acc0[4 * g4 + 2] * rv, acc0[4 * g4 + 3] * rv)};
            *(LAS u32x2*)(Qt + (32 * wq + r) * MO_KST + (d0 + 32) * 2) = (u32x2){cvtpk(acc1[4 * g4] * rv, acc1[4 * g4 + 1] * rv), cvtpk(acc1[4 * g4 + 2] * rv, acc1[4 * g4 + 3] * rv)}; }
    }
    __syncthreads();
    const LAS unsigned char* qrow = Qt + (32 * wq + r) * MO_KST + 16 * hh;
#define MO_QF(ks) (*(const LAS bf16x8*)(qrow + 32 * (ks)))
    unsigned mask = 0xffffffffu;
    if (MODE == 0) {
        float g0 = 0, g1 = 0, g2 = 0, g3 = 0, g4 = 0, g5 = 0, g6 = 0;
#pragma unroll
        for (int ks = 0; ks < 8; ++ks)
            { const bf16x8 qv8 = MO_QF(ks);
#pragma unroll
            for (int j = 0; j < 8; ++j) { const float qv = bf2f((bf16)qv8[j]); const int d = 16 * ks + 8 * hh + j;
                g0 += qv * km[d]; g1 += qv * km[128 + d]; g2 += qv * km[256 + d]; g3 += qv * km[384 + d]; g4 += qv * km[512 + d]; g5 += qv * km[640 + d]; g6 += qv * km[768 + d]; } }
        g0 += __shfl_xor(g0, 32); g1 += __shfl_xor(g1, 32); g2 += __shfl_xor(g2, 32); g3 += __shfl_xor(g3, 32); g4 += __shfl_xor(g4, 32); g5 += __shfl_xor(g5, 32); g6 += __shfl_xor(g6, 32);
        const float gv[7] = {g0, g1, g2, g3, g4, g5, g6};
        mask = 0;
        if (qb <= 3) mask = (1u << qb) - 1u;
        else {
#pragma unroll
            for (int pass = 0; pass < 3; ++pass) { float best = -INFINITY; int bi = -1;
#pragma unroll
                for (int j = 0; j < 7; ++j) if (j < qb && !((mask >> j) & 1u) && gv[j] > best) { best = gv[j]; bi = j; }
                if (bi >= 0) mask |= 1u << bi; }
        }
        mask |= 1u << qb;
    }
    const float LOG2E = 1.4426950408889634f;
    const float c1 = 0.08838834764831845f * LOG2E;
    const float slope = (h == 0) ? 0.25f : (h == 1) ? 0.0625f : (h == 2) ? 0.015625f : (h == 3) ? 0.00390625f : (h == 4) ? 0.5f : 0.125f;
    const float slope2 = MODE == 0 ? slope * LOG2E : 0.f;
    const int nh = MODE == 0 ? (tb - ta) >> 1 : 2, tile0 = (MODE == 0 ? ta : 0) + grp * nh;
    LAS unsigned char* Kt = L + grp * MO_GRP; LAS unsigned char* Vt = Kt + MO_KB;
    f32x16 O[4];
#pragma unroll
    for (int i = 0; i < 4; ++i)
#pragma unroll
        for (int j = 0; j < 16; ++j) O[i][j] = 0.f;
    float mrun = -1e30f, lsum = 0.f;
    u32x4 kreg[4], vreg[4];
#define MO_LOAD(ti) do { const int s0_ = (ti) * 64; _Pragma("unroll") for (int i_ = 0; i_ < 4; ++i_) { const int c_ = tg + 256 * i_; \
        kreg[i_] = *(const u32x4*)(krow + (size_t)(s0_ + (c_ >> 4)) * LDK + KC + h * 128 + (c_ & 15) * 8); \
        vreg[i_] = *(const u32x4*)(vt + (size_t)(c_ >> 3) * LDV + s0_ + (c_ & 7) * 8); } } while (0)
#define MO_STORE() do { _Pragma("unroll") for (int i_ = 0; i_ < 4; ++i_) { const int c_ = tg + 256 * i_; \
        *(LAS u32x4*)(Kt + (c_ >> 4) * MO_KST + (c_ & 15) * 16) = kreg[i_]; \
        LAS u32x2* vd_ = (LAS u32x2*)(Vt + (c_ >> 3) * MO_VST + (c_ & 7) * 16); vd_[0] = (u32x2){vreg[i_].x, vreg[i_].y}; vd_[1] = (u32x2){vreg[i_].z, vreg[i_].w}; } } while (0)
    MO_LOAD(tile0);
    for (int i = 0; i < nh; ++i) {
        const int ti = tile0 + i, s0 = ti * 64, j = ti >> 2;
        MO_STORE();
        __syncthreads();
        if (i + 1 < nh) MO_LOAD(ti + 1);
        const bool sel = MODE == 0 ? ((mask >> j) & 1u) : true;
        const bool active = MODE == 0 ? ((__ballot(sel) != 0ull) && (s0 <= t0 + 32 * wq + 31)) : true;
        if (active) {
            f32x16 S0, S1;
#pragma unroll
            for (int q = 0; q < 16; ++q) { S0[q] = 0.f; S1[q] = 0.f; }
#pragma unroll
            for (int ks = 0; ks < 8; ++ks) {
                const bf16x8 k0 = *(const LAS bf16x8*)(Kt + r * MO_KST + (16 * ks + 8 * hh) * 2);
                const bf16x8 k1 = *(const LAS bf16x8*)(Kt + (32 + r) * MO_KST + (16 * ks + 8 * hh) * 2);
                const bf16x8 qq = MO_QF(ks); S0 = MFMA32(k0, qq, S0); S1 = MFMA32(k1, qq, S1);
            }
            const float base0 = MODE == 0 ? slope2 * (float)(s0 + 4 * hh - tq) : 0.f, s32 = 32.0f * slope2;
            const bool need_mask = MODE == 0 && ((__ballot(sel) != ~0ull) || (s0 + 63 > t0 + 32 * wq));
            float mx = -INFINITY;
            if (need_mask) {
#pragma unroll
                for (int R = 0; R < 16; ++R) { const int ko = (R & 3) + 8 * (R >> 2); const int sa = s0 + 4 * hh + ko, sb = sa + 32;
                    const float bb = base0 + slope2 * (float)ko; float za = S0[R] * c1 + bb, zb = S1[R] * c1 + (bb + s32);
                    za = (sel && sa <= tq) ? za : -INFINITY; zb = (sel && sb <= tq) ? zb : -INFINITY;
                    S0[R] = za; S1[R] = zb; mx = fmaxf(mx, fmaxf(za, zb)); }
            } else {
#pragma unroll
                for (int R = 0; R < 16; ++R) { const int ko = (R & 3) + 8 * (R >> 2);
                    const float bb = base0 + slope2 * (float)ko; const float za = S0[R] * c1 + bb, zb = S1[R] * c1 + (bb + s32);
                    S0[R] = za; S1[R] = zb; mx = fmaxf(mx, fmaxf(za, zb)); }
            }
            { auto rr = __builtin_amdgcn_permlane32_swap(__float_as_uint(mx), __float_as_uint(mx), false, false); mx = fmaxf(__uint_as_float(rr[0]), __uint_as_float(rr[1])); }
            if (__any(mx > mrun + 8.0f)) {
                const float mnew = fmaxf(mrun, mx), alpha = __builtin_amdgcn_exp2f(mrun - mnew); mrun = mnew; lsum *= alpha;
#pragma unroll
                for (int i2 = 0; i2 < 4; ++i2)
#pragma unroll
                    for (int q = 0; q < 16; ++q) O[i2][q] *= alpha;
            }
            float ps = 0.f;
#pragma unroll
            for (int R = 0; R < 16; ++R) { S0[R] = __builtin_amdgcn_exp2f(S0[R] - mrun); S1[R] = __builtin_amdgcn_exp2f(S1[R] - mrun); ps += S0[R] + S1[R]; }
            lsum += ps;
            const bf16x8 p00 = pack8(S0[0], S0[1], S0[2], S0[3], S0[4], S0[5], S0[6], S0[7]), p01 = pack8(S0[8], S0[9], S0[10], S0[11], S0[12], S0[13], S0[14], S0[15]);
            const bf16x8 p10 = pack8(S1[0], S1[1], S1[2], S1[3], S1[4], S1[5], S1[6], S1[7]), p11 = pack8(S1[8], S1[9], S1[10], S1[11], S1[12], S1[13], S1[14], S1[15]);
#pragma unroll
            for (int db = 0; db < 4; ++db) {
                const LAS unsigned char* vrow = Vt + (32 * db + r) * MO_VST + 8 * hh;
#define MO_VF(kb, s) ({ const u32x2 lo_ = *(const LAS u32x2*)(vrow + (32 * (kb) + 16 * (s)) * 2), hi_ = *(const LAS u32x2*)(vrow + (32 * (kb) + 16 * (s) + 8) * 2); \
                        u32x4 u_ = {lo_.x, lo_.y, hi_.x, hi_.y}; __builtin_bit_cast(bf16x8, u_); })
                O[db] = MFMA32(MO_VF(0, 0), p00, O[db]); O[db] = MFMA32(MO_VF(0, 1), p01, O[db]);
                O[db] = MFMA32(MO_VF(1, 0), p10, O[db]); O[db] = MFMA32(MO_VF(1, 1), p11, O[db]);
            }
        }
        __syncthreads();
    }
    lsum += __shfl_xor(lsum, 32);
    LAS float* X = (LAS float*)L;
    if (grp == 1) {
#pragma unroll
        for (int db = 0; db < 4; ++db)
#pragma unroll
            for (int q = 0; q < 16; ++q) X[(wq * 66 + db * 16 + q) * 64 + lane] = O[db][q];
        X[(wq * 66 + 64) * 64 + lane] = mrun; X[(wq * 66 + 65) * 64 + lane] = lsum;
    }
    __syncthreads();
    if (grp == 0) {
        const float m1 = X[(wq * 66 + 64) * 64 + lane], l1 = X[(wq * 66 + 65) * 64 + lane];
        const float mm = fmaxf(mrun, m1), a0 = __builtin_amdgcn_exp2f(mrun - mm), a1 = __builtin_amdgcn_exp2f(m1 - mm);
        if (MODE == 0 && slot >= 0) {
            float* Xg = part + (size_t)slot * (4 * 66 * 64);
#pragma unroll
            for (int db = 0; db < 4; ++db)
#pragma unroll
                for (int q = 0; q < 16; ++q) Xg[(wq * 66 + db * 16 + q) * 64 + lane] = O[db][q] * a0 + X[(wq * 66 + db * 16 + q) * 64 + lane] * a1;
            Xg[(wq * 66 + 64) * 64 + lane] = mm; Xg[(wq * 66 + 65) * 64 + lane] = lsum * a0 + l1 * a1;
            return;
        }
        const float inv = 1.0f / (lsum * a0 + l1 * a1);
        const size_t m = (size_t)b * T + tq;
#pragma unroll
        for (int db = 0; db < 4; ++db)
#pragma unroll
            for (int g4 = 0; g4 < 4; ++g4) { const int d = 32 * db + 8 * g4 + 4 * hh;
                float o[4];
#pragma unroll
                for (int e = 0; e < 4; ++e) o[e] = (O[db][4 * g4 + e] * a0 + X[(wq * 66 + db * 16 + 4 * g4 + e) * 64 + lane] * a1) * inv;
                if (MODE == 0) { const u32x2 zz = *(const u32x2*)(p + m * NP + C_Z + h * 128 + d);
                    const float z0 = bf2f((bf16)(zz.x & 0xffff)), z1 = bf2f((bf16)(zz.x >> 16)), z2 = bf2f((bf16)(zz.y & 0xffff)), z3 = bf2f((bf16)(zz.y >> 16));
                    u32x2 w; w.x = cvtpk(o[0] * silu(z0), o[1] * silu(z1)); w.y = cvtpk(o[2] * silu(z2), o[3] * silu(z3));
                    *(u32x2*)(y + m * D + 1280 + h * 128 + d) = w; }
                else { u32x2 w; w.x = cvtpk(o[0], o[1]); w.y = cvtpk(o[2], o[3]); *(u32x2*)(y + m * 512 + h * 128 + d) = w; } }
    }
#undef MO_LOAD
#undef MO_STORE
#undef MO_VF
#undef MO_QF
}
__device__ __forceinline__ void ph_mo_merge(const float* part, const bf16* p, bf16* y, int gw, int NGW, int lane) {
    const int r = lane & 31, hh = lane >> 5;
    for (int it = gw; it < 192 * 4; it += NGW) { const int pi = it >> 2, wq = it & 3, qh = 15 - pi / 24, bh = pi % 24, b = bh / 6, h = bh % 6;
        const float* X0 = part + (size_t)(2 * pi) * (4 * 66 * 64) + (size_t)wq * 66 * 64 + lane; const float* X1 = X0 + 4 * 66 * 64;
        const float m0 = X0[64 * 64], m1 = X1[64 * 64], l0 = X0[65 * 64], l1 = X1[65 * 64];
        const float mm = fmaxf(m0, m1), a0 = __builtin_amdgcn_exp2f(m0 - mm), a1 = __builtin_amdgcn_exp2f(m1 - mm), inv = 1.0f / (l0 * a0 + l1 * a1);
        const size_t m = (size_t)b * T + qh * 128 + 32 * wq + r;
#pragma unroll
        for (int db = 0; db < 4; ++db)
#pragma unroll
            for (int g4 = 0; g4 < 4; ++g4) { const int d = 32 * db + 8 * g4 + 4 * hh; float o[4];
#pragma unroll
                for (int e = 0; e < 4; ++e) { const int idx = db * 16 + 4 * g4 + e; o[e] = (X0[idx * 64] * a0 + X1[idx * 64] * a1) * inv; }
                const u32x2 zz = *(const u32x2*)(p + m * NP + C_Z + h * 128 + d);
                const float z0 = bf2f((bf16)(zz.x & 0xffff)), z1 = bf2f((bf16)(zz.x >> 16)), z2 = bf2f((bf16)(zz.y & 0xffff)), z3 = bf2f((bf16)(zz.y >> 16));
                u32x2 w; w.x = cvtpk(o[0] * silu(z0), o[1] * silu(z1)); w.y = cvtpk(o[2] * silu(z2), o[3] * silu(z3));
                *(u32x2*)(y + m * D + 1280 + h * 128 + d) = w; }
    }
}
__device__ __forceinline__ void ph_mem_vt(const bf16* KV, bf16* VTm, LAS unsigned char* L, int gw, int NGW, int wave, int lane) {
    LAS bf16* scr = (LAS bf16*)(L + wave * 8448);
    for (int it = gw; it < DEPTH * NB * 4 * 8; it += NGW) {
        const int cb = it & 7, sb = (it >> 3) & 3, b = (it >> 5) & 3, l = it >> 7; const int h = cb >> 1, d0 = (cb & 1) * 64, s0 = sb * 64;
        tr64_item(KV + ((size_t)l * MM + b * MEM + s0) * 1024 + 512 + h * 128 + d0, 1024, VTm + (((size_t)l * 16 + b * 4 + h) * 128 + d0) * MEM + s0, MEM, scr, lane);
    }
}
constexpr int MLC_ST = 272;
constexpr int MLC_B_OFF = 192 * MLC_ST, MLC_VS_OFF = 2 * 192 * MLC_ST, MLC_KS_OFF = MLC_VS_OFF + 64 * 194 * 2, MLC_TB_OFF = MLC_KS_OFF + 64 * 194 * 2;
__device__ __forceinline__ void ml_chunk_unit(LAS unsigned char* L, const bf16* p, const float* gates, const float* cw, const float* cb, const float* wq, const float* wk, const float* wv, const float* bi, const float* bf,
                                              const bf16* xb, const float* rinv, const float* Wg, bf16* Q, bf16* K, bf16* VT, float* Fl, float* Ib, bf16* Cloc, float* nloc, int unit) {
    int tid_ = threadIdx.x; asm volatile("" : "+v"(tid_)); const int tid = tid_, lane = tid & 63, wave = __builtin_amdgcn_readfirstlane(tid >> 6), r = lane & 31, hh = lane >> 5;
    const int c = unit & 15, bh = unit >> 4, b = bh >> 2, h = bh & 3, t0 = c * 128;
    LAS unsigned char* At = L; LAS unsigned char* Bt = L + MLC_B_OFF; LAS bf16* Vs = (LAS bf16*)(L + MLC_VS_OFF); LAS bf16* Ks = (LAS bf16*)(L + MLC_KS_OFF);
    LAS float* Fls = (LAS float*)(L + MLC_TB_OFF); LAS float* wvs = Fls + 128; LAS float* tot = wvs + 128;
    __syncthreads();
    { LAS float* wgi = (LAS float*)L; LAS float* wgf = wgi + 2048; LAS float* part = wgf + 2048;
      for (int k = tid; k < 2048; k += 512) { wgi[k] = Wg[(size_t)k * 8 + h]; wgf[k] = Wg[(size_t)k * 8 + 4 + h]; }
      __syncthreads();
      const int tk = tid >> 2, qd = tid & 3; const bf16* xr = xb + ((size_t)b * T + t0 + tk) * D + qd * 512; float ai = 0.f, af = 0.f;
#pragma unroll 4
      for (int i = 0; i < 64; ++i) { const u32x4 xv = *(const u32x4*)(xr + 8 * i);
          const f32x4v wi0 = *(const LAS f32x4v*)(wgi + qd * 512 + 8 * i), wi1 = *(const LAS f32x4v*)(wgi + qd * 512 + 8 * i + 4), wf0 = *(const LAS f32x4v*)(wgf + qd * 512 + 8 * i), wf1 = *(const LAS f32x4v*)(wgf + qd * 512 + 8 * i + 4);
          const float x0 = __uint_as_float(xv.x << 16), x1 = __uint_as_float(xv.x & 0xffff0000u), x2 = __uint_as_float(xv.y << 16), x3 = __uint_as_float(xv.y & 0xffff0000u), x4 = __uint_as_float(xv.z << 16), x5 = __uint_as_float(xv.z & 0xffff0000u), x6 = __uint_as_float(xv.w << 16), x7 = __uint_as_float(xv.w & 0xffff0000u);
          ai += (x0 * wi0[0] + x1 * wi0[1]) + (x2 * wi0[2] + x3 * wi0[3]) + (x4 * wi1[0] + x5 * wi1[1]) + (x6 * wi1[2] + x7 * wi1[3]);
          af += (x0 * wf0[0] + x1 * wf0[1]) + (x2 * wf0[2] + x3 * wf0[3]) + (x4 * wf1[0] + x5 * wf1[1]) + (x6 * wf1[2] + x7 * wf1[3]); }
      ai += __shfl_xor(ai, 1); ai += __shfl_xor(ai, 2); af += __shfl_xor(af, 1); af += __shfl_xor(af, 2);
      if (qd == 0) { const float rv = rinv[(size_t)b * T + t0 + tk]; part[tk] = ai * rv; part[128 + tk] = af * rv; }
      __syncthreads(); }
    float igv = 0.f, inc = 0.f;
    if (tid < 128) { LAS float* part = (LAS float*)L + 4096; const float lf = logsig(part[128 + tid] + bf[h]); igv = part[tid] + bi[h]; inc = lf;
#pragma unroll
        for (int o = 1; o < 64; o <<= 1) { const float v = __shfl_up(inc, o); if (lane >= o) inc += v; }
        if (tid == 63) tot[0] = inc; }
    __syncthreads();
    if (tid < 128) { if (tid >= 64) inc += tot[0]; Fls[tid] = inc; Fl[bh * T + t0 + tid] = inc; Ib[bh * T + t0 + tid] = igv; }
    __syncthreads();
    if (tid < 128) wvs[tid] = expf(Fls[127] - inc + igv);
    const int j4 = tid % 48, tsub = tid / 48, cc = h * 192 + 4 * j4, jg = h * 48 + j4; const bool worker = tid < 384;
    float cwr[4][4], cbr[4], wqr[16], wkr[16], wvr[16];
#pragma unroll
    for (int e = 0; e < 4; ++e) { cbr[e] = cb[cc + e];
#pragma unroll
        for (int jj = 0; jj < 4; ++jj) cwr[jj][e] = cw[jj * 768 + cc + e]; }
    { const f32x4v* a = (const f32x4v*)(wq + jg * 16); const f32x4v* bq = (const f32x4v*)(wk + jg * 16); const f32x4v* cq = (const f32x4v*)(wv + jg * 16);
#pragma unroll
      for (int e = 0; e < 4; ++e) { const f32x4v x = a[e], y = bq[e], z = cq[e];
#pragma unroll
          for (int o = 0; o < 4; ++o) { wqr[e * 4 + o] = x[o]; wkr[e * 4 + o] = y[o] * 0.07216878364870322f; wvr[e * 4 + o] = z[o]; } } }
#pragma unroll 1
    for (int half = 0; half < 2; ++half) {
        const int ts = t0 + 64 * half;
        if (worker) {
            const int tl0 = 8 * tsub, tfirst = ts + tl0; const size_t m0 = (size_t)b * T + tfirst;
            float xw[3][4];
#pragma unroll
            for (int jj = 0; jj < 3; ++jj) { u32x2 uu = {0u, 0u}; if (tfirst - 3 + jj >= 0) uu = *(const u32x2*)(p + (m0 - 3 + jj) * NP + C_MU + cc);
                xw[jj][0] = __uint_as_float(uu.x << 16); xw[jj][1] = __uint_as_float(uu.x & 0xffff0000u); xw[jj][2] = __uint_as_float(uu.y << 16); xw[jj][3] = __uint_as_float(uu.y & 0xffff0000u); }
            u32x2 un[8];
#pragma unroll
            for (int i = 0; i < 8; ++i) un[i] = *(const u32x2*)(p + (m0 + i) * NP + C_MU + cc);
#pragma unroll
            for (int i = 0; i < 8; ++i) {
                float u4[4] = {__uint_as_float(un[i].x << 16), __uint_as_float(un[i].x & 0xffff0000u), __uint_as_float(un[i].y << 16), __uint_as_float(un[i].y & 0xffff0000u)};
                float uc[4];
#pragma unroll
                for (int e = 0; e < 4; ++e) uc[e] = silu(cbr[e] + cwr[0][e] * xw[0][e] + cwr[1][e] * xw[1][e] + cwr[2][e] * xw[2][e] + cwr[3][e] * u4[e]);
                float q[4], k[4], v[4];
#pragma unroll
                for (int o = 0; o < 4; ++o) { q[o] = uc[0] * wqr[o] + uc[1] * wqr[4 + o] + uc[2] * wqr[8 + o] + uc[3] * wqr[12 + o];
                    k[o] = uc[0] * wkr[o] + uc[1] * wkr[4 + o] + uc[2] * wkr[8 + o] + uc[3] * wkr[12 + o];
                    v[o] = u4[0] * wvr[o] + u4[1] * wvr[4 + o] + u4[2] * wvr[8 + o] + u4[3] * wvr[12 + o]; }
                u32x2 qw, kw; qw.x = cvtpk(q[0], q[1]); qw.y = cvtpk(q[2], q[3]); kw.x = cvtpk(k[0], k[1]); kw.y = cvtpk(k[2], k[3]);
                *(u32x2*)(Q + (m0 + i) * 768 + cc) = qw; *(u32x2*)(K + (m0 + i) * 768 + cc) = kw;
                LAS unsigned* vd = (LAS unsigned*)(Vs + (tl0 + i) * 194 + 4 * j4); vd[0] = cvtpk(v[0], v[1]); vd[1] = cvtpk(v[2], v[3]);
                LAS unsigned* kd = (LAS unsigned*)(Ks + (tl0 + i) * 194 + 4 * j4); kd[0] = kw.x; kd[1] = kw.y;
#pragma unroll
                for (int e = 0; e < 4; ++e) { xw[0][e] = xw[1][e]; xw[1][e] = xw[2][e]; xw[2][e] = u4[e]; }
            }
        }
        __syncthreads();
#pragma unroll 1
        for (int i = 0; i < 3; ++i) {
            const int idx = tid + 512 * i, d = idx >> 3, ch = idx & 7;
            unsigned short ev[8]; float fk[8];
#pragma unroll
            for (int k = 0; k < 8; ++k) { ev[k] = Vs[(ch * 8 + k) * 194 + d]; fk[k] = bf2f(Ks[(ch * 8 + k) * 194 + d]) * wvs[64 * half + ch * 8 + k]; }
            u32x4 ov, ok; ov.x = ev[0] | ((unsigned)ev[1] << 16); ov.y = ev[2] | ((unsigned)ev[3] << 16); ov.z = ev[4] | ((unsigned)ev[5] << 16); ov.w = ev[6] | ((unsigned)ev[7] << 16);
            ok.x = cvtpk(fk[0], fk[1]); ok.y = cvtpk(fk[2], fk[3]); ok.z = cvtpk(fk[4], fk[5]); ok.w = cvtpk(fk[6], fk[7]);
            *(u32x4*)(VT + ((size_t)bh * 192 + d) * T + ts + ch * 8) = ov;
            *(LAS u32x4*)(At + d * MLC_ST + (64 * half + ch * 8) * 2) = ov; *(LAS u32x4*)(Bt + d * MLC_ST + (64 * half + ch * 8) * 2) = ok;
        }
        __syncthreads();
    }
    if (tid < 192) { float s = 0.f; const LAS bf16* row = (const LAS bf16*)(Bt + tid * MLC_ST);
#pragma unroll 8
        for (int k = 0; k < 128; ++k) s += bf2f(row[k]);
        nloc[(size_t)unit * 192 + tid] = s; }
#pragma unroll 1
    for (int ti = wave; ti < 36; ti += 8) { const int rb = ti / 6, cbk = ti % 6;
        f32x16 acc;
#pragma unroll
        for (int q = 0; q < 16; ++q) acc[q] = 0.f;
#pragma unroll
        for (int ks = 0; ks < 8; ++ks) { const bf16x8 a = *(const LAS bf16x8*)(At + (32 * rb + r) * MLC_ST + (16 * ks + 8 * hh) * 2), bb = *(const LAS bf16x8*)(Bt + (32 * cbk + r) * MLC_ST + (16 * ks + 8 * hh) * 2);
            acc = MFMA32(a, bb, acc); }
        bf16* out = Cloc + ((size_t)unit * 192 + 32 * rb + 4 * hh) * 192 + 32 * cbk + r;
#pragma unroll
        for (int R = 0; R < 16; ++R) out[(size_t)((R & 3) + 8 * (R >> 2)) * 192] = f2bf(acc[R]);
    }
}
constexpr int MLO_KST = 400, MLO_VST = 264;
constexpr int MLO_V_OFF = 128 * MLO_KST, MLO_T_OFF = MLO_V_OFF + 192 * MLO_VST;
__device__ __forceinline__ void ml_out_unit(LAS unsigned char* L, const bf16* Q, const bf16* K, const bf16* VT, const bf16* __restrict__ Cloc, const float* __restrict__ nloc, const float* Fb, const float* Ib, const bf16* p, const float* ng, bf16* y, int unit) {
    int tid_ = threadIdx.x; asm volatile("" : "+v"(tid_)); const int tid = tid_, lane = tid & 63, wave = __builtin_amdgcn_readfirstlane(tid >> 6), r = lane & 31, hh = lane >> 5, tb = wave & 3, dh = wave >> 2;
    const int c = unit & 15, bh = unit >> 4, b = bh >> 2, h = bh & 3, t0 = c * 128;
    LAS unsigned char* Kt = L; LAS unsigned char* Vt = L + MLO_V_OFF; LAS unsigned char* Ct = L;
    LAS float* Fs = (LAS float*)(L + MLO_T_OFF); LAS float* Is = Fs + 128; LAS float* np = Is + 128; LAS float* st = np + 192; LAS float* dcy = st + 512;
    __syncthreads();
    if (tid < 128) { Fs[tid] = Fb[bh * T + t0 + tid]; Is[tid] = Ib[bh * T + t0 + tid]; }
    if (tid == 128) { float d = 1.f; for (int j = c - 1; j >= 0; --j) { dcy[j] = d; d *= expf(Fb[bh * T + 128 * j + 127]); } }
    const int t = t0 + 32 * tb + r; const size_t m = (size_t)b * T + t;
    bf16x8 qf[12];
#pragma unroll
    for (int ks = 0; ks < 12; ++ks) qf[ks] = *(const bf16x8*)(Q + m * 768 + h * 192 + 16 * ks + 8 * hh);
    __syncthreads();
    f32x16 acc[3];
#pragma unroll
    for (int i = 0; i < 3; ++i)
#pragma unroll
        for (int q = 0; q < 16; ++q) acc[i][q] = 0.f;
    const float Ft = Fs[32 * tb + r], dec = expf(Ft);
    if (c > 0) {
        const bf16* cbase = Cloc + (size_t)(bh * 16) * 36864 + 8 * tid;
        float a[9][8];
#pragma unroll
        for (int i = 0; i < 9; ++i)
#pragma unroll
            for (int e = 0; e < 8; ++e) a[i][e] = 0.f;
#pragma unroll 1
        for (int j = 0; j < c; ++j) { const float dj = dcy[j]; u32x4 v[9];
#pragma unroll
            for (int i = 0; i < 9; ++i) v[i] = *(const u32x4*)(cbase + (size_t)j * 36864 + 4096 * i);
#pragma unroll
            for (int i = 0; i < 9; ++i) { a[i][0] += dj * __uint_as_float(v[i].x << 16); a[i][1] += dj * __uint_as_float(v[i].x & 0xffff0000u); a[i][2] += dj * __uint_as_float(v[i].y << 16); a[i][3] += dj * __uint_as_float(v[i].y & 0xffff0000u);
                a[i][4] += dj * __uint_as_float(v[i].z << 16); a[i][5] += dj * __uint_as_float(v[i].z & 0xffff0000u); a[i][6] += dj * __uint_as_float(v[i].w << 16); a[i][7] += dj * __uint_as_float(v[i].w & 0xffff0000u); } }
#pragma unroll
        for (int i = 0; i < 9; ++i) { const int e = 8 * (tid + 512 * i), dv = e / 192, dk = e % 192;
            *(LAS u32x4*)(Ct + dv * MLO_KST + dk * 2) = (u32x4){cvtpk(a[i][0], a[i][1]), cvtpk(a[i][2], a[i][3]), cvtpk(a[i][4], a[i][5]), cvtpk(a[i][6], a[i][7])}; }
        if (tid < 192) { float s = 0.f; for (int j = 0; j < c; ++j) s += dcy[j] * nloc[(size_t)(bh * 16 + j) * 192 + tid]; np[tid] = s; }
        __syncthreads();
        const LAS unsigned char* cp = Ct + (32 * (3 * dh) + r) * MLO_KST + 16 * hh;
#pragma unroll
        for (int blk = 0; blk < 3; ++blk)
#pragma unroll
            for (int ks = 0; ks < 12; ++ks) { const bf16x8 a = *(const LAS bf16x8*)(cp + (32 * blk) * MLO_KST + 32 * ks); acc[blk] = MFMA32(a, qf[ks], acc[blk]); }
#pragma unroll
        for (int i = 0; i < 3; ++i)
#pragma unroll
            for (int q = 0; q < 16; ++q) acc[i][q] *= dec;
    } else { if (tid < 192) np[tid] = 0.f; }
    __syncthreads();
#pragma unroll 1
    for (int i = 0; i < 6; ++i) { const int idx = tid + 512 * i;
        { const int s2 = idx / 24, ch = idx % 24; *(LAS u32x4*)(Kt + s2 * MLO_KST + ch * 16) = *(const u32x4*)(K + (size_t)(b * T + t0 + s2) * 768 + h * 192 + ch * 8); }
        { const int d = idx >> 4, ch = idx & 15; const u32x4 v = *(const u32x4*)(VT + ((size_t)bh * 192 + d) * T + t0 + ch * 8);
          LAS u32x2* vd = (LAS u32x2*)(Vt + d * MLO_VST + ch * 16); vd[0] = (u32x2){v.x, v.y}; vd[1] = (u32x2){v.z, v.w}; } }
    __syncthreads();
    float qn = 0.f;
#pragma unroll
    for (int ks = 0; ks < 12; ++ks)
#pragma unroll
        for (int j = 0; j < 8; ++j) qn += bf2f((bf16)qf[ks][j]) * np[16 * ks + 8 * hh + j];
    qn += __shfl_xor(qn, 32);
    float den = dec * qn, dpart = 0.f;
    for (int kb = 0; kb <= tb; ++kb) {
        f32x16 S;
#pragma unroll
        for (int q = 0; q < 16; ++q) S[q] = 0.f;
#pragma unroll
        for (int ks = 0; ks < 12; ++ks) { const bf16x8 kf = *(const LAS bf16x8*)(Kt + (32 * kb + r) * MLO_KST + (16 * ks + 8 * hh) * 2); S = MFMA32(kf, qf[ks], S); }
#pragma unroll
        for (int R = 0; R < 16; ++R) { const int sl = 32 * kb + (R & 3) + 8 * (R >> 2) + 4 * hh; const float wgt = (t0 + sl <= t) ? expf(Ft - Fs[sl] + Is[sl]) : 0.f; S[R] *= wgt; dpart += S[R]; }
        const bf16x8 p0 = pack8(S[0], S[1], S[2], S[3], S[4], S[5], S[6], S[7]), p1 = pack8(S[8], S[9], S[10], S[11], S[12], S[13], S[14], S[15]);
#pragma unroll
        for (int blk = 0; blk < 3; ++blk) { const LAS unsigned char* vrow = Vt + (32 * (3 * dh + blk) + r) * MLO_VST + 8 * hh + 64 * kb;
            { const u32x2 lo = *(const LAS u32x2*)(vrow), hi = *(const LAS u32x2*)(vrow + 16); u32x4 u = {lo.x, lo.y, hi.x, hi.y}; acc[blk] = MFMA32(__builtin_bit_cast(bf16x8, u), p0, acc[blk]); }
            { const u32x2 lo = *(const LAS u32x2*)(vrow + 32), hi = *(const LAS u32x2*)(vrow + 48); u32x4 u = {lo.x, lo.y, hi.x, hi.y}; acc[blk] = MFMA32(__builtin_bit_cast(bf16x8, u), p1, acc[blk]); } }
    }
    den += dpart + __shfl_xor(dpart, 32);
    const float inv = 1.0f / fmaxf(fabsf(den), 1.0f);
    float s1 = 0.f, s2 = 0.f;
#pragma unroll
    for (int blk = 0; blk < 3; ++blk)
#pragma unroll
        for (int g4 = 0; g4 < 4; ++g4) { const int d = 32 * (3 * dh + blk) + 8 * g4 + 4 * hh; const u32x2 oo = *(const u32x2*)(p + m * NP + C_MO + h * 192 + d);
            const float o0 = bf2f((bf16)(oo.x & 0xffff)), o1 = bf2f((bf16)(oo.x >> 16)), o2 = bf2f((bf16)(oo.y & 0xffff)), o3 = bf2f((bf16)(oo.y >> 16));
            float v0 = acc[blk][4 * g4] * inv * sigm(o0), v1 = acc[blk][4 * g4 + 1] * inv * sigm(o1), v2 = acc[blk][4 * g4 + 2] * inv * sigm(o2), v3 = acc[blk][4 * g4 + 3] * inv * sigm(o3);
            acc[blk][4 * g4] = v0; acc[blk][4 * g4 + 1] = v1; acc[blk][4 * g4 + 2] = v2; acc[blk][4 * g4 + 3] = v3;
            s1 += (v0 + v1) + (v2 + v3); s2 += (v0 * v0 + v1 * v1) + (v2 * v2 + v3 * v3); }
    s1 += __shfl_xor(s1, 32); s2 += __shfl_xor(s2, 32);
    if (hh == 0) { st[(dh * 128 + 32 * tb + r) * 2] = s1; st[(dh * 128 + 32 * tb + r) * 2 + 1] = s2; }
    __syncthreads();
    const float t1 = st[(32 * tb + r) * 2] + st[(128 + 32 * tb + r) * 2], t2 = st[(32 * tb + r) * 2 + 1] + st[(128 + 32 * tb + r) * 2 + 1];
    const float mu = t1 * (1.0f / 192.0f), var = fmaxf(t2 * (1.0f / 192.0f) - mu * mu, 0.f), rs = 1.0f / sqrtf(var + LN_EPS);
#pragma unroll
    for (int blk = 0; blk < 3; ++blk)
#pragma unroll
        for (int g4 = 0; g4 < 4; ++g4) { const int d = 32 * (3 * dh + blk) + 8 * g4 + 4 * hh; const u32x2 zz = *(const u32x2*)(p + m * NP + C_MZ + h * 192 + d);
            const float z0 = bf2f((bf16)(zz.x & 0xffff)), z1 = bf2f((bf16)(zz.x >> 16)), z2 = bf2f((bf16)(zz.y & 0xffff)), z3 = bf2f((bf16)(zz.y >> 16));
            const float4 gg = *(const float4*)(ng + h * 192 + d);
            u32x2 w; w.x = cvtpk((acc[blk][4 * g4] - mu) * rs * gg.x * silu(z0), (acc[blk][4 * g4 + 1] - mu) * rs * gg.y * silu(z1));
            w.y = cvtpk((acc[blk][4 * g4 + 2] - mu) * rs * gg.z * silu(z2), (acc[blk][4 * g4 + 3] - mu) * rs * gg.w * silu(z3));
            *(u32x2*)(y + m * D + 512 + h * 192 + d) = w; }
}

#define MFMA16(a, b, c) __builtin_amdgcn_mfma_f32_16x16x32_bf16((a), (b), (c), 0, 0, 0)
__device__ __forceinline__ void ph_lru_wt(const float* wa, const float* wx, bf16* Wt, int gt, int NGT) {
    for (int idx = gt; idx < DEPTH * 2 * 4 * 128 * 128; idx += NGT) {
        const int i = idx & 127, o = (idx >> 7) & 127, g = (idx >> 14) & 3, gate = (idx >> 16) & 1, l = idx >> 17;
        const float* src = gate ? wx : wa;
        Wt[idx] = f2bf(src[(((size_t)l * 4 + g) * 128 + i) * 128 + o]);
    }
}
constexpr int LR_XCB_OFF = 32768, LR_XCB_ST = 1040, LR_A_OFF = LR_XCB_OFF + 16 * LR_XCB_ST, LR_U_OFF = LR_A_OFF + 32768;
__device__ __forceinline__ void lru_unit(LAS unsigned char* L, const bf16* p, const float* cw, const float* cb, const bf16* Wt  , const float* ba, const float* bx, const float* lam,
                                         float* hloc, float* cumA, float* aggA, float* aggH, int unit) {
    int tid_ = threadIdx.x; asm volatile("" : "+v"(tid_)); const int tid = tid_, lane = tid & 63, wave = __builtin_amdgcn_readfirstlane(tid >> 6);
    const int m0 = unit * 16, t0 = m0 % T;
    LAS float* xcf = (LAS float*)L; LAS unsigned char* xcb = L + LR_XCB_OFF; LAS float* As = (LAS float*)(L + LR_A_OFF); LAS float* Us = (LAS float*)(L + LR_U_OFF);
    __syncthreads();
    { const int c = tid; const float w0 = cw[c], w1 = cw[512 + c], w2 = cw[1024 + c], w3 = cw[1536 + c], bb = cb[c];
      float x0 = (t0 >= 3) ? bf2f(p[(size_t)(m0 - 3) * NP + C_LX + c]) : 0.f, x1 = (t0 >= 2) ? bf2f(p[(size_t)(m0 - 2) * NP + C_LX + c]) : 0.f, x2 = (t0 >= 1) ? bf2f(p[(size_t)(m0 - 1) * NP + C_LX + c]) : 0.f;
#pragma unroll
      for (int t = 0; t < 16; ++t) { const float x3 = bf2f(p[(size_t)(m0 + t) * NP + C_LX + c]); const float s = bb + w0 * x0 + w1 * x1 + w2 * x2 + w3 * x3;
          xcf[t * 512 + c] = s; *(LAS bf16*)(xcb + t * LR_XCB_ST + c * 2) = f2bf(s); x0 = x1; x1 = x2; x2 = x3; } }
    __syncthreads();
    const int g = wave >> 1, ob = (wave & 1) * 64, fr = lane & 15, kq = lane >> 4;
    f32x4v acc[2][4];
#pragma unroll
    for (int a = 0; a < 2; ++a)
#pragma unroll
        for (int nb = 0; nb < 4; ++nb) acc[a][nb] = (f32x4v){0.f, 0.f, 0.f, 0.f};
#pragma unroll
    for (int ks = 0; ks < 4; ++ks) {
        const bf16x8 af = *(const LAS bf16x8*)(xcb + fr * LR_XCB_ST + (g * 128 + 32 * ks + 8 * kq) * 2);
#pragma unroll
        for (int a = 0; a < 2; ++a)
#pragma unroll
            for (int nb = 0; nb < 4; ++nb) { const bf16x8 bfg = *(const bf16x8*)(Wt + ((size_t)(a * 4 + g) * 128 + ob + 16 * nb + fr) * 128 + 32 * ks + 8 * kq);
                acc[a][nb] = MFMA16(af, bfg, acc[a][nb]); }
    }
#pragma unroll
    for (int nb = 0; nb < 4; ++nb) { const int c = 64 * wave + 16 * nb + fr; const float bav = ba[c], bxv = bx[c], sp8 = 8.0f * log1pf(expf(-lam[c]));
#pragma unroll
        for (int rg = 0; rg < 4; ++rg) { const int t = 4 * kq + rg; const float r = sigm(acc[0][nb][rg] + bav), ig = sigm(acc[1][nb][rg] + bxv);
            const float la = -r * sp8, a = expf(la), u = sqrtf(-expm1f(2.0f * la)) * (ig * xcf[t * 512 + c]);
            As[t * 512 + c] = a; Us[t * 512 + c] = u; } }
    __syncthreads();
    { const int c = tid; float h = 0.f, P = 1.f;
#pragma unroll
      for (int t = 0; t < 16; ++t) { const float a = As[t * 512 + c], u = Us[t * 512 + c]; P *= a; h = a * h + u; hloc[(size_t)(m0 + t) * 512 + c] = h; cumA[(size_t)(m0 + t) * 512 + c] = P; }
      aggA[(size_t)unit * 512 + c] = P; aggH[(size_t)unit * 512 + c] = h; }
}
__device__ __forceinline__ void lru_apply_unit(const float* __restrict__ hloc, const float* __restrict__ cumA, const float* __restrict__ aggA, const float* __restrict__ aggH, const bf16* __restrict__ p, bf16* __restrict__ y, int unit) {
    int tid_ = threadIdx.x; asm volatile("" : "+v"(tid_)); const int c = tid_;
    const int b = unit >> 5, grp = unit & 31; float h = 0.f;
    const int nprev = 4 * grp;
#pragma unroll 1
    for (int k0 = 0; k0 < nprev; k0 += 16) { float a[16], hh[16];
#pragma unroll
        for (int k = 0; k < 16; ++k) { const int kk = k0 + k < nprev ? k0 + k : nprev - 1; const size_t o = (size_t)(b * 128 + kk) * 512 + c; a[k] = aggA[o]; hh[k] = aggH[o]; }
#pragma unroll
        for (int k = 0; k < 16; ++k) if (k0 + k < nprev) h = a[k] * h + hh[k]; }
#pragma unroll 1
    for (int k = 4 * grp; k < 4 * grp + 4; ++k) { const size_t m0 = (size_t)b * T + 16 * k;
        float hl[16], ca[16]; unsigned short zz[16];
#pragma unroll
        for (int t = 0; t < 16; ++t) { hl[t] = hloc[(m0 + t) * 512 + c]; ca[t] = cumA[(m0 + t) * 512 + c]; zz[t] = p[(m0 + t) * NP + C_LZ + c]; }
#pragma unroll
        for (int t = 0; t < 16; ++t) y[(m0 + t) * D + c] = f2bf((hl[t] + ca[t] * h) * silu(bf2f(zz[t])));
        const size_t o = (size_t)(b * 128 + k) * 512 + c; h = aggA[o] * h + aggH[o]; }
}
#ifndef R_T0
#define R_T0 1
#endif
#ifndef R_T1
#define R_T1 1
#endif
#ifndef R_T2
#define R_T2 1
#endif
#ifndef R_A1
#define R_A1 1
#endif
#ifndef R_A2
#define R_A2 1
#endif
#ifndef R_A3
#define R_A3 1
#endif
#ifndef R_A4
#define R_A4 1
#endif
#ifndef R_P0
#define R_P0 1
#endif
#ifndef R_KV
#define R_KV 1
#endif
#ifndef R_P1
#define R_P1 1
#endif
#ifndef R_P2A
#define R_P2A 1
#endif
#ifndef R_P2B
#define R_P2B 1
#endif
#ifndef R_P2C
#define R_P2C 1
#endif
#ifndef R_P3
#define R_P3 1
#endif
#ifndef R_X
#define R_X 1
#endif
#ifndef R_WO
#define R_WO 1
#endif
#ifndef R_FIN
#define R_FIN 1
#endif
#define REP(n) _Pragma("unroll 1") for (int rep_ = 0; rep_ < (n); ++rep_)

struct Args { const float* in[26]; float* out; unsigned char* ws; };

__device__ __forceinline__ void ph_wt(const float* W, int ldw, int K, int N, const float* g, bf16* Wt, int mode, float* scr, int gw, int NGW, int lane) {
    const int nblk = N / 32, nitems = (K / 64) * nblk;
    for (int it = gw; it < nitems; it += NGW) {
        const int kb = it / nblk, nb = it % nblk, n0 = nb * 32;
        const int src = (mode == 1 && n0 >= SRC_GATE) ? n0 + 8 : n0;
        wt_item(W, ldw, src, g, Wt, K, n0, scr, kb * 64, lane);
    }
}
__device__ __forceinline__ void ph_gatew(const float* W, const float* g, float* Wg, int gt, int NGT) {
    for (int idx = gt; idx < D * 8; idx += NGT) { const int k = idx >> 3, c = idx & 7; Wg[idx] = g[k] * W[(size_t)k * INC + SRC_GATE + c]; }
}
__device__ __forceinline__ void ph_prep(const float* x, bf16* xb, float* rinv, const float* Wg, float* gates, int nrows, int gw, int NGW, int lane) {
    for (int row = gw; row < nrows; row += NGW) {
        const float4* xr = (const float4*)(x + (size_t)row * D); float4 v[8]; float ss = 0.f;
#pragma unroll
        for (int j = 0; j < 8; ++j) { v[j] = xr[lane + 64 * j]; ss += v[j].x * v[j].x + v[j].y * v[j].y + v[j].z * v[j].z + v[j].w * v[j].w; }
        ss = wave_sum(ss); const float r = 1.0f / sqrtf(ss * (1.0f / D) + RMS_EPS);
        uint2* ob = (uint2*)(xb + (size_t)row * D);
#pragma unroll
        for (int j = 0; j < 8; ++j) { uint2 o; o.x = pk2(v[j].x, v[j].y); o.y = pk2(v[j].z, v[j].w); ob[lane + 64 * j] = o; }
        if (lane == 0) rinv[row] = r;
        if (Wg) {
            float a0 = 0, a1 = 0, a2 = 0, a3 = 0, a4 = 0, a5 = 0, a6 = 0, a7 = 0;
#pragma unroll
            for (int j = 0; j < 8; ++j) {
                const float xe[4] = {v[j].x, v[j].y, v[j].z, v[j].w};
#pragma unroll
                for (int e = 0; e < 4; ++e) { const int k = 4 * (lane + 64 * j) + e; const float4 w0 = *(const float4*)(Wg + (size_t)k * 8), w1 = *(const float4*)(Wg + (size_t)k * 8 + 4);
                    a0 += xe[e] * w0.x; a1 += xe[e] * w0.y; a2 += xe[e] * w0.z; a3 += xe[e] * w0.w; a4 += xe[e] * w1.x; a5 += xe[e] * w1.y; a6 += xe[e] * w1.z; a7 += xe[e] * w1.w; }
            }
            a0 = wave_sum(a0); a1 = wave_sum(a1); a2 = wave_sum(a2); a3 = wave_sum(a3); a4 = wave_sum(a4); a5 = wave_sum(a5); a6 = wave_sum(a6); a7 = wave_sum(a7);
            if (lane == 0) { float4* go = (float4*)(gates + (size_t)row * 8); go[0] = make_float4(a0 * r, a1 * r, a2 * r, a3 * r); go[1] = make_float4(a4 * r, a5 * r, a6 * r, a7 * r); }
        }
    }
}
__device__ __forceinline__ void ph_final(const float* x, const float* g, float* out, int gw, int NGW, int lane) {
    for (int row = gw; row < M; row += NGW) {
        const float4* xr = (const float4*)(x + (size_t)row * D); float4 v[8]; float ss = 0.f;
#pragma unroll
        for (int j = 0; j < 8; ++j) { v[j] = xr[lane + 64 * j]; ss += v[j].x * v[j].x + v[j].y * v[j].y + v[j].z * v[j].z + v[j].w * v[j].w; }
        ss = wave_sum(ss); const float r = 1.0f / sqrtf(ss * (1.0f / D) + RMS_EPS);
        float4* o = (float4*)(out + (size_t)row * D); const float4* gg = (const float4*)g;
#pragma unroll
        for (int j = 0; j < 8; ++j) { const float4 gv = gg[lane + 64 * j]; o[lane + 64 * j] = make_float4(v[j].x * r * gv.x, v[j].y * r * gv.y, v[j].z * r * gv.z, v[j].w * r * gv.w); }
    }
}
__device__ __forceinline__ void ph_final2(const bf16* x, const float* rinv, const float* g, float* out, int gt, int NGT) {
    for (int idx = gt; idx < M * (D / 4); idx += NGT) { const int row = idx >> 9, c4 = idx & 511; const float r = rinv[row];
        const uint2 xv = ((const uint2*)x)[idx]; const float4 gv = ((const float4*)g)[c4];
        ((float4*)out)[idx] = make_float4(__uint_as_float(xv.x << 16) * r * gv.x, __uint_as_float(xv.x & 0xffff0000u) * r * gv.y, __uint_as_float(xv.y << 16) * r * gv.z, __uint_as_float(xv.y & 0xffff0000u) * r * gv.w); }
}
__device__ __forceinline__ void ph_lru_gates(float* xc, const bf16* p, const float* cw, const float* cb, const float* wa, const float* ba, const float* wx, const float* bx, const float* lam, float* A, float* U, int vb, int G, int tid) {
    for (int m = vb; m < M; m += G) {
        const int t = m % T, c = tid;
        { float s = cb[c];
#pragma unroll
          for (int j = 0; j < 4; ++j) { const int tt = t - 3 + j; if (tt >= 0) s += cw[j * 512 + c] * bf2f(p[(size_t)(m - 3 + j) * NP + C_LX + c]); }
          xc[c] = s; }
        __syncthreads();
        { const int g = c >> 7, o = c & 127; float ra = ba[c], ri = bx[c];
          for (int i = 0; i < 128; ++i) { const float xv = xc[g * 128 + i]; ra += xv * wa[(size_t)(g * 128 + i) * 128 + o]; ri += xv * wx[(size_t)(g * 128 + i) * 128 + o]; }
          const float r = sigm(ra), ig = sigm(ri); const float la = -8.0f * r * log1pf(expf(-lam[c])); const float a = expf(la); const float u = sqrtf(-expm1f(2.0f * la)) * (ig * xc[c]);
          A[(size_t)m * 512 + c] = a; U[(size_t)m * 512 + c] = u; }
        __syncthreads();
    }
}
__device__ __forceinline__ void ph_lru_scan(const float* A, const float* U, const bf16* p, bf16* y, int gt) {
    if (gt < NB * 512) { const int b = gt / 512, c = gt % 512; float h = 0.f;
        for (int t = 0; t < T; ++t) { const size_t m = (size_t)b * T + t; h = A[m * 512 + c] * h + U[m * 512 + c]; const float z = bf2f(p[m * NP + C_LZ + c]); y[m * D + c] = f2bf(h * silu(z)); } }
}
__device__ __forceinline__ void ph_ml_prep(const bf16* p, const float* cw, const float* cb, const float* wq, const float* wk, const float* wv, bf16* Q, bf16* K, bf16* V, int gt, int NGT) {
    for (int idx = gt; idx < M * 192; idx += NGT) {
        const int m = idx / 192, j = idx % 192, t = m % T;
        float u4[4], uc[4];
#pragma unroll
        for (int i = 0; i < 4; ++i) { const int c = 4 * j + i; float s = cb[c];
#pragma unroll
            for (int jj = 0; jj < 4; ++jj) { const int tt = t - 3 + jj; if (tt >= 0) s += cw[jj * 768 + c] * bf2f(p[(size_t)(m - 3 + jj) * NP + C_MU + c]); }
            uc[i] = silu(s); u4[i] = bf2f(p[(size_t)m * NP + C_MU + c]); }
        const float ks = 0.07216878364870322f;
#pragma unroll
        for (int o = 0; o < 4; ++o) { float q = 0.f, k = 0.f, v = 0.f;
#pragma unroll
            for (int i = 0; i < 4; ++i) { q += uc[i] * wq[(j * 4 + i) * 4 + o]; k += uc[i] * wk[(j * 4 + i) * 4 + o]; v += u4[i] * wv[(j * 4 + i) * 4 + o]; }
            Q[(size_t)m * 768 + 4 * j + o] = f2bf(q); K[(size_t)m * 768 + 4 * j + o] = f2bf(k * ks); V[(size_t)m * 768 + 4 * j + o] = f2bf(v); }
    }
}
__device__ __forceinline__ void ph_ml_F(const float* gates, const float* bi, const float* bf, float* Fb, float* Ib, int vb, int tid) {
    if (vb < 16 && tid == 0) { const int bh = vb, b = bh >> 2, h = bh & 3; float F = 0.f;
        for (int t = 0; t < T; ++t) { const size_t m = (size_t)b * T + t; F += logsig(gates[m * 8 + 4 + h] + bf[h]); Fb[bh * T + t] = F; Ib[bh * T + t] = gates[m * 8 + h] + bi[h]; } }
}
__device__ __forceinline__ void ph_ml_attn(float* L, const bf16* Q, const bf16* K, const bf16* V, const float* Fb, const float* Ib, const bf16* p, const float* ng, bf16* y, int vb, int G, int tid) {
    float* Qs = L; float* Ks = Qs + 32 * 192; float* Vs = Ks + 32 * 193; float* Ss = Vs + 32 * 192; float* Ft = Ss + 32 * 32; float* Fs = Ft + 32; float* Is = Fs + 32;
    const int r = tid >> 4, cl = tid & 15;
    for (int unit = vb; unit < 16 * 64; unit += G) {
        const int bh = unit >> 6, b = bh >> 2, h = bh & 3, t0 = (unit & 63) * 32;
        __syncthreads();
        for (int e = tid; e < 32 * 192; e += NTHR) { const int rr = e / 192, d = e % 192; Qs[rr * 192 + d] = bf2f(Q[(size_t)(b * T + t0 + rr) * 768 + h * 192 + d]); }
        if (tid < 32) Ft[tid] = Fb[bh * T + t0 + tid];
        float acc[12]; float den = 0.f;
#pragma unroll
        for (int i = 0; i < 12; ++i) acc[i] = 0.f;
        for (int s0 = 0; s0 < t0 + 32; s0 += 32) {
            __syncthreads();
            for (int e = tid; e < 32 * 192; e += NTHR) { const int i = e / 192, d = e % 192; const size_t g = (size_t)(b * T + s0 + i) * 768 + h * 192 + d; Ks[i * 193 + d] = bf2f(K[g]); Vs[i * 192 + d] = bf2f(V[g]); }
            if (tid < 32) { Fs[tid] = Fb[bh * T + s0 + tid]; Is[tid] = Ib[bh * T + s0 + tid]; }
            __syncthreads();
#pragma unroll
            for (int w = 0; w < 2; ++w) { const int s = cl + 16 * w; float dot = 0.f;
                for (int d = 0; d < 192; ++d) dot += Qs[r * 192 + d] * Ks[s * 193 + d];
                const int tt = t0 + r, ss = s0 + s; const float wgt = (ss <= tt) ? expf(Ft[r] - Fs[s] + Is[s]) : 0.f; Ss[r * 32 + s] = dot * wgt; }
            __syncthreads();
            for (int s = 0; s < 32; ++s) { const float sv = Ss[r * 32 + s]; den += sv;
#pragma unroll
                for (int i = 0; i < 12; ++i) acc[i] += sv * Vs[s * 192 + cl + 16 * i]; }
        }
        const float dn = fmaxf(fabsf(den), 1.0f); const size_t m = (size_t)b * T + t0 + r; float hv[12]; float s1 = 0.f;
#pragma unroll
        for (int i = 0; i < 12; ++i) { const int d = cl + 16 * i; hv[i] = acc[i] / dn * sigm(bf2f(p[m * NP + C_MO + h * 192 + d])); s1 += hv[i]; }
        s1 += __shfl_xor(s1, 1); s1 += __shfl_xor(s1, 2); s1 += __shfl_xor(s1, 4); s1 += __shfl_xor(s1, 8);
        const float mu = s1 * (1.0f / 192.0f); float s2 = 0.f;
#pragma unroll
        for (int i = 0; i < 12; ++i) { const float dd = hv[i] - mu; s2 += dd * dd; }
        s2 += __shfl_xor(s2, 1); s2 += __shfl_xor(s2, 2); s2 += __shfl_xor(s2, 4); s2 += __shfl_xor(s2, 8);
        const float rs = 1.0f / sqrtf(s2 * (1.0f / 192.0f) + LN_EPS);
#pragma unroll
        for (int i = 0; i < 12; ++i) { const int d = cl + 16 * i; const float z = bf2f(p[m * NP + C_MZ + h * 192 + d]); y[m * D + 512 + h * 192 + d] = f2bf((hv[i] - mu) * rs * ng[h * 192 + d] * silu(z)); }
    }
}
__device__ __forceinline__ void ph_mo_kmean(const bf16* p, float* kmean, int gt, int NGT) {
    for (int idx = gt; idx < NB * 6 * 8 * 128; idx += NGT) {
        const int d = idx & 127, blk = (idx >> 7) & 7, bh = idx >> 10, b = bh / 6, h = bh % 6; float s = 0.f;
        for (int i = 0; i < 256; ++i) s += bf2f(p[(size_t)(b * T + blk * 256 + i) * NP + C_K + h * 128 + d]);
        kmean[idx] = s * (1.0f / 256.0f);
    }
}
__device__ __forceinline__ void ph_mo_sel(const bf16* p, const float* kmean, unsigned char* sel, int gt, int NGT) {
    for (int idx = gt; idx < NB * 6 * T; idx += NGT) {
        const int t = idx % T, bh = idx / T, b = bh / 6, h = bh % 6, bq = t >> 8;
        const bf16* q = p + (size_t)(b * T + t) * NP + C_Q + h * 128;
        float g0 = 0, g1 = 0, g2 = 0, g3 = 0, g4 = 0, g5 = 0, g6 = 0;
        const float* km = kmean + (size_t)bh * 8 * 128;
        for (int d = 0; d < 128; ++d) { const float qv = bf2f(q[d]); g0 += qv * km[d]; g1 += qv * km[128 + d]; g2 += qv * km[256 + d]; g3 += qv * km[384 + d]; g4 += qv * km[512 + d]; g5 += qv * km[640 + d]; g6 += qv * km[768 + d]; }
        const float gv[7] = {g0, g1, g2, g3, g4, g5, g6};
        unsigned mask = 0;
        if (bq <= 3) mask = (1u << bq) - 1u;
        else {
#pragma unroll
            for (int pass = 0; pass < 3; ++pass) { float best = -INFINITY; int bi = -1;
#pragma unroll
                for (int j = 0; j < 7; ++j) if (j < bq && !((mask >> j) & 1u) && gv[j] > best) { best = gv[j]; bi = j; }
                if (bi >= 0) mask |= 1u << bi; }
        }
        mask |= 1u << bq;
        sel[(size_t)(b * T + t) * 8 + h] = (unsigned char)mask;
    }
}
template <int MODE> __device__ __forceinline__ void ph_attn32(float* L, const bf16* Qp, int ldq, int qcol, const bf16* Kp, const bf16* Vp, int ldk, const unsigned char* sel, const bf16* zp, bf16* outp, int ldo, int ocol, int vb, int G, int tid) {
    float* Qs = L; float* Ks = Qs + 32 * 128; float* Vs = Ks + 32 * 129; float* Ss = Vs + 32 * 128; unsigned* anym = (unsigned*)(Ss + 32 * 32);
    constexpr int NH = MODE == 0 ? 6 : 4; const int r = tid >> 4, cl = tid & 15;
    for (int unit = vb; unit < NB * NH * 64; unit += G) {
        const int bh = unit >> 6, b = bh / NH, h = bh % NH, t0 = (unit & 63) * 32; const size_t m = (size_t)b * T + t0 + r;
        __syncthreads();
        for (int e = tid; e < 32 * 128; e += NTHR) { const int rr = e >> 7, d = e & 127; Qs[rr * 128 + d] = bf2f(Qp[(size_t)(b * T + t0 + rr) * ldq + qcol + h * 128 + d]); }
        unsigned mymask = 0xffffffffu;
        if (MODE == 0) { if (tid == 0) *anym = 0; __syncthreads(); mymask = sel[m * 8 + h]; if (cl == 0) atomicOr(anym, mymask); __syncthreads(); }
        const float scale = 0.08838834764831845f;
        float slope = 0.f;
        if (MODE == 0) { slope = (h == 0) ? 0.25f : (h == 1) ? 0.0625f : (h == 2) ? 0.015625f : (h == 3) ? 0.00390625f : (h == 4) ? 0.5f : 0.125f; }
        float acc[8]; float mrun = -1e30f, l = 0.f;
#pragma unroll
        for (int i = 0; i < 8; ++i) acc[i] = 0.f;
        const int nblk = MODE == 0 ? (t0 >> 8) + 1 : 1; const unsigned am = MODE == 0 ? *anym : 1u;
        const int kbase = MODE == 0 ? b * T : b * MEM;
        for (int j = 0; j < nblk; ++j) {
            if (!((am >> j) & 1u)) continue;
            for (int ch = 0; ch < 8; ++ch) {
                const int s0 = j * 256 + ch * 32; if (MODE == 0 && s0 > t0 + 31) break;
                __syncthreads();
                for (int e = tid; e < 32 * 128; e += NTHR) { const int i = e >> 7, d = e & 127; const size_t g = (size_t)(kbase + s0 + i) * ldk + h * 128 + d; Ks[i * 129 + d] = bf2f(Kp[g]); Vs[i * 128 + d] = bf2f(Vp[g]); }
                __syncthreads();
#pragma unroll
                for (int w = 0; w < 2; ++w) { const int s = cl + 16 * w; float dot = 0.f;
                    for (int d = 0; d < 128; ++d) dot += Qs[r * 128 + d] * Ks[s * 129 + d];
                    float lg = dot * scale;
                    if (MODE == 0) { const int tt = t0 + r, ss = s0 + s; const bool valid = ((mymask >> j) & 1u) && (ss <= tt); lg = valid ? lg - slope * (float)(tt - ss) : -INFINITY; }
                    Ss[r * 32 + s] = lg; }
                __syncthreads();
                float mx = -INFINITY;
                for (int s = 0; s < 32; ++s) mx = fmaxf(mx, Ss[r * 32 + s]);
                const float mnew = fmaxf(mrun, mx); const float corr = expf(mrun - mnew); l *= corr;
#pragma unroll
                for (int i = 0; i < 8; ++i) acc[i] *= corr;
                for (int s = 0; s < 32; ++s) { const float pv = expf(Ss[r * 32 + s] - mnew); l += pv;
#pragma unroll
                    for (int i = 0; i < 8; ++i) acc[i] += pv * Vs[s * 128 + cl + 16 * i]; }
                mrun = mnew;
            }
        }
        const float inv = 1.0f / l;
#pragma unroll
        for (int i = 0; i < 8; ++i) { const int d = cl + 16 * i; float o = acc[i] * inv;
            if (MODE == 0) { const float z = bf2f(zp[m * NP + C_Z + h * 128 + d]); o *= silu(z); }
            outp[m * ldo + ocol + h * 128 + d] = f2bf(o); }
    }
}

typedef const __attribute__((address_space(4))) Args* kargs_t;
#define PH_VARS \
    kargs_t ap = (kargs_t)__builtin_amdgcn_kernarg_segment_ptr(); asm volatile("" : "+s"(ap)); \
    unsigned char* const ws = ap->ws; (void)ws; \
    int tid = threadIdx.x; asm volatile("" : "+v"(tid)); const int lane = tid & 63, wave = __builtin_amdgcn_readfirstlane(tid >> 6); (void)lane; \
    const int G = gridDim.x, vb = blockIdx.x, gw = vb * NWAVES + wave, NGW = G * NWAVES, gt = vb * NTHR + tid, NGT = G * NTHR; (void)gw; (void)NGW; (void)gt; (void)NGT; \
    float* const Lf = (float*)lds; (void)Lf; LAS unsigned char* const ldsl = (LAS unsigned char*)lds; (void)ldsl;
#define WSP(T, off) ((T*)(ws + (off)))
__global__ void __launch_bounds__(NTHR, 2) mk_fwd(Args a_unused) {
    extern __shared__ __attribute__((aligned(16))) unsigned char lds[];
    { PH_VARS
      for (int u = tid; u < (LDS_BYTES - LDSCTL_OFF) / 4; u += NTHR) ((LAS unsigned*)(ldsl + LDSCTL_OFF))[u] = 0u;
      __syncthreads();
      (void)xcd_barrier_post((unsigned*)(ws + WS_CTL) + CW_BAR, (volatile LAS unsigned*)(ldsl + MISC_OFF) + 8); }
#define GRID_BAR() do { PH_VARS XcdBarrier bar_; bar_.bar = (unsigned*)(ws + WS_CTL) + CW_BAR; bar_.x = xb_xcc_id(); bar_.st = (volatile LAS unsigned*)(ldsl + MISC_OFF) + 8; xcd_barrier(bar_); } while (0)
    REP(R_P0) {
#pragma unroll 1
    for (int l = 0; l < DEPTH; ++l) {
      { PH_VARS float* scr = Lf + wave * (64 * 33); ph_wt(ap->in[3] + (size_t)l * D * INC, INC, D, NP, ap->in[2] + l * D, WSP(bf16, WS_WIN) + (size_t)l * NP * D, 1, scr, gw, NGW, lane); }
      if (l == 0) { PH_VARS ph_lru_wt(ap->in[6], ap->in[8], WSP(bf16, WS_LRUW), gt, NGT); }
      { PH_VARS ph_gatew(ap->in[3] + (size_t)l * D * INC, ap->in[2] + l * D, WSP(float, WS_WG) + (size_t)l * D * 8, gt, NGT); }
      { PH_VARS float* scr = Lf + wave * (64 * 33); ph_wt(ap->in[19] + (size_t)l * D * D, D, D, D, nullptr, WSP(bf16, WS_WOUT) + (size_t)l * D * D, 0, scr, gw, NGW, lane); }
      { PH_VARS float* scr = Lf + wave * (64 * 33); ph_wt(ap->in[22] + (size_t)l * D * 512, 512, D, 512, ap->in[20] + l * D, WSP(bf16, WS_WQ) + (size_t)l * 512 * D, 0, scr, gw, NGW, lane); }
      { PH_VARS float* scr = Lf + wave * (64 * 33); ph_wt(ap->in[23] + (size_t)l * D * 1024, 1024, D, 1024, ap->in[21] + l * D, WSP(bf16, WS_WKV) + (size_t)l * 1024 * D, 0, scr, gw, NGW, lane); }
      { PH_VARS float* scr = Lf + wave * (64 * 33); ph_wt(ap->in[24] + (size_t)l * 512 * D, D, 512, D, nullptr, WSP(bf16, WS_WO) + (size_t)l * D * 512, 0, scr, gw, NGW, lane); }
    }
    { PH_VARS ph_prep(ap->in[1], WSP(bf16, WS_MEMB), WSP(float, WS_RINVM), nullptr, nullptr, MM, gw, NGW, lane); }
    { PH_VARS ph_prep(ap->in[0], WSP(bf16, WS_XB), WSP(float, WS_RINV), nullptr, nullptr, M, gw, NGW, lane); }
    GRID_BAR();
    }
    REP(R_KV) {
#pragma unroll 1
    for (int l = 0; l < DEPTH; ++l) { PH_VARS
        pg8::Gemm g{WSP(bf16, WS_MEMB), WSP(bf16, WS_WKV) + (size_t)l * 1024 * D, MM, 1024, D, 0}; EpiScaleBf16 E{WSP(bf16, WS_KV) + (size_t)l * MM * 1024, WSP(float, WS_RINVM), 1024, 0};
        pg8::StaticOrder S; S.init(MM, 1024, G, (vb + 64 + 32 * l) % G);
        pg8::gemm_phase<EpiScaleBf16, pg8::StaticOrder, true, true>(ldsl, g, S, E);
    }
    }
#pragma unroll 1
    for (int l = 0; l < DEPTH; ++l) {
        REP(R_P1) {
        { PH_VARS pg8::Gemm g{WSP(bf16, WS_XB), WSP(bf16, WS_WIN) + (size_t)l * NP * D, M, NP, D, 0}; EpiScaleBf16 E{WSP(bf16, WS_P), WSP(float, WS_RINV), NP, 0}; pg8::StaticOrder S; S.init(M, NP, G, vb);
          pg8::gemm_phase<EpiScaleBf16, pg8::StaticOrder, true, true>(ldsl, g, S, E); }
        GRID_BAR();
        }
        REP(R_P2A) {
        REP(R_A1) { PH_VARS for (int unit = vb; unit < 512; unit += G) lru_unit(ldsl, WSP(bf16, WS_P), ap->in[4] + l * 4 * 512, ap->in[5] + l * 512, WSP(bf16, WS_LRUW) + (size_t)l * 2 * 4 * 128 * 128, ap->in[7] + l * 512, ap->in[9] + l * 512, ap->in[10] + l * 512, WSP(float, WS_A), WSP(float, WS_U), ap->out + OUT_AGGA, ap->out + OUT_AGGH, unit); }
        REP(R_A2) { PH_VARS for (int unit = vb; unit < 256; unit += G) ml_chunk_unit(ldsl, WSP(bf16, WS_P), nullptr, ap->in[11] + l * 4 * 768, ap->in[12] + l * 768, ap->in[13] + l * 192 * 16, ap->in[14] + l * 192 * 16, ap->in[15] + l * 192 * 16, ap->in[16] + l * 4, ap->in[17] + l * 4, WSP(bf16, WS_XB), WSP(float, WS_RINV), WSP(float, WS_WG) + (size_t)l * D * 8, WSP(bf16, WS_MQ), WSP(bf16, WS_MK), WSP(bf16, WS_MV), WSP(float, WS_F), WSP(float, WS_I), (bf16*)ap->out, ap->out + OUT_NLOC, unit); }
        REP(R_A3) { PH_VARS ph_mo_kmean2(WSP(bf16, WS_P), WSP(float, WS_KMEAN), Lf, vb, G, tid); }
        REP(R_A4) { PH_VARS __syncthreads(); ph_mo_vt(WSP(bf16, WS_P), WSP(bf16, WS_MOVT), ldsl, gw, NGW, wave, lane); }
        if (l == 0) { PH_VARS ph_mem_vt(WSP(bf16, WS_KV), WSP(bf16, WS_VTM), ldsl, gw, NGW, wave, lane); }
        GRID_BAR();
        }
        REP(R_P2B) {
        { PH_VARS
#pragma unroll 1
          for (int i = 0; i < MIX_K; ++i) { const int e = MIX_TAB[vb & 255][i]; if (e < 0) continue; const int ty = e >> 12, unit = e & 4095;
            if (ty == 0) REP(R_T0) attn_unit<0>(ldsl, WSP(bf16, WS_P), WSP(bf16, WS_MOVT), WSP(float, WS_KMEAN), WSP(bf16, WS_Y), unit, nullptr, nullptr, 0, 2 * ((unit >> 5) + 1));
            else if (ty == 1) REP(R_T1) ml_out_unit(ldsl, WSP(bf16, WS_MQ), WSP(bf16, WS_MK), WSP(bf16, WS_MV), (const bf16*)ap->out, ap->out + OUT_NLOC, WSP(float, WS_F), WSP(float, WS_I), WSP(bf16, WS_P), ap->in[18] + l * 768, WSP(bf16, WS_Y), unit);
            else REP(R_T2) lru_apply_unit(WSP(float, WS_A), WSP(float, WS_U), ap->out + OUT_AGGA, ap->out + OUT_AGGH, WSP(bf16, WS_P), WSP(bf16, WS_Y), unit); } }
        GRID_BAR();
        }
        REP(R_P3 - 1) { PH_VARS pg8::Gemm g{WSP(bf16, WS_Y), WSP(bf16, WS_WOUT) + (size_t)l * D * D, M, D, D, 0};
          EpiResPart<true> E{ap->in[0], (bf16*)(ws + WS_XRES + 20000000), WSP(float, WS_A), (unsigned*)(ws + WS_CTL) + 16384 + (l * 2 + 0) * 2048 + 64 * 32 * rep_, WSP(float, WS_U), D, 0}; pg8::StaticOrder S; S.init(M, D, G, vb);
          pg8::gemm_phase<EpiResPart<true>, pg8::StaticOrder, true, true>(ldsl, g, S, E); GRID_BAR(); }
        if (l == 0) { PH_VARS pg8::Gemm g{WSP(bf16, WS_Y), WSP(bf16, WS_WOUT) + (size_t)l * D * D, M, D, D, 0};
          EpiResPart<true> E{ap->in[0], WSP(bf16, WS_XB), ap->out + OUT_PART, (unsigned*)(ws + WS_CTL) + CW_PANEL + (l * 2 + 0) * 2048, WSP(float, WS_RINV), D, 0}; pg8::StaticOrder S; S.init(M, D, G, vb);
          pg8::gemm_phase<EpiResPart<true>, pg8::StaticOrder, true, true>(ldsl, g, S, E); }
        else { PH_VARS pg8::Gemm g{WSP(bf16, WS_Y), WSP(bf16, WS_WOUT) + (size_t)l * D * D, M, D, D, 0};
          EpiResPart<false> E{WSP(bf16, WS_XB), WSP(bf16, WS_XB), ap->out + OUT_PART, (unsigned*)(ws + WS_CTL) + CW_PANEL + (l * 2 + 0) * 2048, WSP(float, WS_RINV), D, 0}; pg8::StaticOrder S; S.init(M, D, G, vb);
          pg8::gemm_phase<EpiResPart<false>, pg8::StaticOrder, true, true>(ldsl, g, S, E); }
        GRID_BAR();
        REP(R_X) {
        { PH_VARS const bf16* kvl = WSP(bf16, WS_KV) + (size_t)l * MM * 1024; for (int unit = vb; unit < 256; unit += G) attn_unit<1>(ldsl, WSP(bf16, WS_XB), WSP(bf16, WS_VTM) + (size_t)l * 16 * 128 * MEM, (const float*)kvl, WSP(bf16, WS_XO), unit, WSP(float, WS_RINV), WSP(bf16, WS_WQ) + (size_t)l * 512 * D); }
        GRID_BAR();
        }
        REP(R_WO - 1) { PH_VARS pg8::Gemm g{WSP(bf16, WS_XO), WSP(bf16, WS_WO) + (size_t)l * D * 512, M, D, 512, 0};
          EpiResPart<false> E{WSP(bf16, WS_XB), (bf16*)(ws + WS_XRES + 20000000), WSP(float, WS_A), (unsigned*)(ws + WS_CTL) + 16384 + (l * 2 + 1) * 2048 + 64 * 32 * rep_, WSP(float, WS_U), D, 0}; pg8::StaticOrder S; S.init(M, D, G, vb);
          pg8::gemm_phase<EpiResPart<false>, pg8::StaticOrder, true, true>(ldsl, g, S, E); GRID_BAR(); }
        { PH_VARS pg8::Gemm g{WSP(bf16, WS_XO), WSP(bf16, WS_WO) + (size_t)l * D * 512, M, D, 512, 0};
          EpiResPart<false> E{WSP(bf16, WS_XB), WSP(bf16, WS_XB), ap->out + OUT_PART, (unsigned*)(ws + WS_CTL) + CW_PANEL + (l * 2 + 1) * 2048, WSP(float, WS_RINV), D, 0}; pg8::StaticOrder S; S.init(M, D, G, vb);
          pg8::gemm_phase<EpiResPart<false>, pg8::StaticOrder, true, true>(ldsl, g, S, E); }
        GRID_BAR();
    }
    REP(R_FIN - 1) { PH_VARS ph_final2(WSP(bf16, WS_XB), WSP(float, WS_RINV), ap->in[25], (float*)(ws + WS_P), gt, NGT); GRID_BAR(); }
    { PH_VARS ph_final2(WSP(bf16, WS_XB), WSP(float, WS_RINV), ap->in[25], ap->out, gt, NGT); }
}

extern "C" void kernel_launch(void* const* d_in, const int* in_sizes, int n_in, void* d_out, int out_size, void* d_ws, size_t ws_size, hipStream_t stream) {
    static int grid = 0;
    if (grid == 0) {
        if (ws_size < WS_END || n_in != 26) { fprintf(stderr, "kernel_launch: ws_size %zu < %zu or n_in %d != 26\n", ws_size, (size_t)WS_END, n_in); grid = -1; return; }
        int dev = 0, cus = 0, per_cu = 0;
        if (hipGetDevice(&dev) != hipSuccess || hipDeviceGetAttribute(&cus, hipDeviceAttributeMultiprocessorCount, dev) != hipSuccess) { grid = -1; return; }
        if (hipFuncSetAttribute((const void*)mk_fwd, hipFuncAttributeMaxDynamicSharedMemorySize, LDS_BYTES) != hipSuccess) { fprintf(stderr, "kernel_launch: hipFuncSetAttribute failed\n"); grid = -1; return; }
        if (hipOccupancyMaxActiveBlocksPerMultiprocessor(&per_cu, (const void*)mk_fwd, NTHR, LDS_BYTES) != hipSuccess || per_cu < 1) fprintf(stderr, "kernel_launch: occupancy query reports %d\n", per_cu);
        (void)hipGetLastError();
        grid = cus;
    }
    if (grid < 0) return;
    if (hipMemsetAsync((char*)d_ws + WS_CTL, 0, CTL_ZERO_BYTES, stream) != hipSuccess) { fprintf(stderr, "kernel_launch: memset failed\n"); return; }
    Args a{};
    for (int i = 0; i < 26; ++i) a.in[i] = (const float*)d_in[i];
    a.out = (float*)d_out; a.ws = (unsigned char*)d_ws;
    hipLaunchKernelGGL(mk_fwd, dim3(grid), dim3(NTHR), LDS_BYTES, stream, a);
}
```

```cpp
#include <hip/hip_runtime.h>
#include <cstdio>
#include <cstdint>
namespace pg8 {
#define PG8_LAS __attribute__((address_space(3)))
typedef unsigned short bf16_t;
typedef short bf16x8 __attribute__((ext_vector_type(8)));
typedef float f32x4 __attribute__((ext_vector_type(4)));
typedef unsigned u32x4 __attribute__((ext_vector_type(4)));
constexpr int BM = 256, BK = 64, HALF = 128, HTB = HALF * BK * 2  , STAGE_BYTES = 8 * HTB, NXCD = 8, WGM = 8;

__host__ __device__ __forceinline__ int lds_byte(int r, int c) { const int st = (r >> 4) * 2 + (c >> 5), rr = r & 15, cc = c & 31, ob = rr * 64 + cc * 2; return st * 1024 + (ob ^ (((ob >> 9) & 1) << 5)); }
__host__ __device__ __forceinline__ void stage_rc(int b, int& R, int& C) { const int st = b / 1024, sb = b % 1024, swz = sb ^ (((sb >> 9) & 1) << 5); R = (st >> 1) * 16 + swz / 64; C = (st & 1) * 32 + (swz % 64) / 2; }
__host__ __device__ __forceinline__ int perm32(int rho) { const int n = rho >> 4, i = rho & 15; return 8 * (i >> 2) + 4 * n + (i & 3); }

struct Unit { int pm, pn; };
struct Gemm { const bf16_t* A; const bf16_t* Bt; int M, N, K, pad; };

struct StaticOrder {
    int nM, nN, nwg, G, c;
    __host__ __device__ void init(int M, int N, int G_, int c_) { nM = M / BM; nN = N / BM; nwg = nM * nN; G = G_; c = c_; }
    __host__ __device__ bool next(int i, Unit& u) const {
        const long L = (long)i * G + c; if (L >= nwg) return false;
        int wgid = (int)L; { const int q = nwg / NXCD, r = nwg % NXCD, xcd = wgid % NXCD, off = wgid / NXCD; wgid = (xcd < r ? xcd * (q + 1) : r * (q + 1) + (xcd - r) * q) + off; }
        const int nig = WGM * nN, gid = wgid / nig, fm = gid * WGM, gsz = (nM - fm) < WGM ? (nM - fm) : WGM;
        u.pm = fm + ((wgid % nig) % gsz); u.pn = (wgid % nig) / gsz; return true;
    }
    __device__ __forceinline__ void a_ready(const Unit&) const {}
    __device__ __forceinline__ void done(const Unit&) const {}
};

__device__ __forceinline__ unsigned cvt_pk_bf16(float lo, float hi) { unsigned r; asm volatile("v_cvt_pk_bf16_f32 %0, %1, %2" : "=v"(r) : "v"(lo), "v"(hi)); return r; }
template <class Epi, class Sched, bool ALIGN_EPI = false, bool SP2 = false>
__device__ __forceinline__ void gemm_phase(PG8_LAS unsigned char* lds, const Gemm g, const Sched& S, const Epi& E) {
    int tid_ = threadIdx.x; asm volatile("" : "+v"(tid_));
    const int tid = tid_, wid = __builtin_amdgcn_readfirstlane(tid >> 6), lane = tid & 63, wr = wid >> 2, wc = wid & 3, fr = lane & 15, fq = lane >> 4;
    const int K = g.K, nt = K / BK;
    unsigned voffA[2], voffB[2];
#pragma unroll
    for (int i = 0; i < 2; ++i) { int R, C; stage_rc(tid * 16 + i * 8192, R, C); const int Rb = Epi::PERM ? ((R & ~31) + perm32(R & 31)) : R;
        voffA[i] = (unsigned)(R * K + C) * 2u; voffB[i] = (unsigned)(Rb * K + C) * 2u; }
    const size_t kstep = (size_t)(BK * 2);
    const size_t hstep = (size_t)HALF * K * 2;
    const size_t tstep = 2 * hstep;
    const unsigned ldsw = (unsigned)wid * 1024u;
    const int aoff = lds_byte(wr * 64 + fr, fq * 8), boff = lds_byte(wc * 32 + fr, fq * 8);
#define PG8_SA(b, h) (((b) * 2 + (h)) * HTB)
#define PG8_SB(b, h) ((4 + (b) * 2 + (h)) * HTB)
#define PG8_STAGE(bufoff, gbase, voff) do { _Pragma("unroll") for (int _i = 0; _i < 2; ++_i) \
        __builtin_amdgcn_global_load_lds((const unsigned*)((const char*)(gbase) + (voff)[_i]), (PG8_LAS unsigned*)(lds + (bufoff) + ldsw + _i * 8192), 16, 0, 0); } while (0)
#define PG8_LDA(dst, b, h) do { _Pragma("unroll") for (int m = 0; m < 4; ++m) _Pragma("unroll") for (int k = 0; k < 2; ++k) dst[m][k] = *(const PG8_LAS bf16x8*)(lds + PG8_SA(b, h) + aoff + m * 2048 + k * 1024); } while (0)
#define PG8_LDB(dst, b, h) do { _Pragma("unroll") for (int n = 0; n < 2; ++n) _Pragma("unroll") for (int k = 0; k < 2; ++k) dst[n][k] = *(const PG8_LAS bf16x8*)(lds + PG8_SB(b, h) + boff + n * 2048 + k * 1024); } while (0)
#define PG8_MMA(ai, bj, At, Bt) do { __builtin_amdgcn_s_setprio(1); _Pragma("unroll") for (int m = 0; m < 4; ++m) _Pragma("unroll") for (int n = 0; n < 2; ++n) _Pragma("unroll") for (int k = 0; k < 2; ++k) \
        acc[ai][bj][m][n] = __builtin_amdgcn_mfma_f32_16x16x32_bf16(Bt[n][k], At[m][k], acc[ai][bj][m][n], 0, 0, 0); __builtin_amdgcn_s_setprio(0); } while (0)
#define PG8_WAIT_V(n) asm volatile("s_waitcnt vmcnt(" #n ")" ::: "memory")
#define PG8_WAIT_L(n) asm volatile("s_waitcnt lgkmcnt(" #n ")" ::: "memory")
#define PG8_BAR __builtin_amdgcn_s_barrier()
#define PG8_SCHED __builtin_amdgcn_sched_barrier(0)
    Unit cur, nxt; int ui = 0;
    if (!S.next(0, cur)) return;
    f32x4 acc[2][2][4][2];
#pragma unroll
    for (int a = 0; a < 2; ++a)
#pragma unroll
        for (int b = 0; b < 2; ++b)
#pragma unroll
            for (int m = 0; m < 4; ++m)
#pragma unroll
                for (int n = 0; n < 2; ++n) acc[a][b][m][n] = (f32x4){0.f, 0.f, 0.f, 0.f};
    bf16x8 At[4][2], B0[2][2], B1[2][2];
    const char* cA = (const char*)g.A + (size_t)cur.pm * tstep; const char* cB = (const char*)g.Bt + (size_t)cur.pn * tstep;
    S.a_ready(cur);
    if constexpr (SP2) {
        PG8_STAGE(PG8_SB(0, 0), cB, voffB); PG8_STAGE(PG8_SB(0, 1), cB + hstep, voffB); PG8_STAGE(PG8_SA(0, 0), cA, voffA); PG8_STAGE(PG8_SA(0, 1), cA + hstep, voffA);
        if (wr == 1) PG8_BAR;
        PG8_WAIT_V(2); PG8_BAR;
        PG8_STAGE(PG8_SB(1, 0), cB + kstep, voffB); PG8_STAGE(PG8_SA(1, 0), cA + kstep, voffA); PG8_STAGE(PG8_SB(1, 1), cB + hstep + kstep, voffB);
        PG8_WAIT_V(6); PG8_BAR;
    } else {
        PG8_STAGE(PG8_SB(0, 0), cB, voffB); PG8_STAGE(PG8_SA(0, 0), cA, voffA); PG8_STAGE(PG8_SB(0, 1), cB + hstep, voffB); PG8_STAGE(PG8_SA(0, 1), cA + hstep, voffA);
        if (wr == 1) PG8_BAR;
        PG8_WAIT_V(4); PG8_BAR;
        PG8_STAGE(PG8_SB(1, 0), cB + kstep, voffB); PG8_STAGE(PG8_SA(1, 0), cA + kstep, voffA); PG8_STAGE(PG8_SB(1, 1), cB + hstep + kstep, voffB);
        PG8_WAIT_V(6); PG8_BAR;
    }
    for (;;) {
        const bool has_next = S.next(ui + 1, nxt);
        const char* nA = has_next ? (const char*)g.A + (size_t)nxt.pm * tstep : cA; const char* nB = has_next ? (const char*)g.Bt + (size_t)nxt.pn * tstep : cB;
        for (int t = 0; t < nt; t += 2) {
            const bool last = (t == nt - 2);
            const char* a1 = cA + (size_t)(t + 1) * kstep;
            const char* a2 = last ? nA : cA + (size_t)(t + 2) * kstep; const char* b2 = last ? nB : cB + (size_t)(t + 2) * kstep;
            const char* a3 = a2 + kstep; const char* b3 = b2 + kstep;
            if (last && has_next) S.a_ready(nxt);
            if constexpr (SP2) {
            PG8_LDB(B0, 0, 0); PG8_LDB(B1, 0, 1); PG8_SCHED; PG8_LDA(At, 0, 0); PG8_STAGE(PG8_SA(1, 1), a1 + hstep, voffA);
            PG8_WAIT_V(8); PG8_WAIT_L(0); PG8_BAR; PG8_MMA(0, 0, At, B0); PG8_MMA(0, 1, At, B1); PG8_BAR; PG8_SCHED;
            PG8_LDA(At, 0, 1); PG8_STAGE(PG8_SB(0, 0), b2, voffB); PG8_STAGE(PG8_SB(0, 1), b2 + hstep, voffB); PG8_STAGE(PG8_SA(0, 0), a2, voffA);
            PG8_WAIT_V(8); PG8_WAIT_L(0); PG8_BAR; PG8_MMA(1, 0, At, B0); PG8_MMA(1, 1, At, B1); PG8_BAR; PG8_SCHED;
            PG8_LDB(B0, 1, 0); PG8_LDB(B1, 1, 1); PG8_SCHED; PG8_LDA(At, 1, 0); PG8_STAGE(PG8_SA(0, 1), a2 + hstep, voffA);
            PG8_WAIT_V(8); PG8_WAIT_L(0); PG8_BAR; PG8_MMA(0, 0, At, B0); PG8_MMA(0, 1, At, B1); PG8_BAR; PG8_SCHED;
            PG8_LDA(At, 1, 1); PG8_STAGE(PG8_SB(1, 0), b3, voffB); PG8_STAGE(PG8_SB(1, 1), b3 + hstep, voffB); PG8_STAGE(PG8_SA(1, 0), a3, voffA);
            PG8_WAIT_V(8); PG8_WAIT_L(0); PG8_BAR; PG8_MMA(1, 0, At, B0); PG8_MMA(1, 1, At, B1); PG8_BAR; PG8_SCHED;
            } else {
            PG8_LDB(B0, 0, 0); PG8_SCHED; PG8_LDA(At, 0, 0); PG8_STAGE(PG8_SA(1, 1), a1 + hstep, voffA);
            PG8_WAIT_L(8); PG8_BAR; PG8_WAIT_L(0); PG8_MMA(0, 0, At, B0); PG8_BAR; PG8_SCHED;
            PG8_LDB(B1, 0, 1); PG8_STAGE(PG8_SB(0, 0), b2, voffB);
            PG8_BAR; PG8_WAIT_L(0); PG8_MMA(0, 1, At, B1); PG8_BAR;
            PG8_LDA(At, 0, 1); PG8_STAGE(PG8_SA(0, 0), a2, voffA);
            PG8_BAR; PG8_WAIT_L(0); PG8_MMA(1, 0, At, B0); PG8_BAR; PG8_SCHED;
            PG8_STAGE(PG8_SB(0, 1), b2 + hstep, voffB);
            PG8_WAIT_V(6); PG8_BAR; PG8_MMA(1, 1, At, B1); PG8_BAR;
            PG8_LDB(B0, 1, 0); PG8_SCHED; PG8_LDA(At, 1, 0); PG8_STAGE(PG8_SA(0, 1), a2 + hstep, voffA);
            PG8_WAIT_L(8); PG8_BAR; PG8_WAIT_L(0); PG8_MMA(0, 0, At, B0); PG8_BAR; PG8_SCHED;
            PG8_LDB(B1, 1, 1); PG8_STAGE(PG8_SB(1, 0), b3, voffB);
            PG8_BAR; PG8_WAIT_L(0); PG8_MMA(0, 1, At, B1); PG8_BAR;
            PG8_LDA(At, 1, 1); PG8_STAGE(PG8_SA(1, 0), a3, voffA);
            PG8_BAR; PG8_WAIT_L(0); PG8_MMA(1, 0, At, B0); PG8_BAR; PG8_SCHED;
            PG8_STAGE(PG8_SB(1, 1), b3 + hstep, voffB);
            PG8_WAIT_V(6); PG8_BAR; PG8_MMA(1, 1, At, B1); PG8_BAR;
            }
        }
        if constexpr (ALIGN_EPI) { if (wr == 0) PG8_BAR; }
        if constexpr (!Epi::AFTER_DRAIN) { E(acc, cur, wr, wc, fr, fq); S.done(cur); }
        if (!has_next) break;
#pragma unroll
        for (int a = 0; a < 2; ++a)
#pragma unroll
            for (int b = 0; b < 2; ++b)
#pragma unroll
                for (int m = 0; m < 4; ++m)
#pragma unroll
                    for (int n = 0; n < 2; ++n) acc[a][b][m][n] = (f32x4){0.f, 0.f, 0.f, 0.f};
        cur = nxt; cA = nA; cB = nB; ++ui;
        if constexpr (ALIGN_EPI) { if (wr == 1) PG8_BAR; }
    }
    PG8_WAIT_V(0);
    if constexpr (!ALIGN_EPI) { if (wr == 0) PG8_BAR; }
    PG8_BAR;
    if constexpr (Epi::AFTER_DRAIN) { E.fused(acc, cur, wr, wc, fr, fq, lds, wid, lane); S.done(cur); }
#undef PG8_SA
#undef PG8_SB
#undef PG8_STAGE
#undef PG8_LDA
#undef PG8_LDB
#undef PG8_MMA
#undef PG8_WAIT_V
#undef PG8_WAIT_L
#undef PG8_BAR
#undef PG8_SCHED
}
}

constexpr int NB = 4, T = 2048, D = 2048, M = NB * T, DEPTH = 2, MEM = 256, MM = NB * MEM;
constexpr int INC = 6408, NP = 6400;
constexpr int ML_DH = 192, MO_DH = 128;
constexpr int C_LX = 0, C_LZ = 512, C_MU = 1024, C_MO = 1792, C_MZ = 2560, C_Q = 3328, C_K = 4096, C_V = 4864, C_Z = 5632;
constexpr int SRC_GATE = 3328;
constexpr float RMS_EPS = 1e-6f, LN_EPS = 1e-5f;

typedef unsigned short bf16;
#define LAS __attribute__((address_space(3)))
__device__ __forceinline__ float bf2f(bf16 v) { return __uint_as_float(((unsigned)v) << 16); }
__device__ __forceinline__ bf16 f2bf(float f) { unsigned u = __float_as_uint(f); return (bf16)((u + 0x7fffu + ((u >> 16) & 1u)) >> 16); }
__device__ __forceinline__ unsigned pk2(float lo, float hi) { return (unsigned)f2bf(lo) | ((unsigned)f2bf(hi) << 16); }
__device__ __forceinline__ float fexp(float x) { return __builtin_amdgcn_exp2f(x * 1.4426950408889634f); }
__device__ __forceinline__ float sigm(float x) { return __builtin_amdgcn_rcpf(1.f + fexp(-x)); }
__device__ __forceinline__ float silu(float x) { return x * __builtin_amdgcn_rcpf(1.f + fexp(-x)); }
__device__ __forceinline__ float logsig(float x) { return fminf(x, 0.f) - log1pf(expf(-fabsf(x))); }
__device__ __forceinline__ float wave_sum(float v) {
#pragma unroll
    for (int o = 1; o < 64; o <<= 1) v += __shfl_xor(v, o);
    return v;
}

constexpr size_t al256(size_t x) { return (x + 255) & ~(size_t)255; }
constexpr size_t WS_CTL = 0;
constexpr size_t WS_WIN = 1u << 20;
constexpr size_t WS_WOUT = WS_WIN + (size_t)DEPTH * NP * D * 2;
constexpr size_t WS_WQ = WS_WOUT + (size_t)DEPTH * D * D * 2;
constexpr size_t WS_WKV = WS_WQ + (size_t)DEPTH * 512 * D * 2;
constexpr size_t WS_WO = WS_WKV + (size_t)DEPTH * 1024 * D * 2;
constexpr size_t WS_WG = WS_WO + (size_t)DEPTH * D * 512 * 2;
constexpr size_t WS_MEMB = WS_WG + (size_t)DEPTH * D * 8 * 4;
constexpr size_t WS_RINVM = WS_MEMB + (size_t)MM * D * 2;
constexpr size_t WS_KV = WS_RINVM + (size_t)MM * 4;
constexpr size_t WS_XB = WS_KV + (size_t)DEPTH * MM * 1024 * 2;
constexpr size_t WS_RINV = WS_XB + (size_t)M * D * 2;
constexpr size_t WS_GATES = WS_RINV + (size_t)M * 4;
constexpr size_t WS_XRES = WS_GATES + (size_t)M * 8 * 4;
constexpr size_t WS_Y = WS_XRES + (size_t)M * D * 4;
constexpr size_t WS_P = WS_Y + (size_t)M * D * 2;
constexpr size_t WS_A = WS_P + (size_t)M * NP * 2;
constexpr size_t WS_U = WS_A + (size_t)M * 512 * 4;
constexpr size_t WS_MQ = WS_U + (size_t)M * 512 * 4;
constexpr size_t WS_MK = WS_MQ + (size_t)M * 768 * 2;
constexpr size_t WS_MV = WS_MK + (size_t)M * 768 * 2;
constexpr size_t WS_F = WS_MV + (size_t)M * 768 * 2;
constexpr size_t WS_I = WS_F + (size_t)16 * T * 4;
constexpr size_t WS_KMEAN = WS_I + (size_t)16 * T * 4;
constexpr size_t WS_SEL = WS_KMEAN + (size_t)NB * 6 * 8 * 128 * 4;
constexpr size_t WS_MOVT = WS_SEL + (size_t)M * 8;
constexpr size_t WS_END = WS_MOVT + (size_t)NB * 6 * 128 * T * 2;
constexpr size_t WS_XQ = WS_P;
constexpr size_t WS_XO = WS_P + (size_t)M * 512 * 2;
constexpr size_t WS_CPREV = WS_XRES;
constexpr size_t WS_MOPART = WS_XRES + 20000000;
static_assert(WS_CPREV + (size_t)256 * 36864 * 2 <= WS_MOPART && WS_MOPART + (size_t)384 * 4 * 66 * 64 * 4 <= WS_Y, "xres region overlays");
constexpr size_t WS_VTM = WS_MEMB;
constexpr size_t WS_LRUW = 512u << 10;
constexpr size_t OUT_CLOC = 0, OUT_NLOC = (size_t)256 * 36864, OUT_NPREV = OUT_NLOC + 256 * 192, OUT_AGGA = OUT_NPREV + 256 * 192, OUT_AGGH = OUT_AGGA + 512 * 512, OUT_CARRY = OUT_AGGH + 512 * 512, OUT_PART = OUT_CARRY + 512 * 512;
static_assert(OUT_PART + (size_t)M * 32 <= (size_t)M * D, "d_out scratch");
static_assert(WS_END <= 419954688ull, "workspace map exceeds the guaranteed ws_size");

__device__ __forceinline__ void wt_item(const float* W, int ldw, int src_col, const float* g, bf16* Wt, int K, int dst_row, float* scr, int k0, int lane) {
    typedef float f32x4w __attribute__((ext_vector_type(4)));
    f32x4w v[8];
#pragma unroll
    for (int i = 0; i < 8; ++i) v[i] = *(const f32x4w*)(W + (size_t)(k0 + 8 * i + (lane >> 3)) * ldw + src_col + (lane & 7) * 4);
#pragma unroll
    for (int i = 0; i < 8; ++i) { const int kk = 8 * i + (lane >> 3); const float gg = g ? g[k0 + kk] : 1.f; float* d = scr + kk * 33 + (lane & 7) * 4;
        d[0] = v[i][0] * gg; d[1] = v[i][1] * gg; d[2] = v[i][2] * gg; d[3] = v[i][3] * gg; }
    __builtin_amdgcn_s_waitcnt(0xc07f); asm volatile("" ::: "memory");
    const int c = lane & 7;
#pragma unroll
    for (int j = 0; j < 4; ++j) { const int n = (lane >> 3) + 8 * j; const float* s = scr + (8 * c) * 33 + n;
        uint4 o; o.x = pk2(s[0 * 33], s[1 * 33]); o.y = pk2(s[2 * 33], s[3 * 33]); o.z = pk2(s[4 * 33], s[5 * 33]); o.w = pk2(s[6 * 33], s[7 * 33]);
        *(uint4*)(Wt + (size_t)(dst_row + n) * K + k0 + 8 * c) = o; }
    __builtin_amdgcn_s_waitcnt(0xc07f); asm volatile("" ::: "memory");
}
struct EpiScaleBf16 {
    static constexpr bool PERM = true, AFTER_DRAIN = false;
    bf16* O; const float* rs; int ldc, pad;
    __device__ __forceinline__ void operator()(const pg8::f32x4 (&acc)[2][2][4][2], const pg8::Unit& u, int wr, int wc, int fr, int fq) const {
        const int row0 = u.pm * 256 + wr * 64 + fr, col0 = u.pn * 256 + wc * 32 + 8 * fq;
#pragma unroll
        for (int ai = 0; ai < 2; ++ai)
#pragma unroll
            for (int m = 0; m < 4; ++m) { const int row = row0 + ai * 128 + m * 16; const float s = rs ? rs[row] : 1.f; bf16* rowp = O + (size_t)row * ldc + col0;
#pragma unroll
                for (int bj = 0; bj < 2; ++bj) { const pg8::f32x4 v0 = acc[ai][bj][m][0] * s, v1 = acc[ai][bj][m][1] * s; pg8::u32x4 w;
                    w.x = pg8::cvt_pk_bf16(v0[0], v0[1]); w.y = pg8::cvt_pk_bf16(v0[2], v0[3]); w.z = pg8::cvt_pk_bf16(v1[0], v1[1]); w.w = pg8::cvt_pk_bf16(v1[2], v1[3]);
                    *(pg8::u32x4*)(rowp + bj * 128) = w; } }
    }
};
template <bool BASE_F32> struct EpiResPart {
    static constexpr bool PERM = true, AFTER_DRAIN = false;
    const void* base; bf16* xb; float* part; unsigned* cnt; float* rinv; int ldc, pad;
    __device__ __forceinline__ void operator()(const pg8::f32x4 (&acc)[2][2][4][2], const pg8::Unit& u, int wr, int wc, int fr, int fq) const {
        const int row0 = u.pm * 256 + wr * 64 + fr, col0 = u.pn * 256 + wc * 32 + 8 * fq;
#pragma unroll
        for (int ai = 0; ai < 2; ++ai)
#pragma unroll
            for (int m = 0; m < 4; ++m) { const int row = row0 + ai * 128 + m * 16; const size_t off = (size_t)row * ldc + col0; float ss = 0.f;
#pragma unroll
                for (int bj = 0; bj < 2; ++bj) { pg8::f32x4 b0, b1;
                    if (BASE_F32) { b0 = *(const pg8::f32x4*)((const float*)base + off + bj * 128); b1 = *(const pg8::f32x4*)((const float*)base + off + bj * 128 + 4); }
                    else { const pg8::u32x4 bb = *(const pg8::u32x4*)((const bf16*)base + off + bj * 128);
                        b0 = (pg8::f32x4){__uint_as_float(bb.x << 16), __uint_as_float(bb.x & 0xffff0000u), __uint_as_float(bb.y << 16), __uint_as_float(bb.y & 0xffff0000u)};
                        b1 = (pg8::f32x4){__uint_as_float(bb.z << 16), __uint_as_float(bb.z & 0xffff0000u), __uint_as_float(bb.w << 16), __uint_as_float(bb.w & 0xffff0000u)}; }
                    const pg8::f32x4 v0 = b0 + acc[ai][bj][m][0], v1 = b1 + acc[ai][bj][m][1];
                    ss += ((v0[0] * v0[0] + v0[1] * v0[1]) + (v0[2] * v0[2] + v0[3] * v0[3])) + ((v1[0] * v1[0] + v1[1] * v1[1]) + (v1[2] * v1[2] + v1[3] * v1[3]));
                    pg8::u32x4 w; w.x = pg8::cvt_pk_bf16(v0[0], v0[1]); w.y = pg8::cvt_pk_bf16(v0[2], v0[3]); w.z = pg8::cvt_pk_bf16(v1[0], v1[1]); w.w = pg8::cvt_pk_bf16(v1[2], v1[3]);
                    *(pg8::u32x4*)(xb + off + bj * 128) = w; }
                ss += __shfl_xor(ss, 16); ss += __shfl_xor(ss, 32);
                if (fq == 0) __hip_atomic_store((unsigned*)part + (size_t)row * 32 + u.pn * 4 + wc, __float_as_uint(ss), __ATOMIC_RELAXED, __HIP_MEMORY_SCOPE_AGENT); }
        asm volatile("s_waitcnt vmcnt(0)" ::: "memory");
        unsigned old = 0u; const int lane = fq * 16 + fr;
        if (lane == 0) old = __hip_atomic_fetch_add(cnt + 64 * u.pm, 1u, __ATOMIC_RELAXED, __HIP_MEMORY_SCOPE_AGENT);
        old = (unsigned)__builtin_amdgcn_readfirstlane((int)old);
        if (old == 63u) {
            __builtin_amdgcn_fence(__ATOMIC_ACQUIRE, "agent"); asm volatile("s_waitcnt vmcnt(0)" ::: "memory");
#pragma unroll 1
            for (int i = 0; i < 4; ++i) { const int row = u.pm * 256 + lane + 64 * i; const pg8::f32x4* pp = (const pg8::f32x4*)(part + (size_t)row * 32); float s = 0.f;
#pragma unroll
                for (int k = 0; k < 8; ++k) { const pg8::f32x4 v = pp[k]; s += (v[0] + v[1]) + (v[2] + v[3]); }
                rinv[row] = 1.0f / sqrtf(s * (1.0f / D) + RMS_EPS); }
        }
    }
};
struct EpiResF32 {
    static constexpr bool PERM = false, AFTER_DRAIN = false;
    const float* base; float* out; int ldc, pad;
    __device__ __forceinline__ void operator()(const pg8::f32x4 (&acc)[2][2][4][2], const pg8::Unit& u, int wr, int wc, int fr, int fq) const {
        const int row0 = u.pm * 256 + wr * 64 + fr, col0 = u.pn * 256 + wc * 32 + 4 * fq;
#pragma unroll
        for (int ai = 0; ai < 2; ++ai)
#pragma unroll
            for (int m = 0; m < 4; ++m) { const size_t off = (size_t)(row0 + ai * 128 + m * 16) * ldc + col0;
#pragma unroll
                for (int bj = 0; bj < 2; ++bj)
#pragma unroll
                    for (int n = 0; n < 2; ++n) { const pg8::f32x4 b = *(const pg8::f32x4*)(base + off + bj * 128 + n * 16); *(pg8::f32x4*)(out + off + bj * 128 + n * 16) = b + acc[ai][bj][m][n]; } }
    }
};
constexpr int NWAVES = 8, NTHR = 512;
constexpr int RING_BYTES = 131072, LDSCTL_OFF = 162816, MISC_OFF = LDSCTL_OFF + 320, LDS_BYTES = 163840;
constexpr size_t CTL_ZERO_BYTES = 1u << 20;
constexpr int CW_BAR = 4096, CW_PANEL = 8192;
typedef __attribute__((address_space(1))) unsigned gu32;
#define RLX_AGENT __ATOMIC_RELAXED, __HIP_MEMORY_SCOPE_AGENT
#define XB_TMO      128
#define XB_XCNT(j)  (256  + 64 * (j))
#define XB_XSUB(j)  (1280 + 64 * (j))
#define XB_XGEN(j)  (2304 + 64 * (j))
#define XB_TOP      3328
#define XB_TOPGEN   3392
#define XCD_BAR_WORDS 3456
#define XB_SPIN_CAP (1u << 18)

__device__ __forceinline__ unsigned xb_ld(unsigned* p)              { return __hip_atomic_load(p, __ATOMIC_RELAXED, __HIP_MEMORY_SCOPE_AGENT); }
__device__ __forceinline__ unsigned xb_add(unsigned* p, unsigned v) { return __hip_atomic_fetch_add(p, v, __ATOMIC_RELAXED, __HIP_MEMORY_SCOPE_AGENT); }
__device__ __forceinline__ unsigned xb_xcc_id() { return (unsigned)__builtin_amdgcn_s_getreg((3 << 11) | 20) & 0xFu; }
#define XB_SPIN(cond, bar) do { unsigned _sp = 0; while (cond) { __builtin_amdgcn_s_sleep(1); \
    if ((++_sp & 255u) == 0u) { if (xb_ld(&(bar)[XB_TMO])) break; if (_sp > XB_SPIN_CAP) { atomicAdd(&(bar)[XB_TMO], 1u); break; } } } } while (0)

struct XcdBarrier {
    unsigned* bar; unsigned x;
    volatile LAS unsigned* st;
};

__device__ __forceinline__ XcdBarrier xcd_barrier_post(unsigned* bar, volatile LAS unsigned* st) {
    XcdBarrier b; b.bar = bar; b.x = xb_xcc_id(); b.st = st;
    if (threadIdx.x == 0) (void)xb_add(&bar[XB_XCNT(b.x)], 1u);
    return b;
}
__device__ __forceinline__ void xcd_barrier_complete(unsigned* bar, unsigned x, unsigned& nloc, unsigned& nx) {
    const unsigned G = gridDim.x * gridDim.y * gridDim.z;
    unsigned sum, cnt, mine, sp = 0u;
    for (;;) {
        sum = 0u; cnt = 0u; mine = 0u;
#pragma unroll
        for (unsigned j = 0; j < 16; ++j) { const unsigned c = xb_ld(&bar[XB_XCNT(j)]); sum += c; cnt += (c > 0u) ? 1u : 0u; mine = (j == x) ? c : mine; }
        if (sum == G) break;
        __builtin_amdgcn_s_sleep(1);
        if ((++sp & 255u) == 0u) { if (xb_ld(&bar[XB_TMO])) break; if (sp > XB_SPIN_CAP) { atomicAdd(&bar[XB_TMO], 1u); break; } }
    }
    nloc = mine > 0u ? mine : 1u; nx = cnt > 0u ? cnt : 1u;
}

__device__ __forceinline__ void xcd_barrier(const XcdBarrier& b) {
    asm volatile("s_waitcnt vmcnt(0)" ::: "memory");
    __syncthreads();
    if (threadIdx.x == 0) {
        unsigned* bar = b.bar;
        __builtin_amdgcn_s_waitcnt(0);
        unsigned nloc = b.st[0], nx = b.st[1];
        if (nloc == 0u) { xcd_barrier_complete(bar, b.x, nloc, nx); b.st[0] = nloc; b.st[1] = nx; }
        const unsigned old = xb_add(&bar[XB_XSUB(b.x)], 1u);
        const unsigned gen = old / nloc;
        if (old + 1u == (gen + 1u) * nloc) {
            __builtin_amdgcn_fence(__ATOMIC_RELEASE, "agent");
            asm volatile("s_waitcnt vmcnt(0)" ::: "memory");
            const unsigned og = xb_add(&bar[XB_TOP], 1u);
            const unsigned tg = og / nx;
            if (og + 1u == (tg + 1u) * nx) xb_add(&bar[XB_TOPGEN], 1u);
            else XB_SPIN(xb_ld(&bar[XB_TOPGEN]) == tg, bar);
            __builtin_amdgcn_fence(__ATOMIC_ACQUIRE, "agent");
            xb_add(&bar[XB_XGEN(b.x)], 1u);
            asm volatile("s_waitcnt vmcnt(0)" ::: "memory");
        } else {
            XB_SPIN(xb_ld(&bar[XB_XGEN(b.x)]) == gen, bar);
            __builtin_amdgcn_fence(__ATOMIC_ACQUIRE, "agent");
            asm volatile("s_waitcnt vmcnt(0)" ::: "memory");
        }
    }
    __syncthreads();
}

constexpr int MIX_K = 3;
__device__ const int MIX_TAB[256][3] = {{480,194,8256},{483,197,4},{486,200,7},{489,203,10},{492,206,13},{495,209,16},{498,212,19},{501,215,22},{481,160,8264},{484,163,8265},{487,166,8266},{490,169,8267},{493,172,8268},{496,175,8269},{499,178,8270},{502,181,8271},{482,161,8296},{485,164,8297},{488,167,8298},{491,170,8299},{494,173,8300},{497,176,8301},{500,179,8302},{503,182,8303},{448,4112,8288},{451,4144,5},{454,4176,8},{457,4208,11},{460,4240,14},{463,4272,17},{466,4304,20},{469,4336,23},{449,192,0},{452,195,8193},{455,198,8194},{458,201,8195},{461,204,8196},{464,207,8197},{467,210,8198},{470,213,8199},{450,193,1},{453,196,8225},{456,199,8226},{459,202,8227},{462,205,8228},{465,208,8229},{468,211,8230},{471,214,8231},{416,225,2},{419,228,8257},{422,231,8258},{425,234,8259},{428,237,8260},{431,240,8261},{434,243,8262},{437,246,8263},{417,226,8192},{420,229,8289},{423,232,8290},{426,235,8291},{429,238,8292},{432,241,8293},{435,244,8294},{438,247,8295},{418,4096,8224},{421,4128,3},{424,4160,6},{427,4192,9},{430,4224,12},{433,4256,15},{436,4288,18},{439,4320,21},{384,4097,8200},{387,4129,8201},{390,4161,8202},{393,4193,8203},{396,4225,8204},{399,4257,8205},{402,4289,8206},{405,4321,8207},{385,4113,8232},{388,4145,8233},{391,4177,8234},{394,4209,8235},{397,4241,8236},{400,4273,8237},{403,4305,8238},{406,4337,8239},{386,224,8304},{389,227,8305},{392,230,8306},{395,233,8307},{398,236,8308},{401,239,49},{404,242,52},{407,245,55},{352,4115,34},{355,4147,37},{358,4179,40},{361,4211,43},{364,4243,46},{367,4275,8277},{370,4307,8278},{373,4339,8279},{353,4098,98},{356,4130,101},{359,4162,104},{362,4194,107},{365,4226,110},{368,4258,113},{371,4290,116},{374,4322,119},{354,4114,64},{357,4146,67},{360,4178,70},{363,4210,73},{366,4242,76},{369,4274,79},{372,4306,82},{375,4338,85},{4111,4116,8208},{4143,4148,8209},{4175,4180,8210},{4207,4212,8211},{4239,4244,8212},{4271,4276,8309},{4303,4308,8310},{4335,4340,8311},{4127,4099,65},{4159,4131,68},{4191,4163,71},{4223,4195,74},{4255,4227,77},{4287,4259,80},{4319,4291,83},{4351,4323,86},{4110,258,66},{4142,261,69},{4174,264,72},{4206,267,75},{4238,270,78},{4270,273,81},{4302,276,84},{4334,279,87},{4126,4100,8216},{4158,4132,8217},{4190,4164,8218},{4222,4196,8219},{4254,4228,8220},{4286,4260,8221},{4318,4292,8222},{4350,4324,8223},{4109,256,162},{4141,259,165},{4173,262,168},{4205,265,171},{4237,268,174},{4269,271,177},{4301,274,180},{4333,277,183},{4125,257,128},{4157,260,131},{4189,263,134},{4221,266,137},{4253,269,140},{4285,272,143},{4317,275,146},{4349,278,149},{320,4119,8240},{323,4151,8241},{326,4183,8242},{329,4215,8243},{332,4247,8244},{335,4279,47},{338,4311,50},{341,4343,53},{321,4102,8248},{324,4134,8249},{327,4166,8250},{330,4198,8251},{333,4230,8252},{336,4262,8253},{339,4294,8254},{342,4326,8255},{322,4118,8280},{325,4150,8281},{328,4182,8282},{331,4214,8283},{334,4246,8284},{337,4278,8285},{340,4310,8286},{343,4342,8287},{4108,4101,129},{4140,4133,132},{4172,4165,135},{4204,4197,138},{4236,4229,141},{4268,4261,144},{4300,4293,147},{4332,4325,150},{4124,4117,130},{4156,4149,133},{4188,4181,136},{4220,4213,139},{4252,4245,142},{4284,4277,145},{4316,4309,148},{4348,4341,151},{4107,4120,8272},{4139,4152,8273},{4171,4184,8274},{4203,4216,8275},{4235,4248,8276},{4267,4280,48},{4299,4312,51},{4331,4344,54},{4123,4103,8312},{4155,4135,8313},{4187,4167,8314},{4219,4199,8315},{4251,4231,8316},{4283,4263,8317},{4315,4295,8318},{4347,4327,8319},{4106,290,32},{4138,293,35},{4170,296,38},{4202,299,41},{4234,302,44},{4266,305,8213},{4298,308,8214},{4330,311,8215},{4122,4104,33},{4154,4136,36},{4186,4168,39},{4218,4200,42},{4250,4232,45},{4282,4264,8245},{4314,4296,8246},{4346,4328,8247},{4105,288,96},{4137,291,99},{4169,294,102},{4201,297,105},{4233,300,108},{4265,303,111},{4297,306,114},{4329,309,117},{4121,289,97},{4153,292,100},{4185,295,103},{4217,298,106},{4249,301,109},{4281,304,112},{4313,307,115},{4345,310,118}};
constexpr int MIXA_K = 5;
__device__ const int MIXA_TAB[256][5] = {{12288,192,416,-1,-1},{12289,193,417,-1,-1},{12290,194,418,-1,-1},{12291,195,419,-1,-1},{12292,196,420,-1,-1},{12293,197,421,-1,-1},{12294,198,422,-1,-1},{12295,199,423,-1,-1},{12296,200,424,-1,-1},{12297,201,425,-1,-1},{12298,202,426,-1,-1},{12299,203,427,-1,-1},{12300,204,428,-1,-1},{12301,205,429,-1,-1},{12302,206,430,-1,-1},{12303,207,431,-1,-1},{12304,208,432,-1,-1},{12305,209,433,-1,-1},{12306,210,434,-1,-1},{12307,211,435,-1,-1},{12308,212,436,-1,-1},{12309,213,437,-1,-1},{12310,214,438,-1,-1},{12311,215,439,-1,-1},{12312,216,440,-1,-1},{12313,217,441,-1,-1},{12314,218,442,-1,-1},{12315,219,443,-1,-1},{12316,220,444,-1,-1},{12317,221,445,-1,-1},{12318,222,446,-1,-1},{12319,223,447,-1,-1},{4096,4320,-1,-1,-1},{4097,4321,-1,-1,-1},{4098,4322,-1,-1,-1},{4099,4323,-1,-1,-1},{4100,4324,-1,-1,-1},{4101,4325,-1,-1,-1},{4102,4326,-1,-1,-1},{4103,4327,-1,-1,-1},{4104,4328,-1,-1,-1},{4105,4329,-1,-1,-1},{4106,4330,-1,-1,-1},{4107,4331,-1,-1,-1},{4108,4332,-1,-1,-1},{4109,4333,-1,-1,-1},{4110,4334,-1,-1,-1},{4111,4335,-1,-1,-1},{4112,4336,-1,-1,-1},{4113,4337,-1,-1,-1},{4114,4338,-1,-1,-1},{4115,4339,-1,-1,-1},{4116,4340,-1,-1,-1},{4117,4341,-1,-1,-1},{4118,4342,-1,-1,-1},{4119,4343,-1,-1,-1},{4120,4344,-1,-1,-1},{4121,4345,-1,-1,-1},{4122,4346,-1,-1,-1},{4123,4347,-1,-1,-1},{4124,4348,-1,-1,-1},{4125,4349,-1,-1,-1},{4126,4350,-1,-1,-1},{4127,4351,-1,-1,-1},{4128,0,224,448,-1},{4129,1,225,449,-1},{4130,2,226,450,-1},{4131,3,227,451,-1},{4132,4,228,452,-1},{4133,5,229,453,-1},{4134,6,230,454,-1},{4135,7,231,455,-1},{4136,8,232,456,-1},{4137,9,233,457,-1},{4138,10,234,458,-1},{4139,11,235,459,-1},{4140,12,236,460,-1},{4141,13,237,461,-1},{4142,14,238,462,-1},{4143,15,239,463,-1},{4144,16,240,464,-1},{4145,17,241,465,-1},{4146,18,242,466,-1},{4147,19,243,467,-1},{4148,20,244,468,-1},{4149,21,245,469,-1},{4150,22,246,470,-1},{4151,23,247,471,-1},{4152,24,248,472,-1},{4153,25,249,473,-1},{4154,26,250,474,-1},{4155,27,251,475,-1},{4156,28,252,476,-1},{4157,29,253,477,-1},{4158,30,254,478,-1},{4159,31,255,479,-1},{4160,32,256,480,-1},{4161,33,257,481,-1},{4162,34,258,482,-1},{4163,35,259,483,-1},{4164,36,260,484,-1},{4165,37,261,485,-1},{4166,38,262,486,-1},{4167,39,263,487,-1},{4168,40,264,488,-1},{4169,41,265,489,-1},{4170,42,266,490,-1},{4171,43,267,491,-1},{4172,44,268,492,-1},{4173,45,269,493,-1},{4174,46,270,494,-1},{4175,47,271,495,-1},{4176,48,272,496,-1},{4177,49,273,497,-1},{4178,50,274,498,-1},{4179,51,275,499,-1},{4180,52,276,500,-1},{4181,53,277,501,-1},{4182,54,278,502,-1},{4183,55,279,503,-1},{4184,56,280,504,-1},{4185,57,281,505,-1},{4186,58,282,506,-1},{4187,59,283,507,-1},{4188,60,284,508,-1},{4189,61,285,509,-1},{4190,62,286,510,-1},{4191,63,287,511,-1},{4192,64,288,8192,8320},{4193,65,289,8193,8321},{4194,66,290,8194,8322},{4195,67,291,8195,8323},{4196,68,292,8196,8324},{4197,69,293,8197,8325},{4198,70,294,8198,8326},{4199,71,295,8199,8327},{4200,72,296,8200,8328},{4201,73,297,8201,8329},{4202,74,298,8202,8330},{4203,75,299,8203,8331},{4204,76,300,8204,8332},{4205,77,301,8205,8333},{4206,78,302,8206,8334},{4207,79,303,8207,8335},{4208,80,304,8208,8336},{4209,81,305,8209,8337},{4210,82,306,8210,8338},{4211,83,307,8211,8339},{4212,84,308,8212,8340},{4213,85,309,8213,8341},{4214,86,310,8214,8342},{4215,87,311,8215,8343},{4216,88,312,8216,8344},{4217,89,313,8217,8345},{4218,90,314,8218,8346},{4219,91,315,8219,8347},{4220,92,316,8220,8348},{4221,93,317,8221,8349},{4222,94,318,8222,8350},{4223,95,319,8223,8351},{4224,96,320,8224,8352},{4225,97,321,8225,8353},{4226,98,322,8226,8354},{4227,99,323,8227,8355},{4228,100,324,8228,8356},{4229,101,325,8229,8357},{4230,102,326,8230,8358},{4231,103,327,8231,8359},{4232,104,328,8232,8360},{4233,105,329,8233,8361},{4234,106,330,8234,8362},{4235,107,331,8235,8363},{4236,108,332,8236,8364},{4237,109,333,8237,8365},{4238,110,334,8238,8366},{4239,111,335,8239,8367},{4240,112,336,8240,8368},{4241,113,337,8241,8369},{4242,114,338,8242,8370},{4243,115,339,8243,8371},{4244,116,340,8244,8372},{4245,117,341,8245,8373},{4246,118,342,8246,8374},{4247,119,343,8247,8375},{4248,120,344,8248,8376},{4249,121,345,8249,8377},{4250,122,346,8250,8378},{4251,123,347,8251,8379},{4252,124,348,8252,8380},{4253,125,349,8253,8381},{4254,126,350,8254,8382},{4255,127,351,8255,8383},{4256,128,352,8256,-1},{4257,129,353,8257,-1},{4258,130,354,8258,-1},{4259,131,355,8259,-1},{4260,132,356,8260,-1},{4261,133,357,8261,-1},{4262,134,358,8262,-1},{4263,135,359,8263,-1},{4264,136,360,8264,-1},{4265,137,361,8265,-1},{4266,138,362,8266,-1},{4267,139,363,8267,-1},{4268,140,364,8268,-1},{4269,141,365,8269,-1},{4270,142,366,8270,-1},{4271,143,367,8271,-1},{4272,144,368,8272,-1},{4273,145,369,8273,-1},{4274,146,370,8274,-1},{4275,147,371,8275,-1},{4276,148,372,8276,-1},{4277,149,373,8277,-1},{4278,150,374,8278,-1},{4279,151,375,8279,-1},{4280,152,376,8280,-1},{4281,153,377,8281,-1},{4282,154,378,8282,-1},{4283,155,379,8283,-1},{4284,156,380,8284,-1},{4285,157,381,8285,-1},{4286,158,382,8286,-1},{4287,159,383,8287,-1},{4288,160,384,8288,-1},{4289,161,385,8289,-1},{4290,162,386,8290,-1},{4291,163,387,8291,-1},{4292,164,388,8292,-1},{4293,165,389,8293,-1},{4294,166,390,8294,-1},{4295,167,391,8295,-1},{4296,168,392,8296,-1},{4297,169,393,8297,-1},{4298,170,394,8298,-1},{4299,171,395,8299,-1},{4300,172,396,8300,-1},{4301,173,397,8301,-1},{4302,174,398,8302,-1},{4303,175,399,8303,-1},{4304,176,400,8304,-1},{4305,177,401,8305,-1},{4306,178,402,8306,-1},{4307,179,403,8307,-1},{4308,180,404,8308,-1},{4309,181,405,8309,-1},{4310,182,406,8310,-1},{4311,183,407,8311,-1},{4312,184,408,8312,-1},{4313,185,409,8313,-1},{4314,186,410,8314,-1},{4315,187,411,8315,-1},{4316,188,412,8316,-1},{4317,189,413,8317,-1},{4318,190,414,8318,-1},{4319,191,415,8319,-1}};
typedef short bf16x8 __attribute__((ext_vector_type(8)));
typedef unsigned u32x4 __attribute__((ext_vector_type(4)));
typedef unsigned u32x2 __attribute__((ext_vector_type(2)));
typedef short s16x4 __attribute__((ext_vector_type(4)));
typedef float f32x16 __attribute__((ext_vector_type(16)));
typedef float f32x4v __attribute__((ext_vector_type(4)));
typedef float f32x2_t __attribute__((ext_vector_type(2)));
typedef __bf16 bf16x2_t __attribute__((ext_vector_type(2)));
__device__ __forceinline__ unsigned cvtpk(float lo, float hi) { f32x2_t v = {lo, hi}; bf16x2_t b = __builtin_convertvector(v, bf16x2_t); return __builtin_bit_cast(unsigned, b); }
__device__ __forceinline__ bf16x8 pack8(float a0, float a1, float a2, float a3, float a4, float a5, float a6, float a7) {
    u32x4 u; u.x = cvtpk(a0, a1); u.y = cvtpk(a2, a3); u.z = cvtpk(a4, a5); u.w = cvtpk(a6, a7); return __builtin_bit_cast(bf16x8, u);
}
#define MFMA32(a, b, c) __builtin_amdgcn_mfma_f32_32x32x16_bf16((a), (b), (c), 0, 0, 0)

__device__ __forceinline__ void tr64_item(const bf16* src, size_t ld, bf16* dst, size_t ldt, LAS bf16* scr, int lane) {
#pragma unroll
    for (int i = 0; i < 8; ++i) { const int row = 8 * i + (lane >> 3), ch = lane & 7; const u32x4 v = *(const u32x4*)(src + (size_t)row * ld + ch * 8);
        LAS unsigned* w = (LAS unsigned*)(scr + row * 66 + ch * 8); w[0] = v.x; w[1] = v.y; w[2] = v.z; w[3] = v.w; }
    __builtin_amdgcn_s_waitcnt(0xc07f); asm volatile("" ::: "memory");
#pragma unroll
    for (int i = 0; i < 8; ++i) { const int c = 8 * i + (lane >> 3), tch = lane & 7;
        unsigned short e[8];
#pragma unroll
        for (int k = 0; k < 8; ++k) e[k] = scr[(tch * 8 + k) * 66 + c];
        u32x4 o; o.x = e[0] | ((unsigned)e[1] << 16); o.y = e[2] | ((unsigned)e[3] << 16); o.z = e[4] | ((unsigned)e[5] << 16); o.w = e[6] | ((unsigned)e[7] << 16);
        *(u32x4*)(dst + (size_t)c * ldt + tch * 8) = o; }
    __builtin_amdgcn_s_waitcnt(0xc07f); asm volatile("" ::: "memory");
}
__device__ __forceinline__ void ph_mo_vt(const bf16* p, bf16* VT, LAS unsigned char* L, int gw, int NGW, int wave, int lane) {
    LAS bf16* scr = (LAS bf16*)(L + wave * 8448);
    for (int it = gw; it < NB * (T / 64) * 12; it += NGW) {
        const int cb = it % 12, tb = (it / 12) % (T / 64), b = it / (12 * (T / 64));
        const int h = cb >> 1, d0 = (cb & 1) * 64, t0 = tb * 64;
        tr64_item(p + (size_t)(b * T + t0) * NP + C_V + h * 128 + d0, NP, VT + ((size_t)(b * 6 + h) * 128 + d0) * T + t0, T, scr, lane);
    }
}
__device__ __forceinline__ void mo_kmean_unit(const bf16* p, float* kmean, LAS float* Lf, int unit) {
    int tid_ = threadIdx.x; asm volatile("" : "+v"(tid_)); const int tid = tid_;
    const int blk = unit & 7, bh = unit >> 3, b = bh / 6, h = bh % 6, d = tid & 127, part = tid >> 7; float s = 0.f, s1 = 0.f, s2 = 0.f, s3 = 0.f;
#pragma unroll 4
    for (int i = 0; i < 64; i += 4) { const size_t o = (size_t)(b * T + blk * 256 + part * 64 + i) * NP + C_K + h * 128 + d; s += bf2f(p[o]); s1 += bf2f(p[o + NP]); s2 += bf2f(p[o + 2 * (size_t)NP]); s3 += bf2f(p[o + 3 * (size_t)NP]); }
    s = (s + s1) + (s2 + s3);
    __syncthreads(); Lf[tid] = s; __syncthreads();
    if (tid < 128) kmean[(size_t)unit * 128 + tid] = (Lf[tid] + Lf[128 + tid] + Lf[256 + tid] + Lf[384 + tid]) * (1.0f / 256.0f);
}

constexpr int MO_KST = 272, MO_VST = 136;
constexpr int MO_KB = 64 * MO_KST, MO_VB = 128 * MO_VST, MO_GRP = MO_KB + MO_VB;
constexpr int MO_KM_OFF = 2 * MO_GRP;
constexpr int MO_Q_OFF = MO_KM_OFF + 4096;
template <int MODE> __device__ __forceinline__ void attn_unit(LAS unsigned char* L, const bf16* p, const bf16* VT, const float* kmean, bf16* y, int unit, const float* rinv = nullptr, const bf16* wqw = nullptr, int ta = 0, int tb = 0, int slot = -1, float* part = nullptr) {
    int tid_ = threadIdx.x; asm volatile("" : "+v"(tid_));
    const int tid = tid_, lane = tid & 63, wave = __builtin_amdgcn_readfirstlane(tid >> 6), grp = wave >> 2, wq = wave & 3, r = lane & 31, hh = lane >> 5, tg = tid & 255;
    constexpr int NH = MODE == 0 ? 6 : 4, LDQ = MODE == 0 ? NP : 512, LDK = MODE == 0 ? NP : 1024, LDV = MODE == 0 ? T : MEM, QC = MODE == 0 ? C_Q : 0, KC = MODE == 0 ? C_K : 0;
    const int qh = MODE == 0 ? unit >> 5 : unit / 16, bh = MODE == 0 ? unit & 31 : unit % 16,   b = bh / NH, h = bh % NH, qb = qh >> 1, half = qh & 1, t0 = qh * 128;
    const int tq = t0 + 32 * wq + r;
    const bf16* prow = p + (size_t)(b * T) * LDQ;
    const bf16* krow = MODE == 0 ? prow : (const bf16*)kmean + (size_t)(b * MEM) * LDK;
    const bf16* vt = VT + (size_t)(b * NH + h) * 128 * LDV;
    LAS float* km = (LAS float*)(L + MO_KM_OFF);
    __syncthreads();
    if (MODE == 0) for (int e = tid; e < 8 * 128; e += NTHR) km[e] = kmean[(size_t)bh * 8 * 128 + e];
    LAS unsigned char* Qt = L + MO_Q_OFF;
    if (MODE == 0) {
#pragma unroll
        for (int i_ = 0; i_ < 4; ++i_) { const int c_ = tid + 512 * i_; *(LAS u32x4*)(Qt + (c_ >> 4) * MO_KST + (c_ & 15) * 16) = *(const u32x4*)(prow + (size_t)(t0 + (c_ >> 4)) * LDQ + QC + h * 128 + (c_ & 15) * 8); }
    } else {
        constexpr int GST = 144, GTB = 128 * GST, GSTG = 2 * GTB;
        const bf16* xg = p + (size_t)(b * T + t0) * D; const bf16* wg = wqw + (size_t)(h * 128) * D;
        const int wd = wave >> 2;
        f32x16 acc0, acc1;
#pragma unroll
        for (int q = 0; q < 16; ++q) { acc0[q] = 0.f; acc1[q] = 0.f; }
        u32x4 ra[2], rb[2];
#define QG_LOAD(kt) do { _Pragma("unroll") for (int i_ = 0; i_ < 2; ++i_) { const int c_ = tid + 512 * i_; \
            ra[i_] = *(const u32x4*)(wg + (size_t)(c_ >> 3) * D + (kt) * 64 + (c_ & 7) * 8); rb[i_] = *(const u32x4*)(xg + (size_t)(c_ >> 3) * D + (kt) * 64 + (c_ & 7) * 8); } } while (0)
#define QG_STORE(st) do { _Pragma("unroll") for (int i_ = 0; i_ < 2; ++i_) { const int c_ = tid + 512 * i_; \
            *(LAS u32x4*)(L + (st) * GSTG + (c_ >> 3) * GST + (c_ & 7) * 16) = ra[i_]; *(LAS u32x4*)(L + (st) * GSTG + GTB + (c_ >> 3) * GST + (c_ & 7) * 16) = rb[i_]; } } while (0)
        QG_LOAD(0); QG_STORE(0);
        __syncthreads();
#pragma unroll 1
        for (int kt = 0; kt < 32; ++kt) {
            if (kt + 1 < 32) QG_LOAD(kt + 1);
            const LAS unsigned char* sa = L + (kt & 1) * GSTG + (64 * wd + r) * GST + 16 * hh; const LAS unsigned char* sb = L + (kt & 1) * GSTG + GTB + (32 * wq + r) * GST + 16 * hh;
#pragma unroll
            for (int ks = 0; ks < 4; ++ks) { const bf16x8 bq = *(const LAS bf16x8*)(sb + 32 * ks);
                acc0 = MFMA32(*(const LAS bf16x8*)(sa + 32 * ks), bq, acc0); acc1 = MFMA32(*(const LAS bf16x8*)(sa + 32 * GST + 32 * ks), bq, acc1); }
            if (kt + 1 < 32) QG_STORE((kt + 1) & 1);
            __syncthreads();
        }
#undef QG_LOAD
#undef QG_STORE
        const float rv = rinv[(size_t)b * T + tq];
#pragma unroll
        for (int g4 = 0; g4 < 4; ++g4) { const int d0 = 64 * wd + 8 * g4 + 4 * hh;
            *(LAS u32x2*)(Qt + (32 * wq + r) * MO_KST + d0 * 2) = (u32x2){cvtpk(acc0[4 * g4] * rv, acc0[4 * g4 + 1] * rv), cvtpk(acc0[4 * g4 + 2] * rv, acc0[4 * g4 + 3] * rv)};
            *(LAS u32x2*)(Qt + (32 * wq + r) * MO_KST + (d0 + 32) * 2) = (u32x2){cvtpk(acc1[4 * g4] * rv, acc1[4 * g4 + 1] * rv), cvtpk(acc1[4 * g4 + 2] * rv, acc1[4 * g4 + 3] * rv)}; }
    }
    __syncthreads();
    const LAS unsigned char* qrow = Qt + (32 * wq + r) * MO_KST + 16 * hh;
#define MO_QF(ks) (*(const LAS bf16x8*)(qrow + 32 * (ks)))
    unsigned mask = 0xffffffffu;
    if (MODE == 0) {
        float g0 = 0, g1 = 0, g2 = 0, g3 = 0, g4 = 0, g5 = 0, g6 = 0;
#pragma unroll
        for (int ks = 0; ks < 8; ++ks)
            { const bf16x8 qv8 = MO_QF(ks);
#pragma unroll
            for (int j = 0; j < 8; ++j) { const float qv = bf2f((bf16)qv8[j]); const int d = 16 * ks + 8 * hh + j;
                g0 += qv * km[d]; g1 += qv * km[128 + d]; g2 += qv * km[256 + d]; g3 += qv * km[384 + d]; g4 += qv * km[512 + d]; g5 += qv * km[640 + d]; g6 += qv * km[768 + d]; } }
        g0 += __shfl_xor(g0, 32); g1 += __shfl_xor(g1, 32); g2 += __shfl_xor(g2, 32); g3 += __shfl_xor(g3, 32); g4 += __shfl_xor(g4, 32); g5 += __shfl_xor(g5, 32); g6 += __shfl_xor(g6, 32);
        const float gv[7] = {g0, g1, g2, g3, g4, g5, g6};
        mask = 0;
        if (qb <= 3) mask = (1u << qb) - 1u;
        else {
#pragma unroll
            for (int pass = 0; pass < 3; ++pass) { float best = -INFINITY; int bi = -1;
#pragma unroll
                for (int j = 0; j < 7; ++j) if (j < qb && !((mask >> j) & 1u) && gv[j] > best) { best = gv[j]; bi = j; }
                if (bi >= 0) mask |= 1u << bi; }
        }
        mask |= 1u << qb;
    }
    const float LOG2E = 1.4426950408889634f;
    const float c1 = 0.08838834764831845f * LOG2E;
    const float slope = (h == 0) ? 0.25f : (h == 1) ? 0.0625f : (h == 2) ? 0.015625f : (h == 3) ? 0.00390625f : (h == 4) ? 0.5f : 0.125f;
    const float slope2 = MODE == 0 ? slope * LOG2E : 0.f;
    const int nh = MODE == 0 ? (tb - ta) >> 1 : 2, tile0 = (MODE == 0 ? ta : 0) + grp * nh;
    LAS unsigned char* Kt = L + grp * MO_GRP; LAS unsigned char* Vt = Kt + MO_KB;
    f32x16 O[4];
#pragma unroll
    for (int i = 0; i < 4; ++i)
#pragma unroll
        for (int j = 0; j < 16; ++j) O[i][j] = 0.f;
    float mrun = -1e30f, lsum = 0.f;
    u32x4 kreg[4], vreg[4];
#define MO_LOAD(ti) do { const int s0_ = (ti) * 64; _Pragma("unroll") for (int i_ = 0; i_ < 4; ++i_) { const int c_ = tg + 256 * i_; \
        kreg[i_] = *(const u32x4*)(krow + (size_t)(s0_ + (c_ >> 4)) * LDK + KC + h * 128 + (c_ & 15) * 8); \
        vreg[i_] = *(const u32x4*)(vt + (size_t)(c_ >> 3) * LDV + s0_ + (c_ & 7) * 8); } } while (0)
#define MO_STORE() do { _Pragma("unroll") for (int i_ = 0; i_ < 4; ++i_) { const int c_ = tg + 256 * i_; \
        *(LAS u32x4*)(Kt + (c_ >> 4) * MO_KST + (c_ & 15) * 16) = kreg[i_]; \
        LAS u32x2* vd_ = (LAS u32x2*)(Vt + (c_ >> 3) * MO_VST + (c_ & 7) * 16); vd_[0] = (u32x2){vreg[i_].x, vreg[i_].y}; vd_[1] = (u32x2){vreg[i_].z, vreg[i_].w}; } } while (0)
    MO_LOAD(tile0);
    for (int i = 0; i < nh; ++i) {
        const int ti = tile0 + i, s0 = ti * 64, j = ti >> 2;
        MO_STORE();
        __syncthreads();
        if (i + 1 < nh) MO_LOAD(ti + 1);
        const bool sel = MODE == 0 ? ((mask >> j) & 1u) : true;
        const bool active = MODE == 0 ? ((__ballot(sel) != 0ull) && (s0 <= t0 + 32 * wq + 31)) : true;
        if (active) {
            f32x16 S0, S1;
#pragma unroll
            for (int q = 0; q < 16; ++q) { S0[q] = 0.f; S1[q] = 0.f; }
#pragma unroll
            for (int ks = 0; ks < 8; ++ks) {
                const bf16x8 k0 = *(const LAS bf16x8*)(Kt + r * MO_KST + (16 * ks + 8 * hh) * 2);
                const bf16x8 k1 = *(const LAS bf16x8*)(Kt + (32 + r) * MO_KST + (16 * ks + 8 * hh) * 2);
                const bf16x8 qq = MO_QF(ks); S0 = MFMA32(k0, qq, S0); S1 = MFMA32(k1, qq, S1);
            }
            const float base0 = MODE == 0 ? slope2 * (float)(s0 + 4 * hh - tq) : 0.f, s32 = 32.0f * slope2;
            const bool need_mask = MODE == 0 && ((__ballot(sel) != ~0ull) || (s0 + 63 > t0 + 32 * wq));
            float mx = -INFINITY;
            if (need_mask) {
#pragma unroll
                for (int R = 0; R < 16; ++R) { const int ko = (R & 3) + 8 * (R >> 2); const int sa = s0 + 4 * hh + ko, sb = sa + 32;
                    const float bb = base0 + slope2 * (float)ko; float za = S0[R] * c1 + bb, zb = S1[R] * c1 + (bb + s32);
                    za = (sel && sa <= tq) ? za : -INFINITY; zb = (sel && sb <= tq) ? zb : -INFINITY;
                    S0[R] = za; S1[R] = zb; mx = fmaxf(mx, fmaxf(za, zb)); }
            } else {
#pragma unroll
                for (int R = 0; R < 16; ++R) { const int ko = (R & 3) + 8 * (R >> 2);
                    const float bb = base0 + slope2 * (float)ko; const float za = S0[R] * c1 + bb, zb = S1[R] * c1 + (bb + s32);
                    S0[R] = za; S1[R] = zb; mx = fmaxf(mx, fmaxf(za, zb)); }
            }
            { auto rr = __builtin_amdgcn_permlane32_swap(__float_as_uint(mx), __float_as_uint(mx), false, false); mx = fmaxf(__uint_as_float(rr[0]), __uint_as_float(rr[1])); }
            if (__any(mx > mrun + 8.0f)) {
                const float mnew = fmaxf(mrun, mx), alpha = __builtin_amdgcn_exp2f(mrun - mnew); mrun = mnew; lsum *= alpha;
#pragma unroll
                for (int i2 = 0; i2 < 4; ++i2)
#pragma unroll
                    for (int q = 0; q < 16; ++q) O[i2][q] *= alpha;
            }
            float ps = 0.f;
#pragma unroll
            for (int R = 0; R < 16; ++R) { S0[R] = __builtin_amdgcn_exp2f(S0[R] - mrun); S1[R] = __builtin_amdgcn_exp2f(S1[R] - mrun); ps += S0[R] + S1[R]; }
            lsum += ps;
            const bf16x8 p00 = pack8(S0[0], S0[1], S0[2], S0[3], S0[4], S0[5], S0[6], S0[7]), p01 = pack8(S0[8], S0[9], S0[10], S0[11], S0[12], S0[13], S0[14], S0[15]);
            const bf16x8 p10 = pack8(S1[0], S1[1], S1[2], S1[3], S1[4], S1[5], S1[6], S1[7]), p11 = pack8(S1[8], S1[9], S1[10], S1[11], S1[12], S1[13], S1[14], S1[15]);
#pragma unroll
            for (int db = 0; db < 4; ++db) {
                const LAS unsigned char* vrow = Vt + (32 * db + r) * MO_VST + 8 * hh;
#define MO_VF(kb, s) ({ const u32x2 lo_ = *(const LAS u32x2*)(vrow + (32 * (kb) + 16 * (s)) * 2), hi_ = *(const LAS u32x2*)(vrow + (32 * (kb) + 16 * (s) + 8) * 2); \
                        u32x4 u_ = {lo_.x, lo_.y, hi_.x, hi_.y}; __builtin_bit_cast(bf16x8, u_); })
                O[db] = MFMA32(MO_VF(0, 0), p00, O[db]); O[db] = MFMA32(MO_VF(0, 1), p01, O[db]);
                O[db] = MFMA32(MO_VF(1, 0), p10, O[db]); O[db] = MFMA32(MO_VF(1, 1), p11, O[db]);
            }
        }
        __syncthreads();
    }
    lsum += __shfl_xor(lsum, 32);
    LAS float* X = (LAS float*)L;
    if (grp == 1) {
#pragma unroll
        for (int db = 0; db < 4; ++db)
#pragma unroll
            for (int q = 0; q < 16; ++q) X[(wq * 66 + db * 16 + q) * 64 + lane] = O[db][q];
        X[(wq * 66 + 64) * 64 + lane] = mrun; X[(wq * 66 + 65) * 64 + lane] = lsum;
    }
    __syncthreads();
    if (grp == 0) {
        const float m1 = X[(wq * 66 + 64) * 64 + lane], l1 = X[(wq * 66 + 65) * 64 + lane];
        const float mm = fmaxf(mrun, m1), a0 = __builtin_amdgcn_exp2f(mrun - mm), a1 = __builtin_amdgcn_exp2f(m1 - mm);
        if (MODE == 0 && slot >= 0) {
            float* Xg = part + (size_t)slot * (4 * 66 * 64);
#pragma unroll
            for (int db = 0; db < 4; ++db)
#pragma unroll
                for (int q = 0; q < 16; ++q) Xg[(wq * 66 + db * 16 + q) * 64 + lane] = O[db][q] * a0 + X[(wq * 66 + db * 16 + q) * 64 + lane] * a1;
            Xg[(wq * 66 + 64) * 64 + lane] = mm; Xg[(wq * 66 + 65) * 64 + lane] = lsum * a0 + l1 * a1;
            return;
        }
        const float inv = 1.0f / (lsum * a0 + l1 * a1);
        const size_t m = (size_t)b * T + tq;
#pragma unroll
        for (int db = 0; db < 4; ++db)
#pragma unroll
            for (int g4 = 0; g4 < 4; ++g4) { const int d = 32 * db + 8 * g4 + 4 * hh;
                float o[4];
#pragma unroll
                for (int e = 0; e < 4; ++e) o[e] = (O[db][4 * g4 + e] * a0 + X[(wq * 66 + db * 16 + 4 * g4 + e) * 64 + lane] * a1) * inv;
                if (MODE == 0) { const u32x2 zz = *(const u32x2*)(p + m * NP + C_Z + h * 128 + d);
                    const float z0 = bf2f((bf16)(zz.x & 0xffff)), z1 = bf2f((bf16)(zz.x >> 16)), z2 = bf2f((bf16)(zz.y & 0xffff)), z3 = bf2f((bf16)(zz.y >> 16));
                    u32x2 w; w.x = cvtpk(o[0] * silu(z0), o[1] * silu(z1)); w.y = cvtpk(o[2] * silu(z2), o[3] * silu(z3));
                    *(u32x2*)(y + m * D + 1280 + h * 128 + d) = w; }
                else { u32x2 w; w.x = cvtpk(o[0], o[1]); w.y = cvtpk(o[2], o[3]); *(u32x2*)(y + m * 512 + h * 128 + d) = w; } }
    }
#undef MO_LOAD
#undef MO_STORE
#undef MO_VF
#undef MO_QF
}
__device__ __forceinline__ void ph_mo_merge(const float* part, const bf16* p, bf16* y, int gw, int NGW, int lane) {
    const int r = lane & 31, hh = lane >> 5;
    for (int it = gw; it < 192 * 4; it += NGW) { const int pi = it >> 2, wq = it & 3, qh = 15 - pi / 24, bh = pi % 24, b = bh / 6, h = bh % 6;
        const float* X0 = part + (size_t)(2 * pi) * (4 * 66 * 64) + (size_t)wq * 66 * 64 + lane; const float* X1 = X0 + 4 * 66 * 64;
        const float m0 = X0[64 * 64], m1 = X1[64 * 64], l0 = X0[65 * 64], l1 = X1[65 * 64];
        const float mm = fmaxf(m0, m1), a0 = __builtin_amdgcn_exp2f(m0 - mm), a1 = __builtin_amdgcn_exp2f(m1 - mm), inv = 1.0f / (l0 * a0 + l1 * a1);
        const size_t m = (size_t)b * T + qh * 128 + 32 * wq + r;
#pragma unroll
        for (int db = 0; db < 4; ++db)
#pragma unroll
            for (int g4 = 0; g4 < 4; ++g4) { const int d = 32 * db + 8 * g4 + 4 * hh; float o[4];
#pragma unroll
                for (int e = 0; e < 4; ++e) { const int idx = db * 16 + 4 * g4 + e; o[e] = (X0[idx * 64] * a0 + X1[idx * 64] * a1) * inv; }
                const u32x2 zz = *(const u32x2*)(p + m * NP + C_Z + h * 128 + d);
                const float z0 = bf2f((bf16)(zz.x & 0xffff)), z1 = bf2f((bf16)(zz.x >> 16)), z2 = bf2f((bf16)(zz.y & 0xffff)), z3 = bf2f((bf16)(zz.y >> 16));
                u32x2 w; w.x = cvtpk(o[0] * silu(z0), o[1] * silu(z1)); w.y = cvtpk(o[2] * silu(z2), o[3] * silu(z3));
                *(u32x2*)(y + m * D + 1280 + h * 128 + d) = w; }
    }
}
__device__ __forceinline__ void ph_mem_vt(const bf16* KV, bf16* VTm, LAS unsigned char* L, int gw, int NGW, int wave, int lane) {
    LAS bf16* scr = (LAS bf16*)(L + wave * 8448);
    for (int it = gw; it < DEPTH * NB * 4 * 8; it += NGW) {
        const int cb = it & 7, sb = (it >> 3) & 3, b = (it >> 5) & 3, l = it >> 7; const int h = cb >> 1, d0 = (cb & 1) * 64, s0 = sb * 64;
        tr64_item(KV + ((size_t)l * MM + b * MEM + s0) * 1024 + 512 + h * 128 + d0, 1024, VTm + (((size_t)l * 16 + b * 4 + h) * 128 + d0) * MEM + s0, MEM, scr, lane);
    }
}
constexpr int MLC_ST = 272;
constexpr int MLC_B_OFF = 192 * MLC_ST, MLC_VS_OFF = 2 * 192 * MLC_ST, MLC_KS_OFF = MLC_VS_OFF + 64 * 194 * 2, MLC_TB_OFF = MLC_KS_OFF + 64 * 194 * 2;
__device__ __forceinline__ void ml_chunk_unit(LAS unsigned char* L, const bf16* p, const float* gates, const float* cw, const float* cb, const float* wq, const float* wk, const float* wv, const float* bi, const float* bf,
                                              const bf16* xb, const float* rinv, const float* Wg, bf16* Q, bf16* K, bf16* VT, float* Fl, float* Ib, bf16* Cloc, float* nloc, int unit) {
    int tid_ = threadIdx.x; asm volatile("" : "+v"(tid_)); const int tid = tid_, lane = tid & 63, wave = __builtin_amdgcn_readfirstlane(tid >> 6), r = lane & 31, hh = lane >> 5;
    const int c = unit & 15, bh = unit >> 4, b = bh >> 2, h = bh & 3, t0 = c * 128;
    LAS unsigned char* At = L; LAS unsigned char* Bt = L + MLC_B_OFF; LAS bf16* Vs = (LAS bf16*)(L + MLC_VS_OFF); LAS bf16* Ks = (LAS bf16*)(L + MLC_KS_OFF);
    LAS float* Fls = (LAS float*)(L + MLC_TB_OFF); LAS float* wvs = Fls + 128; LAS float* tot = wvs + 128;
    __syncthreads();
    { LAS float* wgi = (LAS float*)L; LAS float* wgf = wgi + 2048; LAS float* part = wgf + 2048;
      for (int k = tid; k < 2048; k += 512) { wgi[k] = Wg[(size_t)k * 8 + h]; wgf[k] = Wg[(size_t)k * 8 + 4 + h]; }
      __syncthreads();
      const int tk = tid >> 2, qd = tid & 3; const bf16* xr = xb + ((size_t)b * T + t0 + tk) * D + qd * 512; float ai = 0.f, af = 0.f;
#pragma unroll 1
      for (int i0 = 0; i0 < 64; i0 += 16) { u32x4 xq[16];
#pragma unroll
      for (int i = 0; i < 16; ++i) xq[i] = *(const u32x4*)(xr + 8 * (i0 + i));
#pragma unroll
      for (int ii = 0; ii < 16; ++ii) { const int i = i0 + ii; const u32x4 xv = xq[ii];
          const f32x4v wi0 = *(const LAS f32x4v*)(wgi + qd * 512 + 8 * i), wi1 = *(const LAS f32x4v*)(wgi + qd * 512 + 8 * i + 4), wf0 = *(const LAS f32x4v*)(wgf + qd * 512 + 8 * i), wf1 = *(const LAS f32x4v*)(wgf + qd * 512 + 8 * i + 4);
          const float x0 = __uint_as_float(xv.x << 16), x1 = __uint_as_float(xv.x & 0xffff0000u), x2 = __uint_as_float(xv.y << 16), x3 = __uint_as_float(xv.y & 0xffff0000u), x4 = __uint_as_float(xv.z << 16), x5 = __uint_as_float(xv.z & 0xffff0000u), x6 = __uint_as_float(xv.w << 16), x7 = __uint_as_float(xv.w & 0xffff0000u);
          ai += (x0 * wi0[0] + x1 * wi0[1]) + (x2 * wi0[2] + x3 * wi0[3]) + (x4 * wi1[0] + x5 * wi1[1]) + (x6 * wi1[2] + x7 * wi1[3]);
          af += (x0 * wf0[0] + x1 * wf0[1]) + (x2 * wf0[2] + x3 * wf0[3]) + (x4 * wf1[0] + x5 * wf1[1]) + (x6 * wf1[2] + x7 * wf1[3]); } }
      ai += __shfl_xor(ai, 1); ai += __shfl_xor(ai, 2); af += __shfl_xor(af, 1); af += __shfl_xor(af, 2);
      if (qd == 0) { const float rv = rinv[(size_t)b * T + t0 + tk]; part[tk] = ai * rv; part[128 + tk] = af * rv; }
      __syncthreads(); }
    float igv = 0.f, inc = 0.f;
    if (tid < 128) { LAS float* part = (LAS float*)L + 4096; const float lf = logsig(part[128 + tid] + bf[h]); igv = part[tid] + bi[h]; inc = lf;
#pragma unroll
        for (int o = 1; o < 64; o <<= 1) { const float v = __shfl_up(inc, o); if (lane >= o) inc += v; }
        if (tid == 63) tot[0] = inc; }
    __syncthreads();
    if (tid < 128) { if (tid >= 64) inc += tot[0]; Fls[tid] = inc; Fl[bh * T + t0 + tid] = inc; Ib[bh * T + t0 + tid] = igv; }
    __syncthreads();
    if (tid < 128) wvs[tid] = fexp(Fls[127] - inc + igv);
    const int j4 = tid % 48, tsub = tid / 48, cc = h * 192 + 4 * j4, jg = h * 48 + j4; const bool worker = tid < 384;
    float cwr[4][4], cbr[4], wqr[16], wkr[16], wvr[16];
#pragma unroll
    for (int e = 0; e < 4; ++e) { cbr[e] = cb[cc + e];
#pragma unroll
        for (int jj = 0; jj < 4; ++jj) cwr[jj][e] = cw[jj * 768 + cc + e]; }
    { const f32x4v* a = (const f32x4v*)(wq + jg * 16); const f32x4v* bq = (const f32x4v*)(wk + jg * 16); const f32x4v* cq = (const f32x4v*)(wv + jg * 16);
#pragma unroll
      for (int e = 0; e < 4; ++e) { const f32x4v x = a[e], y = bq[e], z = cq[e];
#pragma unroll
          for (int o = 0; o < 4; ++o) { wqr[e * 4 + o] = x[o]; wkr[e * 4 + o] = y[o] * 0.07216878364870322f; wvr[e * 4 + o] = z[o]; } } }
#pragma unroll 1
    for (int half = 0; half < 2; ++half) {
        const int ts = t0 + 64 * half;
        if (worker) {
            const int tl0 = 8 * tsub, tfirst = ts + tl0; const size_t m0 = (size_t)b * T + tfirst;
            float xw[3][4];
#pragma unroll
            for (int jj = 0; jj < 3; ++jj) { u32x2 uu = {0u, 0u}; if (tfirst - 3 + jj >= 0) uu = *(const u32x2*)(p + (m0 - 3 + jj) * NP + C_MU + cc);
                xw[jj][0] = __uint_as_float(uu.x << 16); xw[jj][1] = __uint_as_float(uu.x & 0xffff0000u); xw[jj][2] = __uint_as_float(uu.y << 16); xw[jj][3] = __uint_as_float(uu.y & 0xffff0000u); }
            u32x2 un[8];
#pragma unroll
            for (int i = 0; i < 8; ++i) un[i] = *(const u32x2*)(p + (m0 + i) * NP + C_MU + cc);
#pragma unroll
            for (int i = 0; i < 8; ++i) {
                float u4[4] = {__uint_as_float(un[i].x << 16), __uint_as_float(un[i].x & 0xffff0000u), __uint_as_float(un[i].y << 16), __uint_as_float(un[i].y & 0xffff0000u)};
                float uc[4];
#pragma unroll
                for (int e = 0; e < 4; ++e) uc[e] = silu(cbr[e] + cwr[0][e] * xw[0][e] + cwr[1][e] * xw[1][e] + cwr[2][e] * xw[2][e] + cwr[3][e] * u4[e]);
                float q[4], k[4], v[4];
#pragma unroll
                for (int o = 0; o < 4; ++o) { q[o] = uc[0] * wqr[o] + uc[1] * wqr[4 + o] + uc[2] * wqr[8 + o] + uc[3] * wqr[12 + o];
                    k[o] = uc[0] * wkr[o] + uc[1] * wkr[4 + o] + uc[2] * wkr[8 + o] + uc[3] * wkr[12 + o];
                    v[o] = u4[0] * wvr[o] + u4[1] * wvr[4 + o] + u4[2] * wvr[8 + o] + u4[3] * wvr[12 + o]; }
                u32x2 qw, kw; qw.x = cvtpk(q[0], q[1]); qw.y = cvtpk(q[2], q[3]); kw.x = cvtpk(k[0], k[1]); kw.y = cvtpk(k[2], k[3]);
                *(u32x2*)(Q + (m0 + i) * 768 + cc) = qw; *(u32x2*)(K + (m0 + i) * 768 + cc) = kw;
                LAS unsigned* vd = (LAS unsigned*)(Vs + (tl0 + i) * 194 + 4 * j4); vd[0] = cvtpk(v[0], v[1]); vd[1] = cvtpk(v[2], v[3]);
                LAS unsigned* kd = (LAS unsigned*)(Ks + (tl0 + i) * 194 + 4 * j4); kd[0] = kw.x; kd[1] = kw.y;
#pragma unroll
                for (int e = 0; e < 4; ++e) { xw[0][e] = xw[1][e]; xw[1][e] = xw[2][e]; xw[2][e] = u4[e]; }
            }
        }
        __syncthreads();
#pragma unroll 1
        for (int i = 0; i < 3; ++i) {
            const int idx = tid + 512 * i, d = idx >> 3, ch = idx & 7;
            unsigned short ev[8]; float fk[8];
#pragma unroll
            for (int k = 0; k < 8; ++k) { ev[k] = Vs[(ch * 8 + k) * 194 + d]; fk[k] = bf2f(Ks[(ch * 8 + k) * 194 + d]) * wvs[64 * half + ch * 8 + k]; }
            u32x4 ov, ok; ov.x = ev[0] | ((unsigned)ev[1] << 16); ov.y = ev[2] | ((unsigned)ev[3] << 16); ov.z = ev[4] | ((unsigned)ev[5] << 16); ov.w = ev[6] | ((unsigned)ev[7] << 16);
            ok.x = cvtpk(fk[0], fk[1]); ok.y = cvtpk(fk[2], fk[3]); ok.z = cvtpk(fk[4], fk[5]); ok.w = cvtpk(fk[6], fk[7]);
            *(u32x4*)(VT + ((size_t)bh * 192 + d) * T + ts + ch * 8) = ov;
            *(LAS u32x4*)(At + d * MLC_ST + (64 * half + ch * 8) * 2) = ov; *(LAS u32x4*)(Bt + d * MLC_ST + (64 * half + ch * 8) * 2) = ok;
        }
        __syncthreads();
    }
    if (tid < 192) { float s = 0.f; const LAS u32x4* row = (const LAS u32x4*)(Bt + tid * MLC_ST);
#pragma unroll
        for (int k = 0; k < 16; ++k) { const u32x4 v = row[k]; s += ((__uint_as_float(v.x << 16) + __uint_as_float(v.x & 0xffff0000u)) + (__uint_as_float(v.y << 16) + __uint_as_float(v.y & 0xffff0000u))) + ((__uint_as_float(v.z << 16) + __uint_as_float(v.z & 0xffff0000u)) + (__uint_as_float(v.w << 16) + __uint_as_float(v.w & 0xffff0000u))); }
        nloc[(size_t)unit * 192 + tid] = s; }
#pragma unroll 1
    for (int ti = wave; ti < 36; ti += 8) { const int rb = ti / 6, cbk = ti % 6;
        f32x16 acc;
#pragma unroll
        for (int q = 0; q < 16; ++q) acc[q] = 0.f;
#pragma unroll
        for (int ks = 0; ks < 8; ++ks) { const bf16x8 a = *(const LAS bf16x8*)(At + (32 * rb + r) * MLC_ST + (16 * ks + 8 * hh) * 2), bb = *(const LAS bf16x8*)(Bt + (32 * cbk + r) * MLC_ST + (16 * ks + 8 * hh) * 2);
            acc = MFMA32(a, bb, acc); }
        bf16* out = Cloc + ((size_t)unit * 192 + 32 * rb + 4 * hh) * 192 + 32 * cbk + r;
#pragma unroll
        for (int R = 0; R < 16; ++R) out[(size_t)((R & 3) + 8 * (R >> 2)) * 192] = f2bf(acc[R]);
    }
}
constexpr int MLO_KST = 400, MLO_VST = 264;
constexpr int MLO_V_OFF = 128 * MLO_KST, MLO_T_OFF = MLO_V_OFF + 192 * MLO_VST;
__device__ __forceinline__ void ml_out_unit(LAS unsigned char* L, const bf16* Q, const bf16* K, const bf16* VT, const bf16* __restrict__ Cloc, const float* __restrict__ nloc, const float* Fb, const float* Ib, const bf16* p, const float* ng, bf16* y, int unit) {
    int tid_ = threadIdx.x; asm volatile("" : "+v"(tid_)); const int tid = tid_, lane = tid & 63, wave = __builtin_amdgcn_readfirstlane(tid >> 6), r = lane & 31, hh = lane >> 5, tb = wave & 3, dh = wave >> 2;
    const int c = unit & 15, bh = unit >> 4, b = bh >> 2, h = bh & 3, t0 = c * 128;
    LAS unsigned char* Kt = L; LAS unsigned char* Vt = L + MLO_V_OFF; LAS unsigned char* Ct = L;
    LAS float* Fs = (LAS float*)(L + MLO_T_OFF); LAS float* Is = Fs + 128; LAS float* np = Is + 128; LAS float* st = np + 192; LAS float* dcy = st + 512;
    __syncthreads();
    if (tid < 128) { Fs[tid] = Fb[bh * T + t0 + tid]; Is[tid] = Ib[bh * T + t0 + tid]; }
    if (tid == 128) { float d = 1.f; for (int j = c - 1; j >= 0; --j) { dcy[j] = d; d *= fexp(Fb[bh * T + 128 * j + 127]); } }
    const int t = t0 + 32 * tb + r; const size_t m = (size_t)b * T + t;
    bf16x8 qf[12];
#pragma unroll
    for (int ks = 0; ks < 12; ++ks) qf[ks] = *(const bf16x8*)(Q + m * 768 + h * 192 + 16 * ks + 8 * hh);
    __syncthreads();
    f32x16 acc[3];
#pragma unroll
    for (int i = 0; i < 3; ++i)
#pragma unroll
        for (int q = 0; q < 16; ++q) acc[i][q] = 0.f;
    const float Ft = Fs[32 * tb + r], dec = fexp(Ft);
    if (c > 0) {
        const bf16* cbase = Cloc + (size_t)(bh * 16) * 36864 + 8 * tid;
        float a[9][8];
#pragma unroll
        for (int i = 0; i < 9; ++i)
#pragma unroll
            for (int e = 0; e < 8; ++e) a[i][e] = 0.f;
#define MLO_ACC(v, dj) do { _Pragma("unroll") for (int i = 0; i < 9; ++i) { a[i][0] += dj * __uint_as_float(v[i].x << 16); a[i][1] += dj * __uint_as_float(v[i].x & 0xffff0000u); a[i][2] += dj * __uint_as_float(v[i].y << 16); a[i][3] += dj * __uint_as_float(v[i].y & 0xffff0000u); \
            a[i][4] += dj * __uint_as_float(v[i].z << 16); a[i][5] += dj * __uint_as_float(v[i].z & 0xffff0000u); a[i][6] += dj * __uint_as_float(v[i].w << 16); a[i][7] += dj * __uint_as_float(v[i].w & 0xffff0000u); } } while (0)
        int j = 0;
#pragma unroll 1
        for (; j + 1 < c; j += 2) { const float d0 = dcy[j], d1 = dcy[j + 1]; u32x4 v[9], w[9];
#pragma unroll
            for (int i = 0; i < 9; ++i) { v[i] = *(const u32x4*)(cbase + (size_t)j * 36864 + 4096 * i); w[i] = *(const u32x4*)(cbase + (size_t)(j + 1) * 36864 + 4096 * i); }
            MLO_ACC(v, d0); MLO_ACC(w, d1); }
        if (j < c) { const float d0 = dcy[j]; u32x4 v[9];
#pragma unroll
            for (int i = 0; i < 9; ++i) v[i] = *(const u32x4*)(cbase + (size_t)j * 36864 + 4096 * i);
            MLO_ACC(v, d0); }
#undef MLO_ACC
#pragma unroll
        for (int i = 0; i < 9; ++i) { const int e = 8 * (tid + 512 * i), dv = e / 192, dk = e % 192;
            *(LAS u32x4*)(Ct + dv * MLO_KST + dk * 2) = (u32x4){cvtpk(a[i][0], a[i][1]), cvtpk(a[i][2], a[i][3]), cvtpk(a[i][4], a[i][5]), cvtpk(a[i][6], a[i][7])}; }
        if (tid < 192) { float s = 0.f; for (int j2 = 0; j2 < c; ++j2) s += dcy[j2] * nloc[(size_t)(bh * 16 + j2) * 192 + tid]; np[tid] = s; }
    } else { if (tid < 192) np[tid] = 0.f; }
    u32x4 kst[6], vst[6];
#pragma unroll
    for (int i = 0; i < 6; ++i) { const int idx = tid + 512 * i; kst[i] = *(const u32x4*)(K + (size_t)(b * T + t0 + idx / 24) * 768 + h * 192 + (idx % 24) * 8); vst[i] = *(const u32x4*)(VT + ((size_t)bh * 192 + (idx >> 4)) * T + t0 + (idx & 15) * 8); }
    if (c > 0) {
        __syncthreads();
        const LAS unsigned char* cp = Ct + (32 * (3 * dh) + r) * MLO_KST + 16 * hh;
#pragma unroll
        for (int blk = 0; blk < 3; ++blk)
#pragma unroll
            for (int ks = 0; ks < 12; ++ks) { const bf16x8 a = *(const LAS bf16x8*)(cp + (32 * blk) * MLO_KST + 32 * ks); acc[blk] = MFMA32(a, qf[ks], acc[blk]); }
#pragma unroll
        for (int i = 0; i < 3; ++i)
#pragma unroll
            for (int q = 0; q < 16; ++q) acc[i][q] *= dec;
    }
    float qn = 0.f;
#pragma unroll
    for (int ks = 0; ks < 12; ++ks) { const f32x4v n0 = *(const LAS f32x4v*)(np + 16 * ks + 8 * hh), n1 = *(const LAS f32x4v*)(np + 16 * ks + 8 * hh + 4);
        qn += (bf2f((bf16)qf[ks][0]) * n0[0] + bf2f((bf16)qf[ks][1]) * n0[1]) + (bf2f((bf16)qf[ks][2]) * n0[2] + bf2f((bf16)qf[ks][3]) * n0[3]) + (bf2f((bf16)qf[ks][4]) * n1[0] + bf2f((bf16)qf[ks][5]) * n1[1]) + (bf2f((bf16)qf[ks][6]) * n1[2] + bf2f((bf16)qf[ks][7]) * n1[3]); }
    qn += __shfl_xor(qn, 32);
    __syncthreads();
#pragma unroll
    for (int i = 0; i < 6; ++i) { const int idx = tid + 512 * i;
        *(LAS u32x4*)(Kt + (idx / 24) * MLO_KST + (idx % 24) * 16) = kst[i];
        LAS u32x2* vd = (LAS u32x2*)(Vt + (idx >> 4) * MLO_VST + (idx & 15) * 16); vd[0] = (u32x2){vst[i].x, vst[i].y}; vd[1] = (u32x2){vst[i].z, vst[i].w}; }
    u32x2 og[12];
#pragma unroll
    for (int blk = 0; blk < 3; ++blk)
#pragma unroll
        for (int g4 = 0; g4 < 4; ++g4) og[blk * 4 + g4] = *(const u32x2*)(p + m * NP + C_MO + h * 192 + 32 * (3 * dh + blk) + 8 * g4 + 4 * hh);
    __syncthreads();
    float den = dec * qn, dpart = 0.f;
    for (int kb = 0; kb <= tb; ++kb) {
        f32x16 S;
#pragma unroll
        for (int q = 0; q < 16; ++q) S[q] = 0.f;
#pragma unroll
        for (int ks = 0; ks < 12; ++ks) { const bf16x8 kf = *(const LAS bf16x8*)(Kt + (32 * kb + r) * MLO_KST + (16 * ks + 8 * hh) * 2); S = MFMA32(kf, qf[ks], S); }
#pragma unroll
        for (int R = 0; R < 16; ++R) { const int sl = 32 * kb + (R & 3) + 8 * (R >> 2) + 4 * hh; const float wgt = (t0 + sl <= t) ? fexp(Ft - Fs[sl] + Is[sl]) : 0.f; S[R] *= wgt; dpart += S[R]; }
        const bf16x8 p0 = pack8(S[0], S[1], S[2], S[3], S[4], S[5], S[6], S[7]), p1 = pack8(S[8], S[9], S[10], S[11], S[12], S[13], S[14], S[15]);
#pragma unroll
        for (int blk = 0; blk < 3; ++blk) { const LAS unsigned char* vrow = Vt + (32 * (3 * dh + blk) + r) * MLO_VST + 8 * hh + 64 * kb;
            { const u32x2 lo = *(const LAS u32x2*)(vrow), hi = *(const LAS u32x2*)(vrow + 16); u32x4 u = {lo.x, lo.y, hi.x, hi.y}; acc[blk] = MFMA32(__builtin_bit_cast(bf16x8, u), p0, acc[blk]); }
            { const u32x2 lo = *(const LAS u32x2*)(vrow + 32), hi = *(const LAS u32x2*)(vrow + 48); u32x4 u = {lo.x, lo.y, hi.x, hi.y}; acc[blk] = MFMA32(__builtin_bit_cast(bf16x8, u), p1, acc[blk]); } }
    }
    den += dpart + __shfl_xor(dpart, 32);
    const float inv = 1.0f / fmaxf(fabsf(den), 1.0f);
    float s1 = 0.f, s2 = 0.f;
#pragma unroll
    for (int blk = 0; blk < 3; ++blk)
#pragma unroll
        for (int g4 = 0; g4 < 4; ++g4) { const u32x2 oo = og[blk * 4 + g4];
            const float o0 = bf2f((bf16)(oo.x & 0xffff)), o1 = bf2f((bf16)(oo.x >> 16)), o2 = bf2f((bf16)(oo.y & 0xffff)), o3 = bf2f((bf16)(oo.y >> 16));
            float v0 = acc[blk][4 * g4] * inv * sigm(o0), v1 = acc[blk][4 * g4 + 1] * inv * sigm(o1), v2 = acc[blk][4 * g4 + 2] * inv * sigm(o2), v3 = acc[blk][4 * g4 + 3] * inv * sigm(o3);
            acc[blk][4 * g4] = v0; acc[blk][4 * g4 + 1] = v1; acc[blk][4 * g4 + 2] = v2; acc[blk][4 * g4 + 3] = v3;
            s1 += (v0 + v1) + (v2 + v3); s2 += (v0 * v0 + v1 * v1) + (v2 * v2 + v3 * v3); }
    s1 += __shfl_xor(s1, 32); s2 += __shfl_xor(s2, 32);
    if (hh == 0) { st[(dh * 128 + 32 * tb + r) * 2] = s1; st[(dh * 128 + 32 * tb + r) * 2 + 1] = s2; }
    u32x2 zg[12];
#pragma unroll
    for (int blk = 0; blk < 3; ++blk)
#pragma unroll
        for (int g4 = 0; g4 < 4; ++g4) zg[blk * 4 + g4] = *(const u32x2*)(p + m * NP + C_MZ + h * 192 + 32 * (3 * dh + blk) + 8 * g4 + 4 * hh);
    __syncthreads();
    const float t1 = st[(32 * tb + r) * 2] + st[(128 + 32 * tb + r) * 2], t2 = st[(32 * tb + r) * 2 + 1] + st[(128 + 32 * tb + r) * 2 + 1];
    const float mu = t1 * (1.0f / 192.0f), var = fmaxf(t2 * (1.0f / 192.0f) - mu * mu, 0.f), rs = 1.0f / sqrtf(var + LN_EPS);
#pragma unroll
    for (int blk = 0; blk < 3; ++blk)
#pragma unroll
        for (int g4 = 0; g4 < 4; ++g4) { const int d = 32 * (3 * dh + blk) + 8 * g4 + 4 * hh; const u32x2 zz = zg[blk * 4 + g4];
            const float z0 = bf2f((bf16)(zz.x & 0xffff)), z1 = bf2f((bf16)(zz.x >> 16)), z2 = bf2f((bf16)(zz.y & 0xffff)), z3 = bf2f((bf16)(zz.y >> 16));
            const float4 gg = *(const float4*)(ng + h * 192 + d);
            u32x2 w; w.x = cvtpk((acc[blk][4 * g4] - mu) * rs * gg.x * silu(z0), (acc[blk][4 * g4 + 1] - mu) * rs * gg.y * silu(z1));
            w.y = cvtpk((acc[blk][4 * g4 + 2] - mu) * rs * gg.z * silu(z2), (acc[blk][4 * g4 + 3] - mu) * rs * gg.w * silu(z3));
            *(u32x2*)(y + m * D + 512 + h * 192 + d) = w; }
}

#define MFMA16(a, b, c) __builtin_amdgcn_mfma_f32_16x16x32_bf16((a), (b), (c), 0, 0, 0)
__device__ __forceinline__ void ph_lru_wt(const float* wa, const float* wx, bf16* Wt, int gt, int NGT) {
    for (int idx = gt; idx < DEPTH * 2 * 4 * 128 * 128; idx += NGT) {
        const int i = idx & 127, o = (idx >> 7) & 127, g = (idx >> 14) & 3, gate = (idx >> 16) & 1, l = idx >> 17;
        const float* src = gate ? wx : wa;
        Wt[idx] = f2bf(src[(((size_t)l * 4 + g) * 128 + i) * 128 + o]);
    }
}
constexpr int LR_XCB_OFF = 32768, LR_XCB_ST = 1040, LR_A_OFF = LR_XCB_OFF + 16 * LR_XCB_ST, LR_U_OFF = LR_A_OFF + 32768;
__device__ __forceinline__ void lru_unit(LAS unsigned char* L, const bf16* p, const float* cw, const float* cb, const bf16* Wt  , const float* ba, const float* bx, const float* lam,
                                         float* hloc, float* cumA, float* aggA, float* aggH, int unit) {
    int tid_ = threadIdx.x; asm volatile("" : "+v"(tid_)); const int tid = tid_, lane = tid & 63, wave = __builtin_amdgcn_readfirstlane(tid >> 6);
    const int m0 = unit * 16, t0 = m0 % T;
    LAS float* xcf = (LAS float*)L; LAS unsigned char* xcb = L + LR_XCB_OFF; LAS float* As = (LAS float*)(L + LR_A_OFF); LAS float* Us = (LAS float*)(L + LR_U_OFF);
    const int g = wave >> 1, ob = (wave & 1) * 64, fr = lane & 15, kq = lane >> 4;
    bf16x8 bw[2][4][4];
#pragma unroll
    for (int a = 0; a < 2; ++a)
#pragma unroll
        for (int nb = 0; nb < 4; ++nb)
#pragma unroll
            for (int ks = 0; ks < 4; ++ks) bw[a][nb][ks] = *(const bf16x8*)(Wt + ((size_t)(a * 4 + g) * 128 + ob + 16 * nb + fr) * 128 + 32 * ks + 8 * kq);
    __syncthreads();
    { const int c = tid; const float w0 = cw[c], w1 = cw[512 + c], w2 = cw[1024 + c], w3 = cw[1536 + c], bb = cb[c];
      float x0 = (t0 >= 3) ? bf2f(p[(size_t)(m0 - 3) * NP + C_LX + c]) : 0.f, x1 = (t0 >= 2) ? bf2f(p[(size_t)(m0 - 2) * NP + C_LX + c]) : 0.f, x2 = (t0 >= 1) ? bf2f(p[(size_t)(m0 - 1) * NP + C_LX + c]) : 0.f;
#pragma unroll
      for (int t = 0; t < 16; ++t) { const float x3 = bf2f(p[(size_t)(m0 + t) * NP + C_LX + c]); const float s = bb + w0 * x0 + w1 * x1 + w2 * x2 + w3 * x3;
          xcf[t * 512 + c] = s; *(LAS bf16*)(xcb + t * LR_XCB_ST + c * 2) = f2bf(s); x0 = x1; x1 = x2; x2 = x3; } }
    __syncthreads();
    f32x4v acc[2][4];
#pragma unroll
    for (int a = 0; a < 2; ++a)
#pragma unroll
        for (int nb = 0; nb < 4; ++nb) acc[a][nb] = (f32x4v){0.f, 0.f, 0.f, 0.f};
#pragma unroll
    for (int ks = 0; ks < 4; ++ks) {
        const bf16x8 af = *(const LAS bf16x8*)(xcb + fr * LR_XCB_ST + (g * 128 + 32 * ks + 8 * kq) * 2);
#pragma unroll
        for (int a = 0; a < 2; ++a)
#pragma unroll
            for (int nb = 0; nb < 4; ++nb) acc[a][nb] = MFMA16(af, bw[a][nb][ks], acc[a][nb]);
    }
#pragma unroll
    for (int nb = 0; nb < 4; ++nb) { const int c = 64 * wave + 16 * nb + fr; const float bav = ba[c], bxv = bx[c], sp8 = 8.0f * log1pf(expf(-lam[c]));
#pragma unroll
        for (int rg = 0; rg < 4; ++rg) { const int t = 4 * kq + rg; const float r = sigm(acc[0][nb][rg] + bav), ig = sigm(acc[1][nb][rg] + bxv);
            const float la = -r * sp8, a = fexp(la), x2 = 2.0f * la, em = -x2 * (1.0f + x2 * (0.5f + x2 * (0.16666667f + x2 * (0.041666668f + x2 * 0.0083333338f)))), u = __builtin_amdgcn_sqrtf(em) * (ig * xcf[t * 512 + c]);
            As[t * 512 + c] = a; Us[t * 512 + c] = u; } }
    __syncthreads();
    { const int c = tid; float h = 0.f, P = 1.f;
#pragma unroll
      for (int t = 0; t < 16; ++t) { const float a = As[t * 512 + c], u = Us[t * 512 + c]; P *= a; h = a * h + u; hloc[(size_t)(m0 + t) * 512 + c] = h; cumA[(size_t)(m0 + t) * 512 + c] = P; }
      aggA[(size_t)unit * 512 + c] = P; aggH[(size_t)unit * 512 + c] = h; }
}
__device__ __forceinline__ void lru_apply_unit(const float* __restrict__ hloc, const float* __restrict__ cumA, const float* __restrict__ aggA, const float* __restrict__ aggH, const bf16* __restrict__ p, bf16* __restrict__ y, int unit) {
    int tid_ = threadIdx.x; asm volatile("" : "+v"(tid_)); const int c = tid_;
    const int b = unit >> 5, grp = unit & 31; float h = 0.f;
    const int nprev = 4 * grp;
#pragma unroll 1
    for (int k0 = 0; k0 < nprev; k0 += 16) { float a[16], hh[16];
#pragma unroll
        for (int k = 0; k < 16; ++k) { const int kk = k0 + k < nprev ? k0 + k : nprev - 1; const size_t o = (size_t)(b * 128 + kk) * 512 + c; a[k] = aggA[o]; hh[k] = aggH[o]; }
#pragma unroll
        for (int k = 0; k < 16; ++k) if (k0 + k < nprev) h = a[k] * h + hh[k]; }
#pragma unroll 1
    for (int k = 4 * grp; k < 4 * grp + 4; ++k) { const size_t m0 = (size_t)b * T + 16 * k;
        float hl[16], ca[16]; unsigned short zz[16];
#pragma unroll
        for (int t = 0; t < 16; ++t) { hl[t] = hloc[(m0 + t) * 512 + c]; ca[t] = cumA[(m0 + t) * 512 + c]; zz[t] = p[(m0 + t) * NP + C_LZ + c]; }
#pragma unroll
        for (int t = 0; t < 16; ++t) y[(m0 + t) * D + c] = f2bf((hl[t] + ca[t] * h) * silu(bf2f(zz[t])));
        const size_t o = (size_t)(b * 128 + k) * 512 + c; h = aggA[o] * h + aggH[o]; }
}
#ifndef R_T0
#define R_T0 1
#endif
#ifndef R_T1
#define R_T1 1
#endif
#ifndef R_T2
#define R_T2 1
#endif
#ifndef R_A1
#define R_A1 1
#endif
#ifndef R_A2
#define R_A2 1
#endif
#ifndef R_A3
#define R_A3 1
#endif
#ifndef R_A4
#define R_A4 1
#endif
#ifndef R_P0
#define R_P0 1
#endif
#ifndef R_KV
#define R_KV 1
#endif
#ifndef R_P1
#define R_P1 1
#endif
#ifndef R_P2A
#define R_P2A 1
#endif
#ifndef R_P2B
#define R_P2B 1
#endif
#ifndef R_P2C
#define R_P2C 1
#endif
#ifndef R_P3
#define R_P3 1
#endif
#ifndef R_X
#define R_X 1
#endif
#ifndef R_WO
#define R_WO 1
#endif
#ifndef R_FIN
#define R_FIN 1
#endif
#define REP(n) _Pragma("unroll 1") for (int rep_ = 0; rep_ < (n); ++rep_)

struct Args { const float* in[26]; float* out; unsigned char* ws; };

__device__ __forceinline__ void ph_wt(const float* W, int ldw, int K, int N, const float* g, bf16* Wt, int mode, float* scr, int gw, int NGW, int lane) {
    const int nblk = N / 32, nitems = (K / 64) * nblk;
    for (int it = gw; it < nitems; it += NGW) {
        const int kb = it / nblk, nb = it % nblk, n0 = nb * 32;
        const int src = (mode == 1 && n0 >= SRC_GATE) ? n0 + 8 : n0;
        wt_item(W, ldw, src, g, Wt, K, n0, scr, kb * 64, lane);
    }
}
__device__ __forceinline__ void ph_gatew(const float* W, const float* g, float* Wg, int gt, int NGT) {
    for (int idx = gt; idx < D * 8; idx += NGT) { const int k = idx >> 3, c = idx & 7; Wg[idx] = g[k] * W[(size_t)k * INC + SRC_GATE + c]; }
}
__device__ __forceinline__ void ph_prep(const float* x, bf16* xb, float* rinv, const float* Wg, float* gates, int nrows, int gw, int NGW, int lane) {
    for (int row = gw; row < nrows; row += NGW) {
        const float4* xr = (const float4*)(x + (size_t)row * D); float4 v[8]; float ss = 0.f;
#pragma unroll
        for (int j = 0; j < 8; ++j) { v[j] = xr[lane + 64 * j]; ss += v[j].x * v[j].x + v[j].y * v[j].y + v[j].z * v[j].z + v[j].w * v[j].w; }
        ss = wave_sum(ss); const float r = 1.0f / sqrtf(ss * (1.0f / D) + RMS_EPS);
        uint2* ob = (uint2*)(xb + (size_t)row * D);
#pragma unroll
        for (int j = 0; j < 8; ++j) { uint2 o; o.x = pk2(v[j].x, v[j].y); o.y = pk2(v[j].z, v[j].w); ob[lane + 64 * j] = o; }
        if (lane == 0) rinv[row] = r;
        if (Wg) {
            float a0 = 0, a1 = 0, a2 = 0, a3 = 0, a4 = 0, a5 = 0, a6 = 0, a7 = 0;
#pragma unroll
            for (int j = 0; j < 8; ++j) {
                const float xe[4] = {v[j].x, v[j].y, v[j].z, v[j].w};
#pragma unroll
                for (int e = 0; e < 4; ++e) { const int k = 4 * (lane + 64 * j) + e; const float4 w0 = *(const float4*)(Wg + (size_t)k * 8), w1 = *(const float4*)(Wg + (size_t)k * 8 + 4);
                    a0 += xe[e] * w0.x; a1 += xe[e] * w0.y; a2 += xe[e] * w0.z; a3 += xe[e] * w0.w; a4 += xe[e] * w1.x; a5 += xe[e] * w1.y; a6 += xe[e] * w1.z; a7 += xe[e] * w1.w; }
            }
            a0 = wave_sum(a0); a1 = wave_sum(a1); a2 = wave_sum(a2); a3 = wave_sum(a3); a4 = wave_sum(a4); a5 = wave_sum(a5); a6 = wave_sum(a6); a7 = wave_sum(a7);
            if (lane == 0) { float4* go = (float4*)(gates + (size_t)row * 8); go[0] = make_float4(a0 * r, a1 * r, a2 * r, a3 * r); go[1] = make_float4(a4 * r, a5 * r, a6 * r, a7 * r); }
        }
    }
}
__device__ __forceinline__ void ph_final(const float* x, const float* g, float* out, int gw, int NGW, int lane) {
    for (int row = gw; row < M; row += NGW) {
        const float4* xr = (const float4*)(x + (size_t)row * D); float4 v[8]; float ss = 0.f;
#pragma unroll
        for (int j = 0; j < 8; ++j) { v[j] = xr[lane + 64 * j]; ss += v[j].x * v[j].x + v[j].y * v[j].y + v[j].z * v[j].z + v[j].w * v[j].w; }
        ss = wave_sum(ss); const float r = 1.0f / sqrtf(ss * (1.0f / D) + RMS_EPS);
        float4* o = (float4*)(out + (size_t)row * D); const float4* gg = (const float4*)g;
#pragma unroll
        for (int j = 0; j < 8; ++j) { const float4 gv = gg[lane + 64 * j]; o[lane + 64 * j] = make_float4(v[j].x * r * gv.x, v[j].y * r * gv.y, v[j].z * r * gv.z, v[j].w * r * gv.w); }
    }
}
__device__ __forceinline__ void ph_final2(const bf16* x, const float* rinv, const float* g, float* out, int gt, int NGT) {
    for (int idx = gt; idx < M * (D / 4); idx += NGT) { const int row = idx >> 9, c4 = idx & 511; const float r = rinv[row];
        const uint2 xv = ((const uint2*)x)[idx]; const float4 gv = ((const float4*)g)[c4];
        ((float4*)out)[idx] = make_float4(__uint_as_float(xv.x << 16) * r * gv.x, __uint_as_float(xv.x & 0xffff0000u) * r * gv.y, __uint_as_float(xv.y << 16) * r * gv.z, __uint_as_float(xv.y & 0xffff0000u) * r * gv.w); }
}
__device__ __forceinline__ void ph_lru_gates(float* xc, const bf16* p, const float* cw, const float* cb, const float* wa, const float* ba, const float* wx, const float* bx, const float* lam, float* A, float* U, int vb, int G, int tid) {
    for (int m = vb; m < M; m += G) {
        const int t = m % T, c = tid;
        { float s = cb[c];
#pragma unroll
          for (int j = 0; j < 4; ++j) { const int tt = t - 3 + j; if (tt >= 0) s += cw[j * 512 + c] * bf2f(p[(size_t)(m - 3 + j) * NP + C_LX + c]); }
          xc[c] = s; }
        __syncthreads();
        { const int g = c >> 7, o = c & 127; float ra = ba[c], ri = bx[c];
          for (int i = 0; i < 128; ++i) { const float xv = xc[g * 128 + i]; ra += xv * wa[(size_t)(g * 128 + i) * 128 + o]; ri += xv * wx[(size_t)(g * 128 + i) * 128 + o]; }
          const float r = sigm(ra), ig = sigm(ri); const float la = -8.0f * r * log1pf(expf(-lam[c])); const float a = expf(la); const float u = sqrtf(-expm1f(2.0f * la)) * (ig * xc[c]);
          A[(size_t)m * 512 + c] = a; U[(size_t)m * 512 + c] = u; }
        __syncthreads();
    }
}
__device__ __forceinline__ void ph_lru_scan(const float* A, const float* U, const bf16* p, bf16* y, int gt) {
    if (gt < NB * 512) { const int b = gt / 512, c = gt % 512; float h = 0.f;
        for (int t = 0; t < T; ++t) { const size_t m = (size_t)b * T + t; h = A[m * 512 + c] * h + U[m * 512 + c]; const float z = bf2f(p[m * NP + C_LZ + c]); y[m * D + c] = f2bf(h * silu(z)); } }
}
__device__ __forceinline__ void ph_ml_prep(const bf16* p, const float* cw, const float* cb, const float* wq, const float* wk, const float* wv, bf16* Q, bf16* K, bf16* V, int gt, int NGT) {
    for (int idx = gt; idx < M * 192; idx += NGT) {
        const int m = idx / 192, j = idx % 192, t = m % T;
        float u4[4], uc[4];
#pragma unroll
        for (int i = 0; i < 4; ++i) { const int c = 4 * j + i; float s = cb[c];
#pragma unroll
            for (int jj = 0; jj < 4; ++jj) { const int tt = t - 3 + jj; if (tt >= 0) s += cw[jj * 768 + c] * bf2f(p[(size_t)(m - 3 + jj) * NP + C_MU + c]); }
            uc[i] = silu(s); u4[i] = bf2f(p[(size_t)m * NP + C_MU + c]); }
        const float ks = 0.07216878364870322f;
#pragma unroll
        for (int o = 0; o < 4; ++o) { float q = 0.f, k = 0.f, v = 0.f;
#pragma unroll
            for (int i = 0; i < 4; ++i) { q += uc[i] * wq[(j * 4 + i) * 4 + o]; k += uc[i] * wk[(j * 4 + i) * 4 + o]; v += u4[i] * wv[(j * 4 + i) * 4 + o]; }
            Q[(size_t)m * 768 + 4 * j + o] = f2bf(q); K[(size_t)m * 768 + 4 * j + o] = f2bf(k * ks); V[(size_t)m * 768 + 4 * j + o] = f2bf(v); }
    }
}
__device__ __forceinline__ void ph_ml_F(const float* gates, const float* bi, const float* bf, float* Fb, float* Ib, int vb, int tid) {
    if (vb < 16 && tid == 0) { const int bh = vb, b = bh >> 2, h = bh & 3; float F = 0.f;
        for (int t = 0; t < T; ++t) { const size_t m = (size_t)b * T + t; F += logsig(gates[m * 8 + 4 + h] + bf[h]); Fb[bh * T + t] = F; Ib[bh * T + t] = gates[m * 8 + h] + bi[h]; } }
}
__device__ __forceinline__ void ph_ml_attn(float* L, const bf16* Q, const bf16* K, const bf16* V, const float* Fb, const float* Ib, const bf16* p, const float* ng, bf16* y, int vb, int G, int tid) {
    float* Qs = L; float* Ks = Qs + 32 * 192; float* Vs = Ks + 32 * 193; float* Ss = Vs + 32 * 192; float* Ft = Ss + 32 * 32; float* Fs = Ft + 32; float* Is = Fs + 32;
    const int r = tid >> 4, cl = tid & 15;
    for (int unit = vb; unit < 16 * 64; unit += G) {
        const int bh = unit >> 6, b = bh >> 2, h = bh & 3, t0 = (unit & 63) * 32;
        __syncthreads();
        for (int e = tid; e < 32 * 192; e += NTHR) { const int rr = e / 192, d = e % 192; Qs[rr * 192 + d] = bf2f(Q[(size_t)(b * T + t0 + rr) * 768 + h * 192 + d]); }
        if (tid < 32) Ft[tid] = Fb[bh * T + t0 + tid];
        float acc[12]; float den = 0.f;
#pragma unroll
        for (int i = 0; i < 12; ++i) acc[i] = 0.f;
        for (int s0 = 0; s0 < t0 + 32; s0 += 32) {
            __syncthreads();
            for (int e = tid; e < 32 * 192; e += NTHR) { const int i = e / 192, d = e % 192; const size_t g = (size_t)(b * T + s0 + i) * 768 + h * 192 + d; Ks[i * 193 + d] = bf2f(K[g]); Vs[i * 192 + d] = bf2f(V[g]); }
            if (tid < 32) { Fs[tid] = Fb[bh * T + s0 + tid]; Is[tid] = Ib[bh * T + s0 + tid]; }
            __syncthreads();
#pragma unroll
            for (int w = 0; w < 2; ++w) { const int s = cl + 16 * w; float dot = 0.f;
                for (int d = 0; d < 192; ++d) dot += Qs[r * 192 + d] * Ks[s * 193 + d];
                const int tt = t0 + r, ss = s0 + s; const float wgt = (ss <= tt) ? expf(Ft[r] - Fs[s] + Is[s]) : 0.f; Ss[r * 32 + s] = dot * wgt; }
            __syncthreads();
            for (int s = 0; s < 32; ++s) { const float sv = Ss[r * 32 + s]; den += sv;
#pragma unroll
                for (int i = 0; i < 12; ++i) acc[i] += sv * Vs[s * 192 + cl + 16 * i]; }
        }
        const float dn = fmaxf(fabsf(den), 1.0f); const size_t m = (size_t)b * T + t0 + r; float hv[12]; float s1 = 0.f;
#pragma unroll
        for (int i = 0; i < 12; ++i) { const int d = cl + 16 * i; hv[i] = acc[i] / dn * sigm(bf2f(p[m * NP + C_MO + h * 192 + d])); s1 += hv[i]; }
        s1 += __shfl_xor(s1, 1); s1 += __shfl_xor(s1, 2); s1 += __shfl_xor(s1, 4); s1 += __shfl_xor(s1, 8);
        const float mu = s1 * (1.0f / 192.0f); float s2 = 0.f;
#pragma unroll
        for (int i = 0; i < 12; ++i) { const float dd = hv[i] - mu; s2 += dd * dd; }
        s2 += __shfl_xor(s2, 1); s2 += __shfl_xor(s2, 2); s2 += __shfl_xor(s2, 4); s2 += __shfl_xor(s2, 8);
        const float rs = 1.0f / sqrtf(s2 * (1.0f / 192.0f) + LN_EPS);
#pragma unroll
        for (int i = 0; i < 12; ++i) { const int d = cl + 16 * i; const float z = bf2f(p[m * NP + C_MZ + h * 192 + d]); y[m * D + 512 + h * 192 + d] = f2bf((hv[i] - mu) * rs * ng[h * 192 + d] * silu(z)); }
    }
}
__device__ __forceinline__ void ph_mo_kmean(const bf16* p, float* kmean, int gt, int NGT) {
    for (int idx = gt; idx < NB * 6 * 8 * 128; idx += NGT) {
        const int d = idx & 127, blk = (idx >> 7) & 7, bh = idx >> 10, b = bh / 6, h = bh % 6; float s = 0.f;
        for (int i = 0; i < 256; ++i) s += bf2f(p[(size_t)(b * T + blk * 256 + i) * NP + C_K + h * 128 + d]);
        kmean[idx] = s * (1.0f / 256.0f);
    }
}
__device__ __forceinline__ void ph_mo_sel(const bf16* p, const float* kmean, unsigned char* sel, int gt, int NGT) {
    for (int idx = gt; idx < NB * 6 * T; idx += NGT) {
        const int t = idx % T, bh = idx / T, b = bh / 6, h = bh % 6, bq = t >> 8;
        const bf16* q = p + (size_t)(b * T + t) * NP + C_Q + h * 128;
        float g0 = 0, g1 = 0, g2 = 0, g3 = 0, g4 = 0, g5 = 0, g6 = 0;
        const float* km = kmean + (size_t)bh * 8 * 128;
        for (int d = 0; d < 128; ++d) { const float qv = bf2f(q[d]); g0 += qv * km[d]; g1 += qv * km[128 + d]; g2 += qv * km[256 + d]; g3 += qv * km[384 + d]; g4 += qv * km[512 + d]; g5 += qv * km[640 + d]; g6 += qv * km[768 + d]; }
        const float gv[7] = {g0, g1, g2, g3, g4, g5, g6};
        unsigned mask = 0;
        if (bq <= 3) mask = (1u << bq) - 1u;
        else {
#pragma unroll
            for (int pass = 0; pass < 3; ++pass) { float best = -INFINITY; int bi = -1;
#pragma unroll
                for (int j = 0; j < 7; ++j) if (j < bq && !((mask >> j) & 1u) && gv[j] > best) { best = gv[j]; bi = j; }
                if (bi >= 0) mask |= 1u << bi; }
        }
        mask |= 1u << bq;
        sel[(size_t)(b * T + t) * 8 + h] = (unsigned char)mask;
    }
}
template <int MODE> __device__ __forceinline__ void ph_attn32(float* L, const bf16* Qp, int ldq, int qcol, const bf16* Kp, const bf16* Vp, int ldk, const unsigned char* sel, const bf16* zp, bf16* outp, int ldo, int ocol, int vb, int G, int tid) {
    float* Qs = L; float* Ks = Qs + 32 * 128; float* Vs = Ks + 32 * 129; float* Ss = Vs + 32 * 128; unsigned* anym = (unsigned*)(Ss + 32 * 32);
    constexpr int NH = MODE == 0 ? 6 : 4; const int r = tid >> 4, cl = tid & 15;
    for (int unit = vb; unit < NB * NH * 64; unit += G) {
        const int bh = unit >> 6, b = bh / NH, h = bh % NH, t0 = (unit & 63) * 32; const size_t m = (size_t)b * T + t0 + r;
        __syncthreads();
        for (int e = tid; e < 32 * 128; e += NTHR) { const int rr = e >> 7, d = e & 127; Qs[rr * 128 + d] = bf2f(Qp[(size_t)(b * T + t0 + rr) * ldq + qcol + h * 128 + d]); }
        unsigned mymask = 0xffffffffu;
        if (MODE == 0) { if (tid == 0) *anym = 0; __syncthreads(); mymask = sel[m * 8 + h]; if (cl == 0) atomicOr(anym, mymask); __syncthreads(); }
        const float scale = 0.08838834764831845f;
        float slope = 0.f;
        if (MODE == 0) { slope = (h == 0) ? 0.25f : (h == 1) ? 0.0625f : (h == 2) ? 0.015625f : (h == 3) ? 0.00390625f : (h == 4) ? 0.5f : 0.125f; }
        float acc[8]; float mrun = -1e30f, l = 0.f;
#pragma unroll
        for (int i = 0; i < 8; ++i) acc[i] = 0.f;
        const int nblk = MODE == 0 ? (t0 >> 8) + 1 : 1; const unsigned am = MODE == 0 ? *anym : 1u;
        const int kbase = MODE == 0 ? b * T : b * MEM;
        for (int j = 0; j < nblk; ++j) {
            if (!((am >> j) & 1u)) continue;
            for (int ch = 0; ch < 8; ++ch) {
                const int s0 = j * 256 + ch * 32; if (MODE == 0 && s0 > t0 + 31) break;
                __syncthreads();
                for (int e = tid; e < 32 * 128; e += NTHR) { const int i = e >> 7, d = e & 127; const size_t g = (size_t)(kbase + s0 + i) * ldk + h * 128 + d; Ks[i * 129 + d] = bf2f(Kp[g]); Vs[i * 128 + d] = bf2f(Vp[g]); }
                __syncthreads();
#pragma unroll
                for (int w = 0; w < 2; ++w) { const int s = cl + 16 * w; float dot = 0.f;
                    for (int d = 0; d < 128; ++d) dot += Qs[r * 128 + d] * Ks[s * 129 + d];
                    float lg = dot * scale;
                    if (MODE == 0) { const int tt = t0 + r, ss = s0 + s; const bool valid = ((mymask >> j) & 1u) && (ss <= tt); lg = valid ? lg - slope * (float)(tt - ss) : -INFINITY; }
                    Ss[r * 32 + s] = lg; }
                __syncthreads();
                float mx = -INFINITY;
                for (int s = 0; s < 32; ++s) mx = fmaxf(mx, Ss[r * 32 + s]);
                const float mnew = fmaxf(mrun, mx); const float corr = expf(mrun - mnew); l *= corr;
#pragma unroll
                for (int i = 0; i < 8; ++i) acc[i] *= corr;
                for (int s = 0; s < 32; ++s) { const float pv = expf(Ss[r * 32 + s] - mnew); l += pv;
#pragma unroll
                    for (int i = 0; i < 8; ++i) acc[i] += pv * Vs[s * 128 + cl + 16 * i]; }
                mrun = mnew;
            }
        }
        const float inv = 1.0f / l;
#pragma unroll
        for (int i = 0; i < 8; ++i) { const int d = cl + 16 * i; float o = acc[i] * inv;
            if (MODE == 0) { const float z = bf2f(zp[m * NP + C_Z + h * 128 + d]); o *= silu(z); }
            outp[m * ldo + ocol + h * 128 + d] = f2bf(o); }
    }
}

struct OneTile { int pm, pn;
    __device__ __forceinline__ bool next(int i, pg8::Unit& u) const { if (i) return false; u.pm = pm; u.pn = pn; return true; }
    __device__ __forceinline__ void a_ready(const pg8::Unit&) const {}
    __device__ __forceinline__ void done(const pg8::Unit&) const {} };
typedef const __attribute__((address_space(4))) Args* kargs_t;
#define PH_VARS \
    kargs_t ap = (kargs_t)__builtin_amdgcn_kernarg_segment_ptr(); asm volatile("" : "+s"(ap)); \
    unsigned char* const ws = ap->ws; (void)ws; \
    int tid = threadIdx.x; asm volatile("" : "+v"(tid)); const int lane = tid & 63, wave = __builtin_amdgcn_readfirstlane(tid >> 6); (void)lane; \
    const int G = gridDim.x, vb = blockIdx.x, gw = vb * NWAVES + wave, NGW = G * NWAVES, gt = vb * NTHR + tid, NGT = G * NTHR; (void)gw; (void)NGW; (void)gt; (void)NGT; \
    float* const Lf = (float*)lds; (void)Lf; LAS unsigned char* const ldsl = (LAS unsigned char*)lds; (void)ldsl;
#define WSP(T, off) ((T*)(ws + (off)))
__global__ void __launch_bounds__(NTHR, 2) mk_fwd(Args a_unused) {
    extern __shared__ __attribute__((aligned(16))) unsigned char lds[];
    { PH_VARS
      for (int u = tid; u < (LDS_BYTES - LDSCTL_OFF) / 4; u += NTHR) ((LAS unsigned*)(ldsl + LDSCTL_OFF))[u] = 0u;
      __syncthreads();
      (void)xcd_barrier_post((unsigned*)(ws + WS_CTL) + CW_BAR, (volatile LAS unsigned*)(ldsl + MISC_OFF) + 8); }
#define GRID_BAR() do { PH_VARS XcdBarrier bar_; bar_.bar = (unsigned*)(ws + WS_CTL) + CW_BAR; bar_.x = xb_xcc_id(); bar_.st = (volatile LAS unsigned*)(ldsl + MISC_OFF) + 8; xcd_barrier(bar_); } while (0)
    REP(R_P0) {
#pragma unroll 1
    for (int l = 0; l < DEPTH; ++l) {
      { PH_VARS float* scr = Lf + wave * (64 * 33); ph_wt(ap->in[3] + (size_t)l * D * INC, INC, D, NP, ap->in[2] + l * D, WSP(bf16, WS_WIN) + (size_t)l * NP * D, 1, scr, gw, NGW, lane); }
      if (l == 0) { PH_VARS ph_lru_wt(ap->in[6], ap->in[8], WSP(bf16, WS_LRUW), gt, NGT); }
      { PH_VARS ph_gatew(ap->in[3] + (size_t)l * D * INC, ap->in[2] + l * D, WSP(float, WS_WG) + (size_t)l * D * 8, gt, NGT); }
      { PH_VARS float* scr = Lf + wave * (64 * 33); ph_wt(ap->in[19] + (size_t)l * D * D, D, D, D, nullptr, WSP(bf16, WS_WOUT) + (size_t)l * D * D, 0, scr, gw, NGW, lane); }
      { PH_VARS float* scr = Lf + wave * (64 * 33); ph_wt(ap->in[22] + (size_t)l * D * 512, 512, D, 512, ap->in[20] + l * D, WSP(bf16, WS_WQ) + (size_t)l * 512 * D, 0, scr, gw, NGW, lane); }
      { PH_VARS float* scr = Lf + wave * (64 * 33); ph_wt(ap->in[23] + (size_t)l * D * 1024, 1024, D, 1024, ap->in[21] + l * D, WSP(bf16, WS_WKV) + (size_t)l * 1024 * D, 0, scr, gw, NGW, lane); }
      { PH_VARS float* scr = Lf + wave * (64 * 33); ph_wt(ap->in[24] + (size_t)l * 512 * D, D, 512, D, nullptr, WSP(bf16, WS_WO) + (size_t)l * D * 512, 0, scr, gw, NGW, lane); }
    }
    { PH_VARS ph_prep(ap->in[1], WSP(bf16, WS_MEMB), WSP(float, WS_RINVM), nullptr, nullptr, MM, gw, NGW, lane); }
    { PH_VARS ph_prep(ap->in[0], WSP(bf16, WS_XB), WSP(float, WS_RINV), nullptr, nullptr, M, gw, NGW, lane); }
    GRID_BAR();
    }
    REP(R_KV) {
#pragma unroll 1
    for (int l = 0; l < DEPTH; ++l) { PH_VARS
        pg8::Gemm g{WSP(bf16, WS_MEMB), WSP(bf16, WS_WKV) + (size_t)l * 1024 * D, MM, 1024, D, 0}; EpiScaleBf16 E{WSP(bf16, WS_KV) + (size_t)l * MM * 1024, WSP(float, WS_RINVM), 1024, 0};
        pg8::StaticOrder S; S.init(MM, 1024, G, (vb + 64 + 32 * l) % G);
        pg8::gemm_phase<EpiScaleBf16, pg8::StaticOrder, true, true>(ldsl, g, S, E);
    }
    }
#pragma unroll 1
    for (int l = 0; l < DEPTH; ++l) {
        REP(R_P1) {
        { PH_VARS pg8::Gemm g{WSP(bf16, WS_XB), WSP(bf16, WS_WIN) + (size_t)l * NP * D, M, NP - 256, D, 0}; EpiScaleBf16 E{WSP(bf16, WS_P), WSP(float, WS_RINV), NP, 0}; pg8::StaticOrder S; S.init(M, NP - 256, G, vb);
          pg8::gemm_phase<EpiScaleBf16, pg8::StaticOrder, true, true>(ldsl, g, S, E); }
        GRID_BAR();
        }
        REP(R_P2A) {
        { PH_VARS
#pragma unroll 1
          for (int i = 0; i < MIXA_K; ++i) { const int e = MIXA_TAB[vb & 255][i]; if (e < 0) continue; const int ty = e >> 12, unit = e & 4095;
            if (ty == 0) lru_unit(ldsl, WSP(bf16, WS_P), ap->in[4] + l * 4 * 512, ap->in[5] + l * 512, WSP(bf16, WS_LRUW) + (size_t)l * 2 * 4 * 128 * 128, ap->in[7] + l * 512, ap->in[9] + l * 512, ap->in[10] + l * 512, WSP(float, WS_A), WSP(float, WS_U), ap->out + OUT_AGGA, ap->out + OUT_AGGH, unit);
            else if (ty == 1) ml_chunk_unit(ldsl, WSP(bf16, WS_P), nullptr, ap->in[11] + l * 4 * 768, ap->in[12] + l * 768, ap->in[13] + l * 192 * 16, ap->in[14] + l * 192 * 16, ap->in[15] + l * 192 * 16, ap->in[16] + l * 4, ap->in[17] + l * 4, WSP(bf16, WS_XB), WSP(float, WS_RINV), WSP(float, WS_WG) + (size_t)l * D * 8, WSP(bf16, WS_MQ), WSP(bf16, WS_MK), WSP(bf16, WS_MV), WSP(float, WS_F), WSP(float, WS_I), (bf16*)ap->out, ap->out + OUT_NLOC, unit);
            else if (ty == 2) mo_kmean_unit(WSP(bf16, WS_P), WSP(float, WS_KMEAN), (LAS float*)ldsl, unit);
            else { __syncthreads(); pg8::Gemm g{WSP(bf16, WS_XB), WSP(bf16, WS_WIN) + (size_t)l * NP * D, M, NP, D, 0}; EpiScaleBf16 E{WSP(bf16, WS_P), WSP(float, WS_RINV), NP, 0}; OneTile S{unit, 24};
                   pg8::gemm_phase<EpiScaleBf16, OneTile, true, true>(ldsl, g, S, E); } } }
        REP(R_A4) { PH_VARS __syncthreads(); ph_mo_vt(WSP(bf16, WS_P), WSP(bf16, WS_MOVT), ldsl, gw, NGW, wave, lane); }
        if (l == 0) { PH_VARS ph_mem_vt(WSP(bf16, WS_KV), WSP(bf16, WS_VTM), ldsl, gw, NGW, wave, lane); }
        GRID_BAR();
        }
        REP(R_P2B) {
        { PH_VARS
#pragma unroll 1
          for (int i = 0; i < MIX_K; ++i) { const int e = MIX_TAB[vb & 255][i]; if (e < 0) continue; const int ty = e >> 12, unit = e & 4095;
            if (ty == 0) REP(R_T0) attn_unit<0>(ldsl, WSP(bf16, WS_P), WSP(bf16, WS_MOVT), WSP(float, WS_KMEAN), WSP(bf16, WS_Y), unit, nullptr, nullptr, 0, 2 * ((unit >> 5) + 1));
            else if (ty == 1) REP(R_T1) ml_out_unit(ldsl, WSP(bf16, WS_MQ), WSP(bf16, WS_MK), WSP(bf16, WS_MV), (const bf16*)ap->out, ap->out + OUT_NLOC, WSP(float, WS_F), WSP(float, WS_I), WSP(bf16, WS_P), ap->in[18] + l * 768, WSP(bf16, WS_Y), unit);
            else REP(R_T2) lru_apply_unit(WSP(float, WS_A), WSP(float, WS_U), ap->out + OUT_AGGA, ap->out + OUT_AGGH, WSP(bf16, WS_P), WSP(bf16, WS_Y), unit); } }
        GRID_BAR();
        }
        REP(R_P3 - 1) { PH_VARS pg8::Gemm g{WSP(bf16, WS_Y), WSP(bf16, WS_WOUT) + (size_t)l * D * D, M, D, D, 0};
          EpiResPart<true> E{ap->in[0], (bf16*)(ws + WS_XRES + 20000000), WSP(float, WS_A), (unsigned*)(ws + WS_CTL) + 16384 + (l * 2 + 0) * 2048 + 64 * 32 * rep_, WSP(float, WS_U), D, 0}; pg8::StaticOrder S; S.init(M, D, G, vb);
          pg8::gemm_phase<EpiResPart<true>, pg8::StaticOrder, true, true>(ldsl, g, S, E); GRID_BAR(); }
        if (l == 0) { PH_VARS pg8::Gemm g{WSP(bf16, WS_Y), WSP(bf16, WS_WOUT) + (size_t)l * D * D, M, D, D, 0};
          EpiResPart<true> E{ap->in[0], WSP(bf16, WS_XB), ap->out + OUT_PART, (unsigned*)(ws + WS_CTL) + CW_PANEL + (l * 2 + 0) * 2048, WSP(float, WS_RINV), D, 0}; pg8::StaticOrder S; S.init(M, D, G, vb);
          pg8::gemm_phase<EpiResPart<true>, pg8::StaticOrder, true, true>(ldsl, g, S, E); }
        else { PH_VARS pg8::Gemm g{WSP(bf16, WS_Y), WSP(bf16, WS_WOUT) + (size_t)l * D * D, M, D, D, 0};
          EpiResPart<false> E{WSP(bf16, WS_XB), WSP(bf16, WS_XB), ap->out + OUT_PART, (unsigned*)(ws + WS_CTL) + CW_PANEL + (l * 2 + 0) * 2048, WSP(float, WS_RINV), D, 0}; pg8::StaticOrder S; S.init(M, D, G, vb);
          pg8::gemm_phase<EpiResPart<false>, pg8::StaticOrder, true, true>(ldsl, g, S, E); }
        GRID_BAR();
        REP(R_X) {
        { PH_VARS const bf16* kvl = WSP(bf16, WS_KV) + (size_t)l * MM * 1024; for (int unit = vb; unit < 256; unit += G) attn_unit<1>(ldsl, WSP(bf16, WS_XB), WSP(bf16, WS_VTM) + (size_t)l * 16 * 128 * MEM, (const float*)kvl, WSP(bf16, WS_XO), unit, WSP(float, WS_RINV), WSP(bf16, WS_WQ) + (size_t)l * 512 * D); }
        GRID_BAR();
        }
        REP(R_WO - 1) { PH_VARS pg8::Gemm g{WSP(bf16, WS_XO), WSP(bf16, WS_WO) + (size_t)l * D * 512, M, D, 512, 0};
          EpiResPart<false> E{WSP(bf16, WS_XB), (bf16*)(ws + WS_XRES + 20000000), WSP(float, WS_A), (unsigned*)(ws + WS_CTL) + 16384 + (l * 2 + 1) * 2048 + 64 * 32 * rep_, WSP(float, WS_U), D, 0}; pg8::StaticOrder S; S.init(M, D, G, vb);
          pg8::gemm_phase<EpiResPart<false>, pg8::StaticOrder, true, true>(ldsl, g, S, E); GRID_BAR(); }
        { PH_VARS pg8::Gemm g{WSP(bf16, WS_XO), WSP(bf16, WS_WO) + (size_t)l * D * 512, M, D, 512, 0};
          EpiResPart<false> E{WSP(bf16, WS_XB), WSP(bf16, WS_XB), ap->out + OUT_PART, (unsigned*)(ws + WS_CTL) + CW_PANEL + (l * 2 + 1) * 2048, WSP(float, WS_RINV), D, 0}; pg8::StaticOrder S; S.init(M, D, G, vb);
          pg8::gemm_phase<EpiResPart<false>, pg8::StaticOrder, true, true>(ldsl, g, S, E); }
        GRID_BAR();
    }
    REP(R_FIN - 1) { PH_VARS ph_final2(WSP(bf16, WS_XB), WSP(float, WS_RINV), ap->in[25], (float*)(ws + WS_P), gt, NGT); GRID_BAR(); }
    { PH_VARS ph_final2(WSP(bf16, WS_XB), WSP(float, WS_RINV), ap->in[25], ap->out, gt, NGT); }
}

extern "C" void kernel_launch(void* const* d_in, const int* in_sizes, int n_in, void* d_out, int out_size, void* d_ws, size_t ws_size, hipStream_t stream) {
    static int grid = 0;
    if (grid == 0) {
        if (ws_size < WS_END || n_in != 26) { fprintf(stderr, "kernel_launch: ws_size %zu < %zu or n_in %d != 26\n", ws_size, (size_t)WS_END, n_in); grid = -1; return; }
        int dev = 0, cus = 0, per_cu = 0;
        if (hipGetDevice(&dev) != hipSuccess || hipDeviceGetAttribute(&cus, hipDeviceAttributeMultiprocessorCount, dev) != hipSuccess) { grid = -1; return; }
        if (hipFuncSetAttribute((const void*)mk_fwd, hipFuncAttributeMaxDynamicSharedMemorySize, LDS_BYTES) != hipSuccess) { fprintf(stderr, "kernel_launch: hipFuncSetAttribute failed\n"); grid = -1; return; }
        if (hipOccupancyMaxActiveBlocksPerMultiprocessor(&per_cu, (const void*)mk_fwd, NTHR, LDS_BYTES) != hipSuccess || per_cu < 1) fprintf(stderr, "kernel_launch: occupancy query reports %d\n", per_cu);
        (void)hipGetLastError();
        grid = cus;
    }
    if (grid < 0) return;
    if (hipMemsetAsync((char*)d_ws + WS_CTL, 0, CTL_ZERO_BYTES, stream) != hipSuccess) { fprintf(stderr, "kernel_launch: memset failed\n"); return; }
    Args a{};
    for (int i = 0; i < 26; ++i) a.in[i] = (const float*)d_in[i];
    a.out = (float*)d_out; a.ws = (unsigned char*)d_ws;
    hipLaunchKernelGGL(mk_fwd, dim3(grid), dim3(NTHR), LDS_BYTES, stream, a);
}
```

```cpp
#include <hip/hip_runtime.h>
#include <cstdio>
#include <cstdint>
namespace pg8 {
#define PG8_LAS __attribute__((address_space(3)))
typedef unsigned short bf16_t;
typedef short bf16x8 __attribute__((ext_vector_type(8)));
typedef float f32x4 __attribute__((ext_vector_type(4)));
typedef unsigned u32x4 __attribute__((ext_vector_type(4)));
constexpr int BM = 256, BK = 64, HALF = 128, HTB = HALF * BK * 2  , STAGE_BYTES = 8 * HTB, NXCD = 8, WGM = 8;

__host__ __device__ __forceinline__ int lds_byte(int r, int c) { const int st = (r >> 4) * 2 + (c >> 5), rr = r & 15, cc = c & 31, ob = rr * 64 + cc * 2; return st * 1024 + (ob ^ (((ob >> 9) & 1) << 5)); }
__host__ __device__ __forceinline__ void stage_rc(int b, int& R, int& C) { const int st = b / 1024, sb = b % 1024, swz = sb ^ (((sb >> 9) & 1) << 5); R = (st >> 1) * 16 + swz / 64; C = (st & 1) * 32 + (swz % 64) / 2; }
__host__ __device__ __forceinline__ int perm32(int rho) { const int n = rho >> 4, i = rho & 15; return 8 * (i >> 2) + 4 * n + (i & 3); }

struct Unit { int pm, pn; };
struct Gemm { const bf16_t* A; const bf16_t* Bt; int M, N, K, pad; };

struct StaticOrder {
    int nM, nN, nwg, G, c;
    __host__ __device__ void init(int M, int N, int G_, int c_) { nM = M / BM; nN = N / BM; nwg = nM * nN; G = G_; c = c_; }
    __host__ __device__ bool next(int i, Unit& u) const {
        const long L = (long)i * G + c; if (L >= nwg) return false;
        int wgid = (int)L; { const int q = nwg / NXCD, r = nwg % NXCD, xcd = wgid % NXCD, off = wgid / NXCD; wgid = (xcd < r ? xcd * (q + 1) : r * (q + 1) + (xcd - r) * q) + off; }
        const int nig = WGM * nN, gid = wgid / nig, fm = gid * WGM, gsz = (nM - fm) < WGM ? (nM - fm) : WGM;
        u.pm = fm + ((wgid % nig) % gsz); u.pn = (wgid % nig) / gsz; return true;
    }
    __device__ __forceinline__ void a_ready(const Unit&) const {}
    __device__ __forceinline__ void done(const Unit&) const {}
};

__device__ __forceinline__ unsigned cvt_pk_bf16(float lo, float hi) { unsigned r; asm volatile("v_cvt_pk_bf16_f32 %0, %1, %2" : "=v"(r) : "v"(lo), "v"(hi)); return r; }
template <class Epi, class Sched, bool ALIGN_EPI = false, bool SP2 = false>
__device__ __forceinline__ void gemm_phase(PG8_LAS unsigned char* lds, const Gemm g, const Sched& S, const Epi& E) {
    int tid_ = threadIdx.x; asm volatile("" : "+v"(tid_));
    const int tid = tid_, wid = __builtin_amdgcn_readfirstlane(tid >> 6), lane = tid & 63, wr = wid >> 2, wc = wid & 3, fr = lane & 15, fq = lane >> 4;
    const int K = g.K, nt = K / BK;
    unsigned voffA[2], voffB[2];
#pragma unroll
    for (int i = 0; i < 2; ++i) { int R, C; stage_rc(tid * 16 + i * 8192, R, C); const int Rb = Epi::PERM ? ((R & ~31) + perm32(R & 31)) : R;
        voffA[i] = (unsigned)(R * K + C) * 2u; voffB[i] = (unsigned)(Rb * K + C) * 2u; }
    const size_t kstep = (size_t)(BK * 2);
    const size_t hstep = (size_t)HALF * K * 2;
    const size_t tstep = 2 * hstep;
    const unsigned ldsw = (unsigned)wid * 1024u;
    const int aoff = lds_byte(wr * 64 + fr, fq * 8), boff = lds_byte(wc * 32 + fr, fq * 8);
#define PG8_SA(b, h) (((b) * 2 + (h)) * HTB)
#define PG8_SB(b, h) ((4 + (b) * 2 + (h)) * HTB)
#define PG8_STAGE(bufoff, gbase, voff) do { _Pragma("unroll") for (int _i = 0; _i < 2; ++_i) \
        __builtin_amdgcn_global_load_lds((const unsigned*)((const char*)(gbase) + (voff)[_i]), (PG8_LAS unsigned*)(lds + (bufoff) + ldsw + _i * 8192), 16, 0, 0); } while (0)
#define PG8_LDA(dst, b, h) do { _Pragma("unroll") for (int m = 0; m < 4; ++m) _Pragma("unroll") for (int k = 0; k < 2; ++k) dst[m][k] = *(const PG8_LAS bf16x8*)(lds + PG8_SA(b, h) + aoff + m * 2048 + k * 1024); } while (0)
#define PG8_LDB(dst, b, h) do { _Pragma("unroll") for (int n = 0; n < 2; ++n) _Pragma("unroll") for (int k = 0; k < 2; ++k) dst[n][k] = *(const PG8_LAS bf16x8*)(lds + PG8_SB(b, h) + boff + n * 2048 + k * 1024); } while (0)
#define PG8_MMA(ai, bj, At, Bt) do { __builtin_amdgcn_s_setprio(1); _Pragma("unroll") for (int m = 0; m < 4; ++m) _Pragma("unroll") for (int n = 0; n < 2; ++n) _Pragma("unroll") for (int k = 0; k < 2; ++k) \
        acc[ai][bj][m][n] = __builtin_amdgcn_mfma_f32_16x16x32_bf16(Bt[n][k], At[m][k], acc[ai][bj][m][n], 0, 0, 0); __builtin_amdgcn_s_setprio(0); } while (0)
#define PG8_WAIT_V(n) asm volatile("s_waitcnt vmcnt(" #n ")" ::: "memory")
#define PG8_WAIT_L(n) asm volatile("s_waitcnt lgkmcnt(" #n ")" ::: "memory")
#define PG8_BAR __builtin_amdgcn_s_barrier()
#define PG8_SCHED __builtin_amdgcn_sched_barrier(0)
    Unit cur, nxt; int ui = 0;
    if (!S.next(0, cur)) return;
    f32x4 acc[2][2][4][2];
#pragma unroll
    for (int a = 0; a < 2; ++a)
#pragma unroll
        for (int b = 0; b < 2; ++b)
#pragma unroll
            for (int m = 0; m < 4; ++m)
#pragma unroll
                for (int n = 0; n < 2; ++n) acc[a][b][m][n] = (f32x4){0.f, 0.f, 0.f, 0.f};
    bf16x8 At[4][2], B0[2][2], B1[2][2];
    const char* cA = (const char*)g.A + (size_t)cur.pm * tstep; const char* cB = (const char*)g.Bt + (size_t)cur.pn * tstep;
    S.a_ready(cur);
    if constexpr (SP2) {
        PG8_STAGE(PG8_SB(0, 0), cB, voffB); PG8_STAGE(PG8_SB(0, 1), cB + hstep, voffB); PG8_STAGE(PG8_SA(0, 0), cA, voffA); PG8_STAGE(PG8_SA(0, 1), cA + hstep, voffA);
        if (wr == 1) PG8_BAR;
        PG8_WAIT_V(2); PG8_BAR;
        PG8_STAGE(PG8_SB(1, 0), cB + kstep, voffB); PG8_STAGE(PG8_SA(1, 0), cA + kstep, voffA); PG8_STAGE(PG8_SB(1, 1), cB + hstep + kstep, voffB);
        PG8_WAIT_V(6); PG8_BAR;
    } else {
        PG8_STAGE(PG8_SB(0, 0), cB, voffB); PG8_STAGE(PG8_SA(0, 0), cA, voffA); PG8_STAGE(PG8_SB(0, 1), cB + hstep, voffB); PG8_STAGE(PG8_SA(0, 1), cA + hstep, voffA);
        if (wr == 1) PG8_BAR;
        PG8_WAIT_V(4); PG8_BAR;
        PG8_STAGE(PG8_SB(1, 0), cB + kstep, voffB); PG8_STAGE(PG8_SA(1, 0), cA + kstep, voffA); PG8_STAGE(PG8_SB(1, 1), cB + hstep + kstep, voffB);
        PG8_WAIT_V(6); PG8_BAR;
    }
    for (;;) {
        const bool has_next = S.next(ui + 1, nxt);
        const char* nA = has_next ? (const char*)g.A + (size_t)nxt.pm * tstep : cA; const char* nB = has_next ? (const char*)g.Bt + (size_t)nxt.pn * tstep : cB;
        for (int t = 0; t < nt; t += 2) {
            const bool last = (t == nt - 2);
            const char* a1 = cA + (size_t)(t + 1) * kstep;
            const char* a2 = last ? nA : cA + (size_t)(t + 2) * kstep; const char* b2 = last ? nB : cB + (size_t)(t + 2) * kstep;
            const char* a3 = a2 + kstep; const char* b3 = b2 + kstep;
            if (last && has_next) S.a_ready(nxt);
            if constexpr (SP2) {
            PG8_LDB(B0, 0, 0); PG8_LDB(B1, 0, 1); PG8_SCHED; PG8_LDA(At, 0, 0); PG8_STAGE(PG8_SA(1, 1), a1 + hstep, voffA);
            PG8_WAIT_V(8); PG8_WAIT_L(0); PG8_BAR; PG8_MMA(0, 0, At, B0); PG8_MMA(0, 1, At, B1); PG8_BAR; PG8_SCHED;
            PG8_LDA(At, 0, 1); PG8_STAGE(PG8_SB(0, 0), b2, voffB); PG8_STAGE(PG8_SB(0, 1), b2 + hstep, voffB); PG8_STAGE(PG8_SA(0, 0), a2, voffA);
            PG8_WAIT_V(8); PG8_WAIT_L(0); PG8_BAR; PG8_MMA(1, 0, At, B0); PG8_MMA(1, 1, At, B1); PG8_BAR; PG8_SCHED;
            PG8_LDB(B0, 1, 0); PG8_LDB(B1, 1, 1); PG8_SCHED; PG8_LDA(At, 1, 0); PG8_STAGE(PG8_SA(0, 1), a2 + hstep, voffA);
            PG8_WAIT_V(8); PG8_WAIT_L(0); PG8_BAR; PG8_MMA(0, 0, At, B0); PG8_MMA(0, 1, At, B1); PG8_BAR; PG8_SCHED;
            PG8_LDA(At, 1, 1); PG8_STAGE(PG8_SB(1, 0), b3, voffB); PG8_STAGE(PG8_SB(1, 1), b3 + hstep, voffB); PG8_STAGE(PG8_SA(1, 0), a3, voffA);
            PG8_WAIT_V(8); PG8_WAIT_L(0); PG8_BAR; PG8_MMA(1, 0, At, B0); PG8_MMA(1, 1, At, B1); PG8_BAR; PG8_SCHED;
            } else {
            PG8_LDB(B0, 0, 0); PG8_SCHED; PG8_LDA(At, 0, 0); PG8_STAGE(PG8_SA(1, 1), a1 + hstep, voffA);
            PG8_WAIT_L(8); PG8_BAR; PG8_WAIT_L(0); PG8_MMA(0, 0, At, B0); PG8_BAR; PG8_SCHED;
            PG8_LDB(B1, 0, 1); PG8_STAGE(PG8_SB(0, 0), b2, voffB);
            PG8_BAR; PG8_WAIT_L(0); PG8_MMA(0, 1, At, B1); PG8_BAR;
            PG8_LDA(At, 0, 1); PG8_STAGE(PG8_SA(0, 0), a2, voffA);
            PG8_BAR; PG8_WAIT_L(0); PG8_MMA(1, 0, At, B0); PG8_BAR; PG8_SCHED;
            PG8_STAGE(PG8_SB(0, 1), b2 + hstep, voffB);
            PG8_WAIT_V(6); PG8_BAR; PG8_MMA(1, 1, At, B1); PG8_BAR;
            PG8_LDB(B0, 1, 0); PG8_SCHED; PG8_LDA(At, 1, 0); PG8_STAGE(PG8_SA(0, 1), a2 + hstep, voffA);
            PG8_WAIT_L(8); PG8_BAR; PG8_WAIT_L(0); PG8_MMA(0, 0, At, B0); PG8_BAR; PG8_SCHED;
            PG8_LDB(B1, 1, 1); PG8_STAGE(PG8_SB(1, 0), b3, voffB);
            PG8_BAR; PG8_WAIT_L(0); PG8_MMA(0, 1, At, B1); PG8_BAR;
            PG8_LDA(At, 1, 1); PG8_STAGE(PG8_SA(1, 0), a3, voffA);
            PG8_BAR; PG8_WAIT_L(0); PG8_MMA(1, 0, At, B0); PG8_BAR; PG8_SCHED;
            PG8_STAGE(PG8_SB(1, 1), b3 + hstep, voffB);
            PG8_WAIT_V(6); PG8_BAR; PG8_MMA(1, 1, At, B1); PG8_BAR;
            }
        }
        if constexpr (ALIGN_EPI) { if (wr == 0) PG8_BAR; }
        if constexpr (!Epi::AFTER_DRAIN) { E(acc, cur, wr, wc, fr, fq); S.done(cur); }
        if (!has_next) break;
#pragma unroll
        for (int a = 0; a < 2; ++a)
#pragma unroll
            for (int b = 0; b < 2; ++b)
#pragma unroll
                for (int m = 0; m < 4; ++m)
#pragma unroll
                    for (int n = 0; n < 2; ++n) acc[a][b][m][n] = (f32x4){0.f, 0.f, 0.f, 0.f};
        cur = nxt; cA = nA; cB = nB; ++ui;
        if constexpr (ALIGN_EPI) { if (wr == 1) PG8_BAR; }
    }
    PG8_WAIT_V(0);
    if constexpr (!ALIGN_EPI) { if (wr == 0) PG8_BAR; }
    PG8_BAR;
    if constexpr (Epi::AFTER_DRAIN) { E.fused(acc, cur, wr, wc, fr, fq, lds, wid, lane); S.done(cur); }
#undef PG8_SA
#undef PG8_SB
#undef PG8_STAGE
#undef PG8_LDA
#undef PG8_LDB
#undef PG8_MMA
#undef PG8_WAIT_V
#undef PG8_WAIT_L
#undef PG8_BAR
#undef PG8_SCHED
}
}

constexpr int NB = 4, T = 2048, D = 2048, M = NB * T, DEPTH = 2, MEM = 256, MM = NB * MEM;
constexpr int INC = 6408, NP = 6400;
constexpr int ML_DH = 192, MO_DH = 128;
constexpr int C_LX = 0, C_LZ = 512, C_MU = 1024, C_MO = 1792, C_MZ = 2560, C_Q = 3328, C_K = 4096, C_V = 4864, C_Z = 5632;
constexpr int SRC_GATE = 3328;
constexpr float RMS_EPS = 1e-6f, LN_EPS = 1e-5f;

typedef unsigned short bf16;
#define LAS __attribute__((address_space(3)))
__device__ __forceinline__ float bf2f(bf16 v) { return __uint_as_float(((unsigned)v) << 16); }
__device__ __forceinline__ bf16 f2bf(float f) { unsigned u = __float_as_uint(f); return (bf16)((u + 0x7fffu + ((u >> 16) & 1u)) >> 16); }
__device__ __forceinline__ unsigned pk2(float lo, float hi) { return (unsigned)f2bf(lo) | ((unsigned)f2bf(hi) << 16); }
__device__ __forceinline__ float fexp(float x) { return __builtin_amdgcn_exp2f(x * 1.4426950408889634f); }
__device__ __forceinline__ float sigm(float x) { return __builtin_amdgcn_rcpf(1.f + fexp(-x)); }
__device__ __forceinline__ float silu(float x) { return x * __builtin_amdgcn_rcpf(1.f + fexp(-x)); }
__device__ __forceinline__ float logsig(float x) { return fminf(x, 0.f) - 0.6931471805599453f * __builtin_amdgcn_logf(1.0f + fexp(-fabsf(x))); }
__device__ __forceinline__ float wave_sum(float v) {
#pragma unroll
    for (int o = 1; o < 64; o <<= 1) v += __shfl_xor(v, o);
    return v;
}

constexpr size_t al256(size_t x) { return (x + 255) & ~(size_t)255; }
constexpr size_t WS_CTL = 0;
constexpr size_t WS_WIN = 1u << 20;
constexpr size_t WS_WOUT = WS_WIN + (size_t)DEPTH * NP * D * 2;
constexpr size_t WS_WQ = WS_WOUT + (size_t)DEPTH * D * D * 2;
constexpr size_t WS_WKV = WS_WQ + (size_t)DEPTH * 512 * D * 2;
constexpr size_t WS_WO = WS_WKV + (size_t)DEPTH * 1024 * D * 2;
constexpr size_t WS_WG = WS_WO + (size_t)DEPTH * D * 512 * 2;
constexpr size_t WS_MEMB = WS_WG + (size_t)DEPTH * D * 8 * 4;
constexpr size_t WS_RINVM = WS_MEMB + (size_t)MM * D * 2;
constexpr size_t WS_KV = WS_RINVM + (size_t)MM * 4;
constexpr size_t WS_XB = WS_KV + (size_t)DEPTH * MM * 1024 * 2;
constexpr size_t WS_RINV = WS_XB + (size_t)M * D * 2;
constexpr size_t WS_GATES = WS_RINV + (size_t)M * 4;
constexpr size_t WS_XRES = WS_GATES + (size_t)M * 8 * 4;
constexpr size_t WS_Y = WS_XRES + (size_t)M * D * 4;
constexpr size_t WS_P = WS_Y + (size_t)M * D * 2;
constexpr size_t WS_A = WS_P + (size_t)M * NP * 2;
constexpr size_t WS_U = WS_A + (size_t)M * 512 * 4;
constexpr size_t WS_MQ = WS_U + (size_t)M * 512 * 4;
constexpr size_t WS_MK = WS_MQ + (size_t)M * 768 * 2;
constexpr size_t WS_MV = WS_MK + (size_t)M * 768 * 2;
constexpr size_t WS_F = WS_MV + (size_t)M * 768 * 2;
constexpr size_t WS_I = WS_F + (size_t)16 * T * 4;
constexpr size_t WS_KMEAN = WS_I + (size_t)16 * T * 4;
constexpr size_t WS_SEL = WS_KMEAN + (size_t)NB * 6 * 8 * 128 * 4;
constexpr size_t WS_MOVT = WS_SEL + (size_t)M * 8;
constexpr size_t WS_END = WS_MOVT + (size_t)NB * 6 * 128 * T * 2;
constexpr size_t WS_XQ = WS_P;
constexpr size_t WS_XO = WS_P + (size_t)M * 512 * 2;
constexpr size_t WS_CPREV = WS_XRES;
constexpr size_t WS_MOPART = WS_XRES + 20000000;
static_assert(WS_CPREV + (size_t)256 * 36864 * 2 <= WS_MOPART && WS_MOPART + (size_t)384 * 4 * 66 * 64 * 4 <= WS_Y, "xres region overlays");
constexpr size_t WS_VTM = WS_MEMB;
constexpr size_t WS_LRUW = 512u << 10;
constexpr size_t OUT_CLOC = 0, OUT_NLOC = (size_t)256 * 36864, OUT_NPREV = OUT_NLOC + 256 * 192, OUT_AGGA = OUT_NPREV + 256 * 192, OUT_AGGH = OUT_AGGA + 512 * 512, OUT_CARRY = OUT_AGGH + 512 * 512, OUT_PART = OUT_CARRY + 512 * 512;
static_assert(OUT_PART + (size_t)M * 32 <= (size_t)M * D, "d_out scratch");
static_assert(WS_END <= 419954688ull, "workspace map exceeds the guaranteed ws_size");

__device__ __forceinline__ void wt_item(const float* W, int ldw, int src_col, const float* g, bf16* Wt, int K, int dst_row, float* scr, int k0, int lane) {
    typedef float f32x4w __attribute__((ext_vector_type(4)));
    f32x4w v[8];
#pragma unroll
    for (int i = 0; i < 8; ++i) v[i] = *(const f32x4w*)(W + (size_t)(k0 + 8 * i + (lane >> 3)) * ldw + src_col + (lane & 7) * 4);
#pragma unroll
    for (int i = 0; i < 8; ++i) { const int kk = 8 * i + (lane >> 3); const float gg = g ? g[k0 + kk] : 1.f; float* d = scr + kk * 33 + (lane & 7) * 4;
        d[0] = v[i][0] * gg; d[1] = v[i][1] * gg; d[2] = v[i][2] * gg; d[3] = v[i][3] * gg; }
    __builtin_amdgcn_s_waitcnt(0xc07f); asm volatile("" ::: "memory");
    const int c = lane & 7;
#pragma unroll
    for (int j = 0; j < 4; ++j) { const int n = (lane >> 3) + 8 * j; const float* s = scr + (8 * c) * 33 + n;
        uint4 o; o.x = pk2(s[0 * 33], s[1 * 33]); o.y = pk2(s[2 * 33], s[3 * 33]); o.z = pk2(s[4 * 33], s[5 * 33]); o.w = pk2(s[6 * 33], s[7 * 33]);
        *(uint4*)(Wt + (size_t)(dst_row + n) * K + k0 + 8 * c) = o; }
    __builtin_amdgcn_s_waitcnt(0xc07f); asm volatile("" ::: "memory");
}
struct EpiScaleBf16 {
    static constexpr bool PERM = true, AFTER_DRAIN = false;
    bf16* O; const float* rs; int ldc, pad;
    __device__ __forceinline__ void operator()(const pg8::f32x4 (&acc)[2][2][4][2], const pg8::Unit& u, int wr, int wc, int fr, int fq) const {
        const int row0 = u.pm * 256 + wr * 64 + fr, col0 = u.pn * 256 + wc * 32 + 8 * fq;
#pragma unroll
        for (int ai = 0; ai < 2; ++ai)
#pragma unroll
            for (int m = 0; m < 4; ++m) { const int row = row0 + ai * 128 + m * 16; const float s = rs ? rs[row] : 1.f; bf16* rowp = O + (size_t)row * ldc + col0;
#pragma unroll
                for (int bj = 0; bj < 2; ++bj) { const pg8::f32x4 v0 = acc[ai][bj][m][0] * s, v1 = acc[ai][bj][m][1] * s; pg8::u32x4 w;
                    w.x = pg8::cvt_pk_bf16(v0[0], v0[1]); w.y = pg8::cvt_pk_bf16(v0[2], v0[3]); w.z = pg8::cvt_pk_bf16(v1[0], v1[1]); w.w = pg8::cvt_pk_bf16(v1[2], v1[3]);
                    *(pg8::u32x4*)(rowp + bj * 128) = w; } }
    }
};
template <bool BASE_F32> struct EpiResPart {
    static constexpr bool PERM = true, AFTER_DRAIN = false;
    const void* base; bf16* xb; float* part; unsigned* cnt; float* rinv; int ldc, pad;
    __device__ __forceinline__ void operator()(const pg8::f32x4 (&acc)[2][2][4][2], const pg8::Unit& u, int wr, int wc, int fr, int fq) const {
        const int row0 = u.pm * 256 + wr * 64 + fr, col0 = u.pn * 256 + wc * 32 + 8 * fq;
#pragma unroll
        for (int ai = 0; ai < 2; ++ai)
#pragma unroll
            for (int m = 0; m < 4; ++m) { const int row = row0 + ai * 128 + m * 16; const size_t off = (size_t)row * ldc + col0; float ss = 0.f;
#pragma unroll
                for (int bj = 0; bj < 2; ++bj) { pg8::f32x4 b0, b1;
                    if (BASE_F32) { b0 = *(const pg8::f32x4*)((const float*)base + off + bj * 128); b1 = *(const pg8::f32x4*)((const float*)base + off + bj * 128 + 4); }
                    else { const pg8::u32x4 bb = *(const pg8::u32x4*)((const bf16*)base + off + bj * 128);
                        b0 = (pg8::f32x4){__uint_as_float(bb.x << 16), __uint_as_float(bb.x & 0xffff0000u), __uint_as_float(bb.y << 16), __uint_as_float(bb.y & 0xffff0000u)};
                        b1 = (pg8::f32x4){__uint_as_float(bb.z << 16), __uint_as_float(bb.z & 0xffff0000u), __uint_as_float(bb.w << 16), __uint_as_float(bb.w & 0xffff0000u)}; }
                    const pg8::f32x4 v0 = b0 + acc[ai][bj][m][0], v1 = b1 + acc[ai][bj][m][1];
                    ss += ((v0[0] * v0[0] + v0[1] * v0[1]) + (v0[2] * v0[2] + v0[3] * v0[3])) + ((v1[0] * v1[0] + v1[1] * v1[1]) + (v1[2] * v1[2] + v1[3] * v1[3]));
                    pg8::u32x4 w; w.x = pg8::cvt_pk_bf16(v0[0], v0[1]); w.y = pg8::cvt_pk_bf16(v0[2], v0[3]); w.z = pg8::cvt_pk_bf16(v1[0], v1[1]); w.w = pg8::cvt_pk_bf16(v1[2], v1[3]);
                    *(pg8::u32x4*)(xb + off + bj * 128) = w; }
                ss += __shfl_xor(ss, 16); ss += __shfl_xor(ss, 32);
                if (fq == 0) __hip_atomic_store((unsigned*)part + (size_t)row * 32 + u.pn * 4 + wc, __float_as_uint(ss), __ATOMIC_RELAXED, __HIP_MEMORY_SCOPE_AGENT); }
        asm volatile("s_waitcnt vmcnt(0)" ::: "memory");
        unsigned old = 0u; const int lane = fq * 16 + fr;
        if (lane == 0) old = __hip_atomic_fetch_add(cnt + 64 * u.pm, 1u, __ATOMIC_RELAXED, __HIP_MEMORY_SCOPE_AGENT);
        old = (unsigned)__builtin_amdgcn_readfirstlane((int)old);
        if (old == 63u) {
            __builtin_amdgcn_fence(__ATOMIC_ACQUIRE, "agent"); asm volatile("s_waitcnt vmcnt(0)" ::: "memory");
#pragma unroll 1
            for (int i = 0; i < 4; ++i) { const int row = u.pm * 256 + lane + 64 * i; const pg8::f32x4* pp = (const pg8::f32x4*)(part + (size_t)row * 32); float s = 0.f;
#pragma unroll
                for (int k = 0; k < 8; ++k) { const pg8::f32x4 v = pp[k]; s += (v[0] + v[1]) + (v[2] + v[3]); }
                rinv[row] = 1.0f / sqrtf(s * (1.0f / D) + RMS_EPS); }
        }
    }
};
struct EpiResF32 {
    static constexpr bool PERM = false, AFTER_DRAIN = false;
    const float* base; float* out; int ldc, pad;
    __device__ __forceinline__ void operator()(const pg8::f32x4 (&acc)[2][2][4][2], const pg8::Unit& u, int wr, int wc, int fr, int fq) const {
        const int row0 = u.pm * 256 + wr * 64 + fr, col0 = u.pn * 256 + wc * 32 + 4 * fq;
#pragma unroll
        for (int ai = 0; ai < 2; ++ai)
#pragma unroll
            for (int m = 0; m < 4; ++m) { const size_t off = (size_t)(row0 + ai * 128 + m * 16) * ldc + col0;
#pragma unroll
                for (int bj = 0; bj < 2; ++bj)
#pragma unroll
                    for (int n = 0; n < 2; ++n) { const pg8::f32x4 b = *(const pg8::f32x4*)(base + off + bj * 128 + n * 16); *(pg8::f32x4*)(out + off + bj * 128 + n * 16) = b + acc[ai][bj][m][n]; } }
    }
};
constexpr int NWAVES = 8, NTHR = 512;
constexpr int RING_BYTES = 131072, LDSCTL_OFF = 162816, MISC_OFF = LDSCTL_OFF + 320, LDS_BYTES = 163840;
constexpr size_t CTL_ZERO_BYTES = 1u << 20;
constexpr int CW_BAR = 4096, CW_PANEL = 8192;
typedef __attribute__((address_space(1))) unsigned gu32;
#define RLX_AGENT __ATOMIC_RELAXED, __HIP_MEMORY_SCOPE_AGENT
#define XB_TMO      128
#define XB_XCNT(j)  (256  + 64 * (j))
#define XB_XSUB(j)  (1280 + 64 * (j))
#define XB_XGEN(j)  (2304 + 64 * (j))
#define XB_TOP      3328
#define XB_TOPGEN   3392
#define XCD_BAR_WORDS 3456
#define XB_SPIN_CAP (1u << 18)

__device__ __forceinline__ unsigned xb_ld(unsigned* p)              { return __hip_atomic_load(p, __ATOMIC_RELAXED, __HIP_MEMORY_SCOPE_AGENT); }
__device__ __forceinline__ unsigned xb_add(unsigned* p, unsigned v) { return __hip_atomic_fetch_add(p, v, __ATOMIC_RELAXED, __HIP_MEMORY_SCOPE_AGENT); }
__device__ __forceinline__ unsigned xb_xcc_id() { return (unsigned)__builtin_amdgcn_s_getreg((3 << 11) | 20) & 0xFu; }
#define XB_SPIN(cond, bar) do { unsigned _sp = 0; while (cond) { __builtin_amdgcn_s_sleep(1); \
    if ((++_sp & 255u) == 0u) { if (xb_ld(&(bar)[XB_TMO])) break; if (_sp > XB_SPIN_CAP) { atomicAdd(&(bar)[XB_TMO], 1u); break; } } } } while (0)

struct XcdBarrier {
    unsigned* bar; unsigned x;
    volatile LAS unsigned* st;
};

__device__ __forceinline__ XcdBarrier xcd_barrier_post(unsigned* bar, volatile LAS unsigned* st) {
    XcdBarrier b; b.bar = bar; b.x = xb_xcc_id(); b.st = st;
    if (threadIdx.x == 0) (void)xb_add(&bar[XB_XCNT(b.x)], 1u);
    return b;
}
__device__ __forceinline__ void xcd_barrier_complete(unsigned* bar, unsigned x, unsigned& nloc, unsigned& nx) {
    const unsigned G = gridDim.x * gridDim.y * gridDim.z;
    unsigned sum, cnt, mine, sp = 0u;
    for (;;) {
        sum = 0u; cnt = 0u; mine = 0u;
#pragma unroll
        for (unsigned j = 0; j < 16; ++j) { const unsigned c = xb_ld(&bar[XB_XCNT(j)]); sum += c; cnt += (c > 0u) ? 1u : 0u; mine = (j == x) ? c : mine; }
        if (sum == G) break;
        __builtin_amdgcn_s_sleep(1);
        if ((++sp & 255u) == 0u) { if (xb_ld(&bar[XB_TMO])) break; if (sp > XB_SPIN_CAP) { atomicAdd(&bar[XB_TMO], 1u); break; } }
    }
    nloc = mine > 0u ? mine : 1u; nx = cnt > 0u ? cnt : 1u;
}

__device__ __forceinline__ void xcd_barrier(const XcdBarrier& b) {
    asm volatile("s_waitcnt vmcnt(0)" ::: "memory");
    __syncthreads();
    if (threadIdx.x == 0) {
        unsigned* bar = b.bar;
        __builtin_amdgcn_s_waitcnt(0);
        unsigned nloc = b.st[0], nx = b.st[1];
        if (nloc == 0u) { xcd_barrier_complete(bar, b.x, nloc, nx); b.st[0] = nloc; b.st[1] = nx; }
        const unsigned old = xb_add(&bar[XB_XSUB(b.x)], 1u);
        const unsigned gen = old / nloc;
        if (old + 1u == (gen + 1u) * nloc) {
            __builtin_amdgcn_fence(__ATOMIC_RELEASE, "agent");
            asm volatile("s_waitcnt vmcnt(0)" ::: "memory");
            const unsigned og = xb_add(&bar[XB_TOP], 1u);
            const unsigned tg = og / nx;
            if (og + 1u == (tg + 1u) * nx) xb_add(&bar[XB_TOPGEN], 1u);
            else XB_SPIN(xb_ld(&bar[XB_TOPGEN]) == tg, bar);
            __builtin_amdgcn_fence(__ATOMIC_ACQUIRE, "agent");
            xb_add(&bar[XB_XGEN(b.x)], 1u);
            asm volatile("s_waitcnt vmcnt(0)" ::: "memory");
        } else {
            XB_SPIN(xb_ld(&bar[XB_XGEN(b.x)]) == gen, bar);
            __builtin_amdgcn_fence(__ATOMIC_ACQUIRE, "agent");
            asm volatile("s_waitcnt vmcnt(0)" ::: "memory");
        }
    }
    __syncthreads();
}

constexpr int MIX_K = 3;
__device__ const int MIX_TAB[256][3] = {{480,194,8256},{483,197,4},{486,200,7},{489,203,10},{492,206,13},{495,209,16},{498,212,19},{501,215,22},{481,160,8264},{484,163,8265},{487,166,8266},{490,169,8267},{493,172,8268},{496,175,8269},{499,178,8270},{502,181,8271},{482,161,8296},{485,164,8297},{488,167,8298},{491,170,8299},{494,173,8300},{497,176,8301},{500,179,8302},{503,182,8303},{448,4112,8288},{451,4144,5},{454,4176,8},{457,4208,11},{460,4240,14},{463,4272,17},{466,4304,20},{469,4336,23},{449,192,0},{452,195,8193},{455,198,8194},{458,201,8195},{461,204,8196},{464,207,8197},{467,210,8198},{470,213,8199},{450,193,1},{453,196,8225},{456,199,8226},{459,202,8227},{462,205,8228},{465,208,8229},{468,211,8230},{471,214,8231},{416,225,2},{419,228,8257},{422,231,8258},{425,234,8259},{428,237,8260},{431,240,8261},{434,243,8262},{437,246,8263},{417,226,8192},{420,229,8289},{423,232,8290},{426,235,8291},{429,238,8292},{432,241,8293},{435,244,8294},{438,247,8295},{418,4096,8224},{421,4128,3},{424,4160,6},{427,4192,9},{430,4224,12},{433,4256,15},{436,4288,18},{439,4320,21},{384,4097,8200},{387,4129,8201},{390,4161,8202},{393,4193,8203},{396,4225,8204},{399,4257,8205},{402,4289,8206},{405,4321,8207},{385,4113,8232},{388,4145,8233},{391,4177,8234},{394,4209,8235},{397,4241,8236},{400,4273,8237},{403,4305,8238},{406,4337,8239},{386,224,8304},{389,227,8305},{392,230,8306},{395,233,8307},{398,236,8308},{401,239,49},{404,242,52},{407,245,55},{352,4115,34},{355,4147,37},{358,4179,40},{361,4211,43},{364,4243,46},{367,4275,8277},{370,4307,8278},{373,4339,8279},{353,4098,98},{356,4130,101},{359,4162,104},{362,4194,107},{365,4226,110},{368,4258,113},{371,4290,116},{374,4322,119},{354,4114,64},{357,4146,67},{360,4178,70},{363,4210,73},{366,4242,76},{369,4274,79},{372,4306,82},{375,4338,85},{4111,4116,8208},{4143,4148,8209},{4175,4180,8210},{4207,4212,8211},{4239,4244,8212},{4271,4276,8309},{4303,4308,8310},{4335,4340,8311},{4127,4099,65},{4159,4131,68},{4191,4163,71},{4223,4195,74},{4255,4227,77},{4287,4259,80},{4319,4291,83},{4351,4323,86},{4110,258,66},{4142,261,69},{4174,264,72},{4206,267,75},{4238,270,78},{4270,273,81},{4302,276,84},{4334,279,87},{4126,4100,8216},{4158,4132,8217},{4190,4164,8218},{4222,4196,8219},{4254,4228,8220},{4286,4260,8221},{4318,4292,8222},{4350,4324,8223},{4109,256,162},{4141,259,165},{4173,262,168},{4205,265,171},{4237,268,174},{4269,271,177},{4301,274,180},{4333,277,183},{4125,257,128},{4157,260,131},{4189,263,134},{4221,266,137},{4253,269,140},{4285,272,143},{4317,275,146},{4349,278,149},{320,4119,8240},{323,4151,8241},{326,4183,8242},{329,4215,8243},{332,4247,8244},{335,4279,47},{338,4311,50},{341,4343,53},{321,4102,8248},{324,4134,8249},{327,4166,8250},{330,4198,8251},{333,4230,8252},{336,4262,8253},{339,4294,8254},{342,4326,8255},{322,4118,8280},{325,4150,8281},{328,4182,8282},{331,4214,8283},{334,4246,8284},{337,4278,8285},{340,4310,8286},{343,4342,8287},{4108,4101,129},{4140,4133,132},{4172,4165,135},{4204,4197,138},{4236,4229,141},{4268,4261,144},{4300,4293,147},{4332,4325,150},{4124,4117,130},{4156,4149,133},{4188,4181,136},{4220,4213,139},{4252,4245,142},{4284,4277,145},{4316,4309,148},{4348,4341,151},{4107,4120,8272},{4139,4152,8273},{4171,4184,8274},{4203,4216,8275},{4235,4248,8276},{4267,4280,48},{4299,4312,51},{4331,4344,54},{4123,4103,8312},{4155,4135,8313},{4187,4167,8314},{4219,4199,8315},{4251,4231,8316},{4283,4263,8317},{4315,4295,8318},{4347,4327,8319},{4106,290,32},{4138,293,35},{4170,296,38},{4202,299,41},{4234,302,44},{4266,305,8213},{4298,308,8214},{4330,311,8215},{4122,4104,33},{4154,4136,36},{4186,4168,39},{4218,4200,42},{4250,4232,45},{4282,4264,8245},{4314,4296,8246},{4346,4328,8247},{4105,288,96},{4137,291,99},{4169,294,102},{4201,297,105},{4233,300,108},{4265,303,111},{4297,306,114},{4329,309,117},{4121,289,97},{4153,292,100},{4185,295,103},{4217,298,106},{4249,301,109},{4281,304,112},{4313,307,115},{4345,310,118}};
constexpr int MIXA_K = 5;
__device__ const int MIXA_TAB[256][5] = {{12288,192,416,-1,-1},{12289,193,417,-1,-1},{12290,194,418,-1,-1},{12291,195,419,-1,-1},{12292,196,420,-1,-1},{12293,197,421,-1,-1},{12294,198,422,-1,-1},{12295,199,423,-1,-1},{12296,200,424,-1,-1},{12297,201,425,-1,-1},{12298,202,426,-1,-1},{12299,203,427,-1,-1},{12300,204,428,-1,-1},{12301,205,429,-1,-1},{12302,206,430,-1,-1},{12303,207,431,-1,-1},{12304,208,432,-1,-1},{12305,209,433,-1,-1},{12306,210,434,-1,-1},{12307,211,435,-1,-1},{12308,212,436,-1,-1},{12309,213,437,-1,-1},{12310,214,438,-1,-1},{12311,215,439,-1,-1},{12312,216,440,-1,-1},{12313,217,441,-1,-1},{12314,218,442,-1,-1},{12315,219,443,-1,-1},{12316,220,444,-1,-1},{12317,221,445,-1,-1},{12318,222,446,-1,-1},{12319,223,447,-1,-1},{4096,4320,-1,-1,-1},{4097,4321,-1,-1,-1},{4098,4322,-1,-1,-1},{4099,4323,-1,-1,-1},{4100,4324,-1,-1,-1},{4101,4325,-1,-1,-1},{4102,4326,-1,-1,-1},{4103,4327,-1,-1,-1},{4104,4328,-1,-1,-1},{4105,4329,-1,-1,-1},{4106,4330,-1,-1,-1},{4107,4331,-1,-1,-1},{4108,4332,-1,-1,-1},{4109,4333,-1,-1,-1},{4110,4334,-1,-1,-1},{4111,4335,-1,-1,-1},{4112,4336,-1,-1,-1},{4113,4337,-1,-1,-1},{4114,4338,-1,-1,-1},{4115,4339,-1,-1,-1},{4116,4340,-1,-1,-1},{4117,4341,-1,-1,-1},{4118,4342,-1,-1,-1},{4119,4343,-1,-1,-1},{4120,4344,-1,-1,-1},{4121,4345,-1,-1,-1},{4122,4346,-1,-1,-1},{4123,4347,-1,-1,-1},{4124,4348,-1,-1,-1},{4125,4349,-1,-1,-1},{4126,4350,-1,-1,-1},{4127,4351,-1,-1,-1},{4128,0,224,448,-1},{4129,1,225,449,-1},{4130,2,226,450,-1},{4131,3,227,451,-1},{4132,4,228,452,-1},{4133,5,229,453,-1},{4134,6,230,454,-1},{4135,7,231,455,-1},{4136,8,232,456,-1},{4137,9,233,457,-1},{4138,10,234,458,-1},{4139,11,235,459,-1},{4140,12,236,460,-1},{4141,13,237,461,-1},{4142,14,238,462,-1},{4143,15,239,463,-1},{4144,16,240,464,-1},{4145,17,241,465,-1},{4146,18,242,466,-1},{4147,19,243,467,-1},{4148,20,244,468,-1},{4149,21,245,469,-1},{4150,22,246,470,-1},{4151,23,247,471,-1},{4152,24,248,472,-1},{4153,25,249,473,-1},{4154,26,250,474,-1},{4155,27,251,475,-1},{4156,28,252,476,-1},{4157,29,253,477,-1},{4158,30,254,478,-1},{4159,31,255,479,-1},{4160,32,256,480,-1},{4161,33,257,481,-1},{4162,34,258,482,-1},{4163,35,259,483,-1},{4164,36,260,484,-1},{4165,37,261,485,-1},{4166,38,262,486,-1},{4167,39,263,487,-1},{4168,40,264,488,-1},{4169,41,265,489,-1},{4170,42,266,490,-1},{4171,43,267,491,-1},{4172,44,268,492,-1},{4173,45,269,493,-1},{4174,46,270,494,-1},{4175,47,271,495,-1},{4176,48,272,496,-1},{4177,49,273,497,-1},{4178,50,274,498,-1},{4179,51,275,499,-1},{4180,52,276,500,-1},{4181,53,277,501,-1},{4182,54,278,502,-1},{4183,55,279,503,-1},{4184,56,280,504,-1},{4185,57,281,505,-1},{4186,58,282,506,-1},{4187,59,283,507,-1},{4188,60,284,508,-1},{4189,61,285,509,-1},{4190,62,286,510,-1},{4191,63,287,511,-1},{4192,64,288,8192,8320},{4193,65,289,8193,8321},{4194,66,290,8194,8322},{4195,67,291,8195,8323},{4196,68,292,8196,8324},{4197,69,293,8197,8325},{4198,70,294,8198,8326},{4199,71,295,8199,8327},{4200,72,296,8200,8328},{4201,73,297,8201,8329},{4202,74,298,8202,8330},{4203,75,299,8203,8331},{4204,76,300,8204,8332},{4205,77,301,8205,8333},{4206,78,302,8206,8334},{4207,79,303,8207,8335},{4208,80,304,8208,8336},{4209,81,305,8209,8337},{4210,82,306,8210,8338},{4211,83,307,8211,8339},{4212,84,308,8212,8340},{4213,85,309,8213,8341},{4214,86,310,8214,8342},{4215,87,311,8215,8343},{4216,88,312,8216,8344},{4217,89,313,8217,8345},{4218,90,314,8218,8346},{4219,91,315,8219,8347},{4220,92,316,8220,8348},{4221,93,317,8221,8349},{4222,94,318,8222,8350},{4223,95,319,8223,8351},{4224,96,320,8224,8352},{4225,97,321,8225,8353},{4226,98,322,8226,8354},{4227,99,323,8227,8355},{4228,100,324,8228,8356},{4229,101,325,8229,8357},{4230,102,326,8230,8358},{4231,103,327,8231,8359},{4232,104,328,8232,8360},{4233,105,329,8233,8361},{4234,106,330,8234,8362},{4235,107,331,8235,8363},{4236,108,332,8236,8364},{4237,109,333,8237,8365},{4238,110,334,8238,8366},{4239,111,335,8239,8367},{4240,112,336,8240,8368},{4241,113,337,8241,8369},{4242,114,338,8242,8370},{4243,115,339,8243,8371},{4244,116,340,8244,8372},{4245,117,341,8245,8373},{4246,118,342,8246,8374},{4247,119,343,8247,8375},{4248,120,344,8248,8376},{4249,121,345,8249,8377},{4250,122,346,8250,8378},{4251,123,347,8251,8379},{4252,124,348,8252,8380},{4253,125,349,8253,8381},{4254,126,350,8254,8382},{4255,127,351,8255,8383},{4256,128,352,8256,-1},{4257,129,353,8257,-1},{4258,130,354,8258,-1},{4259,131,355,8259,-1},{4260,132,356,8260,-1},{4261,133,357,8261,-1},{4262,134,358,8262,-1},{4263,135,359,8263,-1},{4264,136,360,8264,-1},{4265,137,361,8265,-1},{4266,138,362,8266,-1},{4267,139,363,8267,-1},{4268,140,364,8268,-1},{4269,141,365,8269,-1},{4270,142,366,8270,-1},{4271,143,367,8271,-1},{4272,144,368,8272,-1},{4273,145,369,8273,-1},{4274,146,370,8274,-1},{4275,147,371,8275,-1},{4276,148,372,8276,-1},{4277,149,373,8277,-1},{4278,150,374,8278,-1},{4279,151,375,8279,-1},{4280,152,376,8280,-1},{4281,153,377,8281,-1},{4282,154,378,8282,-1},{4283,155,379,8283,-1},{4284,156,380,8284,-1},{4285,157,381,8285,-1},{4286,158,382,8286,-1},{4287,159,383,8287,-1},{4288,160,384,8288,-1},{4289,161,385,8289,-1},{4290,162,386,8290,-1},{4291,163,387,8291,-1},{4292,164,388,8292,-1},{4293,165,389,8293,-1},{4294,166,390,8294,-1},{4295,167,391,8295,-1},{4296,168,392,8296,-1},{4297,169,393,8297,-1},{4298,170,394,8298,-1},{4299,171,395,8299,-1},{4300,172,396,8300,-1},{4301,173,397,8301,-1},{4302,174,398,8302,-1},{4303,175,399,8303,-1},{4304,176,400,8304,-1},{4305,177,401,8305,-1},{4306,178,402,8306,-1},{4307,179,403,8307,-1},{4308,180,404,8308,-1},{4309,181,405,8309,-1},{4310,182,406,8310,-1},{4311,183,407,8311,-1},{4312,184,408,8312,-1},{4313,185,409,8313,-1},{4314,186,410,8314,-1},{4315,187,411,8315,-1},{4316,188,412,8316,-1},{4317,189,413,8317,-1},{4318,190,414,8318,-1},{4319,191,415,8319,-1}};
typedef short bf16x8 __attribute__((ext_vector_type(8)));
typedef unsigned u32x4 __attribute__((ext_vector_type(4)));
typedef unsigned u32x2 __attribute__((ext_vector_type(2)));
typedef short s16x4 __attribute__((ext_vector_type(4)));
typedef float f32x16 __attribute__((ext_vector_type(16)));
typedef float f32x4v __attribute__((ext_vector_type(4)));
typedef float f32x2_t __attribute__((ext_vector_type(2)));
typedef __bf16 bf16x2_t __attribute__((ext_vector_type(2)));
__device__ __forceinline__ unsigned cvtpk(float lo, float hi) { f32x2_t v = {lo, hi}; bf16x2_t b = __builtin_convertvector(v, bf16x2_t); return __builtin_bit_cast(unsigned, b); }
__device__ __forceinline__ bf16x8 pack8(float a0, float a1, float a2, float a3, float a4, float a5, float a6, float a7) {
    u32x4 u; u.x = cvtpk(a0, a1); u.y = cvtpk(a2, a3); u.z = cvtpk(a4, a5); u.w = cvtpk(a6, a7); return __builtin_bit_cast(bf16x8, u);
}
#define MFMA32(a, b, c) __builtin_amdgcn_mfma_f32_32x32x16_bf16((a), (b), (c), 0, 0, 0)

__device__ __forceinline__ void tr64_item(const bf16* src, size_t ld, bf16* dst, size_t ldt, LAS bf16* scr, int lane) {
#pragma unroll
    for (int i = 0; i < 8; ++i) { const int row = 8 * i + (lane >> 3), ch = lane & 7; const u32x4 v = *(const u32x4*)(src + (size_t)row * ld + ch * 8);
        LAS unsigned* w = (LAS unsigned*)(scr + row * 66 + ch * 8); w[0] = v.x; w[1] = v.y; w[2] = v.z; w[3] = v.w; }
    __builtin_amdgcn_s_waitcnt(0xc07f); asm volatile("" ::: "memory");
#pragma unroll
    for (int i = 0; i < 8; ++i) { const int c = 8 * i + (lane >> 3), tch = lane & 7;
        unsigned short e[8];
#pragma unroll
        for (int k = 0; k < 8; ++k) e[k] = scr[(tch * 8 + k) * 66 + c];
        u32x4 o; o.x = e[0] | ((unsigned)e[1] << 16); o.y = e[2] | ((unsigned)e[3] << 16); o.z = e[4] | ((unsigned)e[5] << 16); o.w = e[6] | ((unsigned)e[7] << 16);
        *(u32x4*)(dst + (size_t)c * ldt + tch * 8) = o; }
    __builtin_amdgcn_s_waitcnt(0xc07f); asm volatile("" ::: "memory");
}
__device__ __forceinline__ void ph_mo_vt(const bf16* p, bf16* VT, LAS unsigned char* L, int gw, int NGW, int wave, int lane) {
    LAS bf16* scr = (LAS bf16*)(L + wave * 8448);
    for (int it = gw; it < NB * (T / 64) * 12; it += NGW) {
        const int cb = it % 12, tb = (it / 12) % (T / 64), b = it / (12 * (T / 64));
        const int h = cb >> 1, d0 = (cb & 1) * 64, t0 = tb * 64;
        tr64_item(p + (size_t)(b * T + t0) * NP + C_V + h * 128 + d0, NP, VT + ((size_t)(b * 6 + h) * 128 + d0) * T + t0, T, scr, lane);
    }
}
__device__ __forceinline__ void mo_kmean_unit(const bf16* p, float* kmean, LAS float* Lf, int unit) {
    int tid_ = threadIdx.x; asm volatile("" : "+v"(tid_)); const int tid = tid_;
    const int blk = unit & 7, bh = unit >> 3, b = bh / 6, h = bh % 6, d = tid & 127, part = tid >> 7; float s = 0.f, s1 = 0.f, s2 = 0.f, s3 = 0.f;
#pragma unroll 4
    for (int i = 0; i < 64; i += 4) { const size_t o = (size_t)(b * T + blk * 256 + part * 64 + i) * NP + C_K + h * 128 + d; s += bf2f(p[o]); s1 += bf2f(p[o + NP]); s2 += bf2f(p[o + 2 * (size_t)NP]); s3 += bf2f(p[o + 3 * (size_t)NP]); }
    s = (s + s1) + (s2 + s3);
    __syncthreads(); Lf[tid] = s; __syncthreads();
    if (tid < 128) kmean[(size_t)unit * 128 + tid] = (Lf[tid] + Lf[128 + tid] + Lf[256 + tid] + Lf[384 + tid]) * (1.0f / 256.0f);
}

constexpr int MO_KST = 272, MO_VST = 144;
constexpr int MO_KB = 64 * MO_KST, MO_VB = 128 * MO_VST, MO_GRP = MO_KB + MO_VB;
constexpr int MO_KM_OFF = 4 * MO_GRP;
constexpr int MO_Q_OFF = 73728;
template <int MODE> __device__ __forceinline__ void attn_unit(LAS unsigned char* L, const bf16* p, const bf16* VT, const float* kmean, bf16* y, int unit, const float* rinv = nullptr, const bf16* wqw = nullptr, int ta = 0, int tb = 0, int slot = -1, float* part = nullptr) {
    int tid_ = threadIdx.x; asm volatile("" : "+v"(tid_));
    const int tid = tid_, lane = tid & 63, wave = __builtin_amdgcn_readfirstlane(tid >> 6), grp = wave >> 2, wq = wave & 3, r = lane & 31, hh = lane >> 5, tg = tid & 255;
    constexpr int NH = MODE == 0 ? 6 : 4, LDQ = MODE == 0 ? NP : 512, LDK = MODE == 0 ? NP : 1024, LDV = MODE == 0 ? T : MEM, QC = MODE == 0 ? C_Q : 0, KC = MODE == 0 ? C_K : 0;
    const int qh = MODE == 0 ? unit >> 5 : unit / 16, bh = MODE == 0 ? unit & 31 : unit % 16,   b = bh / NH, h = bh % NH, qb = qh >> 1, half = qh & 1, t0 = qh * 128;
    const int tq = t0 + 32 * wq + r;
    const bf16* prow = p + (size_t)(b * T) * LDQ;
    const bf16* krow = MODE == 0 ? prow : (const bf16*)kmean + (size_t)(b * MEM) * LDK;
    const bf16* vt = VT + (size_t)(b * NH + h) * 128 * LDV;
    LAS float* km = (LAS float*)(L + MO_KM_OFF);
    __syncthreads();
    if (MODE == 0) for (int e = tid; e < 8 * 128; e += NTHR) km[e] = kmean[(size_t)bh * 8 * 128 + e];
    LAS unsigned char* Qt = L + MO_Q_OFF; bf16x8 qf[8];
    if (MODE == 0) {
#pragma unroll
        for (int ks = 0; ks < 8; ++ks) qf[ks] = *(const bf16x8*)(prow + (size_t)tq * LDQ + QC + h * 128 + 16 * ks + 8 * hh);
    } else {
        constexpr int GST = 144, GTB = 128 * GST, GSTG = 2 * GTB;
        const bf16* xg = p + (size_t)(b * T + t0) * D; const bf16* wg = wqw + (size_t)(h * 128) * D;
        const int wd = wave >> 2;
        f32x16 acc0, acc1;
#pragma unroll
        for (int q = 0; q < 16; ++q) { acc0[q] = 0.f; acc1[q] = 0.f; }
        u32x4 ra[2], rb[2];
#define QG_LOAD(kt) do { _Pragma("unroll") for (int i_ = 0; i_ < 2; ++i_) { const int c_ = tid + 512 * i_; \
            ra[i_] = *(const u32x4*)(wg + (size_t)(c_ >> 3) * D + (kt) * 64 + (c_ & 7) * 8); rb[i_] = *(const u32x4*)(xg + (size_t)(c_ >> 3) * D + (kt) * 64 + (c_ & 7) * 8); } } while (0)
#define QG_STORE(st) do { _Pragma("unroll") for (int i_ = 0; i_ < 2; ++i_) { const int c_ = tid + 512 * i_; \
            *(LAS u32x4*)(L + (st) * GSTG + (c_ >> 3) * GST + (c_ & 7) * 16) = ra[i_]; *(LAS u32x4*)(L + (st) * GSTG + GTB + (c_ >> 3) * GST + (c_ & 7) * 16) = rb[i_]; } } while (0)
        QG_LOAD(0); QG_STORE(0);
        __syncthreads();
#pragma unroll 1
        for (int kt = 0; kt < 32; ++kt) {
            if (kt + 1 < 32) QG_LOAD(kt + 1);
            const LAS unsigned char* sa = L + (kt & 1) * GSTG + (64 * wd + r) * GST + 16 * hh; const LAS unsigned char* sb = L + (kt & 1) * GSTG + GTB + (32 * wq + r) * GST + 16 * hh;
#pragma unroll
            for (int ks = 0; ks < 4; ++ks) { const bf16x8 bq = *(const LAS bf16x8*)(sb + 32 * ks);
                acc0 = MFMA32(*(const LAS bf16x8*)(sa + 32 * ks), bq, acc0); acc1 = MFMA32(*(const LAS bf16x8*)(sa + 32 * GST + 32 * ks), bq, acc1); }
            if (kt + 1 < 32) QG_STORE((kt + 1) & 1);
            __syncthreads();
        }
#undef QG_LOAD
#undef QG_STORE
        const float rv = rinv[(size_t)b * T + tq];
#pragma unroll
        for (int g4 = 0; g4 < 4; ++g4) { const int d0 = 64 * wd + 8 * g4 + 4 * hh;
            *(LAS u32x2*)(Qt + (32 * wq + r) * MO_KST + d0 * 2) = (u32x2){cvtpk(acc0[4 * g4] * rv, acc0[4 * g4 + 1] * rv), cvtpk(acc0[4 * g4 + 2] * rv, acc0[4 * g4 + 3] * rv)};
            *(LAS u32x2*)(Qt + (32 * wq + r) * MO_KST + (d0 + 32) * 2) = (u32x2){cvtpk(acc1[4 * g4] * rv, acc1[4 * g4 + 1] * rv), cvtpk(acc1[4 * g4 + 2] * rv, acc1[4 * g4 + 3] * rv)}; }
        __syncthreads();
#pragma unroll
        for (int ks = 0; ks < 8; ++ks) qf[ks] = *(const LAS bf16x8*)(Qt + (32 * wq + r) * MO_KST + 16 * hh + 32 * ks);
    }
    __syncthreads();
#define MO_QF(ks) (qf[ks])
    unsigned mask = 0xffffffffu;
    if (MODE == 0) {
        float g0 = 0, g1 = 0, g2 = 0, g3 = 0, g4 = 0, g5 = 0, g6 = 0;
#pragma unroll
        for (int ks = 0; ks < 8; ++ks)
            { const bf16x8 qv8 = MO_QF(ks);
#pragma unroll
            for (int j = 0; j < 8; ++j) { const float qv = bf2f((bf16)qv8[j]); const int d = 16 * ks + 8 * hh + j;
                g0 += qv * km[d]; g1 += qv * km[128 + d]; g2 += qv * km[256 + d]; g3 += qv * km[384 + d]; g4 += qv * km[512 + d]; g5 += qv * km[640 + d]; g6 += qv * km[768 + d]; } }
        g0 += __shfl_xor(g0, 32); g1 += __shfl_xor(g1, 32); g2 += __shfl_xor(g2, 32); g3 += __shfl_xor(g3, 32); g4 += __shfl_xor(g4, 32); g5 += __shfl_xor(g5, 32); g6 += __shfl_xor(g6, 32);
        const float gv[7] = {g0, g1, g2, g3, g4, g5, g6};
        mask = 0;
        if (qb <= 3) mask = (1u << qb) - 1u;
        else {
#pragma unroll
            for (int pass = 0; pass < 3; ++pass) { float best = -INFINITY; int bi = -1;
#pragma unroll
                for (int j = 0; j < 7; ++j) if (j < qb && !((mask >> j) & 1u) && gv[j] > best) { best = gv[j]; bi = j; }
                if (bi >= 0) mask |= 1u << bi; }
        }
        mask |= 1u << qb;
    }
    const float LOG2E = 1.4426950408889634f;
    const float c1 = 0.08838834764831845f * LOG2E;
    const float slope = (h == 0) ? 0.25f : (h == 1) ? 0.0625f : (h == 2) ? 0.015625f : (h == 3) ? 0.00390625f : (h == 4) ? 0.5f : 0.125f;
    const float slope2 = MODE == 0 ? slope * LOG2E : 0.f;
    const int nh = MODE == 0 ? (tb - ta) >> 1 : 2, tile0 = (MODE == 0 ? ta : 0) + grp * nh;
    LAS unsigned char* Kt0 = L + grp * 2 * MO_GRP;
    f32x16 O[4];
#pragma unroll
    for (int i = 0; i < 4; ++i)
#pragma unroll
        for (int j = 0; j < 16; ++j) O[i][j] = 0.f;
    float mrun = -1e30f, lsum = 0.f;
    u32x4 kreg[4], vreg[4];
    const bf16* kp_ = krow + (size_t)(tile0 * 64 + (tg >> 4)) * LDK + KC + h * 128 + (tg & 15) * 8; const bf16* vp_ = vt + (size_t)(tg >> 3) * LDV + tile0 * 64 + (tg & 7) * 8;
#define MO_LOAD(ti) do { _Pragma("unroll") for (int i_ = 0; i_ < 4; ++i_) { kreg[i_] = *(const u32x4*)(kp_ + (size_t)(16 * i_) * LDK); vreg[i_] = *(const u32x4*)(vp_ + (size_t)(32 * i_) * LDV); } \
        kp_ += (size_t)64 * LDK; vp_ += 64; } while (0)
#define MO_STORE(st) do { LAS unsigned char* kd_ = Kt0 + (st) * MO_GRP; _Pragma("unroll") for (int i_ = 0; i_ < 4; ++i_) { const int c_ = tg + 256 * i_; \
        *(LAS u32x4*)(kd_ + (c_ >> 4) * MO_KST + (c_ & 15) * 16) = kreg[i_]; \
        LAS unsigned char* vd_ = kd_ + MO_KB + (c_ >> 3) * MO_VST + ((c_ & 7) >> 1) * 32 + (c_ & 1) * 8; *(LAS u32x2*)vd_ = (u32x2){vreg[i_].x, vreg[i_].y}; *(LAS u32x2*)(vd_ + 16) = (u32x2){vreg[i_].z, vreg[i_].w}; } } while (0)
    MO_LOAD(tile0); MO_STORE(0);
    if (nh > 1) MO_LOAD(tile0 + 1);
    __syncthreads();
    for (int i = 0; i < nh; ++i) {
        const int ti = tile0 + i, s0 = ti * 64, j = ti >> 2;
        if (i + 1 < nh) MO_STORE((i + 1) & 1);
        if (i + 2 < nh) MO_LOAD(ti + 2);
        LAS unsigned char* Kt = Kt0 + (i & 1) * MO_GRP; LAS unsigned char* Vt = Kt + MO_KB;
        const bool sel = MODE == 0 ? ((mask >> j) & 1u) : true;
        const bool active = MODE == 0 ? ((__ballot(sel) != 0ull) && (s0 <= t0 + 32 * wq + 31)) : true;
        if (active) {
            f32x16 S0, S1;
#pragma unroll
            for (int q = 0; q < 16; ++q) { S0[q] = 0.f; S1[q] = 0.f; }
            { const LAS unsigned char* kb0 = Kt + r * MO_KST + 16 * hh;
#define MO_KF(blk, ks) (*(const LAS bf16x8*)(kb0 + (blk) * 32 * MO_KST + 32 * (ks)))
              bf16x8 ka0 = MO_KF(0, 0), ka1 = MO_KF(1, 0);
              __builtin_amdgcn_sched_group_barrier(0x100, 2, 0);
#pragma unroll
              for (int ks = 0; ks < 8; ++ks) { bf16x8 kn0 = ka0, kn1 = ka1;
                  if (ks < 7) { kn0 = MO_KF(0, ks + 1); kn1 = MO_KF(1, ks + 1); }
                  S0 = MFMA32(ka0, MO_QF(ks), S0); S1 = MFMA32(ka1, MO_QF(ks), S1);
                  __builtin_amdgcn_sched_group_barrier(0x100, 2, 0); __builtin_amdgcn_sched_group_barrier(0x008, 2, 0);
                  ka0 = kn0; ka1 = kn1; }
#undef MO_KF
            }
            const float base0 = MODE == 0 ? (sel ? slope2 * (float)(s0 + 4 * hh - tq) : -INFINITY) : 0.f, s32 = 32.0f * slope2;
            const bool need_mask = MODE == 0 && (s0 + 63 > t0 + 32 * wq);
            float mx = -INFINITY;
            if (need_mask) {
#pragma unroll
                for (int R = 0; R < 16; ++R) { const int ko = (R & 3) + 8 * (R >> 2); const int sa = s0 + 4 * hh + ko, sb = sa + 32;
                    const float bb = base0 + slope2 * (float)ko; float za = S0[R] * c1 + bb, zb = S1[R] * c1 + (bb + s32);
                    za = (sa <= tq) ? za : -INFINITY; zb = (sb <= tq) ? zb : -INFINITY;
                    S0[R] = za; S1[R] = zb; mx = fmaxf(mx, fmaxf(za, zb)); }
            } else {
#pragma unroll
                for (int R = 0; R < 16; ++R) { const int ko = (R & 3) + 8 * (R >> 2);
                    const float bb = base0 + slope2 * (float)ko; const float za = S0[R] * c1 + bb, zb = S1[R] * c1 + (bb + s32);
                    S0[R] = za; S1[R] = zb; mx = fmaxf(mx, fmaxf(za, zb)); }
            }
            { auto rr = __builtin_amdgcn_permlane32_swap(__float_as_uint(mx), __float_as_uint(mx), false, false); mx = fmaxf(__uint_as_float(rr[0]), __uint_as_float(rr[1])); }
            if (__any(mx > mrun + 8.0f)) {
                const float mnew = fmaxf(mrun, mx), alpha = __builtin_amdgcn_exp2f(mrun - mnew); mrun = mnew; lsum *= alpha;
#pragma unroll
                for (int i2 = 0; i2 < 4; ++i2)
#pragma unroll
                    for (int q = 0; q < 16; ++q) O[i2][q] *= alpha;
            }
            float ps = 0.f;
#pragma unroll
            for (int R = 0; R < 16; ++R) { S0[R] = __builtin_amdgcn_exp2f(S0[R] - mrun); S1[R] = __builtin_amdgcn_exp2f(S1[R] - mrun); ps += S0[R] + S1[R]; }
            lsum += ps;
            const bf16x8 p00 = pack8(S0[0], S0[1], S0[2], S0[3], S0[4], S0[5], S0[6], S0[7]), p01 = pack8(S0[8], S0[9], S0[10], S0[11], S0[12], S0[13], S0[14], S0[15]);
            const bf16x8 p10 = pack8(S1[0], S1[1], S1[2], S1[3], S1[4], S1[5], S1[6], S1[7]), p11 = pack8(S1[8], S1[9], S1[10], S1[11], S1[12], S1[13], S1[14], S1[15]);
            {
                const LAS unsigned char* vbase = Vt + r * MO_VST + 16 * hh;
#define MO_VF(db, f) (*(const LAS bf16x8*)(vbase + (db) * 32 * MO_VST + (f) * 32))
                bf16x8 va0 = MO_VF(0, 0), va1 = MO_VF(0, 1), va2 = MO_VF(0, 2), va3 = MO_VF(0, 3);
                __builtin_amdgcn_sched_group_barrier(0x100, 4, 0);
#pragma unroll
                for (int db = 0; db < 4; ++db) {
                    bf16x8 vb0 = va0, vb1 = va1, vb2 = va2, vb3 = va3;
                    if (db < 3) { vb0 = MO_VF(db + 1, 0); vb1 = MO_VF(db + 1, 1); vb2 = MO_VF(db + 1, 2); vb3 = MO_VF(db + 1, 3); }
                    O[db] = MFMA32(va0, p00, O[db]); O[db] = MFMA32(va1, p01, O[db]); O[db] = MFMA32(va2, p10, O[db]); O[db] = MFMA32(va3, p11, O[db]);
                    __builtin_amdgcn_sched_group_barrier(0x100, 4, 0); __builtin_amdgcn_sched_group_barrier(0x008, 4, 0);
                    va0 = vb0; va1 = vb1; va2 = vb2; va3 = vb3;
                }
            }
        }
        __syncthreads();
    }
    lsum += __shfl_xor(lsum, 32);
    LAS float* X = (LAS float*)L;
    if (grp == 1) {
#pragma unroll
        for (int db = 0; db < 4; ++db)
#pragma unroll
            for (int q = 0; q < 16; ++q) X[(wq * 66 + db * 16 + q) * 64 + lane] = O[db][q];
        X[(wq * 66 + 64) * 64 + lane] = mrun; X[(wq * 66 + 65) * 64 + lane] = lsum;
    }
    __syncthreads();
    if (grp == 0) {
        const float m1 = X[(wq * 66 + 64) * 64 + lane], l1 = X[(wq * 66 + 65) * 64 + lane];
        const float mm = fmaxf(mrun, m1), a0 = __builtin_amdgcn_exp2f(mrun - mm), a1 = __builtin_amdgcn_exp2f(m1 - mm);
        if (MODE == 0 && slot >= 0) {
            float* Xg = part + (size_t)slot * (4 * 66 * 64);
#pragma unroll
            for (int db = 0; db < 4; ++db)
#pragma unroll
                for (int q = 0; q < 16; ++q) Xg[(wq * 66 + db * 16 + q) * 64 + lane] = O[db][q] * a0 + X[(wq * 66 + db * 16 + q) * 64 + lane] * a1;
            Xg[(wq * 66 + 64) * 64 + lane] = mm; Xg[(wq * 66 + 65) * 64 + lane] = lsum * a0 + l1 * a1;
            return;
        }
        const float inv = 1.0f / (lsum * a0 + l1 * a1);
        const size_t m = (size_t)b * T + tq;
#pragma unroll
        for (int db = 0; db < 4; ++db)
#pragma unroll
            for (int g4 = 0; g4 < 4; ++g4) { const int d = 32 * db + 8 * g4 + 4 * hh;
                float o[4];
#pragma unroll
                for (int e = 0; e < 4; ++e) o[e] = (O[db][4 * g4 + e] * a0 + X[(wq * 66 + db * 16 + 4 * g4 + e) * 64 + lane] * a1) * inv;
                if (MODE == 0) { const u32x2 zz = *(const u32x2*)(p + m * NP + C_Z + h * 128 + d);
                    const float z0 = bf2f((bf16)(zz.x & 0xffff)), z1 = bf2f((bf16)(zz.x >> 16)), z2 = bf2f((bf16)(zz.y & 0xffff)), z3 = bf2f((bf16)(zz.y >> 16));
                    u32x2 w; w.x = cvtpk(o[0] * silu(z0), o[1] * silu(z1)); w.y = cvtpk(o[2] * silu(z2), o[3] * silu(z3));
                    *(u32x2*)(y + m * D + 1280 + h * 128 + d) = w; }
                else { u32x2 w; w.x = cvtpk(o[0], o[1]); w.y = cvtpk(o[2], o[3]); *(u32x2*)(y + m * 512 + h * 128 + d) = w; } }
    }
#undef MO_LOAD
#undef MO_STORE
#undef MO_QF
}
__device__ __forceinline__ void ph_mo_merge(const float* part, const bf16* p, bf16* y, int gw, int NGW, int lane) {
    const int r = lane & 31, hh = lane >> 5;
    for (int it = gw; it < 192 * 4; it += NGW) { const int pi = it >> 2, wq = it & 3, qh = 15 - pi / 24, bh = pi % 24, b = bh / 6, h = bh % 6;
        const float* X0 = part + (size_t)(2 * pi) * (4 * 66 * 64) + (size_t)wq * 66 * 64 + lane; const float* X1 = X0 + 4 * 66 * 64;
        const float m0 = X0[64 * 64], m1 = X1[64 * 64], l0 = X0[65 * 64], l1 = X1[65 * 64];
        const float mm = fmaxf(m0, m1), a0 = __builtin_amdgcn_exp2f(m0 - mm), a1 = __builtin_amdgcn_exp2f(m1 - mm), inv = 1.0f / (l0 * a0 + l1 * a1);
        const size_t m = (size_t)b * T + qh * 128 + 32 * wq + r;
#pragma unroll
        for (int db = 0; db < 4; ++db)
#pragma unroll
            for (int g4 = 0; g4 < 4; ++g4) { const int d = 32 * db + 8 * g4 + 4 * hh; float o[4];
#pragma unroll
                for (int e = 0; e < 4; ++e) { const int idx = db * 16 + 4 * g4 + e; o[e] = (X0[idx * 64] * a0 + X1[idx * 64] * a1) * inv; }
                const u32x2 zz = *(const u32x2*)(p + m * NP + C_Z + h * 128 + d);
                const float z0 = bf2f((bf16)(zz.x & 0xffff)), z1 = bf2f((bf16)(zz.x >> 16)), z2 = bf2f((bf16)(zz.y & 0xffff)), z3 = bf2f((bf16)(zz.y >> 16));
                u32x2 w; w.x = cvtpk(o[0] * silu(z0), o[1] * silu(z1)); w.y = cvtpk(o[2] * silu(z2), o[3] * silu(z3));
                *(u32x2*)(y + m * D + 1280 + h * 128 + d) = w; }
    }
}
__device__ __forceinline__ void ph_mem_vt(const bf16* KV, bf16* VTm, LAS unsigned char* L, int gw, int NGW, int wave, int lane) {
    LAS bf16* scr = (LAS bf16*)(L + wave * 8448);
    for (int it = gw; it < DEPTH * NB * 4 * 8; it += NGW) {
        const int cb = it & 7, sb = (it >> 3) & 3, b = (it >> 5) & 3, l = it >> 7; const int h = cb >> 1, d0 = (cb & 1) * 64, s0 = sb * 64;
        tr64_item(KV + ((size_t)l * MM + b * MEM + s0) * 1024 + 512 + h * 128 + d0, 1024, VTm + (((size_t)l * 16 + b * 4 + h) * 128 + d0) * MEM + s0, MEM, scr, lane);
    }
}
constexpr int MLC_ST = 272;
constexpr int MLC_B_OFF = 192 * MLC_ST, MLC_VS_OFF = 2 * 192 * MLC_ST, MLC_KS_OFF = MLC_VS_OFF + 64 * 194 * 2, MLC_TB_OFF = MLC_KS_OFF + 64 * 194 * 2;
__device__ __forceinline__ void ml_chunk_unit(LAS unsigned char* L, const bf16* p, const float* gates, const float* cw, const float* cb, const float* wq, const float* wk, const float* wv, const float* bi, const float* bf,
                                              const bf16* xb, const float* rinv, const float* Wg, bf16* Q, bf16* K, bf16* VT, float* Fl, float* Ib, bf16* Cloc, float* nloc, int unit) {
    int tid_ = threadIdx.x; asm volatile("" : "+v"(tid_)); const int tid = tid_, lane = tid & 63, wave = __builtin_amdgcn_readfirstlane(tid >> 6), r = lane & 31, hh = lane >> 5;
    const int c = unit & 15, bh = unit >> 4, b = bh >> 2, h = bh & 3, t0 = c * 128;
    LAS unsigned char* At = L; LAS unsigned char* Bt = L + MLC_B_OFF; LAS bf16* Vs = (LAS bf16*)(L + MLC_VS_OFF); LAS bf16* Ks = (LAS bf16*)(L + MLC_KS_OFF);
    LAS float* Fls = (LAS float*)(L + MLC_TB_OFF); LAS float* wvs = Fls + 128; LAS float* tot = wvs + 128;
    __syncthreads();
    { LAS float* wgi = (LAS float*)L; LAS float* wgf = wgi + 2048; LAS float* part = wgf + 2048;
      for (int k = tid; k < 2048; k += 512) { wgi[k] = Wg[(size_t)k * 8 + h]; wgf[k] = Wg[(size_t)k * 8 + 4 + h]; }
      __syncthreads();
      const int tk = tid >> 2, qd = tid & 3; const bf16* xr = xb + ((size_t)b * T + t0 + tk) * D + qd * 512; float ai = 0.f, af = 0.f;
#pragma unroll 1
      for (int i0 = 0; i0 < 64; i0 += 16) { u32x4 xq[16];
#pragma unroll
      for (int i = 0; i < 16; ++i) xq[i] = *(const u32x4*)(xr + 8 * (i0 + i));
#pragma unroll
      for (int ii = 0; ii < 16; ++ii) { const int i = i0 + ii; const u32x4 xv = xq[ii];
          const f32x4v wi0 = *(const LAS f32x4v*)(wgi + qd * 512 + 8 * i), wi1 = *(const LAS f32x4v*)(wgi + qd * 512 + 8 * i + 4), wf0 = *(const LAS f32x4v*)(wgf + qd * 512 + 8 * i), wf1 = *(const LAS f32x4v*)(wgf + qd * 512 + 8 * i + 4);
          const float x0 = __uint_as_float(xv.x << 16), x1 = __uint_as_float(xv.x & 0xffff0000u), x2 = __uint_as_float(xv.y << 16), x3 = __uint_as_float(xv.y & 0xffff0000u), x4 = __uint_as_float(xv.z << 16), x5 = __uint_as_float(xv.z & 0xffff0000u), x6 = __uint_as_float(xv.w << 16), x7 = __uint_as_float(xv.w & 0xffff0000u);
          ai += (x0 * wi0[0] + x1 * wi0[1]) + (x2 * wi0[2] + x3 * wi0[3]) + (x4 * wi1[0] + x5 * wi1[1]) + (x6 * wi1[2] + x7 * wi1[3]);
          af += (x0 * wf0[0] + x1 * wf0[1]) + (x2 * wf0[2] + x3 * wf0[3]) + (x4 * wf1[0] + x5 * wf1[1]) + (x6 * wf1[2] + x7 * wf1[3]); } }
      ai += __shfl_xor(ai, 1); ai += __shfl_xor(ai, 2); af += __shfl_xor(af, 1); af += __shfl_xor(af, 2);
      if (qd == 0) { const float rv = rinv[(size_t)b * T + t0 + tk]; part[tk] = ai * rv; part[128 + tk] = af * rv; }
      __syncthreads(); }
    float igv = 0.f, inc = 0.f;
    if (tid < 128) { LAS float* part = (LAS float*)L + 4096; const float lf = logsig(part[128 + tid] + bf[h]); igv = part[tid] + bi[h]; inc = lf;
#pragma unroll
        for (int o = 1; o < 64; o <<= 1) { const float v = __shfl_up(inc, o); if (lane >= o) inc += v; }
        if (tid == 63) tot[0] = inc; }
    __syncthreads();
    if (tid < 128) { if (tid >= 64) inc += tot[0]; Fls[tid] = inc; Fl[bh * T + t0 + tid] = inc; Ib[bh * T + t0 + tid] = igv; }
    __syncthreads();
    if (tid < 128) wvs[tid] = fexp(Fls[127] - inc + igv);
    const int j4 = tid % 48, tsub = tid / 48, cc = h * 192 + 4 * j4, jg = h * 48 + j4; const bool worker = tid < 384;
    float cwr[4][4], cbr[4], wqr[16], wkr[16], wvr[16];
#pragma unroll
    for (int e = 0; e < 4; ++e) { cbr[e] = cb[cc + e];
#pragma unroll
        for (int jj = 0; jj < 4; ++jj) cwr[jj][e] = cw[jj * 768 + cc + e]; }
    { const f32x4v* a = (const f32x4v*)(wq + jg * 16); const f32x4v* bq = (const f32x4v*)(wk + jg * 16); const f32x4v* cq = (const f32x4v*)(wv + jg * 16);
#pragma unroll
      for (int e = 0; e < 4; ++e) { const f32x4v x = a[e], y = bq[e], z = cq[e];
#pragma unroll
          for (int o = 0; o < 4; ++o) { wqr[e * 4 + o] = x[o]; wkr[e * 4 + o] = y[o] * 0.07216878364870322f; wvr[e * 4 + o] = z[o]; } } }
#pragma unroll 1
    for (int half = 0; half < 2; ++half) {
        const int ts = t0 + 64 * half;
        if (worker) {
            const int tl0 = 8 * tsub, tfirst = ts + tl0; const size_t m0 = (size_t)b * T + tfirst;
            float xw[3][4];
#pragma unroll
            for (int jj = 0; jj < 3; ++jj) { u32x2 uu = {0u, 0u}; if (tfirst - 3 + jj >= 0) uu = *(const u32x2*)(p + (m0 - 3 + jj) * NP + C_MU + cc);
                xw[jj][0] = __uint_as_float(uu.x << 16); xw[jj][1] = __uint_as_float(uu.x & 0xffff0000u); xw[jj][2] = __uint_as_float(uu.y << 16); xw[jj][3] = __uint_as_float(uu.y & 0xffff0000u); }
            u32x2 un[8];
#pragma unroll
            for (int i = 0; i < 8; ++i) un[i] = *(const u32x2*)(p + (m0 + i) * NP + C_MU + cc);
#pragma unroll
            for (int i = 0; i < 8; ++i) {
                float u4[4] = {__uint_as_float(un[i].x << 16), __uint_as_float(un[i].x & 0xffff0000u), __uint_as_float(un[i].y << 16), __uint_as_float(un[i].y & 0xffff0000u)};
                float uc[4];
#pragma unroll
                for (int e = 0; e < 4; ++e) uc[e] = silu(cbr[e] + cwr[0][e] * xw[0][e] + cwr[1][e] * xw[1][e] + cwr[2][e] * xw[2][e] + cwr[3][e] * u4[e]);
                float q[4], k[4], v[4];
#pragma unroll
                for (int o = 0; o < 4; ++o) { q[o] = uc[0] * wqr[o] + uc[1] * wqr[4 + o] + uc[2] * wqr[8 + o] + uc[3] * wqr[12 + o];
                    k[o] = uc[0] * wkr[o] + uc[1] * wkr[4 + o] + uc[2] * wkr[8 + o] + uc[3] * wkr[12 + o];
                    v[o] = u4[0] * wvr[o] + u4[1] * wvr[4 + o] + u4[2] * wvr[8 + o] + u4[3] * wvr[12 + o]; }
                u32x2 qw, kw; qw.x = cvtpk(q[0], q[1]); qw.y = cvtpk(q[2], q[3]); kw.x = cvtpk(k[0], k[1]); kw.y = cvtpk(k[2], k[3]);
                *(u32x2*)(Q + (m0 + i) * 768 + cc) = qw; *(u32x2*)(K + (m0 + i) * 768 + cc) = kw;
                LAS unsigned* vd = (LAS unsigned*)(Vs + (tl0 + i) * 194 + 4 * j4); vd[0] = cvtpk(v[0], v[1]); vd[1] = cvtpk(v[2], v[3]);
                LAS unsigned* kd = (LAS unsigned*)(Ks + (tl0 + i) * 194 + 4 * j4); kd[0] = kw.x; kd[1] = kw.y;
#pragma unroll
                for (int e = 0; e < 4; ++e) { xw[0][e] = xw[1][e]; xw[1][e] = xw[2][e]; xw[2][e] = u4[e]; }
            }
        }
        __syncthreads();
#pragma unroll 1
        for (int i = 0; i < 3; ++i) {
            const int idx = tid + 512 * i, d = idx >> 3, ch = idx & 7;
            unsigned short ev[8]; float fk[8];
#pragma unroll
            for (int k = 0; k < 8; ++k) { ev[k] = Vs[(ch * 8 + k) * 194 + d]; fk[k] = bf2f(Ks[(ch * 8 + k) * 194 + d]) * wvs[64 * half + ch * 8 + k]; }
            u32x4 ov, ok; ov.x = ev[0] | ((unsigned)ev[1] << 16); ov.y = ev[2] | ((unsigned)ev[3] << 16); ov.z = ev[4] | ((unsigned)ev[5] << 16); ov.w = ev[6] | ((unsigned)ev[7] << 16);
            ok.x = cvtpk(fk[0], fk[1]); ok.y = cvtpk(fk[2], fk[3]); ok.z = cvtpk(fk[4], fk[5]); ok.w = cvtpk(fk[6], fk[7]);
            *(u32x4*)(VT + ((size_t)bh * 192 + d) * T + ts + ch * 8) = ov;
            *(LAS u32x4*)(At + d * MLC_ST + (64 * half + ch * 8) * 2) = ov; *(LAS u32x4*)(Bt + d * MLC_ST + (64 * half + ch * 8) * 2) = ok;
        }
        __syncthreads();
    }
    if (tid < 192) { float s = 0.f; const LAS u32x4* row = (const LAS u32x4*)(Bt + tid * MLC_ST);
#pragma unroll
        for (int k = 0; k < 16; ++k) { const u32x4 v = row[k]; s += ((__uint_as_float(v.x << 16) + __uint_as_float(v.x & 0xffff0000u)) + (__uint_as_float(v.y << 16) + __uint_as_float(v.y & 0xffff0000u))) + ((__uint_as_float(v.z << 16) + __uint_as_float(v.z & 0xffff0000u)) + (__uint_as_float(v.w << 16) + __uint_as_float(v.w & 0xffff0000u))); }
        nloc[(size_t)unit * 192 + tid] = s; }
#pragma unroll 1
    for (int ti = wave; ti < 36; ti += 8) { const int rb = ti / 6, cbk = ti % 6;
        f32x16 acc;
#pragma unroll
        for (int q = 0; q < 16; ++q) acc[q] = 0.f;
#pragma unroll
        for (int ks = 0; ks < 8; ++ks) { const bf16x8 a = *(const LAS bf16x8*)(At + (32 * rb + r) * MLC_ST + (16 * ks + 8 * hh) * 2), bb = *(const LAS bf16x8*)(Bt + (32 * cbk + r) * MLC_ST + (16 * ks + 8 * hh) * 2);
            acc = MFMA32(a, bb, acc); }
        bf16* out = Cloc + ((size_t)unit * 192 + 32 * rb + 4 * hh) * 192 + 32 * cbk + r;
#pragma unroll
        for (int R = 0; R < 16; ++R) out[(size_t)((R & 3) + 8 * (R >> 2)) * 192] = f2bf(acc[R]);
    }
}
constexpr int MLO_KST = 400, MLO_VST = 264;
constexpr int MLO_V_OFF = 128 * MLO_KST, MLO_T_OFF = MLO_V_OFF + 192 * MLO_VST;
__device__ __forceinline__ void ml_out_unit(LAS unsigned char* L, const bf16* Q, const bf16* K, const bf16* VT, const bf16* __restrict__ Cloc, const float* __restrict__ nloc, const float* Fb, const float* Ib, const bf16* p, const float* ng, bf16* y, int unit) {
    int tid_ = threadIdx.x; asm volatile("" : "+v"(tid_)); const int tid = tid_, lane = tid & 63, wave = __builtin_amdgcn_readfirstlane(tid >> 6), r = lane & 31, hh = lane >> 5, tb = wave & 3, dh = wave >> 2;
    const int c = unit & 15, bh = unit >> 4, b = bh >> 2, h = bh & 3, t0 = c * 128;
    LAS unsigned char* Kt = L; LAS unsigned char* Vt = L + MLO_V_OFF; LAS unsigned char* Ct = L;
    LAS float* Fs = (LAS float*)(L + MLO_T_OFF); LAS float* Is = Fs + 128; LAS float* np = Is + 128; LAS float* st = np + 192; LAS float* dcy = st + 512;
    __syncthreads();
    if (tid < 128) { Fs[tid] = Fb[bh * T + t0 + tid]; Is[tid] = Ib[bh * T + t0 + tid]; }
    if (tid == 128) { float d = 1.f; for (int j = c - 1; j >= 0; --j) { dcy[j] = d; d *= fexp(Fb[bh * T + 128 * j + 127]); } }
    const int t = t0 + 32 * tb + r; const size_t m = (size_t)b * T + t;
    bf16x8 qf[12];
#pragma unroll
    for (int ks = 0; ks < 12; ++ks) qf[ks] = *(const bf16x8*)(Q + m * 768 + h * 192 + 16 * ks + 8 * hh);
    __syncthreads();
    f32x16 acc[3];
#pragma unroll
    for (int i = 0; i < 3; ++i)
#pragma unroll
        for (int q = 0; q < 16; ++q) acc[i][q] = 0.f;
    const float Ft = Fs[32 * tb + r], dec = fexp(Ft);
    if (c > 0) {
        const bf16* cbase = Cloc + (size_t)(bh * 16) * 36864 + 8 * tid;
        float a[9][8];
#pragma unroll
        for (int i = 0; i < 9; ++i)
#pragma unroll
            for (int e = 0; e < 8; ++e) a[i][e] = 0.f;
#define MLO_ACC(v, dj) do { _Pragma("unroll") for (int i = 0; i < 9; ++i) { a[i][0] += dj * __uint_as_float(v[i].x << 16); a[i][1] += dj * __uint_as_float(v[i].x & 0xffff0000u); a[i][2] += dj * __uint_as_float(v[i].y << 16); a[i][3] += dj * __uint_as_float(v[i].y & 0xffff0000u); \
            a[i][4] += dj * __uint_as_float(v[i].z << 16); a[i][5] += dj * __uint_as_float(v[i].z & 0xffff0000u); a[i][6] += dj * __uint_as_float(v[i].w << 16); a[i][7] += dj * __uint_as_float(v[i].w & 0xffff0000u); } } while (0)
        int j = 0;
#pragma unroll 1
        for (; j + 1 < c; j += 2) { const float d0 = dcy[j], d1 = dcy[j + 1]; u32x4 v[9], w[9];
#pragma unroll
            for (int i = 0; i < 9; ++i) { v[i] = *(const u32x4*)(cbase + (size_t)j * 36864 + 4096 * i); w[i] = *(const u32x4*)(cbase + (size_t)(j + 1) * 36864 + 4096 * i); }
            MLO_ACC(v, d0); MLO_ACC(w, d1); }
        if (j < c) { const float d0 = dcy[j]; u32x4 v[9];
#pragma unroll
            for (int i = 0; i < 9; ++i) v[i] = *(const u32x4*)(cbase + (size_t)j * 36864 + 4096 * i);
            MLO_ACC(v, d0); }
#undef MLO_ACC
#pragma unroll
        for (int i = 0; i < 9; ++i) { const int e = 8 * (tid + 512 * i), dv = e / 192, dk = e % 192;
            *(LAS u32x4*)(Ct + dv * MLO_KST + dk * 2) = (u32x4){cvtpk(a[i][0], a[i][1]), cvtpk(a[i][2], a[i][3]), cvtpk(a[i][4], a[i][5]), cvtpk(a[i][6], a[i][7])}; }
        if (tid < 192) { float s = 0.f; for (int j2 = 0; j2 < c; ++j2) s += dcy[j2] * nloc[(size_t)(bh * 16 + j2) * 192 + tid]; np[tid] = s; }
    } else { if (tid < 192) np[tid] = 0.f; }
    u32x4 kst[6], vst[6];
#pragma unroll
    for (int i = 0; i < 6; ++i) { const int idx = tid + 512 * i; kst[i] = *(const u32x4*)(K + (size_t)(b * T + t0 + idx / 24) * 768 + h * 192 + (idx % 24) * 8); vst[i] = *(const u32x4*)(VT + ((size_t)bh * 192 + (idx >> 4)) * T + t0 + (idx & 15) * 8); }
    if (c > 0) {
        __syncthreads();
        const LAS unsigned char* cp = Ct + (32 * (3 * dh) + r) * MLO_KST + 16 * hh;
#pragma unroll
        for (int blk = 0; blk < 3; ++blk)
#pragma unroll
            for (int ks = 0; ks < 12; ++ks) { const bf16x8 a = *(const LAS bf16x8*)(cp + (32 * blk) * MLO_KST + 32 * ks); acc[blk] = MFMA32(a, qf[ks], acc[blk]); }
#pragma unroll
        for (int i = 0; i < 3; ++i)
#pragma unroll
            for (int q = 0; q < 16; ++q) acc[i][q] *= dec;
    }
    float qn = 0.f;
#pragma unroll
    for (int ks = 0; ks < 12; ++ks) { const f32x4v n0 = *(const LAS f32x4v*)(np + 16 * ks + 8 * hh), n1 = *(const LAS f32x4v*)(np + 16 * ks + 8 * hh + 4);
        qn += (bf2f((bf16)qf[ks][0]) * n0[0] + bf2f((bf16)qf[ks][1]) * n0[1]) + (bf2f((bf16)qf[ks][2]) * n0[2] + bf2f((bf16)qf[ks][3]) * n0[3]) + (bf2f((bf16)qf[ks][4]) * n1[0] + bf2f((bf16)qf[ks][5]) * n1[1]) + (bf2f((bf16)qf[ks][6]) * n1[2] + bf2f((bf16)qf[ks][7]) * n1[3]); }
    qn += __shfl_xor(qn, 32);
    __syncthreads();
#pragma unroll
    for (int i = 0; i < 6; ++i) { const int idx = tid + 512 * i;
        *(LAS u32x4*)(Kt + (idx / 24) * MLO_KST + (idx % 24) * 16) = kst[i];
        LAS u32x2* vd = (LAS u32x2*)(Vt + (idx >> 4) * MLO_VST + (idx & 15) * 16); vd[0] = (u32x2){vst[i].x, vst[i].y}; vd[1] = (u32x2){vst[i].z, vst[i].w}; }
    u32x2 og[12];
#pragma unroll
    for (int blk = 0; blk < 3; ++blk)
#pragma unroll
        for (int g4 = 0; g4 < 4; ++g4) og[blk * 4 + g4] = *(const u32x2*)(p + m * NP + C_MO + h * 192 + 32 * (3 * dh + blk) + 8 * g4 + 4 * hh);
    __syncthreads();
    float den = dec * qn, dpart = 0.f;
    for (int kb = 0; kb <= tb; ++kb) {
        f32x16 S;
#pragma unroll
        for (int q = 0; q < 16; ++q) S[q] = 0.f;
#pragma unroll
        for (int ks = 0; ks < 12; ++ks) { const bf16x8 kf = *(const LAS bf16x8*)(Kt + (32 * kb + r) * MLO_KST + (16 * ks + 8 * hh) * 2); S = MFMA32(kf, qf[ks], S); }
#pragma unroll
        for (int R = 0; R < 16; ++R) { const int sl = 32 * kb + (R & 3) + 8 * (R >> 2) + 4 * hh; const float wgt = (t0 + sl <= t) ? fexp(Ft - Fs[sl] + Is[sl]) : 0.f; S[R] *= wgt; dpart += S[R]; }
        const bf16x8 p0 = pack8(S[0], S[1], S[2], S[3], S[4], S[5], S[6], S[7]), p1 = pack8(S[8], S[9], S[10], S[11], S[12], S[13], S[14], S[15]);
#pragma unroll
        for (int blk = 0; blk < 3; ++blk) { const LAS unsigned char* vrow = Vt + (32 * (3 * dh + blk) + r) * MLO_VST + 8 * hh + 64 * kb;
            { const u32x2 lo = *(const LAS u32x2*)(vrow), hi = *(const LAS u32x2*)(vrow + 16); u32x4 u = {lo.x, lo.y, hi.x, hi.y}; acc[blk] = MFMA32(__builtin_bit_cast(bf16x8, u), p0, acc[blk]); }
            { const u32x2 lo = *(const LAS u32x2*)(vrow + 32), hi = *(const LAS u32x2*)(vrow + 48); u32x4 u = {lo.x, lo.y, hi.x, hi.y}; acc[blk] = MFMA32(__builtin_bit_cast(bf16x8, u), p1, acc[blk]); } }
    }
    den += dpart + __shfl_xor(dpart, 32);
    const float inv = 1.0f / fmaxf(fabsf(den), 1.0f);
    float s1 = 0.f, s2 = 0.f;
#pragma unroll
    for (int blk = 0; blk < 3; ++blk)
#pragma unroll
        for (int g4 = 0; g4 < 4; ++g4) { const u32x2 oo = og[blk * 4 + g4];
            const float o0 = bf2f((bf16)(oo.x & 0xffff)), o1 = bf2f((bf16)(oo.x >> 16)), o2 = bf2f((bf16)(oo.y & 0xffff)), o3 = bf2f((bf16)(oo.y >> 16));
            float v0 = acc[blk][4 * g4] * inv * sigm(o0), v1 = acc[blk][4 * g4 + 1] * inv * sigm(o1), v2 = acc[blk][4 * g4 + 2] * inv * sigm(o2), v3 = acc[blk][4 * g4 + 3] * inv * sigm(o3);
            acc[blk][4 * g4] = v0; acc[blk][4 * g4 + 1] = v1; acc[blk][4 * g4 + 2] = v2; acc[blk][4 * g4 + 3] = v3;
            s1 += (v0 + v1) + (v2 + v3); s2 += (v0 * v0 + v1 * v1) + (v2 * v2 + v3 * v3); }
    s1 += __shfl_xor(s1, 32); s2 += __shfl_xor(s2, 32);
    if (hh == 0) { st[(dh * 128 + 32 * tb + r) * 2] = s1; st[(dh * 128 + 32 * tb + r) * 2 + 1] = s2; }
    u32x2 zg[12];
#pragma unroll
    for (int blk = 0; blk < 3; ++blk)
#pragma unroll
        for (int g4 = 0; g4 < 4; ++g4) zg[blk * 4 + g4] = *(const u32x2*)(p + m * NP + C_MZ + h * 192 + 32 * (3 * dh + blk) + 8 * g4 + 4 * hh);
    __syncthreads();
    const float t1 = st[(32 * tb + r) * 2] + st[(128 + 32 * tb + r) * 2], t2 = st[(32 * tb + r) * 2 + 1] + st[(128 + 32 * tb + r) * 2 + 1];
    const float mu = t1 * (1.0f / 192.0f), var = fmaxf(t2 * (1.0f / 192.0f) - mu * mu, 0.f), rs = 1.0f / sqrtf(var + LN_EPS);
#pragma unroll
    for (int blk = 0; blk < 3; ++blk)
#pragma unroll
        for (int g4 = 0; g4 < 4; ++g4) { const int d = 32 * (3 * dh + blk) + 8 * g4 + 4 * hh; const u32x2 zz = zg[blk * 4 + g4];
            const float z0 = bf2f((bf16)(zz.x & 0xffff)), z1 = bf2f((bf16)(zz.x >> 16)), z2 = bf2f((bf16)(zz.y & 0xffff)), z3 = bf2f((bf16)(zz.y >> 16));
            const float4 gg = *(const float4*)(ng + h * 192 + d);
            u32x2 w; w.x = cvtpk((acc[blk][4 * g4] - mu) * rs * gg.x * silu(z0), (acc[blk][4 * g4 + 1] - mu) * rs * gg.y * silu(z1));
            w.y = cvtpk((acc[blk][4 * g4 + 2] - mu) * rs * gg.z * silu(z2), (acc[blk][4 * g4 + 3] - mu) * rs * gg.w * silu(z3));
            *(u32x2*)(y + m * D + 512 + h * 192 + d) = w; }
}

#define MFMA16(a, b, c) __builtin_amdgcn_mfma_f32_16x16x32_bf16((a), (b), (c), 0, 0, 0)
__device__ __forceinline__ void ph_lru_sp8(const float* lam, float* sp8, int gt, int NGT) { for (int i = gt; i < DEPTH * 512; i += NGT) { const float e = fexp(-lam[i]); sp8[i] = 8.0f * (e < 0.05f ? e * (1.0f - e * (0.5f - e * (0.33333334f - e * 0.25f))) : 0.6931471805599453f * __builtin_amdgcn_logf(1.0f + e)); } }
__device__ __forceinline__ void ph_lru_wt(const float* wa, const float* wx, bf16* Wt, int gt, int NGT) {
    for (int idx = gt; idx < DEPTH * 2 * 4 * 128 * 128; idx += NGT) {
        const int i = idx & 127, o = (idx >> 7) & 127, g = (idx >> 14) & 3, gate = (idx >> 16) & 1, l = idx >> 17;
        const float* src = gate ? wx : wa;
        Wt[idx] = f2bf(src[(((size_t)l * 4 + g) * 128 + i) * 128 + o]);
    }
}
constexpr int LR_XCB_OFF = 32768, LR_XCB_ST = 1040, LR_A_OFF = LR_XCB_OFF + 16 * LR_XCB_ST, LR_U_OFF = LR_A_OFF + 32768;
__device__ __forceinline__ void lru_unit(LAS unsigned char* L, const bf16* p, const float* cw, const float* cb, const bf16* Wt  , const float* ba, const float* bx, const float* lam,
                                         float* hloc, float* cumA, float* aggA, float* aggH, int unit) {
    int tid_ = threadIdx.x; asm volatile("" : "+v"(tid_)); const int tid = tid_, lane = tid & 63, wave = __builtin_amdgcn_readfirstlane(tid >> 6);
    const int m0 = unit * 16, t0 = m0 % T;
    LAS float* xcf = (LAS float*)L; LAS unsigned char* xcb = L + LR_XCB_OFF; LAS float* As = (LAS float*)(L + LR_A_OFF); LAS float* Us = (LAS float*)(L + LR_U_OFF);
    const int g = wave >> 1, ob = (wave & 1) * 64, fr = lane & 15, kq = lane >> 4;
    bf16x8 bw[2][4][4];
#pragma unroll
    for (int a = 0; a < 2; ++a)
#pragma unroll
        for (int nb = 0; nb < 4; ++nb)
#pragma unroll
            for (int ks = 0; ks < 4; ++ks) bw[a][nb][ks] = *(const bf16x8*)(Wt + ((size_t)(a * 4 + g) * 128 + ob + 16 * nb + fr) * 128 + 32 * ks + 8 * kq);
    __syncthreads();
    { const int c = tid; const float w0 = cw[c], w1 = cw[512 + c], w2 = cw[1024 + c], w3 = cw[1536 + c], bb = cb[c];
      float x0 = (t0 >= 3) ? bf2f(p[(size_t)(m0 - 3) * NP + C_LX + c]) : 0.f, x1 = (t0 >= 2) ? bf2f(p[(size_t)(m0 - 2) * NP + C_LX + c]) : 0.f, x2 = (t0 >= 1) ? bf2f(p[(size_t)(m0 - 1) * NP + C_LX + c]) : 0.f;
#pragma unroll
      for (int t = 0; t < 16; ++t) { const float x3 = bf2f(p[(size_t)(m0 + t) * NP + C_LX + c]); const float s = bb + w0 * x0 + w1 * x1 + w2 * x2 + w3 * x3;
          xcf[t * 512 + c] = s; *(LAS bf16*)(xcb + t * LR_XCB_ST + c * 2) = f2bf(s); x0 = x1; x1 = x2; x2 = x3; } }
    __syncthreads();
    f32x4v acc[2][4];
#pragma unroll
    for (int a = 0; a < 2; ++a)
#pragma unroll
        for (int nb = 0; nb < 4; ++nb) acc[a][nb] = (f32x4v){0.f, 0.f, 0.f, 0.f};
#pragma unroll
    for (int ks = 0; ks < 4; ++ks) {
        const bf16x8 af = *(const LAS bf16x8*)(xcb + fr * LR_XCB_ST + (g * 128 + 32 * ks + 8 * kq) * 2);
#pragma unroll
        for (int a = 0; a < 2; ++a)
#pragma unroll
            for (int nb = 0; nb < 4; ++nb) acc[a][nb] = MFMA16(af, bw[a][nb][ks], acc[a][nb]);
    }
#pragma unroll
    for (int nb = 0; nb < 4; ++nb) { const int c = 64 * wave + 16 * nb + fr; const float bav = ba[c], bxv = bx[c], sp8 = lam[c];
#pragma unroll
        for (int rg = 0; rg < 4; ++rg) { const int t = 4 * kq + rg; const float r = sigm(acc[0][nb][rg] + bav), ig = sigm(acc[1][nb][rg] + bxv);
            const float la = -r * sp8, a = fexp(la), x2 = 2.0f * la, em = -x2 * (1.0f + x2 * (0.5f + x2 * (0.16666667f + x2 * (0.041666668f + x2 * 0.0083333338f)))), u = __builtin_amdgcn_sqrtf(em) * (ig * xcf[t * 512 + c]);
            As[t * 512 + c] = a; Us[t * 512 + c] = u; } }
    __syncthreads();
    { const int c = tid; float h = 0.f, P = 1.f;
#pragma unroll
      for (int t = 0; t < 16; ++t) { const float a = As[t * 512 + c], u = Us[t * 512 + c]; P *= a; h = a * h + u; hloc[(size_t)(m0 + t) * 512 + c] = h; cumA[(size_t)(m0 + t) * 512 + c] = P; }
      aggA[(size_t)unit * 512 + c] = P; aggH[(size_t)unit * 512 + c] = h; }
}
__device__ __forceinline__ void lru_apply_unit(const float* __restrict__ hloc, const float* __restrict__ cumA, const float* __restrict__ aggA, const float* __restrict__ aggH, const bf16* __restrict__ p, bf16* __restrict__ y, int unit) {
    int tid_ = threadIdx.x; asm volatile("" : "+v"(tid_)); const int c = tid_;
    const int b = unit >> 5, grp = unit & 31; float h = 0.f;
    const int nprev = 4 * grp;
#pragma unroll 1
    for (int k0 = 0; k0 < nprev; k0 += 16) { float a[16], hh[16];
#pragma unroll
        for (int k = 0; k < 16; ++k) { const int kk = k0 + k < nprev ? k0 + k : nprev - 1; const size_t o = (size_t)(b * 128 + kk) * 512 + c; a[k] = aggA[o]; hh[k] = aggH[o]; }
#pragma unroll
        for (int k = 0; k < 16; ++k) if (k0 + k < nprev) h = a[k] * h + hh[k]; }
#pragma unroll 1
    for (int k = 4 * grp; k < 4 * grp + 4; ++k) { const size_t m0 = (size_t)b * T + 16 * k;
        float hl[16], ca[16]; unsigned short zz[16];
#pragma unroll
        for (int t = 0; t < 16; ++t) { hl[t] = hloc[(m0 + t) * 512 + c]; ca[t] = cumA[(m0 + t) * 512 + c]; zz[t] = p[(m0 + t) * NP + C_LZ + c]; }
#pragma unroll
        for (int t = 0; t < 16; ++t) y[(m0 + t) * D + c] = f2bf((hl[t] + ca[t] * h) * silu(bf2f(zz[t])));
        const size_t o = (size_t)(b * 128 + k) * 512 + c; h = aggA[o] * h + aggH[o]; }
}
#ifndef R_T0
#define R_T0 1
#endif
#ifndef R_T1
#define R_T1 1
#endif
#ifndef R_T2
#define R_T2 1
#endif
#ifndef R_A1
#define R_A1 1
#endif
#ifndef R_A2
#define R_A2 1
#endif
#ifndef R_A3
#define R_A3 1
#endif
#ifndef R_A4
#define R_A4 1
#endif
#ifndef R_P0
#define R_P0 1
#endif
#ifndef R_KV
#define R_KV 1
#endif
#ifndef R_P1
#define R_P1 1
#endif
#ifndef R_P2A
#define R_P2A 1
#endif
#ifndef R_P2B
#define R_P2B 1
#endif
#ifndef R_P2C
#define R_P2C 1
#endif
#ifndef R_P3
#define R_P3 1
#endif
#ifndef R_X
#define R_X 1
#endif
#ifndef R_WO
#define R_WO 1
#endif
#ifndef R_FIN
#define R_FIN 1
#endif
#define REP(n) _Pragma("unroll 1") for (int rep_ = 0; rep_ < (n); ++rep_)

struct Args { const float* in[26]; float* out; unsigned char* ws; };

__device__ __forceinline__ void ph_wt(const float* W, int ldw, int K, int N, const float* g, bf16* Wt, int mode, float* scr, int gw, int NGW, int lane) {
    const int nblk = N / 32, nitems = (K / 64) * nblk;
    for (int it = gw; it < nitems; it += NGW) {
        const int kb = it / nblk, nb = it % nblk, n0 = nb * 32;
        const int src = (mode == 1 && n0 >= SRC_GATE) ? n0 + 8 : n0;
        wt_item(W, ldw, src, g, Wt, K, n0, scr, kb * 64, lane);
    }
}
__device__ __forceinline__ void ph_gatew(const float* W, const float* g, float* Wg, int gt, int NGT) {
    for (int idx = gt; idx < D * 8; idx += NGT) { const int k = idx >> 3, c = idx & 7; Wg[idx] = g[k] * W[(size_t)k * INC + SRC_GATE + c]; }
}
__device__ __forceinline__ void ph_prep(const float* x, bf16* xb, float* rinv, const float* Wg, float* gates, int nrows, int gw, int NGW, int lane) {
    for (int row = gw; row < nrows; row += NGW) {
        const float4* xr = (const float4*)(x + (size_t)row * D); float4 v[8]; float ss = 0.f;
#pragma unroll
        for (int j = 0; j < 8; ++j) { v[j] = xr[lane + 64 * j]; ss += v[j].x * v[j].x + v[j].y * v[j].y + v[j].z * v[j].z + v[j].w * v[j].w; }
        ss = wave_sum(ss); const float r = 1.0f / sqrtf(ss * (1.0f / D) + RMS_EPS);
        uint2* ob = (uint2*)(xb + (size_t)row * D);
#pragma unroll
        for (int j = 0; j < 8; ++j) { uint2 o; o.x = pk2(v[j].x, v[j].y); o.y = pk2(v[j].z, v[j].w); ob[lane + 64 * j] = o; }
        if (lane == 0) rinv[row] = r;
        if (Wg) {
            float a0 = 0, a1 = 0, a2 = 0, a3 = 0, a4 = 0, a5 = 0, a6 = 0, a7 = 0;
#pragma unroll
            for (int j = 0; j < 8; ++j) {
                const float xe[4] = {v[j].x, v[j].y, v[j].z, v[j].w};
#pragma unroll
                for (int e = 0; e < 4; ++e) { const int k = 4 * (lane + 64 * j) + e; const float4 w0 = *(const float4*)(Wg + (size_t)k * 8), w1 = *(const float4*)(Wg + (size_t)k * 8 + 4);
                    a0 += xe[e] * w0.x; a1 += xe[e] * w0.y; a2 += xe[e] * w0.z; a3 += xe[e] * w0.w; a4 += xe[e] * w1.x; a5 += xe[e] * w1.y; a6 += xe[e] * w1.z; a7 += xe[e] * w1.w; }
            }
            a0 = wave_sum(a0); a1 = wave_sum(a1); a2 = wave_sum(a2); a3 = wave_sum(a3); a4 = wave_sum(a4); a5 = wave_sum(a5); a6 = wave_sum(a6); a7 = wave_sum(a7);
            if (lane == 0) { float4* go = (float4*)(gates + (size_t)row * 8); go[0] = make_float4(a0 * r, a1 * r, a2 * r, a3 * r); go[1] = make_float4(a4 * r, a5 * r, a6 * r, a7 * r); }
        }
    }
}
__device__ __forceinline__ void ph_final(const float* x, const float* g, float* out, int gw, int NGW, int lane) {
    for (int row = gw; row < M; row += NGW) {
        const float4* xr = (const float4*)(x + (size_t)row * D); float4 v[8]; float ss = 0.f;
#pragma unroll
        for (int j = 0; j < 8; ++j) { v[j] = xr[lane + 64 * j]; ss += v[j].x * v[j].x + v[j].y * v[j].y + v[j].z * v[j].z + v[j].w * v[j].w; }
        ss = wave_sum(ss); const float r = 1.0f / sqrtf(ss * (1.0f / D) + RMS_EPS);
        float4* o = (float4*)(out + (size_t)row * D); const float4* gg = (const float4*)g;
#pragma unroll
        for (int j = 0; j < 8; ++j) { const float4 gv = gg[lane + 64 * j]; o[lane + 64 * j] = make_float4(v[j].x * r * gv.x, v[j].y * r * gv.y, v[j].z * r * gv.z, v[j].w * r * gv.w); }
    }
}
__device__ __forceinline__ void ph_final2(const bf16* x, const float* rinv, const float* g, float* out, int gt, int NGT) {
    for (int idx = gt; idx < M * (D / 4); idx += NGT) { const int row = idx >> 9, c4 = idx & 511; const float r = rinv[row];
        const uint2 xv = ((const uint2*)x)[idx]; const float4 gv = ((const float4*)g)[c4];
        ((float4*)out)[idx] = make_float4(__uint_as_float(xv.x << 16) * r * gv.x, __uint_as_float(xv.x & 0xffff0000u) * r * gv.y, __uint_as_float(xv.y << 16) * r * gv.z, __uint_as_float(xv.y & 0xffff0000u) * r * gv.w); }
}
__device__ __forceinline__ void ph_lru_gates(float* xc, const bf16* p, const float* cw, const float* cb, const float* wa, const float* ba, const float* wx, const float* bx, const float* lam, float* A, float* U, int vb, int G, int tid) {
    for (int m = vb; m < M; m += G) {
        const int t = m % T, c = tid;
        { float s = cb[c];
#pragma unroll
          for (int j = 0; j < 4; ++j) { const int tt = t - 3 + j; if (tt >= 0) s += cw[j * 512 + c] * bf2f(p[(size_t)(m - 3 + j) * NP + C_LX + c]); }
          xc[c] = s; }
        __syncthreads();
        { const int g = c >> 7, o = c & 127; float ra = ba[c], ri = bx[c];
          for (int i = 0; i < 128; ++i) { const float xv = xc[g * 128 + i]; ra += xv * wa[(size_t)(g * 128 + i) * 128 + o]; ri += xv * wx[(size_t)(g * 128 + i) * 128 + o]; }
          const float r = sigm(ra), ig = sigm(ri); const float la = -8.0f * r * log1pf(expf(-lam[c])); const float a = expf(la); const float u = sqrtf(-expm1f(2.0f * la)) * (ig * xc[c]);
          A[(size_t)m * 512 + c] = a; U[(size_t)m * 512 + c] = u; }
        __syncthreads();
    }
}
__device__ __forceinline__ void ph_lru_scan(const float* A, const float* U, const bf16* p, bf16* y, int gt) {
    if (gt < NB * 512) { const int b = gt / 512, c = gt % 512; float h = 0.f;
        for (int t = 0; t < T; ++t) { const size_t m = (size_t)b * T + t; h = A[m * 512 + c] * h + U[m * 512 + c]; const float z = bf2f(p[m * NP + C_LZ + c]); y[m * D + c] = f2bf(h * silu(z)); } }
}
__device__ __forceinline__ void ph_ml_prep(const bf16* p, const float* cw, const float* cb, const float* wq, const float* wk, const float* wv, bf16* Q, bf16* K, bf16* V, int gt, int NGT) {
    for (int idx = gt; idx < M * 192; idx += NGT) {
        const int m = idx / 192, j = idx % 192, t = m % T;
        float u4[4], uc[4];
#pragma unroll
        for (int i = 0; i < 4; ++i) { const int c = 4 * j + i; float s = cb[c];
#pragma unroll
            for (int jj = 0; jj < 4; ++jj) { const int tt = t - 3 + jj; if (tt >= 0) s += cw[jj * 768 + c] * bf2f(p[(size_t)(m - 3 + jj) * NP + C_MU + c]); }
            uc[i] = silu(s); u4[i] = bf2f(p[(size_t)m * NP + C_MU + c]); }
        const float ks = 0.07216878364870322f;
#pragma unroll
        for (int o = 0; o < 4; ++o) { float q = 0.f, k = 0.f, v = 0.f;
#pragma unroll
            for (int i = 0; i < 4; ++i) { q += uc[i] * wq[(j * 4 + i) * 4 + o]; k += uc[i] * wk[(j * 4 + i) * 4 + o]; v += u4[i] * wv[(j * 4 + i) * 4 + o]; }
            Q[(size_t)m * 768 + 4 * j + o] = f2bf(q); K[(size_t)m * 768 + 4 * j + o] = f2bf(k * ks); V[(size_t)m * 768 + 4 * j + o] = f2bf(v); }
    }
}
__device__ __forceinline__ void ph_ml_F(const float* gates, const float* bi, const float* bf, float* Fb, float* Ib, int vb, int tid) {
    if (vb < 16 && tid == 0) { const int bh = vb, b = bh >> 2, h = bh & 3; float F = 0.f;
        for (int t = 0; t < T; ++t) { const size_t m = (size_t)b * T + t; F += logsig(gates[m * 8 + 4 + h] + bf[h]); Fb[bh * T + t] = F; Ib[bh * T + t] = gates[m * 8 + h] + bi[h]; } }
}
__device__ __forceinline__ void ph_ml_attn(float* L, const bf16* Q, const bf16* K, const bf16* V, const float* Fb, const float* Ib, const bf16* p, const float* ng, bf16* y, int vb, int G, int tid) {
    float* Qs = L; float* Ks = Qs + 32 * 192; float* Vs = Ks + 32 * 193; float* Ss = Vs + 32 * 192; float* Ft = Ss + 32 * 32; float* Fs = Ft + 32; float* Is = Fs + 32;
    const int r = tid >> 4, cl = tid & 15;
    for (int unit = vb; unit < 16 * 64; unit += G) {
        const int bh = unit >> 6, b = bh >> 2, h = bh & 3, t0 = (unit & 63) * 32;
        __syncthreads();
        for (int e = tid; e < 32 * 192; e += NTHR) { const int rr = e / 192, d = e % 192; Qs[rr * 192 + d] = bf2f(Q[(size_t)(b * T + t0 + rr) * 768 + h * 192 + d]); }
        if (tid < 32) Ft[tid] = Fb[bh * T + t0 + tid];
        float acc[12]; float den = 0.f;
#pragma unroll
        for (int i = 0; i < 12; ++i) acc[i] = 0.f;
        for (int s0 = 0; s0 < t0 + 32; s0 += 32) {
            __syncthreads();
            for (int e = tid; e < 32 * 192; e += NTHR) { const int i = e / 192, d = e % 192; const size_t g = (size_t)(b * T + s0 + i) * 768 + h * 192 + d; Ks[i * 193 + d] = bf2f(K[g]); Vs[i * 192 + d] = bf2f(V[g]); }
            if (tid < 32) { Fs[tid] = Fb[bh * T + s0 + tid]; Is[tid] = Ib[bh * T + s0 + tid]; }
            __syncthreads();
#pragma unroll
            for (int w = 0; w < 2; ++w) { const int s = cl + 16 * w; float dot = 0.f;
                for (int d = 0; d < 192; ++d) dot += Qs[r * 192 + d] * Ks[s * 193 + d];
                const int tt = t0 + r, ss = s0 + s; const float wgt = (ss <= tt) ? expf(Ft[r] - Fs[s] + Is[s]) : 0.f; Ss[r * 32 + s] = dot * wgt; }
            __syncthreads();
            for (int s = 0; s < 32; ++s) { const float sv = Ss[r * 32 + s]; den += sv;
#pragma unroll
                for (int i = 0; i < 12; ++i) acc[i] += sv * Vs[s * 192 + cl + 16 * i]; }
        }
        const float dn = fmaxf(fabsf(den), 1.0f); const size_t m = (size_t)b * T + t0 + r; float hv[12]; float s1 = 0.f;
#pragma unroll
        for (int i = 0; i < 12; ++i) { const int d = cl + 16 * i; hv[i] = acc[i] / dn * sigm(bf2f(p[m * NP + C_MO + h * 192 + d])); s1 += hv[i]; }
        s1 += __shfl_xor(s1, 1); s1 += __shfl_xor(s1, 2); s1 += __shfl_xor(s1, 4); s1 += __shfl_xor(s1, 8);
        const float mu = s1 * (1.0f / 192.0f); float s2 = 0.f;
#pragma unroll
        for (int i = 0; i < 12; ++i) { const float dd = hv[i] - mu; s2 += dd * dd; }
        s2 += __shfl_xor(s2, 1); s2 += __shfl_xor(s2, 2); s2 += __shfl_xor(s2, 4); s2 += __shfl_xor(s2, 8);
        const float rs = 1.0f / sqrtf(s2 * (1.0f / 192.0f) + LN_EPS);
#pragma unroll
        for (int i = 0; i < 12; ++i) { const int d = cl + 16 * i; const float z = bf2f(p[m * NP + C_MZ + h * 192 + d]); y[m * D + 512 + h * 192 + d] = f2bf((hv[i] - mu) * rs * ng[h * 192 + d] * silu(z)); }
    }
}
__device__ __forceinline__ void ph_mo_kmean(const bf16* p, float* kmean, int gt, int NGT) {
    for (int idx = gt; idx < NB * 6 * 8 * 128; idx += NGT) {
        const int d = idx & 127, blk = (idx >> 7) & 7, bh = idx >> 10, b = bh / 6, h = bh % 6; float s = 0.f;
        for (int i = 0; i < 256; ++i) s += bf2f(p[(size_t)(b * T + blk * 256 + i) * NP + C_K + h * 128 + d]);
        kmean[idx] = s * (1.0f / 256.0f);
    }
}
__device__ __forceinline__ void ph_mo_sel(const bf16* p, const float* kmean, unsigned char* sel, int gt, int NGT) {
    for (int idx = gt; idx < NB * 6 * T; idx += NGT) {
        const int t = idx % T, bh = idx / T, b = bh / 6, h = bh % 6, bq = t >> 8;
        const bf16* q = p + (size_t)(b * T + t) * NP + C_Q + h * 128;
        float g0 = 0, g1 = 0, g2 = 0, g3 = 0, g4 = 0, g5 = 0, g6 = 0;
        const float* km = kmean + (size_t)bh * 8 * 128;
        for (int d = 0; d < 128; ++d) { const float qv = bf2f(q[d]); g0 += qv * km[d]; g1 += qv * km[128 + d]; g2 += qv * km[256 + d]; g3 += qv * km[384 + d]; g4 += qv * km[512 + d]; g5 += qv * km[640 + d]; g6 += qv * km[768 + d]; }
        const float gv[7] = {g0, g1, g2, g3, g4, g5, g6};
        unsigned mask = 0;
        if (bq <= 3) mask = (1u << bq) - 1u;
        else {
#pragma unroll
            for (int pass = 0; pass < 3; ++pass) { float best = -INFINITY; int bi = -1;
#pragma unroll
                for (int j = 0; j < 7; ++j) if (j < bq && !((mask >> j) & 1u) && gv[j] > best) { best = gv[j]; bi = j; }
                if (bi >= 0) mask |= 1u << bi; }
        }
        mask |= 1u << bq;
        sel[(size_t)(b * T + t) * 8 + h] = (unsigned char)mask;
    }
}
template <int MODE> __device__ __forceinline__ void ph_attn32(float* L, const bf16* Qp, int ldq, int qcol, const bf16* Kp, const bf16* Vp, int ldk, const unsigned char* sel, const bf16* zp, bf16* outp, int ldo, int ocol, int vb, int G, int tid) {
    float* Qs = L; float* Ks = Qs + 32 * 128; float* Vs = Ks + 32 * 129; float* Ss = Vs + 32 * 128; unsigned* anym = (unsigned*)(Ss + 32 * 32);
    constexpr int NH = MODE == 0 ? 6 : 4; const int r = tid >> 4, cl = tid & 15;
    for (int unit = vb; unit < NB * NH * 64; unit += G) {
        const int bh = unit >> 6, b = bh / NH, h = bh % NH, t0 = (unit & 63) * 32; const size_t m = (size_t)b * T + t0 + r;
        __syncthreads();
        for (int e = tid; e < 32 * 128; e += NTHR) { const int rr = e >> 7, d = e & 127; Qs[rr * 128 + d] = bf2f(Qp[(size_t)(b * T + t0 + rr) * ldq + qcol + h * 128 + d]); }
        unsigned mymask = 0xffffffffu;
        if (MODE == 0) { if (tid == 0) *anym = 0; __syncthreads(); mymask = sel[m * 8 + h]; if (cl == 0) atomicOr(anym, mymask); __syncthreads(); }
        const float scale = 0.08838834764831845f;
        float slope = 0.f;
        if (MODE == 0) { slope = (h == 0) ? 0.25f : (h == 1) ? 0.0625f : (h == 2) ? 0.015625f : (h == 3) ? 0.00390625f : (h == 4) ? 0.5f : 0.125f; }
        float acc[8]; float mrun = -1e30f, l = 0.f;
#pragma unroll
        for (int i = 0; i < 8; ++i) acc[i] = 0.f;
        const int nblk = MODE == 0 ? (t0 >> 8) + 1 : 1; const unsigned am = MODE == 0 ? *anym : 1u;
        const int kbase = MODE == 0 ? b * T : b * MEM;
        for (int j = 0; j < nblk; ++j) {
            if (!((am >> j) & 1u)) continue;
            for (int ch = 0; ch < 8; ++ch) {
                const int s0 = j * 256 + ch * 32; if (MODE == 0 && s0 > t0 + 31) break;
                __syncthreads();
                for (int e = tid; e < 32 * 128; e += NTHR) { const int i = e >> 7, d = e & 127; const size_t g = (size_t)(kbase + s0 + i) * ldk + h * 128 + d; Ks[i * 129 + d] = bf2f(Kp[g]); Vs[i * 128 + d] = bf2f(Vp[g]); }
                __syncthreads();
#pragma unroll
                for (int w = 0; w < 2; ++w) { const int s = cl + 16 * w; float dot = 0.f;
                    for (int d = 0; d < 128; ++d) dot += Qs[r * 128 + d] * Ks[s * 129 + d];
                    float lg = dot * scale;
                    if (MODE == 0) { const int tt = t0 + r, ss = s0 + s; const bool valid = ((mymask >> j) & 1u) && (ss <= tt); lg = valid ? lg - slope * (float)(tt - ss) : -INFINITY; }
                    Ss[r * 32 + s] = lg; }
                __syncthreads();
                float mx = -INFINITY;
                for (int s = 0; s < 32; ++s) mx = fmaxf(mx, Ss[r * 32 + s]);
                const float mnew = fmaxf(mrun, mx); const float corr = expf(mrun - mnew); l *= corr;
#pragma unroll
                for (int i = 0; i < 8; ++i) acc[i] *= corr;
                for (int s = 0; s < 32; ++s) { const float pv = expf(Ss[r * 32 + s] - mnew); l += pv;
#pragma unroll
                    for (int i = 0; i < 8; ++i) acc[i] += pv * Vs[s * 128 + cl + 16 * i]; }
                mrun = mnew;
            }
        }
        const float inv = 1.0f / l;
#pragma unroll
        for (int i = 0; i < 8; ++i) { const int d = cl + 16 * i; float o = acc[i] * inv;
            if (MODE == 0) { const float z = bf2f(zp[m * NP + C_Z + h * 128 + d]); o *= silu(z); }
            outp[m * ldo + ocol + h * 128 + d] = f2bf(o); }
    }
}

struct OneTile { int pm, pn;
    __device__ __forceinline__ bool next(int i, pg8::Unit& u) const { if (i) return false; u.pm = pm; u.pn = pn; return true; }
    __device__ __forceinline__ void a_ready(const pg8::Unit&) const {}
    __device__ __forceinline__ void done(const pg8::Unit&) const {} };
typedef const __attribute__((address_space(4))) Args* kargs_t;
#define PH_VARS \
    kargs_t ap = (kargs_t)__builtin_amdgcn_kernarg_segment_ptr(); asm volatile("" : "+s"(ap)); \
    unsigned char* const ws = ap->ws; (void)ws; \
    int tid = threadIdx.x; asm volatile("" : "+v"(tid)); const int lane = tid & 63, wave = __builtin_amdgcn_readfirstlane(tid >> 6); (void)lane; \
    const int G = gridDim.x, vb = blockIdx.x, gw = vb * NWAVES + wave, NGW = G * NWAVES, gt = vb * NTHR + tid, NGT = G * NTHR; (void)gw; (void)NGW; (void)gt; (void)NGT; \
    float* const Lf = (float*)lds; (void)Lf; LAS unsigned char* const ldsl = (LAS unsigned char*)lds; (void)ldsl;
#define WSP(T, off) ((T*)(ws + (off)))
__global__ void __launch_bounds__(NTHR, 2) mk_fwd(Args a_unused) {
    extern __shared__ __attribute__((aligned(16))) unsigned char lds[];
    { PH_VARS
      for (int u = tid; u < (LDS_BYTES - LDSCTL_OFF) / 4; u += NTHR) ((LAS unsigned*)(ldsl + LDSCTL_OFF))[u] = 0u;
      __syncthreads();
      (void)xcd_barrier_post((unsigned*)(ws + WS_CTL) + CW_BAR, (volatile LAS unsigned*)(ldsl + MISC_OFF) + 8); }
#define GRID_BAR() do { PH_VARS XcdBarrier bar_; bar_.bar = (unsigned*)(ws + WS_CTL) + CW_BAR; bar_.x = xb_xcc_id(); bar_.st = (volatile LAS unsigned*)(ldsl + MISC_OFF) + 8; xcd_barrier(bar_); } while (0)
    REP(R_P0) {
#pragma unroll 1
    for (int l = 0; l < DEPTH; ++l) {
      { PH_VARS float* scr = Lf + wave * (64 * 33); ph_wt(ap->in[3] + (size_t)l * D * INC, INC, D, NP, ap->in[2] + l * D, WSP(bf16, WS_WIN) + (size_t)l * NP * D, 1, scr, gw, NGW, lane); }
      if (l == 0) { PH_VARS ph_lru_wt(ap->in[6], ap->in[8], WSP(bf16, WS_LRUW), gt, NGT); ph_lru_sp8(ap->in[10], WSP(float, WS_SEL), gt, NGT); }
      { PH_VARS ph_gatew(ap->in[3] + (size_t)l * D * INC, ap->in[2] + l * D, WSP(float, WS_WG) + (size_t)l * D * 8, gt, NGT); }
      { PH_VARS float* scr = Lf + wave * (64 * 33); ph_wt(ap->in[19] + (size_t)l * D * D, D, D, D, nullptr, WSP(bf16, WS_WOUT) + (size_t)l * D * D, 0, scr, gw, NGW, lane); }
      { PH_VARS float* scr = Lf + wave * (64 * 33); ph_wt(ap->in[22] + (size_t)l * D * 512, 512, D, 512, ap->in[20] + l * D, WSP(bf16, WS_WQ) + (size_t)l * 512 * D, 0, scr, gw, NGW, lane); }
      { PH_VARS float* scr = Lf + wave * (64 * 33); ph_wt(ap->in[23] + (size_t)l * D * 1024, 1024, D, 1024, ap->in[21] + l * D, WSP(bf16, WS_WKV) + (size_t)l * 1024 * D, 0, scr, gw, NGW, lane); }
      { PH_VARS float* scr = Lf + wave * (64 * 33); ph_wt(ap->in[24] + (size_t)l * 512 * D, D, 512, D, nullptr, WSP(bf16, WS_WO) + (size_t)l * D * 512, 0, scr, gw, NGW, lane); }
    }
    { PH_VARS ph_prep(ap->in[1], WSP(bf16, WS_MEMB), WSP(float, WS_RINVM), nullptr, nullptr, MM, gw, NGW, lane); }
    { PH_VARS ph_prep(ap->in[0], WSP(bf16, WS_XB), WSP(float, WS_RINV), nullptr, nullptr, M, gw, NGW, lane); }
    GRID_BAR();
    }
    REP(R_KV) {
#pragma unroll 1
    for (int l = 0; l < DEPTH; ++l) { PH_VARS
        pg8::Gemm g{WSP(bf16, WS_MEMB), WSP(bf16, WS_WKV) + (size_t)l * 1024 * D, MM, 1024, D, 0}; EpiScaleBf16 E{WSP(bf16, WS_KV) + (size_t)l * MM * 1024, WSP(float, WS_RINVM), 1024, 0};
        pg8::StaticOrder S; S.init(MM, 1024, G, (vb + 64 + 32 * l) % G);
        pg8::gemm_phase<EpiScaleBf16, pg8::StaticOrder, true, true>(ldsl, g, S, E);
    }
    }
#pragma unroll 1
    for (int l = 0; l < DEPTH; ++l) {
        REP(R_P1) {
        { PH_VARS pg8::Gemm g{WSP(bf16, WS_XB), WSP(bf16, WS_WIN) + (size_t)l * NP * D, M, NP - 256, D, 0}; EpiScaleBf16 E{WSP(bf16, WS_P), WSP(float, WS_RINV), NP, 0}; pg8::StaticOrder S; S.init(M, NP - 256, G, vb);
          pg8::gemm_phase<EpiScaleBf16, pg8::StaticOrder, true, true>(ldsl, g, S, E); }
        GRID_BAR();
        }
        REP(R_P2A) {
        { PH_VARS
#pragma unroll 1
          for (int i = 0; i < MIXA_K; ++i) { const int e = MIXA_TAB[vb & 255][i]; if (e < 0) continue; const int ty = e >> 12, unit = e & 4095;
            if (ty == 0) lru_unit(ldsl, WSP(bf16, WS_P), ap->in[4] + l * 4 * 512, ap->in[5] + l * 512, WSP(bf16, WS_LRUW) + (size_t)l * 2 * 4 * 128 * 128, ap->in[7] + l * 512, ap->in[9] + l * 512, WSP(float, WS_SEL) + l * 512, WSP(float, WS_A), WSP(float, WS_U), ap->out + OUT_AGGA, ap->out + OUT_AGGH, unit);
            else if (ty == 1) ml_chunk_unit(ldsl, WSP(bf16, WS_P), nullptr, ap->in[11] + l * 4 * 768, ap->in[12] + l * 768, ap->in[13] + l * 192 * 16, ap->in[14] + l * 192 * 16, ap->in[15] + l * 192 * 16, ap->in[16] + l * 4, ap->in[17] + l * 4, WSP(bf16, WS_XB), WSP(float, WS_RINV), WSP(float, WS_WG) + (size_t)l * D * 8, WSP(bf16, WS_MQ), WSP(bf16, WS_MK), WSP(bf16, WS_MV), WSP(float, WS_F), WSP(float, WS_I), (bf16*)ap->out, ap->out + OUT_NLOC, unit);
            else if (ty == 2) mo_kmean_unit(WSP(bf16, WS_P), WSP(float, WS_KMEAN), (LAS float*)ldsl, unit);
            else { __syncthreads(); pg8::Gemm g{WSP(bf16, WS_XB), WSP(bf16, WS_WIN) + (size_t)l * NP * D, M, NP, D, 0}; EpiScaleBf16 E{WSP(bf16, WS_P), WSP(float, WS_RINV), NP, 0}; OneTile S{unit, 24};
                   pg8::gemm_phase<EpiScaleBf16, OneTile, true, true>(ldsl, g, S, E); } } }
        REP(R_A4) { PH_VARS __syncthreads(); ph_mo_vt(WSP(bf16, WS_P), WSP(bf16, WS_MOVT), ldsl, gw, NGW, wave, lane); }
        if (l == 0) { PH_VARS ph_mem_vt(WSP(bf16, WS_KV), WSP(bf16, WS_VTM), ldsl, gw, NGW, wave, lane); }
        GRID_BAR();
        }
        REP(R_P2B) {
        { PH_VARS
#pragma unroll 1
          for (int i = 0; i < MIX_K; ++i) { const int e = MIX_TAB[vb & 255][i]; if (e < 0) continue; const int ty = e >> 12, unit = e & 4095;
            if (ty == 0) REP(R_T0) attn_unit<0>(ldsl, WSP(bf16, WS_P), WSP(bf16, WS_MOVT), WSP(float, WS_KMEAN), WSP(bf16, WS_Y), unit, nullptr, nullptr, 0, 2 * ((unit >> 5) + 1));
            else if (ty == 1) REP(R_T1) ml_out_unit(ldsl, WSP(bf16, WS_MQ), WSP(bf16, WS_MK), WSP(bf16, WS_MV), (const bf16*)ap->out, ap->out + OUT_NLOC, WSP(float, WS_F), WSP(float, WS_I), WSP(bf16, WS_P), ap->in[18] + l * 768, WSP(bf16, WS_Y), unit);
            else REP(R_T2) lru_apply_unit(WSP(float, WS_A), WSP(float, WS_U), ap->out + OUT_AGGA, ap->out + OUT_AGGH, WSP(bf16, WS_P), WSP(bf16, WS_Y), unit); } }
        GRID_BAR();
        }
        REP(R_P3 - 1) { PH_VARS pg8::Gemm g{WSP(bf16, WS_Y), WSP(bf16, WS_WOUT) + (size_t)l * D * D, M, D, D, 0};
          EpiResPart<true> E{ap->in[0], (bf16*)(ws + WS_XRES + 20000000), WSP(float, WS_A), (unsigned*)(ws + WS_CTL) + 16384 + (l * 2 + 0) * 2048 + 64 * 32 * rep_, WSP(float, WS_U), D, 0}; pg8::StaticOrder S; S.init(M, D, G, vb);
          pg8::gemm_phase<EpiResPart<true>, pg8::StaticOrder, true, true>(ldsl, g, S, E); GRID_BAR(); }
        if (l == 0) { PH_VARS pg8::Gemm g{WSP(bf16, WS_Y), WSP(bf16, WS_WOUT) + (size_t)l * D * D, M, D, D, 0};
          EpiResPart<true> E{ap->in[0], WSP(bf16, WS_XB), ap->out + OUT_PART, (unsigned*)(ws + WS_CTL) + CW_PANEL + (l * 2 + 0) * 2048, WSP(float, WS_RINV), D, 0}; pg8::StaticOrder S; S.init(M, D, G, vb);
          pg8::gemm_phase<EpiResPart<true>, pg8::StaticOrder, true, true>(ldsl, g, S, E); }
        else { PH_VARS pg8::Gemm g{WSP(bf16, WS_Y), WSP(bf16, WS_WOUT) + (size_t)l * D * D, M, D, D, 0};
          EpiResPart<false> E{WSP(bf16, WS_XB), WSP(bf16, WS_XB), ap->out + OUT_PART, (unsigned*)(ws + WS_CTL) + CW_PANEL + (l * 2 + 0) * 2048, WSP(float, WS_RINV), D, 0}; pg8::StaticOrder S; S.init(M, D, G, vb);
          pg8::gemm_phase<EpiResPart<false>, pg8::StaticOrder, true, true>(ldsl, g, S, E); }
        GRID_BAR();
        REP(R_X) {
        { PH_VARS const bf16* kvl = WSP(bf16, WS_KV) + (size_t)l * MM * 1024; for (int unit = vb; unit < 256; unit += G) attn_unit<1>(ldsl, WSP(bf16, WS_XB), WSP(bf16, WS_VTM) + (size_t)l * 16 * 128 * MEM, (const float*)kvl, WSP(bf16, WS_XO), unit, WSP(float, WS_RINV), WSP(bf16, WS_WQ) + (size_t)l * 512 * D); }
        GRID_BAR();
        }
        REP(R_WO - 1) { PH_VARS pg8::Gemm g{WSP(bf16, WS_XO), WSP(bf16, WS_WO) + (size_t)l * D * 512, M, D, 512, 0};
          EpiResPart<false> E{WSP(bf16, WS_XB), (bf16*)(ws + WS_XRES + 20000000), WSP(float, WS_A), (unsigned*)(ws + WS_CTL) + 16384 + (l * 2 + 1) * 2048 + 64 * 32 * rep_, WSP(float, WS_U), D, 0}; pg8::StaticOrder S; S.init(M, D, G, vb);
          pg8::gemm_phase<EpiResPart<false>, pg8::StaticOrder, true, true>(ldsl, g, S, E); GRID_BAR(); }
        { PH_VARS pg8::Gemm g{WSP(bf16, WS_XO), WSP(bf16, WS_WO) + (size_t)l * D * 512, M, D, 512, 0};
          EpiResPart<false> E{WSP(bf16, WS_XB), WSP(bf16, WS_XB), ap->out + OUT_PART, (unsigned*)(ws + WS_CTL) + CW_PANEL + (l * 2 + 1) * 2048, WSP(float, WS_RINV), D, 0}; pg8::StaticOrder S; S.init(M, D, G, vb);
          pg8::gemm_phase<EpiResPart<false>, pg8::StaticOrder, true, true>(ldsl, g, S, E); }
        GRID_BAR();
    }
    REP(R_FIN - 1) { PH_VARS ph_final2(WSP(bf16, WS_XB), WSP(float, WS_RINV), ap->in[25], (float*)(ws + WS_P), gt, NGT); GRID_BAR(); }
    { PH_VARS ph_final2(WSP(bf16, WS_XB), WSP(float, WS_RINV), ap->in[25], ap->out, gt, NGT); }
}

extern "C" void kernel_launch(void* const* d_in, const int* in_sizes, int n_in, void* d_out, int out_size, void* d_ws, size_t ws_size, hipStream_t stream) {
    static int grid = 0;
    if (grid == 0) {
        if (ws_size < WS_END || n_in != 26) { fprintf(stderr, "kernel_launch: ws_size %zu < %zu or n_in %d != 26\n", ws_size, (size_t)WS_END, n_in); grid = -1; return; }
        int dev = 0, cus = 0, per_cu = 0;
        if (hipGetDevice(&dev) != hipSuccess || hipDeviceGetAttribute(&cus, hipDeviceAttributeMultiprocessorCount, dev) != hipSuccess) { grid = -1; return; }
        if (hipFuncSetAttribute((const void*)mk_fwd, hipFuncAttributeMaxDynamicSharedMemorySize, LDS_BYTES) != hipSuccess) { fprintf(stderr, "kernel_launch: hipFuncSetAttribute failed\n"); grid = -1; return; }
        if (hipOccupancyMaxActiveBlocksPerMultiprocessor(&per_cu, (const void*)mk_fwd, NTHR, LDS_BYTES) != hipSuccess || per_cu < 1) fprintf(stderr, "kernel_launch: occupancy query reports %d\n", per_cu);
        (void)hipGetLastError();
        grid = cus;
    }
    if (grid < 0) return;
    if (hipMemsetAsync((char*)d_ws + WS_CTL, 0, CTL_ZERO_BYTES, stream) != hipSuccess) { fprintf(stderr, "kernel_launch: memset failed\n"); return; }
    Args a{};
    for (int i = 0; i < 26; ++i) a.in[i] = (const float*)d_in[i];
    a.out = (float*)d_out; a.ws = (unsigned char*)d_ws;
    hipLaunchKernelGGL(mk_fwd, dim3(grid), dim3(NTHR), LDS_BYTES, stream, a);
}
```

```cpp
#include <hip/hip_runtime.h>
#include <cstdio>
#include <cstdint>
namespace pg8 {
#define PG8_LAS __attribute__((address_space(3)))
typedef unsigned short bf16_t;
typedef short bf16x8 __attribute__((ext_vector_type(8)));
typedef float f32x4 __attribute__((ext_vector_type(4)));
typedef unsigned u32x4 __attribute__((ext_vector_type(4)));
constexpr int BM = 256, BK = 64, HALF = 128, HTB = HALF * BK * 2  , STAGE_BYTES = 8 * HTB, NXCD = 8, WGM = 8;

__host__ __device__ __forceinline__ int lds_byte(int r, int c) { const int st = (r >> 4) * 2 + (c >> 5), rr = r & 15, cc = c & 31, ob = rr * 64 + cc * 2; return st * 1024 + (ob ^ (((ob >> 9) & 1) << 5)); }
__host__ __device__ __forceinline__ void stage_rc(int b, int& R, int& C) { const int st = b / 1024, sb = b % 1024, swz = sb ^ (((sb >> 9) & 1) << 5); R = (st >> 1) * 16 + swz / 64; C = (st & 1) * 32 + (swz % 64) / 2; }
__host__ __device__ __forceinline__ int perm32(int rho) { const int n = rho >> 4, i = rho & 15; return 8 * (i >> 2) + 4 * n + (i & 3); }

struct Unit { int pm, pn; };
struct Gemm { const bf16_t* A; const bf16_t* Bt; int M, N, K, pad; };

struct StaticOrder {
    int nM, nN, nwg, G, c;
    __host__ __device__ void init(int M, int N, int G_, int c_) { nM = M / BM; nN = N / BM; nwg = nM * nN; G = G_; c = c_; }
    __host__ __device__ bool next(int i, Unit& u) const {
        const long L = (long)i * G + c; if (L >= nwg) return false;
        int wgid = (int)L; { const int q = nwg / NXCD, r = nwg % NXCD, xcd = wgid % NXCD, off = wgid / NXCD; wgid = (xcd < r ? xcd * (q + 1) : r * (q + 1) + (xcd - r) * q) + off; }
        const int nig = WGM * nN, gid = wgid / nig, fm = gid * WGM, gsz = (nM - fm) < WGM ? (nM - fm) : WGM;
        u.pm = fm + ((wgid % nig) % gsz); u.pn = (wgid % nig) / gsz; return true;
    }
    __device__ __forceinline__ void a_ready(const Unit&) const {}
    __device__ __forceinline__ void done(const Unit&) const {}
};

__device__ __forceinline__ unsigned cvt_pk_bf16(float lo, float hi) { unsigned r; asm volatile("v_cvt_pk_bf16_f32 %0, %1, %2" : "=v"(r) : "v"(lo), "v"(hi)); return r; }
template <class Epi, class Sched, bool ALIGN_EPI = false, bool SP2 = false>
__device__ __forceinline__ void gemm_phase(PG8_LAS unsigned char* lds, const Gemm g, const Sched& S, const Epi& E) {
    int tid_ = threadIdx.x; asm volatile("" : "+v"(tid_));
    const int tid = tid_, wid = __builtin_amdgcn_readfirstlane(tid >> 6), lane = tid & 63, wr = wid >> 2, wc = wid & 3, fr = lane & 15, fq = lane >> 4;
    const int K = g.K, nt = K / BK;
    unsigned voffA[2], voffB[2];
#pragma unroll
    for (int i = 0; i < 2; ++i) { int R, C; stage_rc(tid * 16 + i * 8192, R, C); const int Rb = Epi::PERM ? ((R & ~31) + perm32(R & 31)) : R;
        voffA[i] = (unsigned)(R * K + C) * 2u; voffB[i] = (unsigned)(Rb * K + C) * 2u; }
    const size_t kstep = (size_t)(BK * 2);
    const size_t hstep = (size_t)HALF * K * 2;
    const size_t tstep = 2 * hstep;
    const unsigned ldsw = (unsigned)wid * 1024u;
    const int aoff = lds_byte(wr * 64 + fr, fq * 8), boff = lds_byte(wc * 32 + fr, fq * 8);
#define PG8_SA(b, h) (((b) * 2 + (h)) * HTB)
#define PG8_SB(b, h) ((4 + (b) * 2 + (h)) * HTB)
#define PG8_STAGE(bufoff, gbase, voff) do { _Pragma("unroll") for (int _i = 0; _i < 2; ++_i) \
        __builtin_amdgcn_global_load_lds((const unsigned*)((const char*)(gbase) + (voff)[_i]), (PG8_LAS unsigned*)(lds + (bufoff) + ldsw + _i * 8192), 16, 0, 0); } while (0)
#define PG8_LDA(dst, b, h) do { _Pragma("unroll") for (int m = 0; m < 4; ++m) _Pragma("unroll") for (int k = 0; k < 2; ++k) dst[m][k] = *(const PG8_LAS bf16x8*)(lds + PG8_SA(b, h) + aoff + m * 2048 + k * 1024); } while (0)
#define PG8_LDB(dst, b, h) do { _Pragma("unroll") for (int n = 0; n < 2; ++n) _Pragma("unroll") for (int k = 0; k < 2; ++k) dst[n][k] = *(const PG8_LAS bf16x8*)(lds + PG8_SB(b, h) + boff + n * 2048 + k * 1024); } while (0)
#define PG8_MMA(ai, bj, At, Bt) do { __builtin_amdgcn_s_setprio(1); _Pragma("unroll") for (int m = 0; m < 4; ++m) _Pragma("unroll") for (int n = 0; n < 2; ++n) _Pragma("unroll") for (int k = 0; k < 2; ++k) \
        acc[ai][bj][m][n] = __builtin_amdgcn_mfma_f32_16x16x32_bf16(Bt[n][k], At[m][k], acc[ai][bj][m][n], 0, 0, 0); __builtin_amdgcn_s_setprio(0); } while (0)
#define PG8_WAIT_V(n) asm volatile("s_waitcnt vmcnt(" #n ")" ::: "memory")
#define PG8_WAIT_L(n) asm volatile("s_waitcnt lgkmcnt(" #n ")" ::: "memory")
#define PG8_BAR __builtin_amdgcn_s_barrier()
#define PG8_SCHED __builtin_amdgcn_sched_barrier(0)
    Unit cur, nxt; int ui = 0;
    if (!S.next(0, cur)) return;
    f32x4 acc[2][2][4][2];
#pragma unroll
    for (int a = 0; a < 2; ++a)
#pragma unroll
        for (int b = 0; b < 2; ++b)
#pragma unroll
            for (int m = 0; m < 4; ++m)
#pragma unroll
                for (int n = 0; n < 2; ++n) acc[a][b][m][n] = (f32x4){0.f, 0.f, 0.f, 0.f};
    bf16x8 At[4][2], B0[2][2], B1[2][2];
    const char* cA = (const char*)g.A + (size_t)cur.pm * tstep; const char* cB = (const char*)g.Bt + (size_t)cur.pn * tstep;
    S.a_ready(cur);
    if constexpr (SP2) {
        PG8_STAGE(PG8_SB(0, 0), cB, voffB); PG8_STAGE(PG8_SB(0, 1), cB + hstep, voffB); PG8_STAGE(PG8_SA(0, 0), cA, voffA); PG8_STAGE(PG8_SA(0, 1), cA + hstep, voffA);
        if (wr == 1) PG8_BAR;
        PG8_WAIT_V(2); PG8_BAR;
        PG8_STAGE(PG8_SB(1, 0), cB + kstep, voffB); PG8_STAGE(PG8_SA(1, 0), cA + kstep, voffA); PG8_STAGE(PG8_SB(1, 1), cB + hstep + kstep, voffB);
        PG8_WAIT_V(6); PG8_BAR;
    } else {
        PG8_STAGE(PG8_SB(0, 0), cB, voffB); PG8_STAGE(PG8_SA(0, 0), cA, voffA); PG8_STAGE(PG8_SB(0, 1), cB + hstep, voffB); PG8_STAGE(PG8_SA(0, 1), cA + hstep, voffA);
        if (wr == 1) PG8_BAR;
        PG8_WAIT_V(4); PG8_BAR;
        PG8_STAGE(PG8_SB(1, 0), cB + kstep, voffB); PG8_STAGE(PG8_SA(1, 0), cA + kstep, voffA); PG8_STAGE(PG8_SB(1, 1), cB + hstep + kstep, voffB);
        PG8_WAIT_V(6); PG8_BAR;
    }
    for (;;) {
        const bool has_next = S.next(ui + 1, nxt);
        const char* nA = has_next ? (const char*)g.A + (size_t)nxt.pm * tstep : cA; const char* nB = has_next ? (const char*)g.Bt + (size_t)nxt.pn * tstep : cB;
        for (int t = 0; t < nt; t += 2) {
            const bool last = (t == nt - 2);
            const char* a1 = cA + (size_t)(t + 1) * kstep;
            const char* a2 = last ? nA : cA + (size_t)(t + 2) * kstep; const char* b2 = last ? nB : cB + (size_t)(t + 2) * kstep;
            const char* a3 = a2 + kstep; const char* b3 = b2 + kstep;
            if (last && has_next) S.a_ready(nxt);
            if constexpr (SP2) {
            PG8_LDB(B0, 0, 0); PG8_LDB(B1, 0, 1); PG8_SCHED; PG8_LDA(At, 0, 0); PG8_STAGE(PG8_SA(1, 1), a1 + hstep, voffA);
            PG8_WAIT_V(8); PG8_WAIT_L(0); PG8_BAR; PG8_MMA(0, 0, At, B0); PG8_MMA(0, 1, At, B1); PG8_BAR; PG8_SCHED;
            PG8_LDA(At, 0, 1); PG8_STAGE(PG8_SB(0, 0), b2, voffB); PG8_STAGE(PG8_SB(0, 1), b2 + hstep, voffB); PG8_STAGE(PG8_SA(0, 0), a2, voffA);
            PG8_WAIT_V(8); PG8_WAIT_L(0); PG8_BAR; PG8_MMA(1, 0, At, B0); PG8_MMA(1, 1, At, B1); PG8_BAR; PG8_SCHED;
            PG8_LDB(B0, 1, 0); PG8_LDB(B1, 1, 1); PG8_SCHED; PG8_LDA(At, 1, 0); PG8_STAGE(PG8_SA(0, 1), a2 + hstep, voffA);
            PG8_WAIT_V(8); PG8_WAIT_L(0); PG8_BAR; PG8_MMA(0, 0, At, B0); PG8_MMA(0, 1, At, B1); PG8_BAR; PG8_SCHED;
            PG8_LDA(At, 1, 1); PG8_STAGE(PG8_SB(1, 0), b3, voffB); PG8_STAGE(PG8_SB(1, 1), b3 + hstep, voffB); PG8_STAGE(PG8_SA(1, 0), a3, voffA);
            PG8_WAIT_V(8); PG8_WAIT_L(0); PG8_BAR; PG8_MMA(1, 0, At, B0); PG8_MMA(1, 1, At, B1); PG8_BAR; PG8_SCHED;
            } else {
            PG8_LDB(B0, 0, 0); PG8_SCHED; PG8_LDA(At, 0, 0); PG8_STAGE(PG8_SA(1, 1), a1 + hstep, voffA);
            PG8_WAIT_L(8); PG8_BAR; PG8_WAIT_L(0); PG8_MMA(0, 0, At, B0); PG8_BAR; PG8_SCHED;
            PG8_LDB(B1, 0, 1); PG8_STAGE(PG8_SB(0, 0), b2, voffB);
            PG8_BAR; PG8_WAIT_L(0); PG8_MMA(0, 1, At, B1); PG8_BAR;
            PG8_LDA(At, 0, 1); PG8_STAGE(PG8_SA(0, 0), a2, voffA);
            PG8_BAR; PG8_WAIT_L(0); PG8_MMA(1, 0, At, B0); PG8_BAR; PG8_SCHED;
            PG8_STAGE(PG8_SB(0, 1), b2 + hstep, voffB);
            PG8_WAIT_V(6); PG8_BAR; PG8_MMA(1, 1, At, B1); PG8_BAR;
            PG8_LDB(B0, 1, 0); PG8_SCHED; PG8_LDA(At, 1, 0); PG8_STAGE(PG8_SA(0, 1), a2 + hstep, voffA);
            PG8_WAIT_L(8); PG8_BAR; PG8_WAIT_L(0); PG8_MMA(0, 0, At, B0); PG8_BAR; PG8_SCHED;
            PG8_LDB(B1, 1, 1); PG8_STAGE(PG8_SB(1, 0), b3, voffB);
            PG8_BAR; PG8_WAIT_L(0); PG8_MMA(0, 1, At, B1); PG8_BAR;
            PG8_LDA(At, 1, 1); PG8_STAGE(PG8_SA(1, 0), a3, voffA);
            PG8_BAR; PG8_WAIT_L(0); PG8_MMA(1, 0, At, B0); PG8_BAR; PG8_SCHED;
            PG8_STAGE(PG8_SB(1, 1), b3 + hstep, voffB);
            PG8_WAIT_V(6); PG8_BAR; PG8_MMA(1, 1, At, B1); PG8_BAR;
            }
        }
        if constexpr (ALIGN_EPI) { if (wr == 0) PG8_BAR; }
        if constexpr (!Epi::AFTER_DRAIN) { E(acc, cur, wr, wc, fr, fq); S.done(cur); }
        if (!has_next) break;
#pragma unroll
        for (int a = 0; a < 2; ++a)
#pragma unroll
            for (int b = 0; b < 2; ++b)
#pragma unroll
                for (int m = 0; m < 4; ++m)
#pragma unroll
                    for (int n = 0; n < 2; ++n) acc[a][b][m][n] = (f32x4){0.f, 0.f, 0.f, 0.f};
        cur = nxt; cA = nA; cB = nB; ++ui;
        if constexpr (ALIGN_EPI) { if (wr == 1) PG8_BAR; }
    }
    PG8_WAIT_V(0);
    if constexpr (!ALIGN_EPI) { if (wr == 0) PG8_BAR; }
    PG8_BAR;
    if constexpr (Epi::AFTER_DRAIN) { E.fused(acc, cur, wr, wc, fr, fq, lds, wid, lane); S.done(cur); }
#undef PG8_SA
#undef PG8_SB
#undef PG8_STAGE
#undef PG8_LDA
#undef PG8_LDB
#undef PG8_MMA
#undef PG8_WAIT_V
#undef PG8_WAIT_L
#undef PG8_BAR
#undef PG8_SCHED
}
}

constexpr int NB = 4, T = 2048, D = 2048, M = NB * T, DEPTH = 2, MEM = 256, MM = NB * MEM;
constexpr int INC = 6408, NP = 6400;
constexpr int ML_DH = 192, MO_DH = 128;
constexpr int C_LX = 0, C_LZ = 512, C_MU = 1024, C_MO = 1792, C_MZ = 2560, C_Q = 3328, C_K = 4096, C_V = 4864, C_Z = 5632;
constexpr int SRC_GATE = 3328;
constexpr float RMS_EPS = 1e-6f, LN_EPS = 1e-5f;

typedef unsigned short bf16;
#define LAS __attribute__((address_space(3)))
__device__ __forceinline__ float bf2f(bf16 v) { return __uint_as_float(((unsigned)v) << 16); }
__device__ __forceinline__ bf16 f2bf(float f) { unsigned u = __float_as_uint(f); return (bf16)((u + 0x7fffu + ((u >> 16) & 1u)) >> 16); }
__device__ __forceinline__ unsigned pk2(float lo, float hi) { return (unsigned)f2bf(lo) | ((unsigned)f2bf(hi) << 16); }
__device__ __forceinline__ float fexp(float x) { return __builtin_amdgcn_exp2f(x * 1.4426950408889634f); }
__device__ __forceinline__ float sigm(float x) { return __builtin_amdgcn_rcpf(1.f + fexp(-x)); }
__device__ __forceinline__ float silu(float x) { return x * __builtin_amdgcn_rcpf(1.f + fexp(-x)); }
__device__ __forceinline__ float logsig(float x) { return fminf(x, 0.f) - 0.6931471805599453f * __builtin_amdgcn_logf(1.0f + fexp(-fabsf(x))); }
__device__ __forceinline__ float wave_sum(float v) {
#pragma unroll
    for (int o = 1; o < 64; o <<= 1) v += __shfl_xor(v, o);
    return v;
}

constexpr size_t al256(size_t x) { return (x + 255) & ~(size_t)255; }
constexpr size_t WS_CTL = 0;
constexpr size_t WS_WIN = 1u << 20;
constexpr size_t WS_WOUT = WS_WIN + (size_t)DEPTH * NP * D * 2;
constexpr size_t WS_WQ = WS_WOUT + (size_t)DEPTH * D * D * 2;
constexpr size_t WS_WKV = WS_WQ + (size_t)DEPTH * 512 * D * 2;
constexpr size_t WS_WO = WS_WKV + (size_t)DEPTH * 1024 * D * 2;
constexpr size_t WS_WG = WS_WO + (size_t)DEPTH * D * 512 * 2;
constexpr size_t WS_MEMB = WS_WG + (size_t)DEPTH * D * 8 * 4;
constexpr size_t WS_RINVM = WS_MEMB + (size_t)MM * D * 2;
constexpr size_t WS_KV = WS_RINVM + (size_t)MM * 4;
constexpr size_t WS_XB = WS_KV + (size_t)DEPTH * MM * 1024 * 2;
constexpr size_t WS_RINV = WS_XB + (size_t)M * D * 2;
constexpr size_t WS_GATES = WS_RINV + (size_t)M * 4;
constexpr size_t WS_XRES = WS_GATES + (size_t)M * 8 * 4;
constexpr size_t WS_Y = WS_XRES + (size_t)M * D * 4;
constexpr size_t WS_P = WS_Y + (size_t)M * D * 2;
constexpr size_t WS_A = WS_P + (size_t)M * NP * 2;
constexpr size_t WS_U = WS_A + (size_t)M * 512 * 4;
constexpr size_t WS_MQ = WS_U + (size_t)M * 512 * 4;
constexpr size_t WS_MK = WS_MQ + (size_t)M * 768 * 2;
constexpr size_t WS_MV = WS_MK + (size_t)M * 768 * 2;
constexpr size_t WS_F = WS_MV + (size_t)M * 768 * 2;
constexpr size_t WS_I = WS_F + (size_t)16 * T * 4;
constexpr size_t WS_KMEAN = WS_I + (size_t)16 * T * 4;
constexpr size_t WS_SEL = WS_KMEAN + (size_t)NB * 6 * 8 * 128 * 4;
constexpr size_t WS_MOVT = WS_SEL + (size_t)M * 8;
constexpr size_t WS_END = WS_MOVT + (size_t)NB * 6 * 128 * T * 2;
constexpr size_t WS_XQ = WS_P;
constexpr size_t WS_XO = WS_P + (size_t)M * 512 * 2;
constexpr size_t WS_CPREV = WS_XRES;
constexpr size_t WS_MOPART = WS_XRES + 20000000;
static_assert(WS_CPREV + (size_t)256 * 36864 * 2 <= WS_MOPART && WS_MOPART + (size_t)384 * 4 * 66 * 64 * 4 <= WS_Y, "xres region overlays");
constexpr size_t WS_VTM = WS_MEMB;
constexpr size_t WS_LRUW = 512u << 10;
constexpr size_t OUT_CLOC = 0, OUT_NLOC = (size_t)256 * 36864, OUT_NPREV = OUT_NLOC + 256 * 192, OUT_AGGA = OUT_NPREV + 256 * 192, OUT_AGGH = OUT_AGGA + 512 * 512, OUT_CARRY = OUT_AGGH + 512 * 512, OUT_PART = OUT_CARRY + 512 * 512;
static_assert(OUT_PART + (size_t)M * 32 <= (size_t)M * D, "d_out scratch");
static_assert(WS_END <= 419954688ull, "workspace map exceeds the guaranteed ws_size");

__device__ __forceinline__ void wt_item(const float* W, int ldw, int src_col, const float* g, bf16* Wt, int K, int dst_row, float* scr, int k0, int lane) {
    typedef float f32x4w __attribute__((ext_vector_type(4)));
    f32x4w v[8];
#pragma unroll
    for (int i = 0; i < 8; ++i) v[i] = *(const f32x4w*)(W + (size_t)(k0 + 8 * i + (lane >> 3)) * ldw + src_col + (lane & 7) * 4);
#pragma unroll
    for (int i = 0; i < 8; ++i) { const int kk = 8 * i + (lane >> 3); const float gg = g ? g[k0 + kk] : 1.f; float* d = scr + kk * 33 + (lane & 7) * 4;
        d[0] = v[i][0] * gg; d[1] = v[i][1] * gg; d[2] = v[i][2] * gg; d[3] = v[i][3] * gg; }
    __builtin_amdgcn_s_waitcnt(0xc07f); asm volatile("" ::: "memory");
    const int c = lane & 7;
#pragma unroll
    for (int j = 0; j < 4; ++j) { const int n = (lane >> 3) + 8 * j; const float* s = scr + (8 * c) * 33 + n;
        uint4 o; o.x = pk2(s[0 * 33], s[1 * 33]); o.y = pk2(s[2 * 33], s[3 * 33]); o.z = pk2(s[4 * 33], s[5 * 33]); o.w = pk2(s[6 * 33], s[7 * 33]);
        *(uint4*)(Wt + (size_t)(dst_row + n) * K + k0 + 8 * c) = o; }
    __builtin_amdgcn_s_waitcnt(0xc07f); asm volatile("" ::: "memory");
}
struct EpiScaleBf16 {
    static constexpr bool PERM = true, AFTER_DRAIN = false;
    bf16* O; const float* rs; int ldc, pad;
    __device__ __forceinline__ void operator()(const pg8::f32x4 (&acc)[2][2][4][2], const pg8::Unit& u, int wr, int wc, int fr, int fq) const {
        const int row0 = u.pm * 256 + wr * 64 + fr, col0 = u.pn * 256 + wc * 32 + 8 * fq;
#pragma unroll
        for (int ai = 0; ai < 2; ++ai)
#pragma unroll
            for (int m = 0; m < 4; ++m) { const int row = row0 + ai * 128 + m * 16; const float s = rs ? rs[row] : 1.f; bf16* rowp = O + (size_t)row * ldc + col0;
#pragma unroll
                for (int bj = 0; bj < 2; ++bj) { const pg8::f32x4 v0 = acc[ai][bj][m][0] * s, v1 = acc[ai][bj][m][1] * s; pg8::u32x4 w;
                    w.x = pg8::cvt_pk_bf16(v0[0], v0[1]); w.y = pg8::cvt_pk_bf16(v0[2], v0[3]); w.z = pg8::cvt_pk_bf16(v1[0], v1[1]); w.w = pg8::cvt_pk_bf16(v1[2], v1[3]);
                    *(pg8::u32x4*)(rowp + bj * 128) = w; } }
    }
};
template <bool BASE_F32> struct EpiResPart {
    static constexpr bool PERM = true, AFTER_DRAIN = false;
    const void* base; bf16* xb; float* part; unsigned* cnt; float* rinv; int ldc, pad;
    __device__ __forceinline__ void operator()(const pg8::f32x4 (&acc)[2][2][4][2], const pg8::Unit& u, int wr, int wc, int fr, int fq) const {
        const int row0 = u.pm * 256 + wr * 64 + fr, col0 = u.pn * 256 + wc * 32 + 8 * fq;
#pragma unroll
        for (int ai = 0; ai < 2; ++ai)
#pragma unroll
            for (int m = 0; m < 4; ++m) { const int row = row0 + ai * 128 + m * 16; const size_t off = (size_t)row * ldc + col0; float ss = 0.f;
#pragma unroll
                for (int bj = 0; bj < 2; ++bj) { pg8::f32x4 b0, b1;
                    if (BASE_F32) { b0 = *(const pg8::f32x4*)((const float*)base + off + bj * 128); b1 = *(const pg8::f32x4*)((const float*)base + off + bj * 128 + 4); }
                    else { const pg8::u32x4 bb = *(const pg8::u32x4*)((const bf16*)base + off + bj * 128);
                        b0 = (pg8::f32x4){__uint_as_float(bb.x << 16), __uint_as_float(bb.x & 0xffff0000u), __uint_as_float(bb.y << 16), __uint_as_float(bb.y & 0xffff0000u)};
                        b1 = (pg8::f32x4){__uint_as_float(bb.z << 16), __uint_as_float(bb.z & 0xffff0000u), __uint_as_float(bb.w << 16), __uint_as_float(bb.w & 0xffff0000u)}; }
                    const pg8::f32x4 v0 = b0 + acc[ai][bj][m][0], v1 = b1 + acc[ai][bj][m][1];
                    ss += ((v0[0] * v0[0] + v0[1] * v0[1]) + (v0[2] * v0[2] + v0[3] * v0[3])) + ((v1[0] * v1[0] + v1[1] * v1[1]) + (v1[2] * v1[2] + v1[3] * v1[3]));
                    pg8::u32x4 w; w.x = pg8::cvt_pk_bf16(v0[0], v0[1]); w.y = pg8::cvt_pk_bf16(v0[2], v0[3]); w.z = pg8::cvt_pk_bf16(v1[0], v1[1]); w.w = pg8::cvt_pk_bf16(v1[2], v1[3]);
                    *(pg8::u32x4*)(xb + off + bj * 128) = w; }
                ss += __shfl_xor(ss, 16); ss += __shfl_xor(ss, 32);
                if (fq == 0) __hip_atomic_store((unsigned*)part + (size_t)row * 32 + u.pn * 4 + wc, __float_as_uint(ss), __ATOMIC_RELAXED, __HIP_MEMORY_SCOPE_AGENT); }
        asm volatile("s_waitcnt vmcnt(0)" ::: "memory");
        unsigned old = 0u; const int lane = fq * 16 + fr;
        if (lane == 0) old = __hip_atomic_fetch_add(cnt + 64 * u.pm, 1u, __ATOMIC_RELAXED, __HIP_MEMORY_SCOPE_AGENT);
        old = (unsigned)__builtin_amdgcn_readfirstlane((int)old);
        if (old == 63u) {
            __builtin_amdgcn_fence(__ATOMIC_ACQUIRE, "agent"); asm volatile("s_waitcnt vmcnt(0)" ::: "memory");
#pragma unroll 1
            for (int i = 0; i < 4; ++i) { const int row = u.pm * 256 + lane + 64 * i; const pg8::f32x4* pp = (const pg8::f32x4*)(part + (size_t)row * 32); float s = 0.f;
#pragma unroll
                for (int k = 0; k < 8; ++k) { const pg8::f32x4 v = pp[k]; s += (v[0] + v[1]) + (v[2] + v[3]); }
                rinv[row] = 1.0f / sqrtf(s * (1.0f / D) + RMS_EPS); }
        }
    }
};
struct EpiResF32 {
    static constexpr bool PERM = false, AFTER_DRAIN = false;
    const float* base; float* out; int ldc, pad;
    __device__ __forceinline__ void operator()(const pg8::f32x4 (&acc)[2][2][4][2], const pg8::Unit& u, int wr, int wc, int fr, int fq) const {
        const int row0 = u.pm * 256 + wr * 64 + fr, col0 = u.pn * 256 + wc * 32 + 4 * fq;
#pragma unroll
        for (int ai = 0; ai < 2; ++ai)
#pragma unroll
            for (int m = 0; m < 4; ++m) { const size_t off = (size_t)(row0 + ai * 128 + m * 16) * ldc + col0;
#pragma unroll
                for (int bj = 0; bj < 2; ++bj)
#pragma unroll
                    for (int n = 0; n < 2; ++n) { const pg8::f32x4 b = *(const pg8::f32x4*)(base + off + bj * 128 + n * 16); *(pg8::f32x4*)(out + off + bj * 128 + n * 16) = b + acc[ai][bj][m][n]; } }
    }
};
constexpr int NWAVES = 8, NTHR = 512;
constexpr int RING_BYTES = 131072, LDSCTL_OFF = 162816, MISC_OFF = LDSCTL_OFF + 320, LDS_BYTES = 163840;
constexpr size_t CTL_ZERO_BYTES = 1u << 20;
constexpr int CW_BAR = 4096, CW_PANEL = 8192, CW_QUEUE = 28672;
typedef __attribute__((address_space(1))) unsigned gu32;
#define RLX_AGENT __ATOMIC_RELAXED, __HIP_MEMORY_SCOPE_AGENT
#define XB_TMO      128
#define XB_XCNT(j)  (256  + 64 * (j))
#define XB_XSUB(j)  (1280 + 64 * (j))
#define XB_XGEN(j)  (2304 + 64 * (j))
#define XB_TOP      3328
#define XB_TOPGEN   3392
#define XCD_BAR_WORDS 3456
#define XB_SPIN_CAP (1u << 18)

__device__ __forceinline__ unsigned xb_ld(unsigned* p)              { return __hip_atomic_load(p, __ATOMIC_RELAXED, __HIP_MEMORY_SCOPE_AGENT); }
__device__ __forceinline__ unsigned xb_add(unsigned* p, unsigned v) { return __hip_atomic_fetch_add(p, v, __ATOMIC_RELAXED, __HIP_MEMORY_SCOPE_AGENT); }
__device__ __forceinline__ unsigned xb_xcc_id() { return (unsigned)__builtin_amdgcn_s_getreg((3 << 11) | 20) & 0xFu; }
#define XB_SPIN(cond, bar) do { unsigned _sp = 0; while (cond) { __builtin_amdgcn_s_sleep(1); \
    if ((++_sp & 255u) == 0u) { if (xb_ld(&(bar)[XB_TMO])) break; if (_sp > XB_SPIN_CAP) { atomicAdd(&(bar)[XB_TMO], 1u); break; } } } } while (0)

struct XcdBarrier {
    unsigned* bar; unsigned x;
    volatile LAS unsigned* st;
};

__device__ __forceinline__ XcdBarrier xcd_barrier_post(unsigned* bar, volatile LAS unsigned* st) {
    XcdBarrier b; b.bar = bar; b.x = xb_xcc_id(); b.st = st;
    if (threadIdx.x == 0) (void)xb_add(&bar[XB_XCNT(b.x)], 1u);
    return b;
}
__device__ __forceinline__ void xcd_barrier_complete(unsigned* bar, unsigned x, unsigned& nloc, unsigned& nx) {
    const unsigned G = gridDim.x * gridDim.y * gridDim.z;
    unsigned sum, cnt, mine, sp = 0u;
    for (;;) {
        sum = 0u; cnt = 0u; mine = 0u;
#pragma unroll
        for (unsigned j = 0; j < 16; ++j) { const unsigned c = xb_ld(&bar[XB_XCNT(j)]); sum += c; cnt += (c > 0u) ? 1u : 0u; mine = (j == x) ? c : mine; }
        if (sum == G) break;
        __builtin_amdgcn_s_sleep(1);
        if ((++sp & 255u) == 0u) { if (xb_ld(&bar[XB_TMO])) break; if (sp > XB_SPIN_CAP) { atomicAdd(&bar[XB_TMO], 1u); break; } }
    }
    nloc = mine > 0u ? mine : 1u; nx = cnt > 0u ? cnt : 1u;
}

__device__ __forceinline__ void xcd_barrier(const XcdBarrier& b) {
    asm volatile("s_waitcnt vmcnt(0)" ::: "memory");
    __syncthreads();
    if (threadIdx.x == 0) {
        unsigned* bar = b.bar;
        __builtin_amdgcn_s_waitcnt(0);
        unsigned nloc = b.st[0], nx = b.st[1];
        if (nloc == 0u) { xcd_barrier_complete(bar, b.x, nloc, nx); b.st[0] = nloc; b.st[1] = nx; }
        const unsigned old = xb_add(&bar[XB_XSUB(b.x)], 1u);
        const unsigned gen = old / nloc;
        if (old + 1u == (gen + 1u) * nloc) {
            __builtin_amdgcn_fence(__ATOMIC_RELEASE, "agent");
            asm volatile("s_waitcnt vmcnt(0)" ::: "memory");
            const unsigned og = xb_add(&bar[XB_TOP], 1u);
            const unsigned tg = og / nx;
            if (og + 1u == (tg + 1u) * nx) xb_add(&bar[XB_TOPGEN], 1u);
            else XB_SPIN(xb_ld(&bar[XB_TOPGEN]) == tg, bar);
            __builtin_amdgcn_fence(__ATOMIC_ACQUIRE, "agent");
            xb_add(&bar[XB_XGEN(b.x)], 1u);
            asm volatile("s_waitcnt vmcnt(0)" ::: "memory");
        } else {
            XB_SPIN(xb_ld(&bar[XB_XGEN(b.x)]) == gen, bar);
            __builtin_amdgcn_fence(__ATOMIC_ACQUIRE, "agent");
            asm volatile("s_waitcnt vmcnt(0)" ::: "memory");
        }
    }
    __syncthreads();
}

constexpr int MIXQ_N = 96;
__device__ const int MIXQ_TAB[8][96] = {{480,481,482,448,449,450,416,417,418,384,385,386,352,353,354,320,321,322,288,289,290,4111,4127,4110,4126,4109,4125,256,257,258,4108,4124,4107,4123,4106,4122,4105,4121,4104,4120,4103,4119,224,225,226,4102,4118,4101,4117,4100,4116,4099,4115,4098,4114,4097,4113,4096,4112,192,193,194,160,161,162,128,129,130,96,97,98,64,65,66,32,33,34,8216,8248,8280,8312,8208,8240,8272,8304,8200,8232,8264,8296,8192,8224,8256,8288,0,1,2},{483,484,485,451,452,453,419,420,421,387,388,389,355,356,357,323,324,325,291,292,293,4143,4159,4142,4158,4141,4157,259,260,261,4140,4156,4139,4155,4138,4154,4137,4153,4136,4152,4135,4151,227,228,229,4134,4150,4133,4149,4132,4148,4131,4147,4130,4146,4129,4145,4128,4144,195,196,197,163,164,165,131,132,133,99,100,101,67,68,69,35,36,37,8217,8249,8281,8313,8209,8241,8273,8305,8201,8233,8265,8297,8193,8225,8257,8289,3,4,5},{486,487,488,454,455,456,422,423,424,390,391,392,358,359,360,326,327,328,294,295,296,4175,4191,4174,4190,4173,4189,262,263,264,4172,4188,4171,4187,4170,4186,4169,4185,4168,4184,4167,4183,230,231,232,4166,4182,4165,4181,4164,4180,4163,4179,4162,4178,4161,4177,4160,4176,198,199,200,166,167,168,134,135,136,102,103,104,70,71,72,38,39,40,8218,8250,8282,8314,8210,8242,8274,8306,8202,8234,8266,8298,8194,8226,8258,8290,6,7,8},{489,490,491,457,458,459,425,426,427,393,394,395,361,362,363,329,330,331,297,298,299,4207,4223,4206,4222,4205,4221,265,266,267,4204,4220,4203,4219,4202,4218,4201,4217,4200,4216,4199,4215,233,234,235,4198,4214,4197,4213,4196,4212,4195,4211,4194,4210,4193,4209,4192,4208,201,202,203,169,170,171,137,138,139,105,106,107,73,74,75,41,42,43,8219,8251,8283,8315,8211,8243,8275,8307,8203,8235,8267,8299,8195,8227,8259,8291,9,10,11},{492,493,494,460,461,462,428,429,430,396,397,398,364,365,366,332,333,334,300,301,302,4239,4255,4238,4254,4237,4253,268,269,270,4236,4252,4235,4251,4234,4250,4233,4249,4232,4248,4231,4247,236,237,238,4230,4246,4229,4245,4228,4244,4227,4243,4226,4242,4225,4241,4224,4240,204,205,206,172,173,174,140,141,142,108,109,110,76,77,78,44,45,46,8220,8252,8284,8316,8212,8244,8276,8308,8204,8236,8268,8300,8196,8228,8260,8292,12,13,14},{495,496,497,463,464,465,431,432,433,399,400,401,367,368,369,335,336,337,303,304,305,4271,4287,4270,4286,4269,4285,271,272,273,4268,4284,4267,4283,4266,4282,4265,4281,4264,4280,4263,4279,239,240,241,4262,4278,4261,4277,4260,4276,4259,4275,4258,4274,4257,4273,4256,4272,207,208,209,175,176,177,143,144,145,111,112,113,79,80,81,47,48,49,8221,8253,8285,8317,8213,8245,8277,8309,8205,8237,8269,8301,8197,8229,8261,8293,15,16,17},{498,499,500,466,467,468,434,435,436,402,403,404,370,371,372,338,339,340,306,307,308,4303,4319,4302,4318,4301,4317,274,275,276,4300,4316,4299,4315,4298,4314,4297,4313,4296,4312,4295,4311,242,243,244,4294,4310,4293,4309,4292,4308,4291,4307,4290,4306,4289,4305,4288,4304,210,211,212,178,179,180,146,147,148,114,115,116,82,83,84,50,51,52,8222,8254,8286,8318,8214,8246,8278,8310,8206,8238,8270,8302,8198,8230,8262,8294,18,19,20},{501,502,503,469,470,471,437,438,439,405,406,407,373,374,375,341,342,343,309,310,311,4335,4351,4334,4350,4333,4349,277,278,279,4332,4348,4331,4347,4330,4346,4329,4345,4328,4344,4327,4343,245,246,247,4326,4342,4325,4341,4324,4340,4323,4339,4322,4338,4321,4337,4320,4336,213,214,215,181,182,183,149,150,151,117,118,119,85,86,87,53,54,55,8223,8255,8287,8319,8215,8247,8279,8311,8207,8239,8271,8303,8199,8231,8263,8295,21,22,23}};
constexpr int MIXA_K = 5;
__device__ const int MIXA_TAB[256][5] = {{12288,192,416,-1,-1},{12289,193,417,-1,-1},{12290,194,418,-1,-1},{12291,195,419,-1,-1},{12292,196,420,-1,-1},{12293,197,421,-1,-1},{12294,198,422,-1,-1},{12295,199,423,-1,-1},{12296,200,424,-1,-1},{12297,201,425,-1,-1},{12298,202,426,-1,-1},{12299,203,427,-1,-1},{12300,204,428,-1,-1},{12301,205,429,-1,-1},{12302,206,430,-1,-1},{12303,207,431,-1,-1},{12304,208,432,-1,-1},{12305,209,433,-1,-1},{12306,210,434,-1,-1},{12307,211,435,-1,-1},{12308,212,436,-1,-1},{12309,213,437,-1,-1},{12310,214,438,-1,-1},{12311,215,439,-1,-1},{12312,216,440,-1,-1},{12313,217,441,-1,-1},{12314,218,442,-1,-1},{12315,219,443,-1,-1},{12316,220,444,-1,-1},{12317,221,445,-1,-1},{12318,222,446,-1,-1},{12319,223,447,-1,-1},{4096,4320,-1,-1,-1},{4097,4321,-1,-1,-1},{4098,4322,-1,-1,-1},{4099,4323,-1,-1,-1},{4100,4324,-1,-1,-1},{4101,4325,-1,-1,-1},{4102,4326,-1,-1,-1},{4103,4327,-1,-1,-1},{4104,4328,-1,-1,-1},{4105,4329,-1,-1,-1},{4106,4330,-1,-1,-1},{4107,4331,-1,-1,-1},{4108,4332,-1,-1,-1},{4109,4333,-1,-1,-1},{4110,4334,-1,-1,-1},{4111,4335,-1,-1,-1},{4112,4336,-1,-1,-1},{4113,4337,-1,-1,-1},{4114,4338,-1,-1,-1},{4115,4339,-1,-1,-1},{4116,4340,-1,-1,-1},{4117,4341,-1,-1,-1},{4118,4342,-1,-1,-1},{4119,4343,-1,-1,-1},{4120,4344,-1,-1,-1},{4121,4345,-1,-1,-1},{4122,4346,-1,-1,-1},{4123,4347,-1,-1,-1},{4124,4348,-1,-1,-1},{4125,4349,-1,-1,-1},{4126,4350,-1,-1,-1},{4127,4351,-1,-1,-1},{4128,0,224,448,-1},{4129,1,225,449,-1},{4130,2,226,450,-1},{4131,3,227,451,-1},{4132,4,228,452,-1},{4133,5,229,453,-1},{4134,6,230,454,-1},{4135,7,231,455,-1},{4136,8,232,456,-1},{4137,9,233,457,-1},{4138,10,234,458,-1},{4139,11,235,459,-1},{4140,12,236,460,-1},{4141,13,237,461,-1},{4142,14,238,462,-1},{4143,15,239,463,-1},{4144,16,240,464,-1},{4145,17,241,465,-1},{4146,18,242,466,-1},{4147,19,243,467,-1},{4148,20,244,468,-1},{4149,21,245,469,-1},{4150,22,246,470,-1},{4151,23,247,471,-1},{4152,24,248,472,-1},{4153,25,249,473,-1},{4154,26,250,474,-1},{4155,27,251,475,-1},{4156,28,252,476,-1},{4157,29,253,477,-1},{4158,30,254,478,-1},{4159,31,255,479,-1},{4160,32,256,480,-1},{4161,33,257,481,-1},{4162,34,258,482,-1},{4163,35,259,483,-1},{4164,36,260,484,-1},{4165,37,261,485,-1},{4166,38,262,486,-1},{4167,39,263,487,-1},{4168,40,264,488,-1},{4169,41,265,489,-1},{4170,42,266,490,-1},{4171,43,267,491,-1},{4172,44,268,492,-1},{4173,45,269,493,-1},{4174,46,270,494,-1},{4175,47,271,495,-1},{4176,48,272,496,-1},{4177,49,273,497,-1},{4178,50,274,498,-1},{4179,51,275,499,-1},{4180,52,276,500,-1},{4181,53,277,501,-1},{4182,54,278,502,-1},{4183,55,279,503,-1},{4184,56,280,504,-1},{4185,57,281,505,-1},{4186,58,282,506,-1},{4187,59,283,507,-1},{4188,60,284,508,-1},{4189,61,285,509,-1},{4190,62,286,510,-1},{4191,63,287,511,-1},{4192,64,288,8192,8320},{4193,65,289,8193,8321},{4194,66,290,8194,8322},{4195,67,291,8195,8323},{4196,68,292,8196,8324},{4197,69,293,8197,8325},{4198,70,294,8198,8326},{4199,71,295,8199,8327},{4200,72,296,8200,8328},{4201,73,297,8201,8329},{4202,74,298,8202,8330},{4203,75,299,8203,8331},{4204,76,300,8204,8332},{4205,77,301,8205,8333},{4206,78,302,8206,8334},{4207,79,303,8207,8335},{4208,80,304,8208,8336},{4209,81,305,8209,8337},{4210,82,306,8210,8338},{4211,83,307,8211,8339},{4212,84,308,8212,8340},{4213,85,309,8213,8341},{4214,86,310,8214,8342},{4215,87,311,8215,8343},{4216,88,312,8216,8344},{4217,89,313,8217,8345},{4218,90,314,8218,8346},{4219,91,315,8219,8347},{4220,92,316,8220,8348},{4221,93,317,8221,8349},{4222,94,318,8222,8350},{4223,95,319,8223,8351},{4224,96,320,8224,8352},{4225,97,321,8225,8353},{4226,98,322,8226,8354},{4227,99,323,8227,8355},{4228,100,324,8228,8356},{4229,101,325,8229,8357},{4230,102,326,8230,8358},{4231,103,327,8231,8359},{4232,104,328,8232,8360},{4233,105,329,8233,8361},{4234,106,330,8234,8362},{4235,107,331,8235,8363},{4236,108,332,8236,8364},{4237,109,333,8237,8365},{4238,110,334,8238,8366},{4239,111,335,8239,8367},{4240,112,336,8240,8368},{4241,113,337,8241,8369},{4242,114,338,8242,8370},{4243,115,339,8243,8371},{4244,116,340,8244,8372},{4245,117,341,8245,8373},{4246,118,342,8246,8374},{4247,119,343,8247,8375},{4248,120,344,8248,8376},{4249,121,345,8249,8377},{4250,122,346,8250,8378},{4251,123,347,8251,8379},{4252,124,348,8252,8380},{4253,125,349,8253,8381},{4254,126,350,8254,8382},{4255,127,351,8255,8383},{4256,128,352,8256,-1},{4257,129,353,8257,-1},{4258,130,354,8258,-1},{4259,131,355,8259,-1},{4260,132,356,8260,-1},{4261,133,357,8261,-1},{4262,134,358,8262,-1},{4263,135,359,8263,-1},{4264,136,360,8264,-1},{4265,137,361,8265,-1},{4266,138,362,8266,-1},{4267,139,363,8267,-1},{4268,140,364,8268,-1},{4269,141,365,8269,-1},{4270,142,366,8270,-1},{4271,143,367,8271,-1},{4272,144,368,8272,-1},{4273,145,369,8273,-1},{4274,146,370,8274,-1},{4275,147,371,8275,-1},{4276,148,372,8276,-1},{4277,149,373,8277,-1},{4278,150,374,8278,-1},{4279,151,375,8279,-1},{4280,152,376,8280,-1},{4281,153,377,8281,-1},{4282,154,378,8282,-1},{4283,155,379,8283,-1},{4284,156,380,8284,-1},{4285,157,381,8285,-1},{4286,158,382,8286,-1},{4287,159,383,8287,-1},{4288,160,384,8288,-1},{4289,161,385,8289,-1},{4290,162,386,8290,-1},{4291,163,387,8291,-1},{4292,164,388,8292,-1},{4293,165,389,8293,-1},{4294,166,390,8294,-1},{4295,167,391,8295,-1},{4296,168,392,8296,-1},{4297,169,393,8297,-1},{4298,170,394,8298,-1},{4299,171,395,8299,-1},{4300,172,396,8300,-1},{4301,173,397,8301,-1},{4302,174,398,8302,-1},{4303,175,399,8303,-1},{4304,176,400,8304,-1},{4305,177,401,8305,-1},{4306,178,402,8306,-1},{4307,179,403,8307,-1},{4308,180,404,8308,-1},{4309,181,405,8309,-1},{4310,182,406,8310,-1},{4311,183,407,8311,-1},{4312,184,408,8312,-1},{4313,185,409,8313,-1},{4314,186,410,8314,-1},{4315,187,411,8315,-1},{4316,188,412,8316,-1},{4317,189,413,8317,-1},{4318,190,414,8318,-1},{4319,191,415,8319,-1}};
constexpr int MIXA0_K = 5;
__device__ const int MIXA0_TAB[256][5] = {{12288,128,320,-1,-1},{12289,129,321,-1,-1},{12290,130,322,-1,-1},{12291,131,323,-1,-1},{12292,132,324,-1,-1},{12293,133,325,-1,-1},{12294,134,326,-1,-1},{12295,135,327,-1,-1},{12296,136,328,-1,-1},{12297,137,329,-1,-1},{12298,138,330,-1,-1},{12299,139,331,-1,-1},{12300,140,332,-1,-1},{12301,141,333,-1,-1},{12302,142,334,-1,-1},{12303,143,335,-1,-1},{12304,144,336,-1,-1},{12305,145,337,-1,-1},{12306,146,338,-1,-1},{12307,147,339,-1,-1},{12308,148,340,-1,-1},{12309,149,341,-1,-1},{12310,150,342,-1,-1},{12311,151,343,-1,-1},{12312,152,344,-1,-1},{12313,153,345,-1,-1},{12314,154,346,-1,-1},{12315,155,347,-1,-1},{12316,156,348,-1,-1},{12317,157,349,-1,-1},{12318,158,350,-1,-1},{12319,159,351,-1,-1},{16384,160,352,-1,-1},{16385,161,353,-1,-1},{16386,162,354,-1,-1},{16387,163,355,-1,-1},{16388,164,356,-1,-1},{16389,165,357,-1,-1},{16390,166,358,-1,-1},{16391,167,359,-1,-1},{16392,168,360,-1,-1},{16393,169,361,-1,-1},{16394,170,362,-1,-1},{16395,171,363,-1,-1},{16396,172,364,-1,-1},{16397,173,365,-1,-1},{16398,174,366,-1,-1},{16399,175,367,-1,-1},{16400,176,368,-1,-1},{16401,177,369,-1,-1},{16402,178,370,-1,-1},{16403,179,371,-1,-1},{16404,180,372,-1,-1},{16405,181,373,-1,-1},{16406,182,374,-1,-1},{16407,183,375,-1,-1},{16408,184,376,-1,-1},{16409,185,377,-1,-1},{16410,186,378,-1,-1},{16411,187,379,-1,-1},{16412,188,380,-1,-1},{16413,189,381,-1,-1},{16414,190,382,-1,-1},{16415,191,383,-1,-1},{4096,4288,8192,8256,8320},{4097,4289,8193,8257,8321},{4098,4290,8194,8258,8322},{4099,4291,8195,8259,8323},{4100,4292,8196,8260,8324},{4101,4293,8197,8261,8325},{4102,4294,8198,8262,8326},{4103,4295,8199,8263,8327},{4104,4296,8200,8264,8328},{4105,4297,8201,8265,8329},{4106,4298,8202,8266,8330},{4107,4299,8203,8267,8331},{4108,4300,8204,8268,8332},{4109,4301,8205,8269,8333},{4110,4302,8206,8270,8334},{4111,4303,8207,8271,8335},{4112,4304,8208,8272,8336},{4113,4305,8209,8273,8337},{4114,4306,8210,8274,8338},{4115,4307,8211,8275,8339},{4116,4308,8212,8276,8340},{4117,4309,8213,8277,8341},{4118,4310,8214,8278,8342},{4119,4311,8215,8279,8343},{4120,4312,8216,8280,8344},{4121,4313,8217,8281,8345},{4122,4314,8218,8282,8346},{4123,4315,8219,8283,8347},{4124,4316,8220,8284,8348},{4125,4317,8221,8285,8349},{4126,4318,8222,8286,8350},{4127,4319,8223,8287,8351},{4128,4320,8224,8288,8352},{4129,4321,8225,8289,8353},{4130,4322,8226,8290,8354},{4131,4323,8227,8291,8355},{4132,4324,8228,8292,8356},{4133,4325,8229,8293,8357},{4134,4326,8230,8294,8358},{4135,4327,8231,8295,8359},{4136,4328,8232,8296,8360},{4137,4329,8233,8297,8361},{4138,4330,8234,8298,8362},{4139,4331,8235,8299,8363},{4140,4332,8236,8300,8364},{4141,4333,8237,8301,8365},{4142,4334,8238,8302,8366},{4143,4335,8239,8303,8367},{4144,4336,8240,8304,8368},{4145,4337,8241,8305,8369},{4146,4338,8242,8306,8370},{4147,4339,8243,8307,8371},{4148,4340,8244,8308,8372},{4149,4341,8245,8309,8373},{4150,4342,8246,8310,8374},{4151,4343,8247,8311,8375},{4152,4344,8248,8312,8376},{4153,4345,8249,8313,8377},{4154,4346,8250,8314,8378},{4155,4347,8251,8315,8379},{4156,4348,8252,8316,8380},{4157,4349,8253,8317,8381},{4158,4350,8254,8318,8382},{4159,4351,8255,8319,8383},{4160,0,192,384,-1},{4161,1,193,385,-1},{4162,2,194,386,-1},{4163,3,195,387,-1},{4164,4,196,388,-1},{4165,5,197,389,-1},{4166,6,198,390,-1},{4167,7,199,391,-1},{4168,8,200,392,-1},{4169,9,201,393,-1},{4170,10,202,394,-1},{4171,11,203,395,-1},{4172,12,204,396,-1},{4173,13,205,397,-1},{4174,14,206,398,-1},{4175,15,207,399,-1},{4176,16,208,400,-1},{4177,17,209,401,-1},{4178,18,210,402,-1},{4179,19,211,403,-1},{4180,20,212,404,-1},{4181,21,213,405,-1},{4182,22,214,406,-1},{4183,23,215,407,-1},{4184,24,216,408,-1},{4185,25,217,409,-1},{4186,26,218,410,-1},{4187,27,219,411,-1},{4188,28,220,412,-1},{4189,29,221,413,-1},{4190,30,222,414,-1},{4191,31,223,415,-1},{4192,32,224,416,-1},{4193,33,225,417,-1},{4194,34,226,418,-1},{4195,35,227,419,-1},{4196,36,228,420,-1},{4197,37,229,421,-1},{4198,38,230,422,-1},{4199,39,231,423,-1},{4200,40,232,424,-1},{4201,41,233,425,-1},{4202,42,234,426,-1},{4203,43,235,427,-1},{4204,44,236,428,-1},{4205,45,237,429,-1},{4206,46,238,430,-1},{4207,47,239,431,-1},{4208,48,240,432,-1},{4209,49,241,433,-1},{4210,50,242,434,-1},{4211,51,243,435,-1},{4212,52,244,436,-1},{4213,53,245,437,-1},{4214,54,246,438,-1},{4215,55,247,439,-1},{4216,56,248,440,-1},{4217,57,249,441,-1},{4218,58,250,442,-1},{4219,59,251,443,-1},{4220,60,252,444,-1},{4221,61,253,445,-1},{4222,62,254,446,-1},{4223,63,255,447,-1},{4224,64,256,448,-1},{4225,65,257,449,-1},{4226,66,258,450,-1},{4227,67,259,451,-1},{4228,68,260,452,-1},{4229,69,261,453,-1},{4230,70,262,454,-1},{4231,71,263,455,-1},{4232,72,264,456,-1},{4233,73,265,457,-1},{4234,74,266,458,-1},{4235,75,267,459,-1},{4236,76,268,460,-1},{4237,77,269,461,-1},{4238,78,270,462,-1},{4239,79,271,463,-1},{4240,80,272,464,-1},{4241,81,273,465,-1},{4242,82,274,466,-1},{4243,83,275,467,-1},{4244,84,276,468,-1},{4245,85,277,469,-1},{4246,86,278,470,-1},{4247,87,279,471,-1},{4248,88,280,472,-1},{4249,89,281,473,-1},{4250,90,282,474,-1},{4251,91,283,475,-1},{4252,92,284,476,-1},{4253,93,285,477,-1},{4254,94,286,478,-1},{4255,95,287,479,-1},{4256,96,288,480,-1},{4257,97,289,481,-1},{4258,98,290,482,-1},{4259,99,291,483,-1},{4260,100,292,484,-1},{4261,101,293,485,-1},{4262,102,294,486,-1},{4263,103,295,487,-1},{4264,104,296,488,-1},{4265,105,297,489,-1},{4266,106,298,490,-1},{4267,107,299,491,-1},{4268,108,300,492,-1},{4269,109,301,493,-1},{4270,110,302,494,-1},{4271,111,303,495,-1},{4272,112,304,496,-1},{4273,113,305,497,-1},{4274,114,306,498,-1},{4275,115,307,499,-1},{4276,116,308,500,-1},{4277,117,309,501,-1},{4278,118,310,502,-1},{4279,119,311,503,-1},{4280,120,312,504,-1},{4281,121,313,505,-1},{4282,122,314,506,-1},{4283,123,315,507,-1},{4284,124,316,508,-1},{4285,125,317,509,-1},{4286,126,318,510,-1},{4287,127,319,511,-1}};
typedef short bf16x8 __attribute__((ext_vector_type(8)));
typedef unsigned u32x4 __attribute__((ext_vector_type(4)));
typedef unsigned u32x2 __attribute__((ext_vector_type(2)));
typedef short s16x4 __attribute__((ext_vector_type(4)));
typedef float f32x16 __attribute__((ext_vector_type(16)));
typedef float f32x4v __attribute__((ext_vector_type(4)));
typedef float f32x2_t __attribute__((ext_vector_type(2)));
typedef __bf16 bf16x2_t __attribute__((ext_vector_type(2)));
__device__ __forceinline__ unsigned cvtpk(float lo, float hi) { f32x2_t v = {lo, hi}; bf16x2_t b = __builtin_convertvector(v, bf16x2_t); return __builtin_bit_cast(unsigned, b); }
__device__ __forceinline__ bf16x8 pack8(float a0, float a1, float a2, float a3, float a4, float a5, float a6, float a7) {
    u32x4 u; u.x = cvtpk(a0, a1); u.y = cvtpk(a2, a3); u.z = cvtpk(a4, a5); u.w = cvtpk(a6, a7); return __builtin_bit_cast(bf16x8, u);
}
#define MFMA32(a, b, c) __builtin_amdgcn_mfma_f32_32x32x16_bf16((a), (b), (c), 0, 0, 0)

__device__ __forceinline__ void tr64_item(const bf16* src, size_t ld, bf16* dst, size_t ldt, LAS bf16* scr, int lane) {
#pragma unroll
    for (int i = 0; i < 8; ++i) { const int row = 8 * i + (lane >> 3), ch = lane & 7; const u32x4 v = *(const u32x4*)(src + (size_t)row * ld + ch * 8);
        LAS unsigned* w = (LAS unsigned*)(scr + row * 66 + ch * 8); w[0] = v.x; w[1] = v.y; w[2] = v.z; w[3] = v.w; }
    __builtin_amdgcn_s_waitcnt(0xc07f); asm volatile("" ::: "memory");
#pragma unroll
    for (int i = 0; i < 8; ++i) { const int c = 8 * i + (lane >> 3), tch = lane & 7;
        unsigned short e[8];
#pragma unroll
        for (int k = 0; k < 8; ++k) e[k] = scr[(tch * 8 + k) * 66 + c];
        u32x4 o; o.x = e[0] | ((unsigned)e[1] << 16); o.y = e[2] | ((unsigned)e[3] << 16); o.z = e[4] | ((unsigned)e[5] << 16); o.w = e[6] | ((unsigned)e[7] << 16);
        *(u32x4*)(dst + (size_t)c * ldt + tch * 8) = o; }
    __builtin_amdgcn_s_waitcnt(0xc07f); asm volatile("" ::: "memory");
}
__device__ __forceinline__ void ph_mo_vt(const bf16* p, bf16* VT, LAS unsigned char* L, int gw, int NGW, int wave, int lane) {
    LAS bf16* scr = (LAS bf16*)(L + wave * 8448);
    for (int it = gw; it < NB * (T / 64) * 12; it += NGW) {
        const int cb = it % 12, tb = (it / 12) % (T / 64), b = it / (12 * (T / 64));
        const int h = cb >> 1, d0 = (cb & 1) * 64, t0 = tb * 64;
        tr64_item(p + (size_t)(b * T + t0) * NP + C_V + h * 128 + d0, NP, VT + ((size_t)(b * 6 + h) * 128 + d0) * T + t0, T, scr, lane);
    }
}
__device__ __forceinline__ void mo_kmean_unit(const bf16* p, float* kmean, LAS float* Lf, int unit) {
    int tid_ = threadIdx.x; asm volatile("" : "+v"(tid_)); const int tid = tid_;
    const int blk = unit & 7, bh = unit >> 3, b = bh / 6, h = bh % 6, d = tid & 127, part = tid >> 7; float s = 0.f, s1 = 0.f, s2 = 0.f, s3 = 0.f;
#pragma unroll 4
    for (int i = 0; i < 64; i += 4) { const size_t o = (size_t)(b * T + blk * 256 + part * 64 + i) * NP + C_K + h * 128 + d; s += bf2f(p[o]); s1 += bf2f(p[o + NP]); s2 += bf2f(p[o + 2 * (size_t)NP]); s3 += bf2f(p[o + 3 * (size_t)NP]); }
    s = (s + s1) + (s2 + s3);
    __syncthreads(); Lf[tid] = s; __syncthreads();
    if (tid < 128) kmean[(size_t)unit * 128 + tid] = (Lf[tid] + Lf[128 + tid] + Lf[256 + tid] + Lf[384 + tid]) * (1.0f / 256.0f);
}

constexpr int MO_KST = 272, MO_VST = 144;
constexpr int MO_KB = 64 * MO_KST, MO_VB = 128 * MO_VST, MO_GRP = MO_KB + MO_VB;
constexpr int MO_KM_OFF = 4 * MO_GRP;
constexpr int MO_Q_OFF = 73728;
template <int MODE> __device__ __forceinline__ void attn_unit(LAS unsigned char* L, const bf16* p, const bf16* VT, const float* kmean, bf16* y, int unit, const float* rinv = nullptr, const bf16* wqw = nullptr, int ta = 0, int tb = 0, int slot = -1, float* part = nullptr) {
    int tid_ = threadIdx.x; asm volatile("" : "+v"(tid_));
    const int tid = tid_, lane = tid & 63, wave = __builtin_amdgcn_readfirstlane(tid >> 6), grp = wave >> 2, wq = wave & 3, r = lane & 31, hh = lane >> 5, tg = tid & 255;
    constexpr int NH = MODE == 0 ? 6 : 4, LDQ = MODE == 0 ? NP : 512, LDK = MODE == 0 ? NP : 1024, LDV = MODE == 0 ? T : MEM, QC = MODE == 0 ? C_Q : 0, KC = MODE == 0 ? C_K : 0;
    const int qh = MODE == 0 ? unit >> 5 : unit / 16, bh = MODE == 0 ? unit & 31 : unit % 16,   b = bh / NH, h = bh % NH, qb = qh >> 1, half = qh & 1, t0 = qh * 128;
    const int tq = t0 + 32 * wq + r;
    const bf16* prow = p + (size_t)(b * T) * LDQ;
    const bf16* krow = MODE == 0 ? prow : (const bf16*)kmean + (size_t)(b * MEM) * LDK;
    const bf16* vt = VT + (size_t)(b * NH + h) * 128 * LDV;
    LAS float* km = (LAS float*)(L + MO_KM_OFF);
    __syncthreads();
    if (MODE == 0 && qb > 3) for (int e = tid; e < 8 * 128; e += NTHR) km[e] = kmean[(size_t)bh * 8 * 128 + e];
    LAS unsigned char* Qt = L + MO_Q_OFF; bf16x8 qf[8];
    if (MODE == 0) {
#pragma unroll
        for (int ks = 0; ks < 8; ++ks) qf[ks] = *(const bf16x8*)(prow + (size_t)tq * LDQ + QC + h * 128 + 16 * ks + 8 * hh);
    } else {
        constexpr int GST = 144, GTB = 128 * GST, GSTG = 2 * GTB;
        const bf16* xg = p + (size_t)(b * T + t0) * D; const bf16* wg = wqw + (size_t)(h * 128) * D;
        const int wd = wave >> 2;
        f32x16 acc0, acc1;
#pragma unroll
        for (int q = 0; q < 16; ++q) { acc0[q] = 0.f; acc1[q] = 0.f; }
        u32x4 ra[4][2], rb[4][2];
#define QG_LOAD(set, kt) do { _Pragma("unroll") for (int i_ = 0; i_ < 2; ++i_) { const int c_ = tid + 512 * i_; \
            ra[set][i_] = *(const u32x4*)(wg + (size_t)(c_ >> 3) * D + (kt) * 64 + (c_ & 7) * 8); rb[set][i_] = *(const u32x4*)(xg + (size_t)(c_ >> 3) * D + (kt) * 64 + (c_ & 7) * 8); } } while (0)
#define QG_STORE(set, st) do { _Pragma("unroll") for (int i_ = 0; i_ < 2; ++i_) { const int c_ = tid + 512 * i_; \
            *(LAS u32x4*)(L + (st) * GSTG + (c_ >> 3) * GST + (c_ & 7) * 16) = ra[set][i_]; *(LAS u32x4*)(L + (st) * GSTG + GTB + (c_ >> 3) * GST + (c_ & 7) * 16) = rb[set][i_]; } } while (0)
#define QG_COMPUTE(st) do { const LAS unsigned char* sa = L + (st) * GSTG + (64 * wd + r) * GST + 16 * hh; const LAS unsigned char* sb = L + (st) * GSTG + GTB + (32 * wq + r) * GST + 16 * hh; \
            bf16x8 fb[4], fa0[4], fa1[4]; \
            _Pragma("unroll") for (int ks = 0; ks < 4; ++ks) { fb[ks] = *(const LAS bf16x8*)(sb + 32 * ks); fa0[ks] = *(const LAS bf16x8*)(sa + 32 * ks); fa1[ks] = *(const LAS bf16x8*)(sa + 32 * GST + 32 * ks); } \
            __builtin_amdgcn_sched_group_barrier(0x100, 12, 0); \
            _Pragma("unroll") for (int ks = 0; ks < 4; ++ks) { acc0 = MFMA32(fa0[ks], fb[ks], acc0); acc1 = MFMA32(fa1[ks], fb[ks], acc1); } \
            __builtin_amdgcn_sched_group_barrier(0x008, 8, 0); } while (0)
        QG_LOAD(0, 0); QG_LOAD(1, 1); QG_LOAD(2, 2); QG_LOAD(3, 3);
        QG_STORE(0, 0);
        __syncthreads();
#pragma unroll 1
        for (int kt0 = 0; kt0 < 32; kt0 += 4) {
            const bool more = kt0 + 4 < 32;
            QG_COMPUTE(0); QG_STORE(1, 1); if (more) QG_LOAD(0, kt0 + 4); __syncthreads();
            QG_COMPUTE(1); QG_STORE(2, 0); if (more) QG_LOAD(1, kt0 + 5); __syncthreads();
            QG_COMPUTE(0); QG_STORE(3, 1); if (more) QG_LOAD(2, kt0 + 6); __syncthreads();
            QG_COMPUTE(1); if (more) { QG_STORE(0, 0); QG_LOAD(3, kt0 + 7); } __syncthreads();
        }
#undef QG_COMPUTE
#undef QG_LOAD
#undef QG_STORE
        const float rv = rinv[(size_t)b * T + tq];
#pragma unroll
        for (int g4 = 0; g4 < 4; ++g4) { const int d0 = 64 * wd + 8 * g4 + 4 * hh;
            *(LAS u32x2*)(Qt + (32 * wq + r) * MO_KST + d0 * 2) = (u32x2){cvtpk(acc0[4 * g4] * rv, acc0[4 * g4 + 1] * rv), cvtpk(acc0[4 * g4 + 2] * rv, acc0[4 * g4 + 3] * rv)};
            *(LAS u32x2*)(Qt + (32 * wq + r) * MO_KST + (d0 + 32) * 2) = (u32x2){cvtpk(acc1[4 * g4] * rv, acc1[4 * g4 + 1] * rv), cvtpk(acc1[4 * g4 + 2] * rv, acc1[4 * g4 + 3] * rv)}; }
        __syncthreads();
#pragma unroll
        for (int ks = 0; ks < 8; ++ks) qf[ks] = *(const LAS bf16x8*)(Qt + (32 * wq + r) * MO_KST + 16 * hh + 32 * ks);
    }
    __syncthreads();
#define MO_QF(ks) (qf[ks])
    unsigned mask = 0xffffffffu;
    if (MODE == 0) {
        mask = 0;
        if (qb <= 3) mask = (1u << qb) - 1u;
        else {
            float g[7];
#pragma unroll
            for (int j = 0; j < 7; ++j) g[j] = 0.f;
#pragma unroll
            for (int ks = 0; ks < 8; ++ks) {
                f32x4v k0[7], k1[7];
#pragma unroll
                for (int j = 0; j < 7; ++j) { k0[j] = *(const LAS f32x4v*)(km + 128 * j + 16 * ks + 8 * hh); k1[j] = *(const LAS f32x4v*)(km + 128 * j + 16 * ks + 8 * hh + 4); }
                __builtin_amdgcn_sched_group_barrier(0x100, 14, 0);
                const bf16x8 qv8 = MO_QF(ks);
                const float q0 = bf2f((bf16)qv8[0]), q1 = bf2f((bf16)qv8[1]), q2 = bf2f((bf16)qv8[2]), q3 = bf2f((bf16)qv8[3]), q4 = bf2f((bf16)qv8[4]), q5 = bf2f((bf16)qv8[5]), q6 = bf2f((bf16)qv8[6]), q7 = bf2f((bf16)qv8[7]);
#pragma unroll
                for (int j = 0; j < 7; ++j) g[j] += (q0 * k0[j][0] + q1 * k0[j][1]) + (q2 * k0[j][2] + q3 * k0[j][3]) + (q4 * k1[j][0] + q5 * k1[j][1]) + (q6 * k1[j][2] + q7 * k1[j][3]);
            }
#pragma unroll
            for (int j = 0; j < 7; ++j) g[j] += __shfl_xor(g[j], 32);
#pragma unroll
            for (int pass = 0; pass < 3; ++pass) { float best = -INFINITY; int bi = -1;
#pragma unroll
                for (int j = 0; j < 7; ++j) if (j < qb && !((mask >> j) & 1u) && g[j] > best) { best = g[j]; bi = j; }
                if (bi >= 0) mask |= 1u << bi; }
        }
        mask |= 1u << qb;
    }
    const float LOG2E = 1.4426950408889634f;
    const float c1 = 0.08838834764831845f * LOG2E;
    const float slope = (h == 0) ? 0.25f : (h == 1) ? 0.0625f : (h == 2) ? 0.015625f : (h == 3) ? 0.00390625f : (h == 4) ? 0.5f : 0.125f;
    const float slope2 = MODE == 0 ? slope * LOG2E : 0.f;
    const int nh = MODE == 0 ? (tb - ta) >> 1 : 2, tile0 = (MODE == 0 ? ta : 0) + grp * nh;
    LAS unsigned char* Kt0 = L + grp * 2 * MO_GRP;
    f32x16 O[4];
#pragma unroll
    for (int i = 0; i < 4; ++i)
#pragma unroll
        for (int j = 0; j < 16; ++j) O[i][j] = 0.f;
    float mrun = -1e30f, lsum = 0.f;
    u32x4 kreg[4], vreg[4];
    const bf16* kp_ = krow + (size_t)(tile0 * 64 + (tg >> 4)) * LDK + KC + h * 128 + (tg & 15) * 8; const bf16* vp_ = vt + (size_t)(tg >> 3) * LDV + tile0 * 64 + (tg & 7) * 8;
#define MO_LOAD(ti) do { _Pragma("unroll") for (int i_ = 0; i_ < 4; ++i_) { kreg[i_] = *(const u32x4*)(kp_ + (size_t)(16 * i_) * LDK); vreg[i_] = *(const u32x4*)(vp_ + (size_t)(32 * i_) * LDV); } \
        kp_ += (size_t)64 * LDK; vp_ += 64; } while (0)
#define MO_STORE(st) do { LAS unsigned char* kd_ = Kt0 + (st) * MO_GRP; _Pragma("unroll") for (int i_ = 0; i_ < 4; ++i_) { const int c_ = tg + 256 * i_; \
        *(LAS u32x4*)(kd_ + (c_ >> 4) * MO_KST + (c_ & 15) * 16) = kreg[i_]; \
        LAS unsigned char* vd_ = kd_ + MO_KB + (c_ >> 3) * MO_VST + ((c_ & 7) >> 1) * 32 + (c_ & 1) * 8; *(LAS u32x2*)vd_ = (u32x2){vreg[i_].x, vreg[i_].y}; *(LAS u32x2*)(vd_ + 16) = (u32x2){vreg[i_].z, vreg[i_].w}; } } while (0)
    MO_LOAD(tile0); MO_STORE(0);
    if (nh > 1) MO_LOAD(tile0 + 1);
    __syncthreads();
    for (int i = 0; i < nh; ++i) {
        const int ti = tile0 + i, s0 = ti * 64, j = ti >> 2;
        if (i + 1 < nh) MO_STORE((i + 1) & 1);
        if (i + 2 < nh) MO_LOAD(ti + 2);
        LAS unsigned char* Kt = Kt0 + (i & 1) * MO_GRP; LAS unsigned char* Vt = Kt + MO_KB;
        const bool sel = MODE == 0 ? ((mask >> j) & 1u) : true;
        const bool active = MODE == 0 ? ((__ballot(sel) != 0ull) && (s0 <= t0 + 32 * wq + 31)) : true;
        if (active) {
            f32x16 S0, S1;
#pragma unroll
            for (int q = 0; q < 16; ++q) { S0[q] = 0.f; S1[q] = 0.f; }
            { const LAS unsigned char* kb0 = Kt + r * MO_KST + 16 * hh;
#define MO_KF(blk, ks) (*(const LAS bf16x8*)(kb0 + (blk) * 32 * MO_KST + 32 * (ks)))
              bf16x8 ka0 = MO_KF(0, 0), ka1 = MO_KF(1, 0);
              __builtin_amdgcn_sched_group_barrier(0x100, 2, 0);
#pragma unroll
              for (int ks = 0; ks < 8; ++ks) { bf16x8 kn0 = ka0, kn1 = ka1;
                  if (ks < 7) { kn0 = MO_KF(0, ks + 1); kn1 = MO_KF(1, ks + 1); }
                  S0 = MFMA32(ka0, MO_QF(ks), S0); S1 = MFMA32(ka1, MO_QF(ks), S1);
                  __builtin_amdgcn_sched_group_barrier(0x100, 2, 0); __builtin_amdgcn_sched_group_barrier(0x008, 2, 0);
                  ka0 = kn0; ka1 = kn1; }
#undef MO_KF
            }
            const float base0 = MODE == 0 ? (sel ? slope2 * (float)(s0 + 4 * hh - tq) : -INFINITY) : 0.f, s32 = 32.0f * slope2;
            const bool need_mask = MODE == 0 && (s0 + 63 > t0 + 32 * wq);
            float mx = -INFINITY;
            if (need_mask) {
#pragma unroll
                for (int R = 0; R < 16; ++R) { const int ko = (R & 3) + 8 * (R >> 2); const int sa = s0 + 4 * hh + ko, sb = sa + 32;
                    const float bb = base0 + slope2 * (float)ko; float za = S0[R] * c1 + bb, zb = S1[R] * c1 + (bb + s32);
                    za = (sa <= tq) ? za : -INFINITY; zb = (sb <= tq) ? zb : -INFINITY;
                    S0[R] = za; S1[R] = zb; mx = fmaxf(mx, fmaxf(za, zb)); }
            } else {
#pragma unroll
                for (int R = 0; R < 16; ++R) { const int ko = (R & 3) + 8 * (R >> 2);
                    const float bb = base0 + slope2 * (float)ko; const float za = S0[R] * c1 + bb, zb = S1[R] * c1 + (bb + s32);
                    S0[R] = za; S1[R] = zb; mx = fmaxf(mx, fmaxf(za, zb)); }
            }
            { auto rr = __builtin_amdgcn_permlane32_swap(__float_as_uint(mx), __float_as_uint(mx), false, false); mx = fmaxf(__uint_as_float(rr[0]), __uint_as_float(rr[1])); }
            if (__any(mx > mrun + 8.0f)) {
                const float mnew = fmaxf(mrun, mx), alpha = __builtin_amdgcn_exp2f(mrun - mnew); mrun = mnew; lsum *= alpha;
#pragma unroll
                for (int i2 = 0; i2 < 4; ++i2)
#pragma unroll
                    for (int q = 0; q < 16; ++q) O[i2][q] *= alpha;
            }
            float ps = 0.f;
#pragma unroll
            for (int R = 0; R < 16; ++R) { S0[R] = __builtin_amdgcn_exp2f(S0[R] - mrun); S1[R] = __builtin_amdgcn_exp2f(S1[R] - mrun); ps += S0[R] + S1[R]; }
            lsum += ps;
            const bf16x8 p00 = pack8(S0[0], S0[1], S0[2], S0[3], S0[4], S0[5], S0[6], S0[7]), p01 = pack8(S0[8], S0[9], S0[10], S0[11], S0[12], S0[13], S0[14], S0[15]);
            const bf16x8 p10 = pack8(S1[0], S1[1], S1[2], S1[3], S1[4], S1[5], S1[6], S1[7]), p11 = pack8(S1[8], S1[9], S1[10], S1[11], S1[12], S1[13], S1[14], S1[15]);
            {
                const LAS unsigned char* vbase = Vt + r * MO_VST + 16 * hh;
#define MO_VF(db, f) (*(const LAS bf16x8*)(vbase + (db) * 32 * MO_VST + (f) * 32))
                bf16x8 va0 = MO_VF(0, 0), va1 = MO_VF(0, 1), va2 = MO_VF(0, 2), va3 = MO_VF(0, 3);
                __builtin_amdgcn_sched_group_barrier(0x100, 4, 0);
#pragma unroll
                for (int db = 0; db < 4; ++db) {
                    bf16x8 vb0 = va0, vb1 = va1, vb2 = va2, vb3 = va3;
                    if (db < 3) { vb0 = MO_VF(db + 1, 0); vb1 = MO_VF(db + 1, 1); vb2 = MO_VF(db + 1, 2); vb3 = MO_VF(db + 1, 3); }
                    O[db] = MFMA32(va0, p00, O[db]); O[db] = MFMA32(va1, p01, O[db]); O[db] = MFMA32(va2, p10, O[db]); O[db] = MFMA32(va3, p11, O[db]);
                    __builtin_amdgcn_sched_group_barrier(0x100, 4, 0); __builtin_amdgcn_sched_group_barrier(0x008, 4, 0);
                    va0 = vb0; va1 = vb1; va2 = vb2; va3 = vb3;
                }
            }
        }
        __syncthreads();
    }
    lsum += __shfl_xor(lsum, 32);
    LAS float* X = (LAS float*)L;
    if (grp == 1) {
#pragma unroll
        for (int db = 0; db < 4; ++db)
#pragma unroll
            for (int q = 0; q < 16; ++q) X[(wq * 66 + db * 16 + q) * 64 + lane] = O[db][q];
        X[(wq * 66 + 64) * 64 + lane] = mrun; X[(wq * 66 + 65) * 64 + lane] = lsum;
    }
    __syncthreads();
    if (grp == 0) {
        const float m1 = X[(wq * 66 + 64) * 64 + lane], l1 = X[(wq * 66 + 65) * 64 + lane];
        const float mm = fmaxf(mrun, m1), a0 = __builtin_amdgcn_exp2f(mrun - mm), a1 = __builtin_amdgcn_exp2f(m1 - mm);
        if (MODE == 0 && slot >= 0) {
            float* Xg = part + (size_t)slot * (4 * 66 * 64);
#pragma unroll
            for (int db = 0; db < 4; ++db)
#pragma unroll
                for (int q = 0; q < 16; ++q) Xg[(wq * 66 + db * 16 + q) * 64 + lane] = O[db][q] * a0 + X[(wq * 66 + db * 16 + q) * 64 + lane] * a1;
            Xg[(wq * 66 + 64) * 64 + lane] = mm; Xg[(wq * 66 + 65) * 64 + lane] = lsum * a0 + l1 * a1;
            return;
        }
        const float inv = 1.0f / (lsum * a0 + l1 * a1), s0f = a0 * inv, s1f = a1 * inv;
        const size_t m = (size_t)b * T + tq;
#pragma unroll
        for (int db = 0; db < 4; ++db) { float xv[16];
#pragma unroll
            for (int q = 0; q < 16; ++q) xv[q] = X[(wq * 66 + db * 16 + q) * 64 + lane];
            __builtin_amdgcn_sched_group_barrier(0x100, 16, 0);
#pragma unroll
            for (int q = 0; q < 16; ++q) O[db][q] = O[db][q] * s0f + xv[q] * s1f; }
#pragma unroll
        for (int db = 0; db < 4; ++db)
#pragma unroll
            for (int g4 = 0; g4 < 4; ++g4) { const int d = 32 * db + 8 * g4 + 4 * hh;
                float o[4];
#pragma unroll
                for (int e = 0; e < 4; ++e) o[e] = O[db][4 * g4 + e];
                if (MODE == 0) { const u32x2 zz = *(const u32x2*)(p + m * NP + C_Z + h * 128 + d);
                    const float z0 = bf2f((bf16)(zz.x & 0xffff)), z1 = bf2f((bf16)(zz.x >> 16)), z2 = bf2f((bf16)(zz.y & 0xffff)), z3 = bf2f((bf16)(zz.y >> 16));
                    u32x2 w; w.x = cvtpk(o[0] * silu(z0), o[1] * silu(z1)); w.y = cvtpk(o[2] * silu(z2), o[3] * silu(z3));
                    *(u32x2*)(y + m * D + 1280 + h * 128 + d) = w; }
                else { u32x2 w; w.x = cvtpk(o[0], o[1]); w.y = cvtpk(o[2], o[3]); *(u32x2*)(y + m * 512 + h * 128 + d) = w; } }
    }
#undef MO_LOAD
#undef MO_STORE
#undef MO_QF
}
__device__ __forceinline__ void ph_mo_merge(const float* part, const bf16* p, bf16* y, int gw, int NGW, int lane) {
    const int r = lane & 31, hh = lane >> 5;
    for (int it = gw; it < 192 * 4; it += NGW) { const int pi = it >> 2, wq = it & 3, qh = 15 - pi / 24, bh = pi % 24, b = bh / 6, h = bh % 6;
        const float* X0 = part + (size_t)(2 * pi) * (4 * 66 * 64) + (size_t)wq * 66 * 64 + lane; const float* X1 = X0 + 4 * 66 * 64;
        const float m0 = X0[64 * 64], m1 = X1[64 * 64], l0 = X0[65 * 64], l1 = X1[65 * 64];
        const float mm = fmaxf(m0, m1), a0 = __builtin_amdgcn_exp2f(m0 - mm), a1 = __builtin_amdgcn_exp2f(m1 - mm), inv = 1.0f / (l0 * a0 + l1 * a1);
        const size_t m = (size_t)b * T + qh * 128 + 32 * wq + r;
#pragma unroll
        for (int db = 0; db < 4; ++db)
#pragma unroll
            for (int g4 = 0; g4 < 4; ++g4) { const int d = 32 * db + 8 * g4 + 4 * hh; float o[4];
#pragma unroll
                for (int e = 0; e < 4; ++e) { const int idx = db * 16 + 4 * g4 + e; o[e] = (X0[idx * 64] * a0 + X1[idx * 64] * a1) * inv; }
                const u32x2 zz = *(const u32x2*)(p + m * NP + C_Z + h * 128 + d);
                const float z0 = bf2f((bf16)(zz.x & 0xffff)), z1 = bf2f((bf16)(zz.x >> 16)), z2 = bf2f((bf16)(zz.y & 0xffff)), z3 = bf2f((bf16)(zz.y >> 16));
                u32x2 w; w.x = cvtpk(o[0] * silu(z0), o[1] * silu(z1)); w.y = cvtpk(o[2] * silu(z2), o[3] * silu(z3));
                *(u32x2*)(y + m * D + 1280 + h * 128 + d) = w; }
    }
}
__device__ __forceinline__ void ph_mem_vt(const bf16* KV, bf16* VTm, LAS unsigned char* L, int gw, int NGW, int wave, int lane) {
    LAS bf16* scr = (LAS bf16*)(L + wave * 8448);
    for (int it = gw; it < DEPTH * NB * 4 * 8; it += NGW) {
        const int cb = it & 7, sb = (it >> 3) & 3, b = (it >> 5) & 3, l = it >> 7; const int h = cb >> 1, d0 = (cb & 1) * 64, s0 = sb * 64;
        tr64_item(KV + ((size_t)l * MM + b * MEM + s0) * 1024 + 512 + h * 128 + d0, 1024, VTm + (((size_t)l * 16 + b * 4 + h) * 128 + d0) * MEM + s0, MEM, scr, lane);
    }
}
constexpr int MLC_ST = 272;
constexpr int MLC_B_OFF = 192 * MLC_ST, MLC_VS_OFF = 2 * 192 * MLC_ST, MLC_KS_OFF = MLC_VS_OFF + 64 * 194 * 2, MLC_TB_OFF = MLC_KS_OFF + 64 * 194 * 2;
__device__ __forceinline__ void ml_chunk_unit(LAS unsigned char* L, const bf16* p, const float* gates, const float* cw, const float* cb, const float* wq, const float* wk, const float* wv, const float* bi, const float* bf,
                                              const bf16* xb, const float* rinv, const float* Wg, bf16* Q, bf16* K, bf16* VT, float* Fl, float* Ib, bf16* Cloc, float* nloc, int unit) {
    int tid_ = threadIdx.x; asm volatile("" : "+v"(tid_)); const int tid = tid_, lane = tid & 63, wave = __builtin_amdgcn_readfirstlane(tid >> 6), r = lane & 31, hh = lane >> 5;
    const int c = unit & 15, bh = unit >> 4, b = bh >> 2, h = bh & 3, t0 = c * 128;
    LAS unsigned char* At = L; LAS unsigned char* Bt = L + MLC_B_OFF; LAS bf16* Vs = (LAS bf16*)(L + MLC_VS_OFF); LAS bf16* Ks = (LAS bf16*)(L + MLC_KS_OFF);
    LAS float* Fls = (LAS float*)(L + MLC_TB_OFF); LAS float* wvs = Fls + 128; LAS float* tot = wvs + 128;
    __syncthreads();
    { LAS float* wgi = (LAS float*)L; LAS float* wgf = wgi + 2048; LAS float* part = wgf + 2048;
      for (int k = tid; k < 2048; k += 512) { wgi[k] = Wg[(size_t)k * 8 + h]; wgf[k] = Wg[(size_t)k * 8 + 4 + h]; }
      __syncthreads();
      const int tk = tid >> 2, qd = tid & 3; const bf16* xr = xb + ((size_t)b * T + t0 + tk) * D + qd * 512; float ai = 0.f, af = 0.f;
#pragma unroll 1
      for (int i0 = 0; i0 < 64; i0 += 16) { u32x4 xq[16];
#pragma unroll
      for (int i = 0; i < 16; ++i) xq[i] = *(const u32x4*)(xr + 8 * (i0 + i));
#pragma unroll
      for (int ii = 0; ii < 16; ++ii) { const int i = i0 + ii; const u32x4 xv = xq[ii];
          const f32x4v wi0 = *(const LAS f32x4v*)(wgi + qd * 512 + 8 * i), wi1 = *(const LAS f32x4v*)(wgi + qd * 512 + 8 * i + 4), wf0 = *(const LAS f32x4v*)(wgf + qd * 512 + 8 * i), wf1 = *(const LAS f32x4v*)(wgf + qd * 512 + 8 * i + 4);
          const float x0 = __uint_as_float(xv.x << 16), x1 = __uint_as_float(xv.x & 0xffff0000u), x2 = __uint_as_float(xv.y << 16), x3 = __uint_as_float(xv.y & 0xffff0000u), x4 = __uint_as_float(xv.z << 16), x5 = __uint_as_float(xv.z & 0xffff0000u), x6 = __uint_as_float(xv.w << 16), x7 = __uint_as_float(xv.w & 0xffff0000u);
          ai += (x0 * wi0[0] + x1 * wi0[1]) + (x2 * wi0[2] + x3 * wi0[3]) + (x4 * wi1[0] + x5 * wi1[1]) + (x6 * wi1[2] + x7 * wi1[3]);
          af += (x0 * wf0[0] + x1 * wf0[1]) + (x2 * wf0[2] + x3 * wf0[3]) + (x4 * wf1[0] + x5 * wf1[1]) + (x6 * wf1[2] + x7 * wf1[3]); } }
      ai += __shfl_xor(ai, 1); ai += __shfl_xor(ai, 2); af += __shfl_xor(af, 1); af += __shfl_xor(af, 2);
      if (qd == 0) { const float rv = rinv[(size_t)b * T + t0 + tk]; part[tk] = ai * rv; part[128 + tk] = af * rv; }
      __syncthreads(); }
    float igv = 0.f, inc = 0.f;
    if (tid < 128) { LAS float* part = (LAS float*)L + 4096; const float lf = logsig(part[128 + tid] + bf[h]); igv = part[tid] + bi[h]; inc = lf;
#pragma unroll
        for (int o = 1; o < 64; o <<= 1) { const float v = __shfl_up(inc, o); if (lane >= o) inc += v; }
        if (tid == 63) tot[0] = inc; }
    __syncthreads();
    if (tid < 128) { if (tid >= 64) inc += tot[0]; Fls[tid] = inc; Fl[bh * T + t0 + tid] = inc; Ib[bh * T + t0 + tid] = igv; }
    __syncthreads();
    if (tid < 128) wvs[tid] = fexp(Fls[127] - inc + igv);
    const int j4 = tid % 48, tsub = tid / 48, cc = h * 192 + 4 * j4, jg = h * 48 + j4; const bool worker = tid < 384;
    float cwr[4][4], cbr[4], wqr[16], wkr[16], wvr[16];
#pragma unroll
    for (int e = 0; e < 4; ++e) { cbr[e] = cb[cc + e];
#pragma unroll
        for (int jj = 0; jj < 4; ++jj) cwr[jj][e] = cw[jj * 768 + cc + e]; }
    { const f32x4v* a = (const f32x4v*)(wq + jg * 16); const f32x4v* bq = (const f32x4v*)(wk + jg * 16); const f32x4v* cq = (const f32x4v*)(wv + jg * 16);
#pragma unroll
      for (int e = 0; e < 4; ++e) { const f32x4v x = a[e], y = bq[e], z = cq[e];
#pragma unroll
          for (int o = 0; o < 4; ++o) { wqr[e * 4 + o] = x[o]; wkr[e * 4 + o] = y[o] * 0.07216878364870322f; wvr[e * 4 + o] = z[o]; } } }
#pragma unroll 1
    for (int half = 0; half < 2; ++half) {
        const int ts = t0 + 64 * half;
        if (worker) {
            const int tl0 = 8 * tsub, tfirst = ts + tl0; const size_t m0 = (size_t)b * T + tfirst;
            float xw[3][4];
#pragma unroll
            for (int jj = 0; jj < 3; ++jj) { u32x2 uu = {0u, 0u}; if (tfirst - 3 + jj >= 0) uu = *(const u32x2*)(p + (m0 - 3 + jj) * NP + C_MU + cc);
                xw[jj][0] = __uint_as_float(uu.x << 16); xw[jj][1] = __uint_as_float(uu.x & 0xffff0000u); xw[jj][2] = __uint_as_float(uu.y << 16); xw[jj][3] = __uint_as_float(uu.y & 0xffff0000u); }
            u32x2 un[8];
#pragma unroll
            for (int i = 0; i < 8; ++i) un[i] = *(const u32x2*)(p + (m0 + i) * NP + C_MU + cc);
#pragma unroll
            for (int i = 0; i < 8; ++i) {
                float u4[4] = {__uint_as_float(un[i].x << 16), __uint_as_float(un[i].x & 0xffff0000u), __uint_as_float(un[i].y << 16), __uint_as_float(un[i].y & 0xffff0000u)};
                float uc[4];
#pragma unroll
                for (int e = 0; e < 4; ++e) uc[e] = silu(cbr[e] + cwr[0][e] * xw[0][e] + cwr[1][e] * xw[1][e] + cwr[2][e] * xw[2][e] + cwr[3][e] * u4[e]);
                float q[4], k[4], v[4];
#pragma unroll
                for (int o = 0; o < 4; ++o) { q[o] = uc[0] * wqr[o] + uc[1] * wqr[4 + o] + uc[2] * wqr[8 + o] + uc[3] * wqr[12 + o];
                    k[o] = uc[0] * wkr[o] + uc[1] * wkr[4 + o] + uc[2] * wkr[8 + o] + uc[3] * wkr[12 + o];
                    v[o] = u4[0] * wvr[o] + u4[1] * wvr[4 + o] + u4[2] * wvr[8 + o] + u4[3] * wvr[12 + o]; }
                u32x2 qw, kw; qw.x = cvtpk(q[0], q[1]); qw.y = cvtpk(q[2], q[3]); kw.x = cvtpk(k[0], k[1]); kw.y = cvtpk(k[2], k[3]);
                *(u32x2*)(Q + (m0 + i) * 768 + cc) = qw; *(u32x2*)(K + (m0 + i) * 768 + cc) = kw;
                LAS unsigned* vd = (LAS unsigned*)(Vs + (tl0 + i) * 194 + 4 * j4); vd[0] = cvtpk(v[0], v[1]); vd[1] = cvtpk(v[2], v[3]);
                LAS unsigned* kd = (LAS unsigned*)(Ks + (tl0 + i) * 194 + 4 * j4); kd[0] = kw.x; kd[1] = kw.y;
#pragma unroll
                for (int e = 0; e < 4; ++e) { xw[0][e] = xw[1][e]; xw[1][e] = xw[2][e]; xw[2][e] = u4[e]; }
            }
        }
        __syncthreads();
#pragma unroll 1
        for (int i = 0; i < 3; ++i) {
            const int idx = tid + 512 * i, d = idx >> 3, ch = idx & 7;
            unsigned short ev[8]; float fk[8];
#pragma unroll
            for (int k = 0; k < 8; ++k) { ev[k] = Vs[(ch * 8 + k) * 194 + d]; fk[k] = bf2f(Ks[(ch * 8 + k) * 194 + d]) * wvs[64 * half + ch * 8 + k]; }
            u32x4 ov, ok; ov.x = ev[0] | ((unsigned)ev[1] << 16); ov.y = ev[2] | ((unsigned)ev[3] << 16); ov.z = ev[4] | ((unsigned)ev[5] << 16); ov.w = ev[6] | ((unsigned)ev[7] << 16);
            ok.x = cvtpk(fk[0], fk[1]); ok.y = cvtpk(fk[2], fk[3]); ok.z = cvtpk(fk[4], fk[5]); ok.w = cvtpk(fk[6], fk[7]);
            *(u32x4*)(VT + ((size_t)bh * 192 + d) * T + ts + ch * 8) = ov;
            *(LAS u32x4*)(At + d * MLC_ST + (64 * half + ch * 8) * 2) = ov; *(LAS u32x4*)(Bt + d * MLC_ST + (64 * half + ch * 8) * 2) = ok;
        }
        __syncthreads();
    }
    if (tid < 192) { float s = 0.f; const LAS u32x4* row = (const LAS u32x4*)(Bt + tid * MLC_ST);
#pragma unroll
        for (int k = 0; k < 16; ++k) { const u32x4 v = row[k]; s += ((__uint_as_float(v.x << 16) + __uint_as_float(v.x & 0xffff0000u)) + (__uint_as_float(v.y << 16) + __uint_as_float(v.y & 0xffff0000u))) + ((__uint_as_float(v.z << 16) + __uint_as_float(v.z & 0xffff0000u)) + (__uint_as_float(v.w << 16) + __uint_as_float(v.w & 0xffff0000u))); }
        nloc[(size_t)unit * 192 + tid] = s; }
#pragma unroll 1
    for (int ti = wave; ti < 36; ti += 8) { const int rb = ti / 6, cbk = ti % 6;
        f32x16 acc;
#pragma unroll
        for (int q = 0; q < 16; ++q) acc[q] = 0.f;
#pragma unroll
        for (int kh = 0; kh < 2; ++kh) { bf16x8 fa[4], fb[4];
#pragma unroll
            for (int k2 = 0; k2 < 4; ++k2) { const int ks = 4 * kh + k2; fa[k2] = *(const LAS bf16x8*)(At + (32 * rb + r) * MLC_ST + (16 * ks + 8 * hh) * 2); fb[k2] = *(const LAS bf16x8*)(Bt + (32 * cbk + r) * MLC_ST + (16 * ks + 8 * hh) * 2); }
            __builtin_amdgcn_sched_group_barrier(0x100, 8, 0);
#pragma unroll
            for (int k2 = 0; k2 < 4; ++k2) acc = MFMA32(fa[k2], fb[k2], acc);
            __builtin_amdgcn_sched_group_barrier(0x008, 4, 0); }
        bf16* out = Cloc + ((size_t)unit * 192 + 32 * rb + 4 * hh) * 192 + 32 * cbk + r;
#pragma unroll
        for (int R = 0; R < 16; ++R) out[(size_t)((R & 3) + 8 * (R >> 2)) * 192] = f2bf(acc[R]);
    }
}
constexpr int MLO_KST = 400, MLO_VST = 272;
constexpr int MLO_V_OFF = 128 * MLO_KST, MLO_T_OFF = MLO_V_OFF + 192 * MLO_VST;
__device__ __forceinline__ void ml_out_unit(LAS unsigned char* L, const bf16* Q, const bf16* K, const bf16* VT, const bf16* __restrict__ Cloc, const float* __restrict__ nloc, const float* Fb, const float* Ib, const bf16* p, const float* ng, bf16* y, int unit) {
    int tid_ = threadIdx.x; asm volatile("" : "+v"(tid_)); const int tid = tid_, lane = tid & 63, wave = __builtin_amdgcn_readfirstlane(tid >> 6), r = lane & 31, hh = lane >> 5, tb = wave & 3, dh = wave >> 2;
    const int c = unit & 15, bh = unit >> 4, b = bh >> 2, h = bh & 3, t0 = c * 128;
    LAS unsigned char* Kt = L; LAS unsigned char* Vt = L + MLO_V_OFF; LAS unsigned char* Ct = L;
    LAS float* Fs = (LAS float*)(L + MLO_T_OFF); LAS float* Is = Fs + 128; LAS float* np = Is + 128; LAS float* st = np + 192; LAS float* dcy = st + 512;
    __syncthreads();
    if (tid < 128) { Fs[tid] = Fb[bh * T + t0 + tid]; Is[tid] = Ib[bh * T + t0 + tid]; }
    if (tid == 128) { float d = 1.f; for (int j = c - 1; j >= 0; --j) { dcy[j] = d; d *= fexp(Fb[bh * T + 128 * j + 127]); } }
    const int t = t0 + 32 * tb + r; const size_t m = (size_t)b * T + t;
    bf16x8 qf[12];
#pragma unroll
    for (int ks = 0; ks < 12; ++ks) qf[ks] = *(const bf16x8*)(Q + m * 768 + h * 192 + 16 * ks + 8 * hh);
    __syncthreads();
    f32x16 acc[3];
#pragma unroll
    for (int i = 0; i < 3; ++i)
#pragma unroll
        for (int q = 0; q < 16; ++q) acc[i][q] = 0.f;
    const float Ft = Fs[32 * tb + r], dec = fexp(Ft);
    if (c > 0) {
        const bf16* cbase = Cloc + (size_t)(bh * 16) * 36864 + 8 * tid;
        float a[9][8];
#pragma unroll
        for (int i = 0; i < 9; ++i)
#pragma unroll
            for (int e = 0; e < 8; ++e) a[i][e] = 0.f;
#define MLO_ACC(v, dj) do { _Pragma("unroll") for (int i = 0; i < 9; ++i) { a[i][0] += dj * __uint_as_float(v[i].x << 16); a[i][1] += dj * __uint_as_float(v[i].x & 0xffff0000u); a[i][2] += dj * __uint_as_float(v[i].y << 16); a[i][3] += dj * __uint_as_float(v[i].y & 0xffff0000u); \
            a[i][4] += dj * __uint_as_float(v[i].z << 16); a[i][5] += dj * __uint_as_float(v[i].z & 0xffff0000u); a[i][6] += dj * __uint_as_float(v[i].w << 16); a[i][7] += dj * __uint_as_float(v[i].w & 0xffff0000u); } } while (0)
        int j = 0;
#pragma unroll 1
        for (; j + 1 < c; j += 2) { const float d0 = dcy[j], d1 = dcy[j + 1]; u32x4 v[9], w[9];
#pragma unroll
            for (int i = 0; i < 9; ++i) { v[i] = *(const u32x4*)(cbase + (size_t)j * 36864 + 4096 * i); w[i] = *(const u32x4*)(cbase + (size_t)(j + 1) * 36864 + 4096 * i); }
            MLO_ACC(v, d0); MLO_ACC(w, d1); }
        if (j < c) { const float d0 = dcy[j]; u32x4 v[9];
#pragma unroll
            for (int i = 0; i < 9; ++i) v[i] = *(const u32x4*)(cbase + (size_t)j * 36864 + 4096 * i);
            MLO_ACC(v, d0); }
#undef MLO_ACC
#pragma unroll
        for (int i = 0; i < 9; ++i) { const int e = 8 * (tid + 512 * i), dv = e / 192, dk = e % 192;
            *(LAS u32x4*)(Ct + dv * MLO_KST + dk * 2) = (u32x4){cvtpk(a[i][0], a[i][1]), cvtpk(a[i][2], a[i][3]), cvtpk(a[i][4], a[i][5]), cvtpk(a[i][6], a[i][7])}; }
        if (tid < 192) { float s = 0.f; for (int j2 = 0; j2 < c; ++j2) s += dcy[j2] * nloc[(size_t)(bh * 16 + j2) * 192 + tid]; np[tid] = s; }
    } else { if (tid < 192) np[tid] = 0.f; }
    u32x4 kst[6], vst[6];
#pragma unroll
    for (int i = 0; i < 6; ++i) { const int idx = tid + 512 * i; kst[i] = *(const u32x4*)(K + (size_t)(b * T + t0 + idx / 24) * 768 + h * 192 + (idx % 24) * 8); vst[i] = *(const u32x4*)(VT + ((size_t)bh * 192 + (idx >> 4)) * T + t0 + (idx & 15) * 8); }
    if (c > 0) {
        __syncthreads();
        const LAS unsigned char* cp = Ct + (32 * (3 * dh) + r) * MLO_KST + 16 * hh;
#pragma unroll
        for (int blk = 0; blk < 3; ++blk)
#pragma unroll
            for (int kh = 0; kh < 2; ++kh) { bf16x8 fa[6];
#pragma unroll
                for (int k2 = 0; k2 < 6; ++k2) fa[k2] = *(const LAS bf16x8*)(cp + (32 * blk) * MLO_KST + 32 * (6 * kh + k2));
                __builtin_amdgcn_sched_group_barrier(0x100, 6, 0);
#pragma unroll
                for (int k2 = 0; k2 < 6; ++k2) acc[blk] = MFMA32(fa[k2], qf[6 * kh + k2], acc[blk]);
                __builtin_amdgcn_sched_group_barrier(0x008, 6, 0); }
#pragma unroll
        for (int i = 0; i < 3; ++i)
#pragma unroll
            for (int q = 0; q < 16; ++q) acc[i][q] *= dec;
    }
    float qn = 0.f;
#pragma unroll
    for (int kh = 0; kh < 3; ++kh) { f32x4v n0[4], n1[4];
#pragma unroll
      for (int k2 = 0; k2 < 4; ++k2) { const int ks = 4 * kh + k2; n0[k2] = *(const LAS f32x4v*)(np + 16 * ks + 8 * hh); n1[k2] = *(const LAS f32x4v*)(np + 16 * ks + 8 * hh + 4); }
      __builtin_amdgcn_sched_group_barrier(0x100, 8, 0);
#pragma unroll
      for (int k2 = 0; k2 < 4; ++k2) { const int ks = 4 * kh + k2;
        qn += (bf2f((bf16)qf[ks][0]) * n0[k2][0] + bf2f((bf16)qf[ks][1]) * n0[k2][1]) + (bf2f((bf16)qf[ks][2]) * n0[k2][2] + bf2f((bf16)qf[ks][3]) * n0[k2][3]) + (bf2f((bf16)qf[ks][4]) * n1[k2][0] + bf2f((bf16)qf[ks][5]) * n1[k2][1]) + (bf2f((bf16)qf[ks][6]) * n1[k2][2] + bf2f((bf16)qf[ks][7]) * n1[k2][3]); } }
    qn += __shfl_xor(qn, 32);
    __syncthreads();
#pragma unroll
    for (int i = 0; i < 6; ++i) { const int idx = tid + 512 * i;
        *(LAS u32x4*)(Kt + (idx / 24) * MLO_KST + (idx % 24) * 16) = kst[i];
        LAS unsigned char* vd = Vt + (idx >> 4) * MLO_VST + ((idx & 15) >> 1) * 32 + (idx & 1) * 8; *(LAS u32x2*)vd = (u32x2){vst[i].x, vst[i].y}; *(LAS u32x2*)(vd + 16) = (u32x2){vst[i].z, vst[i].w}; }
    u32x2 og[12];
#pragma unroll
    for (int blk = 0; blk < 3; ++blk)
#pragma unroll
        for (int g4 = 0; g4 < 4; ++g4) og[blk * 4 + g4] = *(const u32x2*)(p + m * NP + C_MO + h * 192 + 32 * (3 * dh + blk) + 8 * g4 + 4 * hh);
    __syncthreads();
    float den = dec * qn, dpart = 0.f;
    for (int kb = 0; kb <= tb; ++kb) {
        f32x16 S;
#pragma unroll
        for (int q = 0; q < 16; ++q) S[q] = 0.f;
        { bf16x8 kf[12];
#pragma unroll
          for (int ks = 0; ks < 12; ++ks) kf[ks] = *(const LAS bf16x8*)(Kt + (32 * kb + r) * MLO_KST + (16 * ks + 8 * hh) * 2);
          __builtin_amdgcn_sched_group_barrier(0x100, 12, 0);
#pragma unroll
          for (int ks = 0; ks < 12; ++ks) S = MFMA32(kf[ks], qf[ks], S);
          __builtin_amdgcn_sched_group_barrier(0x008, 12, 0); }
#pragma unroll
        for (int R = 0; R < 16; ++R) { const int sl = 32 * kb + (R & 3) + 8 * (R >> 2) + 4 * hh; const float wgt = (t0 + sl <= t) ? fexp(Ft - Fs[sl] + Is[sl]) : 0.f; S[R] *= wgt; dpart += S[R]; }
        const bf16x8 p0 = pack8(S[0], S[1], S[2], S[3], S[4], S[5], S[6], S[7]), p1 = pack8(S[8], S[9], S[10], S[11], S[12], S[13], S[14], S[15]);
        { bf16x8 vf[6];
#pragma unroll
          for (int blk = 0; blk < 3; ++blk) { const LAS unsigned char* vrow = Vt + (32 * (3 * dh + blk) + r) * MLO_VST + 16 * hh + 64 * kb; vf[2 * blk] = *(const LAS bf16x8*)vrow; vf[2 * blk + 1] = *(const LAS bf16x8*)(vrow + 32); }
          __builtin_amdgcn_sched_group_barrier(0x100, 6, 0);
#pragma unroll
          for (int blk = 0; blk < 3; ++blk) { acc[blk] = MFMA32(vf[2 * blk], p0, acc[blk]); acc[blk] = MFMA32(vf[2 * blk + 1], p1, acc[blk]); }
          __builtin_amdgcn_sched_group_barrier(0x008, 6, 0); }
    }
    den += dpart + __shfl_xor(dpart, 32);
    const float inv = 1.0f / fmaxf(fabsf(den), 1.0f);
    float s1 = 0.f, s2 = 0.f;
#pragma unroll
    for (int blk = 0; blk < 3; ++blk)
#pragma unroll
        for (int g4 = 0; g4 < 4; ++g4) { const u32x2 oo = og[blk * 4 + g4];
            const float o0 = bf2f((bf16)(oo.x & 0xffff)), o1 = bf2f((bf16)(oo.x >> 16)), o2 = bf2f((bf16)(oo.y & 0xffff)), o3 = bf2f((bf16)(oo.y >> 16));
            float v0 = acc[blk][4 * g4] * inv * sigm(o0), v1 = acc[blk][4 * g4 + 1] * inv * sigm(o1), v2 = acc[blk][4 * g4 + 2] * inv * sigm(o2), v3 = acc[blk][4 * g4 + 3] * inv * sigm(o3);
            acc[blk][4 * g4] = v0; acc[blk][4 * g4 + 1] = v1; acc[blk][4 * g4 + 2] = v2; acc[blk][4 * g4 + 3] = v3;
            s1 += (v0 + v1) + (v2 + v3); s2 += (v0 * v0 + v1 * v1) + (v2 * v2 + v3 * v3); }
    s1 += __shfl_xor(s1, 32); s2 += __shfl_xor(s2, 32);
    if (hh == 0) { st[(dh * 128 + 32 * tb + r) * 2] = s1; st[(dh * 128 + 32 * tb + r) * 2 + 1] = s2; }
    u32x2 zg[12];
#pragma unroll
    for (int blk = 0; blk < 3; ++blk)
#pragma unroll
        for (int g4 = 0; g4 < 4; ++g4) zg[blk * 4 + g4] = *(const u32x2*)(p + m * NP + C_MZ + h * 192 + 32 * (3 * dh + blk) + 8 * g4 + 4 * hh);
    __syncthreads();
    const float t1 = st[(32 * tb + r) * 2] + st[(128 + 32 * tb + r) * 2], t2 = st[(32 * tb + r) * 2 + 1] + st[(128 + 32 * tb + r) * 2 + 1];
    const float mu = t1 * (1.0f / 192.0f), var = fmaxf(t2 * (1.0f / 192.0f) - mu * mu, 0.f), rs = 1.0f / sqrtf(var + LN_EPS);
#pragma unroll
    for (int blk = 0; blk < 3; ++blk)
#pragma unroll
        for (int g4 = 0; g4 < 4; ++g4) { const int d = 32 * (3 * dh + blk) + 8 * g4 + 4 * hh; const u32x2 zz = zg[blk * 4 + g4];
            const float z0 = bf2f((bf16)(zz.x & 0xffff)), z1 = bf2f((bf16)(zz.x >> 16)), z2 = bf2f((bf16)(zz.y & 0xffff)), z3 = bf2f((bf16)(zz.y >> 16));
            const float4 gg = *(const float4*)(ng + h * 192 + d);
            u32x2 w; w.x = cvtpk((acc[blk][4 * g4] - mu) * rs * gg.x * silu(z0), (acc[blk][4 * g4 + 1] - mu) * rs * gg.y * silu(z1));
            w.y = cvtpk((acc[blk][4 * g4 + 2] - mu) * rs * gg.z * silu(z2), (acc[blk][4 * g4 + 3] - mu) * rs * gg.w * silu(z3));
            *(u32x2*)(y + m * D + 512 + h * 192 + d) = w; }
}

#define MFMA16(a, b, c) __builtin_amdgcn_mfma_f32_16x16x32_bf16((a), (b), (c), 0, 0, 0)
__device__ __forceinline__ void ph_lru_sp8(const float* lam, float* sp8, int gt, int NGT) { for (int i = gt; i < DEPTH * 512; i += NGT) { const float e = fexp(-lam[i]); sp8[i] = 8.0f * (e < 0.05f ? e * (1.0f - e * (0.5f - e * (0.33333334f - e * 0.25f))) : 0.6931471805599453f * __builtin_amdgcn_logf(1.0f + e)); } }
__device__ __forceinline__ void ph_lru_wt(const float* wa, const float* wx, bf16* Wt, int gt, int NGT) {
    for (int idx = gt; idx < DEPTH * 2 * 4 * 128 * 128; idx += NGT) {
        const int i = idx & 127, o = (idx >> 7) & 127, g = (idx >> 14) & 3, gate = (idx >> 16) & 1, l = idx >> 17;
        const float* src = gate ? wx : wa;
        Wt[idx] = f2bf(src[(((size_t)l * 4 + g) * 128 + i) * 128 + o]);
    }
}
constexpr int LR_XCB_OFF = 32768, LR_XCB_ST = 1040, LR_A_OFF = LR_XCB_OFF + 16 * LR_XCB_ST, LR_U_OFF = LR_A_OFF + 32768;
__device__ __forceinline__ void lru_unit(LAS unsigned char* L, const bf16* p, const float* cw, const float* cb, const bf16* Wt  , const float* ba, const float* bx, const float* lam,
                                         float* hloc, float* cumA, float* aggA, float* aggH, int unit) {
    int tid_ = threadIdx.x; asm volatile("" : "+v"(tid_)); const int tid = tid_, lane = tid & 63, wave = __builtin_amdgcn_readfirstlane(tid >> 6);
    const int m0 = unit * 16, t0 = m0 % T;
    LAS float* xcf = (LAS float*)L; LAS unsigned char* xcb = L + LR_XCB_OFF; LAS float* As = (LAS float*)(L + LR_A_OFF); LAS float* Us = (LAS float*)(L + LR_U_OFF);
    const int g = wave >> 1, ob = (wave & 1) * 64, fr = lane & 15, kq = lane >> 4;
    bf16x8 bw[2][4][4];
#pragma unroll
    for (int a = 0; a < 2; ++a)
#pragma unroll
        for (int nb = 0; nb < 4; ++nb)
#pragma unroll
            for (int ks = 0; ks < 4; ++ks) bw[a][nb][ks] = *(const bf16x8*)(Wt + ((size_t)(a * 4 + g) * 128 + ob + 16 * nb + fr) * 128 + 32 * ks + 8 * kq);
    __syncthreads();
    { const int c = tid; const float w0 = cw[c], w1 = cw[512 + c], w2 = cw[1024 + c], w3 = cw[1536 + c], bb = cb[c];
      float x0 = (t0 >= 3) ? bf2f(p[(size_t)(m0 - 3) * NP + C_LX + c]) : 0.f, x1 = (t0 >= 2) ? bf2f(p[(size_t)(m0 - 2) * NP + C_LX + c]) : 0.f, x2 = (t0 >= 1) ? bf2f(p[(size_t)(m0 - 1) * NP + C_LX + c]) : 0.f;
#pragma unroll
      for (int t = 0; t < 16; ++t) { const float x3 = bf2f(p[(size_t)(m0 + t) * NP + C_LX + c]); const float s = bb + w0 * x0 + w1 * x1 + w2 * x2 + w3 * x3;
          xcf[t * 512 + c] = s; *(LAS bf16*)(xcb + t * LR_XCB_ST + c * 2) = f2bf(s); x0 = x1; x1 = x2; x2 = x3; } }
    __syncthreads();
    f32x4v acc[2][4];
#pragma unroll
    for (int a = 0; a < 2; ++a)
#pragma unroll
        for (int nb = 0; nb < 4; ++nb) acc[a][nb] = (f32x4v){0.f, 0.f, 0.f, 0.f};
#pragma unroll
    for (int ks = 0; ks < 4; ++ks) {
        const bf16x8 af = *(const LAS bf16x8*)(xcb + fr * LR_XCB_ST + (g * 128 + 32 * ks + 8 * kq) * 2);
#pragma unroll
        for (int a = 0; a < 2; ++a)
#pragma unroll
            for (int nb = 0; nb < 4; ++nb) acc[a][nb] = MFMA16(af, bw[a][nb][ks], acc[a][nb]);
    }
#pragma unroll
    for (int nb = 0; nb < 4; ++nb) { const int c = 64 * wave + 16 * nb + fr; const float bav = ba[c], bxv = bx[c], sp8 = lam[c];
#pragma unroll
        for (int rg = 0; rg < 4; ++rg) { const int t = 4 * kq + rg; const float r = sigm(acc[0][nb][rg] + bav), ig = sigm(acc[1][nb][rg] + bxv);
            const float la = -r * sp8, a = fexp(la), x2 = 2.0f * la, em = -x2 * (1.0f + x2 * (0.5f + x2 * (0.16666667f + x2 * (0.041666668f + x2 * 0.0083333338f)))), u = __builtin_amdgcn_sqrtf(em) * (ig * xcf[t * 512 + c]);
            As[t * 512 + c] = a; Us[t * 512 + c] = u; } }
    __syncthreads();
    { const int c = tid; float h = 0.f, P = 1.f;
#pragma unroll
      for (int t = 0; t < 16; ++t) { const float a = As[t * 512 + c], u = Us[t * 512 + c]; P *= a; h = a * h + u; hloc[(size_t)(m0 + t) * 512 + c] = h; cumA[(size_t)(m0 + t) * 512 + c] = P; }
      aggA[(size_t)unit * 512 + c] = P; aggH[(size_t)unit * 512 + c] = h; }
}
__device__ __forceinline__ void lru_apply_unit(const float* __restrict__ hloc, const float* __restrict__ cumA, const float* __restrict__ aggA, const float* __restrict__ aggH, const bf16* __restrict__ p, bf16* __restrict__ y, int unit) {
    int tid_ = threadIdx.x; asm volatile("" : "+v"(tid_)); const int c = tid_;
    const int b = unit >> 5, grp = unit & 31; float h = 0.f;
    const int nprev = 4 * grp;
#pragma unroll 1
    for (int k0 = 0; k0 < nprev; k0 += 16) { float a[16], hh[16];
#pragma unroll
        for (int k = 0; k < 16; ++k) { const int kk = k0 + k < nprev ? k0 + k : nprev - 1; const size_t o = (size_t)(b * 128 + kk) * 512 + c; a[k] = aggA[o]; hh[k] = aggH[o]; }
#pragma unroll
        for (int k = 0; k < 16; ++k) if (k0 + k < nprev) h = a[k] * h + hh[k]; }
#pragma unroll 1
    for (int k = 4 * grp; k < 4 * grp + 4; ++k) { const size_t m0 = (size_t)b * T + 16 * k;
        float hl[16], ca[16]; unsigned short zz[16];
#pragma unroll
        for (int t = 0; t < 16; ++t) { hl[t] = hloc[(m0 + t) * 512 + c]; ca[t] = cumA[(m0 + t) * 512 + c]; zz[t] = p[(m0 + t) * NP + C_LZ + c]; }
#pragma unroll
        for (int t = 0; t < 16; ++t) y[(m0 + t) * D + c] = f2bf((hl[t] + ca[t] * h) * silu(bf2f(zz[t])));
        const size_t o = (size_t)(b * 128 + k) * 512 + c; h = aggA[o] * h + aggH[o]; }
}
#ifndef R_T0
#define R_T0 1
#endif
#ifndef R_T1
#define R_T1 1
#endif
#ifndef R_T2
#define R_T2 1
#endif
#ifndef R_A1
#define R_A1 1
#endif
#ifndef R_A2
#define R_A2 1
#endif
#ifndef R_A3
#define R_A3 1
#endif
#ifndef R_A4
#define R_A4 1
#endif
#ifndef R_P0
#define R_P0 1
#endif
#ifndef R_KV
#define R_KV 1
#endif
#ifndef R_P1
#define R_P1 1
#endif
#ifndef R_P2A
#define R_P2A 1
#endif
#ifndef R_P2B
#define R_P2B 1
#endif
#ifndef R_P2C
#define R_P2C 1
#endif
#ifndef R_P3
#define R_P3 1
#endif
#ifndef R_X
#define R_X 1
#endif
#ifndef R_WO
#define R_WO 1
#endif
#ifndef R_FIN
#define R_FIN 1
#endif
#define REP(n) _Pragma("unroll 1") for (int rep_ = 0; rep_ < (n); ++rep_)

struct Args { const float* in[26]; float* out; unsigned char* ws; };

__device__ __forceinline__ void ph_wt(const float* W, int ldw, int K, int N, const float* g, bf16* Wt, int mode, float* scr, int gw, int NGW, int lane) {
    const int nblk = N / 32, nitems = (K / 64) * nblk;
    for (int it = gw; it < nitems; it += NGW) {
        const int kb = it / nblk, nb = it % nblk, n0 = nb * 32;
        const int src = (mode == 1 && n0 >= SRC_GATE) ? n0 + 8 : n0;
        wt_item(W, ldw, src, g, Wt, K, n0, scr, kb * 64, lane);
    }
}
__device__ __forceinline__ void ph_gatew(const float* W, const float* g, float* Wg, int gt, int NGT) {
    for (int idx = gt; idx < D * 8; idx += NGT) { const int k = idx >> 3, c = idx & 7; Wg[idx] = g[k] * W[(size_t)k * INC + SRC_GATE + c]; }
}
__device__ __forceinline__ void ph_prep(const float* x, bf16* xb, float* rinv, const float* Wg, float* gates, int nrows, int gw, int NGW, int lane) {
    for (int row = gw; row < nrows; row += NGW) {
        const float4* xr = (const float4*)(x + (size_t)row * D); float4 v[8]; float ss = 0.f;
#pragma unroll
        for (int j = 0; j < 8; ++j) { v[j] = xr[lane + 64 * j]; ss += v[j].x * v[j].x + v[j].y * v[j].y + v[j].z * v[j].z + v[j].w * v[j].w; }
        ss = wave_sum(ss); const float r = 1.0f / sqrtf(ss * (1.0f / D) + RMS_EPS);
        uint2* ob = (uint2*)(xb + (size_t)row * D);
#pragma unroll
        for (int j = 0; j < 8; ++j) { uint2 o; o.x = pk2(v[j].x, v[j].y); o.y = pk2(v[j].z, v[j].w); ob[lane + 64 * j] = o; }
        if (lane == 0) rinv[row] = r;
        if (Wg) {
            float a0 = 0, a1 = 0, a2 = 0, a3 = 0, a4 = 0, a5 = 0, a6 = 0, a7 = 0;
#pragma unroll
            for (int j = 0; j < 8; ++j) {
                const float xe[4] = {v[j].x, v[j].y, v[j].z, v[j].w};
#pragma unroll
                for (int e = 0; e < 4; ++e) { const int k = 4 * (lane + 64 * j) + e; const float4 w0 = *(const float4*)(Wg + (size_t)k * 8), w1 = *(const float4*)(Wg + (size_t)k * 8 + 4);
                    a0 += xe[e] * w0.x; a1 += xe[e] * w0.y; a2 += xe[e] * w0.z; a3 += xe[e] * w0.w; a4 += xe[e] * w1.x; a5 += xe[e] * w1.y; a6 += xe[e] * w1.z; a7 += xe[e] * w1.w; }
            }
            a0 = wave_sum(a0); a1 = wave_sum(a1); a2 = wave_sum(a2); a3 = wave_sum(a3); a4 = wave_sum(a4); a5 = wave_sum(a5); a6 = wave_sum(a6); a7 = wave_sum(a7);
            if (lane == 0) { float4* go = (float4*)(gates + (size_t)row * 8); go[0] = make_float4(a0 * r, a1 * r, a2 * r, a3 * r); go[1] = make_float4(a4 * r, a5 * r, a6 * r, a7 * r); }
        }
    }
}
__device__ __forceinline__ void ph_final(const float* x, const float* g, float* out, int gw, int NGW, int lane) {
    for (int row = gw; row < M; row += NGW) {
        const float4* xr = (const float4*)(x + (size_t)row * D); float4 v[8]; float ss = 0.f;
#pragma unroll
        for (int j = 0; j < 8; ++j) { v[j] = xr[lane + 64 * j]; ss += v[j].x * v[j].x + v[j].y * v[j].y + v[j].z * v[j].z + v[j].w * v[j].w; }
        ss = wave_sum(ss); const float r = 1.0f / sqrtf(ss * (1.0f / D) + RMS_EPS);
        float4* o = (float4*)(out + (size_t)row * D); const float4* gg = (const float4*)g;
#pragma unroll
        for (int j = 0; j < 8; ++j) { const float4 gv = gg[lane + 64 * j]; o[lane + 64 * j] = make_float4(v[j].x * r * gv.x, v[j].y * r * gv.y, v[j].z * r * gv.z, v[j].w * r * gv.w); }
    }
}
__device__ __forceinline__ void ph_final2(const bf16* x, const float* rinv, const float* g, float* out, int gt, int NGT) {
    for (int idx = gt; idx < M * (D / 4); idx += NGT) { const int row = idx >> 9, c4 = idx & 511; const float r = rinv[row];
        const uint2 xv = ((const uint2*)x)[idx]; const float4 gv = ((const float4*)g)[c4];
        ((float4*)out)[idx] = make_float4(__uint_as_float(xv.x << 16) * r * gv.x, __uint_as_float(xv.x & 0xffff0000u) * r * gv.y, __uint_as_float(xv.y << 16) * r * gv.z, __uint_as_float(xv.y & 0xffff0000u) * r * gv.w); }
}
__device__ __forceinline__ void ph_lru_gates(float* xc, const bf16* p, const float* cw, const float* cb, const float* wa, const float* ba, const float* wx, const float* bx, const float* lam, float* A, float* U, int vb, int G, int tid) {
    for (int m = vb; m < M; m += G) {
        const int t = m % T, c = tid;
        { float s = cb[c];
#pragma unroll
          for (int j = 0; j < 4; ++j) { const int tt = t - 3 + j; if (tt >= 0) s += cw[j * 512 + c] * bf2f(p[(size_t)(m - 3 + j) * NP + C_LX + c]); }
          xc[c] = s; }
        __syncthreads();
        { const int g = c >> 7, o = c & 127; float ra = ba[c], ri = bx[c];
          for (int i = 0; i < 128; ++i) { const float xv = xc[g * 128 + i]; ra += xv * wa[(size_t)(g * 128 + i) * 128 + o]; ri += xv * wx[(size_t)(g * 128 + i) * 128 + o]; }
          const float r = sigm(ra), ig = sigm(ri); const float la = -8.0f * r * log1pf(expf(-lam[c])); const float a = expf(la); const float u = sqrtf(-expm1f(2.0f * la)) * (ig * xc[c]);
          A[(size_t)m * 512 + c] = a; U[(size_t)m * 512 + c] = u; }
        __syncthreads();
    }
}
__device__ __forceinline__ void ph_lru_scan(const float* A, const float* U, const bf16* p, bf16* y, int gt) {
    if (gt < NB * 512) { const int b = gt / 512, c = gt % 512; float h = 0.f;
        for (int t = 0; t < T; ++t) { const size_t m = (size_t)b * T + t; h = A[m * 512 + c] * h + U[m * 512 + c]; const float z = bf2f(p[m * NP + C_LZ + c]); y[m * D + c] = f2bf(h * silu(z)); } }
}
__device__ __forceinline__ void ph_ml_prep(const bf16* p, const float* cw, const float* cb, const float* wq, const float* wk, const float* wv, bf16* Q, bf16* K, bf16* V, int gt, int NGT) {
    for (int idx = gt; idx < M * 192; idx += NGT) {
        const int m = idx / 192, j = idx % 192, t = m % T;
        float u4[4], uc[4];
#pragma unroll
        for (int i = 0; i < 4; ++i) { const int c = 4 * j + i; float s = cb[c];
#pragma unroll
            for (int jj = 0; jj < 4; ++jj) { const int tt = t - 3 + jj; if (tt >= 0) s += cw[jj * 768 + c] * bf2f(p[(size_t)(m - 3 + jj) * NP + C_MU + c]); }
            uc[i] = silu(s); u4[i] = bf2f(p[(size_t)m * NP + C_MU + c]); }
        const float ks = 0.07216878364870322f;
#pragma unroll
        for (int o = 0; o < 4; ++o) { float q = 0.f, k = 0.f, v = 0.f;
#pragma unroll
            for (int i = 0; i < 4; ++i) { q += uc[i] * wq[(j * 4 + i) * 4 + o]; k += uc[i] * wk[(j * 4 + i) * 4 + o]; v += u4[i] * wv[(j * 4 + i) * 4 + o]; }
            Q[(size_t)m * 768 + 4 * j + o] = f2bf(q); K[(size_t)m * 768 + 4 * j + o] = f2bf(k * ks); V[(size_t)m * 768 + 4 * j + o] = f2bf(v); }
    }
}
__device__ __forceinline__ void ph_ml_F(const float* gates, const float* bi, const float* bf, float* Fb, float* Ib, int vb, int tid) {
    if (vb < 16 && tid == 0) { const int bh = vb, b = bh >> 2, h = bh & 3; float F = 0.f;
        for (int t = 0; t < T; ++t) { const size_t m = (size_t)b * T + t; F += logsig(gates[m * 8 + 4 + h] + bf[h]); Fb[bh * T + t] = F; Ib[bh * T + t] = gates[m * 8 + h] + bi[h]; } }
}
__device__ __forceinline__ void ph_ml_attn(float* L, const bf16* Q, const bf16* K, const bf16* V, const float* Fb, const float* Ib, const bf16* p, const float* ng, bf16* y, int vb, int G, int tid) {
    float* Qs = L; float* Ks = Qs + 32 * 192; float* Vs = Ks + 32 * 193; float* Ss = Vs + 32 * 192; float* Ft = Ss + 32 * 32; float* Fs = Ft + 32; float* Is = Fs + 32;
    const int r = tid >> 4, cl = tid & 15;
    for (int unit = vb; unit < 16 * 64; unit += G) {
        const int bh = unit >> 6, b = bh >> 2, h = bh & 3, t0 = (unit & 63) * 32;
        __syncthreads();
        for (int e = tid; e < 32 * 192; e += NTHR) { const int rr = e / 192, d = e % 192; Qs[rr * 192 + d] = bf2f(Q[(size_t)(b * T + t0 + rr) * 768 + h * 192 + d]); }
        if (tid < 32) Ft[tid] = Fb[bh * T + t0 + tid];
        float acc[12]; float den = 0.f;
#pragma unroll
        for (int i = 0; i < 12; ++i) acc[i] = 0.f;
        for (int s0 = 0; s0 < t0 + 32; s0 += 32) {
            __syncthreads();
            for (int e = tid; e < 32 * 192; e += NTHR) { const int i = e / 192, d = e % 192; const size_t g = (size_t)(b * T + s0 + i) * 768 + h * 192 + d; Ks[i * 193 + d] = bf2f(K[g]); Vs[i * 192 + d] = bf2f(V[g]); }
            if (tid < 32) { Fs[tid] = Fb[bh * T + s0 + tid]; Is[tid] = Ib[bh * T + s0 + tid]; }
            __syncthreads();
#pragma unroll
            for (int w = 0; w < 2; ++w) { const int s = cl + 16 * w; float dot = 0.f;
                for (int d = 0; d < 192; ++d) dot += Qs[r * 192 + d] * Ks[s * 193 + d];
                const int tt = t0 + r, ss = s0 + s; const float wgt = (ss <= tt) ? expf(Ft[r] - Fs[s] + Is[s]) : 0.f; Ss[r * 32 + s] = dot * wgt; }
            __syncthreads();
            for (int s = 0; s < 32; ++s) { const float sv = Ss[r * 32 + s]; den += sv;
#pragma unroll
                for (int i = 0; i < 12; ++i) acc[i] += sv * Vs[s * 192 + cl + 16 * i]; }
        }
        const float dn = fmaxf(fabsf(den), 1.0f); const size_t m = (size_t)b * T + t0 + r; float hv[12]; float s1 = 0.f;
#pragma unroll
        for (int i = 0; i < 12; ++i) { const int d = cl + 16 * i; hv[i] = acc[i] / dn * sigm(bf2f(p[m * NP + C_MO + h * 192 + d])); s1 += hv[i]; }
        s1 += __shfl_xor(s1, 1); s1 += __shfl_xor(s1, 2); s1 += __shfl_xor(s1, 4); s1 += __shfl_xor(s1, 8);
        const float mu = s1 * (1.0f / 192.0f); float s2 = 0.f;
#pragma unroll
        for (int i = 0; i < 12; ++i) { const float dd = hv[i] - mu; s2 += dd * dd; }
        s2 += __shfl_xor(s2, 1); s2 += __shfl_xor(s2, 2); s2 += __shfl_xor(s2, 4); s2 += __shfl_xor(s2, 8);
        const float rs = 1.0f / sqrtf(s2 * (1.0f / 192.0f) + LN_EPS);
#pragma unroll
        for (int i = 0; i < 12; ++i) { const int d = cl + 16 * i; const float z = bf2f(p[m * NP + C_MZ + h * 192 + d]); y[m * D + 512 + h * 192 + d] = f2bf((hv[i] - mu) * rs * ng[h * 192 + d] * silu(z)); }
    }
}
__device__ __forceinline__ void ph_mo_kmean(const bf16* p, float* kmean, int gt, int NGT) {
    for (int idx = gt; idx < NB * 6 * 8 * 128; idx += NGT) {
        const int d = idx & 127, blk = (idx >> 7) & 7, bh = idx >> 10, b = bh / 6, h = bh % 6; float s = 0.f;
        for (int i = 0; i < 256; ++i) s += bf2f(p[(size_t)(b * T + blk * 256 + i) * NP + C_K + h * 128 + d]);
        kmean[idx] = s * (1.0f / 256.0f);
    }
}
__device__ __forceinline__ void ph_mo_sel(const bf16* p, const float* kmean, unsigned char* sel, int gt, int NGT) {
    for (int idx = gt; idx < NB * 6 * T; idx += NGT) {
        const int t = idx % T, bh = idx / T, b = bh / 6, h = bh % 6, bq = t >> 8;
        const bf16* q = p + (size_t)(b * T + t) * NP + C_Q + h * 128;
        float g0 = 0, g1 = 0, g2 = 0, g3 = 0, g4 = 0, g5 = 0, g6 = 0;
        const float* km = kmean + (size_t)bh * 8 * 128;
        for (int d = 0; d < 128; ++d) { const float qv = bf2f(q[d]); g0 += qv * km[d]; g1 += qv * km[128 + d]; g2 += qv * km[256 + d]; g3 += qv * km[384 + d]; g4 += qv * km[512 + d]; g5 += qv * km[640 + d]; g6 += qv * km[768 + d]; }
        const float gv[7] = {g0, g1, g2, g3, g4, g5, g6};
        unsigned mask = 0;
        if (bq <= 3) mask = (1u << bq) - 1u;
        else {
#pragma unroll
            for (int pass = 0; pass < 3; ++pass) { float best = -INFINITY; int bi = -1;
#pragma unroll
                for (int j = 0; j < 7; ++j) if (j < bq && !((mask >> j) & 1u) && gv[j] > best) { best = gv[j]; bi = j; }
                if (bi >= 0) mask |= 1u << bi; }
        }
        mask |= 1u << bq;
        sel[(size_t)(b * T + t) * 8 + h] = (unsigned char)mask;
    }
}
template <int MODE> __device__ __forceinline__ void ph_attn32(float* L, const bf16* Qp, int ldq, int qcol, const bf16* Kp, const bf16* Vp, int ldk, const unsigned char* sel, const bf16* zp, bf16* outp, int ldo, int ocol, int vb, int G, int tid) {
    float* Qs = L; float* Ks = Qs + 32 * 128; float* Vs = Ks + 32 * 129; float* Ss = Vs + 32 * 128; unsigned* anym = (unsigned*)(Ss + 32 * 32);
    constexpr int NH = MODE == 0 ? 6 : 4; const int r = tid >> 4, cl = tid & 15;
    for (int unit = vb; unit < NB * NH * 64; unit += G) {
        const int bh = unit >> 6, b = bh / NH, h = bh % NH, t0 = (unit & 63) * 32; const size_t m = (size_t)b * T + t0 + r;
        __syncthreads();
        for (int e = tid; e < 32 * 128; e += NTHR) { const int rr = e >> 7, d = e & 127; Qs[rr * 128 + d] = bf2f(Qp[(size_t)(b * T + t0 + rr) * ldq + qcol + h * 128 + d]); }
        unsigned mymask = 0xffffffffu;
        if (MODE == 0) { if (tid == 0) *anym = 0; __syncthreads(); mymask = sel[m * 8 + h]; if (cl == 0) atomicOr(anym, mymask); __syncthreads(); }
        const float scale = 0.08838834764831845f;
        float slope = 0.f;
        if (MODE == 0) { slope = (h == 0) ? 0.25f : (h == 1) ? 0.0625f : (h == 2) ? 0.015625f : (h == 3) ? 0.00390625f : (h == 4) ? 0.5f : 0.125f; }
        float acc[8]; float mrun = -1e30f, l = 0.f;
#pragma unroll
        for (int i = 0; i < 8; ++i) acc[i] = 0.f;
        const int nblk = MODE == 0 ? (t0 >> 8) + 1 : 1; const unsigned am = MODE == 0 ? *anym : 1u;
        const int kbase = MODE == 0 ? b * T : b * MEM;
        for (int j = 0; j < nblk; ++j) {
            if (!((am >> j) & 1u)) continue;
            for (int ch = 0; ch < 8; ++ch) {
                const int s0 = j * 256 + ch * 32; if (MODE == 0 && s0 > t0 + 31) break;
                __syncthreads();
                for (int e = tid; e < 32 * 128; e += NTHR) { const int i = e >> 7, d = e & 127; const size_t g = (size_t)(kbase + s0 + i) * ldk + h * 128 + d; Ks[i * 129 + d] = bf2f(Kp[g]); Vs[i * 128 + d] = bf2f(Vp[g]); }
                __syncthreads();
#pragma unroll
                for (int w = 0; w < 2; ++w) { const int s = cl + 16 * w; float dot = 0.f;
                    for (int d = 0; d < 128; ++d) dot += Qs[r * 128 + d] * Ks[s * 129 + d];
                    float lg = dot * scale;
                    if (MODE == 0) { const int tt = t0 + r, ss = s0 + s; const bool valid = ((mymask >> j) & 1u) && (ss <= tt); lg = valid ? lg - slope * (float)(tt - ss) : -INFINITY; }
                    Ss[r * 32 + s] = lg; }
                __syncthreads();
                float mx = -INFINITY;
                for (int s = 0; s < 32; ++s) mx = fmaxf(mx, Ss[r * 32 + s]);
                const float mnew = fmaxf(mrun, mx); const float corr = expf(mrun - mnew); l *= corr;
#pragma unroll
                for (int i = 0; i < 8; ++i) acc[i] *= corr;
                for (int s = 0; s < 32; ++s) { const float pv = expf(Ss[r * 32 + s] - mnew); l += pv;
#pragma unroll
                    for (int i = 0; i < 8; ++i) acc[i] += pv * Vs[s * 128 + cl + 16 * i]; }
                mrun = mnew;
            }
        }
        const float inv = 1.0f / l;
#pragma unroll
        for (int i = 0; i < 8; ++i) { const int d = cl + 16 * i; float o = acc[i] * inv;
            if (MODE == 0) { const float z = bf2f(zp[m * NP + C_Z + h * 128 + d]); o *= silu(z); }
            outp[m * ldo + ocol + h * 128 + d] = f2bf(o); }
    }
}

struct OneTile { int pm, pn;
    __device__ __forceinline__ bool next(int i, pg8::Unit& u) const { if (i) return false; u.pm = pm; u.pn = pn; return true; }
    __device__ __forceinline__ void a_ready(const pg8::Unit&) const {}
    __device__ __forceinline__ void done(const pg8::Unit&) const {} };
typedef const __attribute__((address_space(4))) Args* kargs_t;
#define PH_VARS \
    kargs_t ap = (kargs_t)__builtin_amdgcn_kernarg_segment_ptr(); asm volatile("" : "+s"(ap)); \
    unsigned char* const ws = ap->ws; (void)ws; \
    int tid = threadIdx.x; asm volatile("" : "+v"(tid)); const int lane = tid & 63, wave = __builtin_amdgcn_readfirstlane(tid >> 6); (void)lane; \
    const int G = gridDim.x, vb = blockIdx.x, gw = vb * NWAVES + wave, NGW = G * NWAVES, gt = vb * NTHR + tid, NGT = G * NTHR; (void)gw; (void)NGW; (void)gt; (void)NGT; \
    float* const Lf = (float*)lds; (void)Lf; LAS unsigned char* const ldsl = (LAS unsigned char*)lds; (void)ldsl;
#define WSP(T, off) ((T*)(ws + (off)))
__global__ void __launch_bounds__(NTHR, 2) mk_fwd(Args a_unused) {
    extern __shared__ __attribute__((aligned(16))) unsigned char lds[];
    { PH_VARS
      for (int u = tid; u < (LDS_BYTES - LDSCTL_OFF) / 4; u += NTHR) ((LAS unsigned*)(ldsl + LDSCTL_OFF))[u] = 0u;
      __syncthreads();
      (void)xcd_barrier_post((unsigned*)(ws + WS_CTL) + CW_BAR, (volatile LAS unsigned*)(ldsl + MISC_OFF) + 8); }
#define GRID_BAR() do { PH_VARS XcdBarrier bar_; bar_.bar = (unsigned*)(ws + WS_CTL) + CW_BAR; bar_.x = xb_xcc_id(); bar_.st = (volatile LAS unsigned*)(ldsl + MISC_OFF) + 8; xcd_barrier(bar_); } while (0)
    REP(R_P0) {
#pragma unroll 1
    for (int l = 0; l < DEPTH; ++l) {
      { PH_VARS float* scr = Lf + wave * (64 * 33); ph_wt(ap->in[3] + (size_t)l * D * INC, INC, D, NP, ap->in[2] + l * D, WSP(bf16, WS_WIN) + (size_t)l * NP * D, 1, scr, gw, NGW, lane); }
      if (l == 0) { PH_VARS ph_lru_wt(ap->in[6], ap->in[8], WSP(bf16, WS_LRUW), gt, NGT); ph_lru_sp8(ap->in[10], WSP(float, WS_SEL), gt, NGT); }
      { PH_VARS ph_gatew(ap->in[3] + (size_t)l * D * INC, ap->in[2] + l * D, WSP(float, WS_WG) + (size_t)l * D * 8, gt, NGT); }
      { PH_VARS float* scr = Lf + wave * (64 * 33); ph_wt(ap->in[19] + (size_t)l * D * D, D, D, D, nullptr, WSP(bf16, WS_WOUT) + (size_t)l * D * D, 0, scr, gw, NGW, lane); }
      { PH_VARS float* scr = Lf + wave * (64 * 33); ph_wt(ap->in[22] + (size_t)l * D * 512, 512, D, 512, ap->in[20] + l * D, WSP(bf16, WS_WQ) + (size_t)l * 512 * D, 0, scr, gw, NGW, lane); }
      { PH_VARS float* scr = Lf + wave * (64 * 33); ph_wt(ap->in[23] + (size_t)l * D * 1024, 1024, D, 1024, ap->in[21] + l * D, WSP(bf16, WS_WKV) + (size_t)l * 1024 * D, 0, scr, gw, NGW, lane); }
      { PH_VARS float* scr = Lf + wave * (64 * 33); ph_wt(ap->in[24] + (size_t)l * 512 * D, D, 512, D, nullptr, WSP(bf16, WS_WO) + (size_t)l * D * 512, 0, scr, gw, NGW, lane); }
    }
    { PH_VARS ph_prep(ap->in[1], WSP(bf16, WS_MEMB), WSP(float, WS_RINVM), nullptr, nullptr, MM, gw, NGW, lane); }
    { PH_VARS ph_prep(ap->in[0], WSP(bf16, WS_XB), WSP(float, WS_RINV), nullptr, nullptr, M, gw, NGW, lane); }
    GRID_BAR();
    }
#pragma unroll 1
    for (int l = 0; l < DEPTH; ++l) {
        REP(R_P1) {
        { PH_VARS pg8::Gemm g{WSP(bf16, WS_XB), WSP(bf16, WS_WIN) + (size_t)l * NP * D, M, NP - 256, D, 0}; EpiScaleBf16 E{WSP(bf16, WS_P), WSP(float, WS_RINV), NP, 0}; pg8::StaticOrder S; S.init(M, NP - 256, G, vb);
          pg8::gemm_phase<EpiScaleBf16, pg8::StaticOrder, true, true>(ldsl, g, S, E); }
        GRID_BAR();
        }
        REP(R_P2A) {
        { PH_VARS
#pragma unroll 1
          for (int i = 0; i < (l == 0 ? MIXA0_K : MIXA_K); ++i) { const int e = l == 0 ? MIXA0_TAB[vb & 255][i] : MIXA_TAB[vb & 255][i < MIXA_K ? i : 0]; if (e < 0) continue; const int ty = e >> 12, unit = e & 4095;
            if (ty == 0) lru_unit(ldsl, WSP(bf16, WS_P), ap->in[4] + l * 4 * 512, ap->in[5] + l * 512, WSP(bf16, WS_LRUW) + (size_t)l * 2 * 4 * 128 * 128, ap->in[7] + l * 512, ap->in[9] + l * 512, WSP(float, WS_SEL) + l * 512, WSP(float, WS_A), WSP(float, WS_U), ap->out + OUT_AGGA, ap->out + OUT_AGGH, unit);
            else if (ty == 1) ml_chunk_unit(ldsl, WSP(bf16, WS_P), nullptr, ap->in[11] + l * 4 * 768, ap->in[12] + l * 768, ap->in[13] + l * 192 * 16, ap->in[14] + l * 192 * 16, ap->in[15] + l * 192 * 16, ap->in[16] + l * 4, ap->in[17] + l * 4, WSP(bf16, WS_XB), WSP(float, WS_RINV), WSP(float, WS_WG) + (size_t)l * D * 8, WSP(bf16, WS_MQ), WSP(bf16, WS_MK), WSP(bf16, WS_MV), WSP(float, WS_F), WSP(float, WS_I), (bf16*)ap->out, ap->out + OUT_NLOC, unit);
            else if (ty == 2) mo_kmean_unit(WSP(bf16, WS_P), WSP(float, WS_KMEAN), (LAS float*)ldsl, unit);
            else if (ty == 3) { __syncthreads(); pg8::Gemm g{WSP(bf16, WS_XB), WSP(bf16, WS_WIN) + (size_t)l * NP * D, M, NP, D, 0}; EpiScaleBf16 E{WSP(bf16, WS_P), WSP(float, WS_RINV), NP, 0}; OneTile S{unit, 24};
                   pg8::gemm_phase<EpiScaleBf16, OneTile, true, true>(ldsl, g, S, E); }
            else { __syncthreads(); const int kl = unit >> 4; pg8::Gemm g{WSP(bf16, WS_MEMB), WSP(bf16, WS_WKV) + (size_t)kl * 1024 * D, MM, 1024, D, 0}; EpiScaleBf16 E{WSP(bf16, WS_KV) + (size_t)kl * MM * 1024, WSP(float, WS_RINVM), 1024, 0}; OneTile S{(unit >> 2) & 3, unit & 3};
                   pg8::gemm_phase<EpiScaleBf16, OneTile, true, true>(ldsl, g, S, E); } } }
        REP(R_A4) { PH_VARS __syncthreads(); ph_mo_vt(WSP(bf16, WS_P), WSP(bf16, WS_MOVT), ldsl, gw, NGW, wave, lane); }
        GRID_BAR();
        }
        REP(R_P2B) {
        if (l == 0) { PH_VARS ph_mem_vt(WSP(bf16, WS_KV), WSP(bf16, WS_VTM), ldsl, gw, NGW, wave, lane); }
        { PH_VARS
          unsigned* qcnt = (unsigned*)(ws + WS_CTL) + CW_QUEUE + ((l * 2 + rep_) * 8 + (vb & 7)) * 64; volatile LAS unsigned* qslot = (volatile LAS unsigned*)(ldsl + MISC_OFF) + 16;
#pragma unroll 1
          for (;;) {
            __syncthreads();
            if (tid == 0) *qslot = __hip_atomic_fetch_add(qcnt, 1u, __ATOMIC_RELAXED, __HIP_MEMORY_SCOPE_AGENT);
            __syncthreads();
            const unsigned k = *qslot; if (k >= (unsigned)MIXQ_N) break;
            const int e = MIXQ_TAB[vb & 7][k], ty = e >> 12, unit = e & 4095;
            if (ty == 0) attn_unit<0>(ldsl, WSP(bf16, WS_P), WSP(bf16, WS_MOVT), WSP(float, WS_KMEAN), WSP(bf16, WS_Y), unit, nullptr, nullptr, 0, 2 * ((unit >> 5) + 1));
            else if (ty == 1) ml_out_unit(ldsl, WSP(bf16, WS_MQ), WSP(bf16, WS_MK), WSP(bf16, WS_MV), (const bf16*)ap->out, ap->out + OUT_NLOC, WSP(float, WS_F), WSP(float, WS_I), WSP(bf16, WS_P), ap->in[18] + l * 768, WSP(bf16, WS_Y), unit);
            else lru_apply_unit(WSP(float, WS_A), WSP(float, WS_U), ap->out + OUT_AGGA, ap->out + OUT_AGGH, WSP(bf16, WS_P), WSP(bf16, WS_Y), unit); } }
        GRID_BAR();
        }
        REP(R_P3 - 1) { PH_VARS pg8::Gemm g{WSP(bf16, WS_Y), WSP(bf16, WS_WOUT) + (size_t)l * D * D, M, D, D, 0};
          EpiResPart<true> E{ap->in[0], (bf16*)(ws + WS_XRES + 20000000), WSP(float, WS_A), (unsigned*)(ws + WS_CTL) + 16384 + (l * 2 + 0) * 2048 + 64 * 32 * rep_, WSP(float, WS_U), D, 0}; pg8::StaticOrder S; S.init(M, D, G, vb);
          pg8::gemm_phase<EpiResPart<true>, pg8::StaticOrder, true, true>(ldsl, g, S, E); GRID_BAR(); }
        if (l == 0) { PH_VARS pg8::Gemm g{WSP(bf16, WS_Y), WSP(bf16, WS_WOUT) + (size_t)l * D * D, M, D, D, 0};
          EpiResPart<true> E{ap->in[0], WSP(bf16, WS_XB), ap->out + OUT_PART, (unsigned*)(ws + WS_CTL) + CW_PANEL + (l * 2 + 0) * 2048, WSP(float, WS_RINV), D, 0}; pg8::StaticOrder S; S.init(M, D, G, vb);
          pg8::gemm_phase<EpiResPart<true>, pg8::StaticOrder, true, true>(ldsl, g, S, E); }
        else { PH_VARS pg8::Gemm g{WSP(bf16, WS_Y), WSP(bf16, WS_WOUT) + (size_t)l * D * D, M, D, D, 0};
          EpiResPart<false> E{WSP(bf16, WS_XB), WSP(bf16, WS_XB), ap->out + OUT_PART, (unsigned*)(ws + WS_CTL) + CW_PANEL + (l * 2 + 0) * 2048, WSP(float, WS_RINV), D, 0}; pg8::StaticOrder S; S.init(M, D, G, vb);
          pg8::gemm_phase<EpiResPart<false>, pg8::StaticOrder, true, true>(ldsl, g, S, E); }
        GRID_BAR();
        REP(R_X) {
        { PH_VARS const bf16* kvl = WSP(bf16, WS_KV) + (size_t)l * MM * 1024; for (int unit = vb; unit < 256; unit += G) attn_unit<1>(ldsl, WSP(bf16, WS_XB), WSP(bf16, WS_VTM) + (size_t)l * 16 * 128 * MEM, (const float*)kvl, WSP(bf16, WS_XO), unit, WSP(float, WS_RINV), WSP(bf16, WS_WQ) + (size_t)l * 512 * D); }
        GRID_BAR();
        }
        REP(R_WO - 1) { PH_VARS pg8::Gemm g{WSP(bf16, WS_XO), WSP(bf16, WS_WO) + (size_t)l * D * 512, M, D, 512, 0};
          EpiResPart<false> E{WSP(bf16, WS_XB), (bf16*)(ws + WS_XRES + 20000000), WSP(float, WS_A), (unsigned*)(ws + WS_CTL) + 16384 + (l * 2 + 1) * 2048 + 64 * 32 * rep_, WSP(float, WS_U), D, 0}; pg8::StaticOrder S; S.init(M, D, G, vb);
          pg8::gemm_phase<EpiResPart<false>, pg8::StaticOrder, true, true>(ldsl, g, S, E); GRID_BAR(); }
        { PH_VARS pg8::Gemm g{WSP(bf16, WS_XO), WSP(bf16, WS_WO) + (size_t)l * D * 512, M, D, 512, 0};
          EpiResPart<false> E{WSP(bf16, WS_XB), WSP(bf16, WS_XB), ap->out + OUT_PART, (unsigned*)(ws + WS_CTL) + CW_PANEL + (l * 2 + 1) * 2048, WSP(float, WS_RINV), D, 0}; pg8::StaticOrder S; S.init(M, D, G, vb);
          pg8::gemm_phase<EpiResPart<false>, pg8::StaticOrder, true, true>(ldsl, g, S, E); }
        GRID_BAR();
    }
    REP(R_FIN - 1) { PH_VARS ph_final2(WSP(bf16, WS_XB), WSP(float, WS_RINV), ap->in[25], (float*)(ws + WS_P), gt, NGT); GRID_BAR(); }
    { PH_VARS ph_final2(WSP(bf16, WS_XB), WSP(float, WS_RINV), ap->in[25], ap->out, gt, NGT); }
}

extern "C" void kernel_launch(void* const* d_in, const int* in_sizes, int n_in, void* d_out, int out_size, void* d_ws, size_t ws_size, hipStream_t stream) {
    static int grid = 0;
    if (grid == 0) {
        if (ws_size < WS_END || n_in != 26) { fprintf(stderr, "kernel_launch: ws_size %zu < %zu or n_in %d != 26\n", ws_size, (size_t)WS_END, n_in); grid = -1; return; }
        int dev = 0, cus = 0, per_cu = 0;
        if (hipGetDevice(&dev) != hipSuccess || hipDeviceGetAttribute(&cus, hipDeviceAttributeMultiprocessorCount, dev) != hipSuccess) { grid = -1; return; }
        if (hipFuncSetAttribute((const void*)mk_fwd, hipFuncAttributeMaxDynamicSharedMemorySize, LDS_BYTES) != hipSuccess) { fprintf(stderr, "kernel_launch: hipFuncSetAttribute failed\n"); grid = -1; return; }
        if (hipOccupancyMaxActiveBlocksPerMultiprocessor(&per_cu, (const void*)mk_fwd, NTHR, LDS_BYTES) != hipSuccess || per_cu < 1) fprintf(stderr, "kernel_launch: occupancy query reports %d\n", per_cu);
        (void)hipGetLastError();
        grid = cus;
    }
    if (grid < 0) return;
    if (hipMemsetAsync((char*)d_ws + WS_CTL, 0, CTL_ZERO_BYTES, stream) != hipSuccess) { fprintf(stderr, "kernel_launch: memset failed\n"); return; }
    Args a{};
    for (int i = 0; i < 26; ++i) a.in[i] = (const float*)d_in[i];
    a.out = (float*)d_out; a.ws = (unsigned char*)d_ws;
    hipLaunchKernelGGL(mk_fwd, dim3(grid), dim3(NTHR), LDS_BYTES, stream, a);
}
```
